# Optimizing an MI355X kernel written in HIP

```python
import jax, jax.numpy as jnp
from jax import lax
import numpy as np

D_MODEL = 1024
BATCH = 8
SEQ = 4096
DEPTH = 4

CTX_LEN = 256
GRID_W = 64
N_MIXERS = 2
N_ATTN_LAYERS = (DEPTH + 1) // 2
N_GLA_LAYERS = DEPTH // 2
HEAD_DIM = 128
N_HEADS = D_MODEL // HEAD_DIM
N_KV_HEADS = 2
Q_PER_KV = N_HEADS // N_KV_HEADS
Q_BLOCK = 128
ROPE_THETA = 10000.0
ROPE_AXIS_DIM = HEAD_DIM // 2
GLA_HEADS = 4
GLA_DK = D_MODEL // 2 // GLA_HEADS
GLA_DV = D_MODEL // GLA_HEADS
GLA_GATE_RANK = 16
GLA_GATE_TAU = 16.0
GLA_CHUNK = 64
D_FF = 2816
N_MOD = 9
EPS = 1e-6

kernel_name = 'hybrid_gqa_gla_macaron_dit'


def rms_norm(x, g):
    xf = x.astype(jnp.float32)
    y = xf * lax.rsqrt(jnp.mean(xf * xf, axis=-1, keepdims=True) + EPS)
    return (y * g.astype(jnp.float32)).astype(x.dtype)


def modulate(h, g, shift, scale):
    return rms_norm(h, g) * (1 + scale) + shift


def swiglu(u, w_in, w_out):
    gate, up = jnp.split(u @ w_in, 2, axis=-1)
    return (jax.nn.silu(gate) * up) @ w_out


def axial_rope_tables(rows):
    row = jnp.repeat(jnp.arange(rows, dtype=jnp.float32), GRID_W)
    col = jnp.tile(jnp.arange(GRID_W, dtype=jnp.float32), rows)
    inv = ROPE_THETA ** (-jnp.arange(0, ROPE_AXIS_DIM, 2, dtype=jnp.float32) / ROPE_AXIS_DIM)
    ang_r = row[:, None] * inv[None, :]
    ang_c = col[:, None] * inv[None, :]
    return (jnp.cos(ang_r), jnp.sin(ang_r), jnp.cos(ang_c), jnp.sin(ang_c))


def rotate(x, cos, sin):
    x1, x2 = jnp.split(x, 2, axis=-1)
    cos = cos[None, :, None, :]
    sin = sin[None, :, None, :]
    return jnp.concatenate([x1 * cos - x2 * sin, x2 * cos + x1 * sin], axis=-1)


def apply_axial_rope(x, rope):
    cos_r, sin_r, cos_c, sin_c = rope
    xr, xc = jnp.split(x, 2, axis=-1)
    return jnp.concatenate([rotate(xr, cos_r, sin_r), rotate(xc, cos_c, sin_c)], axis=-1).astype(x.dtype)


def attend(q, k, v):
    s = jnp.einsum('bqkgd,bskd->bkgqs', q, k).astype(jnp.float32) * (HEAD_DIM ** -0.5)
    p = jax.nn.softmax(s, axis=-1).astype(v.dtype)
    return jnp.einsum('bkgqs,bskd->bqkgd', p, v)


def gqa_axial_attention(uc, ux, w_qkv, q_gain, k_gain, w_o, rope, want_ctx):
    def project(u):
        b_, t_, _ = u.shape
        q, k, v = jnp.split(u @ w_qkv, [N_HEADS * HEAD_DIM, (N_HEADS + N_KV_HEADS) * HEAD_DIM], axis=-1)
        q = rms_norm(q.reshape(b_, t_, N_HEADS, HEAD_DIM), q_gain)
        k = rms_norm(k.reshape(b_, t_, N_KV_HEADS, HEAD_DIM), k_gain)
        v = v.reshape(b_, t_, N_KV_HEADS, HEAD_DIM)
        return q, k, v

    qc, kc, vc = project(uc)
    qx, kx, vx = project(ux)
    qx = apply_axial_rope(qx, rope)
    kx = apply_axial_rope(kx, rope)
    k_all = jnp.concatenate([kc, kx], axis=1)
    v_all = jnp.concatenate([vc, vx], axis=1)
    b_, s_ = qx.shape[:2]
    n_blk = s_ // Q_BLOCK
    q_blocks = jnp.moveaxis(qx.reshape(b_, n_blk, Q_BLOCK, N_KV_HEADS, Q_PER_KV, HEAD_DIM), 1, 0)
    ox = lax.map(lambda qb: attend(qb, k_all, v_all), q_blocks)
    ox = jnp.moveaxis(ox, 0, 1).reshape(b_, s_, N_HEADS * HEAD_DIM) @ w_o
    oc = None
    if want_ctx:
        l_ = qc.shape[1]
        oc = attend(qc.reshape(b_, l_, N_KV_HEADS, Q_PER_KV, HEAD_DIM), kc, vc)
        oc = oc.reshape(b_, l_, N_HEADS * HEAD_DIM) @ w_o
    return ox, oc


def gla_chunked(q, k, v, log_a, state0):
    b_, t_, h_, _ = q.shape
    dv = v.shape[-1]
    n = t_ // GLA_CHUNK

    def blocks(a):
        return jnp.moveaxis(a.astype(jnp.float32).reshape(b_, n, GLA_CHUNK, h_, a.shape[-1]), 1, 0)

    mask = jnp.tril(jnp.ones((GLA_CHUNK, GLA_CHUNK), dtype=bool))

    def step(state, inp):
        qc, kc, vc, gc = inp
        cum = jnp.cumsum(gc, axis=1)
        last = cum[:, -1]
        q_dec = qc * jnp.exp(cum)
        k_inv = kc * jnp.exp(-cum)
        k_end = kc * jnp.exp(last[:, None] - cum)
        scores = jnp.where(mask, jnp.einsum('bihd,bjhd->bhij', q_dec, k_inv), 0.0)
        o = jnp.einsum('bhij,bjhv->bihv', scores, vc) + jnp.einsum('bihd,bhdv->bihv', q_dec, state)
        state = jnp.exp(last)[..., None] * state + jnp.einsum('bjhd,bjhv->bhdv', k_end, vc)
        return state, o

    state, o = lax.scan(step, state0, (blocks(q), blocks(k), blocks(v), blocks(log_a)))
    o = jnp.moveaxis(o, 0, 1).reshape(b_, t_, h_, dv)
    return o, state


def bidirectional_gla(uc, ux, w_in, wa1, wa2, ba, o_gain, w_o, want_ctx):
    hk = GLA_HEADS * GLA_DK
    hv = GLA_HEADS * GLA_DV

    def project(u):
        b_, t_, _ = u.shape
        q, k, v, r = jnp.split(u @ w_in, [hk, 2 * hk, 2 * hk + hv], axis=-1)
        q = q.reshape(b_, t_, GLA_HEADS, GLA_DK) * (GLA_DK ** -0.5)
        k = k.reshape(b_, t_, GLA_HEADS, GLA_DK)
        v = v.reshape(b_, t_, GLA_HEADS, GLA_DV)
        g_fwd = jax.nn.log_sigmoid(((u @ wa1[0]) @ wa2[0] + ba[0]).astype(jnp.float32)) / GLA_GATE_TAU
        g_bwd = jax.nn.log_sigmoid(((u @ wa1[1]) @ wa2[1] + ba[1]).astype(jnp.float32)) / GLA_GATE_TAU
        return q, k, v, r, g_fwd.reshape(b_, t_, GLA_HEADS, GLA_DK), g_bwd.reshape(b_, t_, GLA_HEADS, GLA_DK)

    def flip(a):
        return jnp.flip(a, axis=1)

    qc, kc, vc, rc, gcf, gcb = project(uc)
    qx, kx, vx, rx, gxf, gxb = project(ux)
    s0 = jnp.zeros((uc.shape[0], GLA_HEADS, GLA_DK, GLA_DV), jnp.float32)
    oc_f, sc_f = gla_chunked(qc, kc, vc, gcf, s0)
    oc_b, sc_b = gla_chunked(flip(qc), flip(kc), flip(vc), flip(gcb), s0)
    ox_f, _ = gla_chunked(qx, kx, vx, gxf, sc_f)
    ox_b, _ = gla_chunked(flip(qx), flip(kx), flip(vx), flip(gxb), sc_b)

    def readout(o, r):
        b_, t_ = o.shape[:2]
        o = rms_norm(o, o_gain.reshape(GLA_HEADS, GLA_DV)).reshape(b_, t_, hv).astype(r.dtype)
        return (o * jax.nn.silu(r)) @ w_o

    ox = readout(ox_f + flip(ox_b), rx)
    oc = readout(oc_f + flip(oc_b), rc) if want_ctx else None
    return ox, oc


def setup_inputs(seed: int = 0) -> dict:
    key = jax.random.key(seed)
    ks = jax.random.split(key, 20)

    def normal(k, shape, scale=1.0):
        return jax.random.normal(k, shape, jnp.float32) * scale

    return {
        'x': normal(ks[0], (BATCH, SEQ, D_MODEL)),
        'c': normal(ks[1], (BATCH, D_MODEL)),
        'ctx': normal(ks[2], (BATCH, CTX_LEN, D_MODEL)),
        'c_ctx': normal(ks[3], (D_MODEL,)),
        'ada_w': normal(ks[4], (DEPTH, D_MODEL, N_MOD * D_MODEL), 0.5 * D_MODEL ** -0.5),
        'ada_b': normal(ks[5], (DEPTH, N_MOD * D_MODEL), 0.02),
        'norm_pre': 1.0 + normal(ks[6], (DEPTH, 3, D_MODEL), 0.02),
        'norm_post': 1.0 + normal(ks[7], (DEPTH, 3, D_MODEL), 0.02),
        'ffn_w_in': normal(ks[8], (DEPTH, 2, D_MODEL, 2 * D_FF), D_MODEL ** -0.5),
        'ffn_w_out': normal(ks[9], (DEPTH, 2, D_FF, D_MODEL), D_FF ** -0.5),
        'attn_w_qkv': normal(ks[10], (N_ATTN_LAYERS, D_MODEL, (N_HEADS + 2 * N_KV_HEADS) * HEAD_DIM), D_MODEL ** -0.5),
        'attn_q_gain': 1.0 + normal(ks[11], (N_ATTN_LAYERS, HEAD_DIM), 0.02),
        'attn_k_gain': 1.0 + normal(ks[12], (N_ATTN_LAYERS, HEAD_DIM), 0.02),
        'attn_w_o': normal(ks[13], (N_ATTN_LAYERS, N_HEADS * HEAD_DIM, D_MODEL), (N_HEADS * HEAD_DIM) ** -0.5),
        'gla_w_in': normal(ks[14], (N_GLA_LAYERS, D_MODEL, 2 * GLA_HEADS * GLA_DK + 2 * GLA_HEADS * GLA_DV), D_MODEL ** -0.5),
        'gla_wa1': normal(ks[15], (N_GLA_LAYERS, 2, D_MODEL, GLA_GATE_RANK), D_MODEL ** -0.5),
        'gla_wa2': normal(ks[16], (N_GLA_LAYERS, 2, GLA_GATE_RANK, GLA_HEADS * GLA_DK), GLA_GATE_RANK ** -0.5),
        'gla_ba': normal(ks[17], (N_GLA_LAYERS, 2, GLA_HEADS * GLA_DK), 0.1),
        'gla_o_gain': 1.0 + normal(ks[18], (N_GLA_LAYERS, GLA_HEADS * GLA_DV), 0.02),
        'gla_w_o': normal(ks[19], (N_GLA_LAYERS, GLA_HEADS * GLA_DV, D_MODEL), (GLA_HEADS * GLA_DV) ** -0.5),
    }


def reference(x, c, ctx, c_ctx, ada_w, ada_b, norm_pre, norm_post, ffn_w_in, ffn_w_out,
              attn_w_qkv, attn_q_gain, attn_k_gain, attn_w_o,
              gla_w_in, gla_wa1, gla_wa2, gla_ba, gla_o_gain, gla_w_o):
    b_, n_tok, _ = x.shape
    ROWS = n_tok // GRID_W
    rope = axial_rope_tables(ROWS)
    silu_c = jax.nn.silu(c)
    silu_cc = jax.nn.silu(c_ctx)
    hx, hc = x, ctx
    for i in range(DEPTH):
        last = i == DEPTH - 1
        mod_x = jnp.moveaxis((silu_c @ ada_w[i] + ada_b[i]).reshape(b_, N_MOD, 1, D_MODEL), 1, 0)
        mod_c = (silu_cc @ ada_w[i] + ada_b[i]).reshape(N_MOD, D_MODEL)
        g_pre, g_post = norm_pre[i], norm_post[i]

        def ffn_half(h, mod, j):
            u = modulate(h, g_pre[j], mod[3 * j], mod[3 * j + 1])
            y = swiglu(u, ffn_w_in[i, j // 2], ffn_w_out[i, j // 2])
            return h + 0.5 * mod[3 * j + 2] * rms_norm(y, g_post[j])

        hx = ffn_half(hx, mod_x, 0)
        hc = ffn_half(hc, mod_c, 0)
        ux = modulate(hx, g_pre[1], mod_x[3], mod_x[4])
        uc = modulate(hc, g_pre[1], mod_c[3], mod_c[4])
        m = i // N_MIXERS
        if i % N_MIXERS == 0:
            ox, oc = gqa_axial_attention(uc, ux, attn_w_qkv[m], attn_q_gain[m], attn_k_gain[m], attn_w_o[m],
                                         rope, not last)
        else:
            ox, oc = bidirectional_gla(uc, ux, gla_w_in[m], gla_wa1[m], gla_wa2[m], gla_ba[m], gla_o_gain[m],
                                       gla_w_o[m], not last)
        hx = hx + mod_x[5] * rms_norm(ox, g_post[1])
        hx = ffn_half(hx, mod_x, 2)
        if not last:
            hc = hc + mod_c[5] * rms_norm(oc, g_post[1])
            hc = ffn_half(hc, mod_c, 2)
    return hx
```

```cpp
#include <hip/hip_runtime.h>
#include <hip/hip_cooperative_groups.h>
#include <hip/hip_bf16.h>
#include <cstdio>
#include <cstdint>
namespace cg = cooperative_groups;
__device__ __forceinline__ int tid_l() { int t = threadIdx.x; asm volatile("" : "+v"(t)); return t; }
__device__ __forceinline__ int blk_l() { int t = blockIdx.x; asm volatile("" : "+s"(t)); return t; }
__device__ __forceinline__ int grd_l() { int t = gridDim.x; asm volatile("" : "+s"(t)); return t; }
namespace pg8 {
#define PG8_LAS __attribute__((address_space(3)))
typedef unsigned short bf16_t;
typedef short bf16x8 __attribute__((ext_vector_type(8)));
typedef float f32x4 __attribute__((ext_vector_type(4)));
typedef unsigned u32x4 __attribute__((ext_vector_type(4)));
constexpr int BM = 256, BK = 64, HALF = 128, HTB = HALF * BK * 2  , STAGE_BYTES = 8 * HTB, NXCD = 8, WGM = 8;

__host__ __device__ __forceinline__ int lds_byte(int r, int c) { const int st = (r >> 4) * 2 + (c >> 5), rr = r & 15, cc = c & 31, ob = rr * 64 + cc * 2; return st * 1024 + (ob ^ (((ob >> 9) & 1) << 5)); }
__host__ __device__ __forceinline__ void stage_rc(int b, int& R, int& C) { const int st = b / 1024, sb = b % 1024, swz = sb ^ (((sb >> 9) & 1) << 5); R = (st >> 1) * 16 + swz / 64; C = (st & 1) * 32 + (swz % 64) / 2; }
__host__ __device__ __forceinline__ int perm32(int rho) { const int n = rho >> 4, i = rho & 15; return 8 * (i >> 2) + 4 * n + (i & 3); }

struct Unit { int pm, pn; };
struct Gemm { const bf16_t* A; const bf16_t* Bt; int M, N, K, lda; };

struct StaticOrder {
    int nM, nN, nwg, G, c;
    __host__ __device__ void init(int M, int N, int G_, int c_) { nM = M / BM; nN = N / BM; nwg = nM * nN; G = G_; c = c_; }
    __host__ __device__ bool next(int i, Unit& u) const {
        const long L = (long)i * G + c; if (L >= nwg) return false;
        int wgid = (int)L; { const int q = nwg / NXCD, r = nwg % NXCD, xcd = wgid % NXCD, off = wgid / NXCD; wgid = (xcd < r ? xcd * (q + 1) : r * (q + 1) + (xcd - r) * q) + off; }
        const int nig = WGM * nN, gid = wgid / nig, fm = gid * WGM, gsz = (nM - fm) < WGM ? (nM - fm) : WGM;
        u.pm = fm + ((wgid % nig) % gsz); u.pn = (wgid % nig) / gsz; return true;
    }
    __device__ __forceinline__ void a_ready(const Unit&) const {}
    __device__ __forceinline__ void done(const Unit&) const {}
};

typedef float f32x2c_t __attribute__((ext_vector_type(2))); typedef __bf16 bf16x2c_t __attribute__((ext_vector_type(2)));
__device__ __forceinline__ unsigned cvt_pk_bf16(float lo, float hi) { f32x2c_t v = {lo, hi}; bf16x2c_t b = __builtin_convertvector(v, bf16x2c_t); return __builtin_bit_cast(unsigned, b); }
typedef float f32x2 __attribute__((ext_vector_type(2)));
struct EpiBf16s {
    static constexpr bool PERM = true, AFTER_DRAIN = false;
    bf16_t* O; int ldc;
    __device__ __forceinline__ void operator()(const f32x4 (&acc)[2][2][4][2], const Unit& u, int wr, int wc, int fr, int fq) const {
        const int row0 = u.pm * BM + wr * 64 + fr; const int col0 = u.pn * BM + wc * 32 + 8 * fq;
#pragma unroll
        for (int ai = 0; ai < 2; ++ai)
#pragma unroll
            for (int m = 0; m < 4; ++m) { bf16_t* rowp = O + (size_t)(row0 + ai * HALF + m * 16) * ldc + col0;
#pragma unroll
                for (int bj = 0; bj < 2; ++bj) { const f32x4 v0 = acc[ai][bj][m][0], v1 = acc[ai][bj][m][1];
                    u32x4 w; w.x = cvt_pk_bf16(v0[0], v0[1]); w.y = cvt_pk_bf16(v0[2], v0[3]); w.z = cvt_pk_bf16(v1[0], v1[1]); w.w = cvt_pk_bf16(v1[2], v1[3]);
                    *(u32x4*)(rowp + bj * HALF) = w; } }
    }
};
__device__ __forceinline__ float silu_f(float g) { return g * __builtin_amdgcn_rcpf(1.0f + __expf(-g)); }
struct EpiSwiglu {
    static constexpr bool PERM = true, AFTER_DRAIN = false;
    bf16_t* H; int ldh;
    __device__ __forceinline__ void operator()(const f32x4 (&acc)[2][2][4][2], const Unit& u, int wr, int wc, int fr, int fq) const {
        const int row0 = u.pm * BM + wr * 64 + fr; const int col0 = u.pn * HALF + wc * 32 + 8 * fq;
#pragma unroll
        for (int ai = 0; ai < 2; ++ai)
#pragma unroll
            for (int m = 0; m < 4; ++m) { bf16_t* rowp = H + (size_t)(row0 + ai * HALF + m * 16) * ldh + col0;
                const f32x4 g0 = acc[ai][0][m][0], g1 = acc[ai][0][m][1], u0 = acc[ai][1][m][0], u1 = acc[ai][1][m][1];
                u32x4 w;
                w.x = cvt_pk_bf16(silu_f(g0[0]) * u0[0], silu_f(g0[1]) * u0[1]); w.y = cvt_pk_bf16(silu_f(g0[2]) * u0[2], silu_f(g0[3]) * u0[3]);
                w.z = cvt_pk_bf16(silu_f(g1[0]) * u1[0], silu_f(g1[1]) * u1[1]); w.w = cvt_pk_bf16(silu_f(g1[2]) * u1[2], silu_f(g1[3]) * u1[3]);
                *(u32x4*)rowp = w; }
    }
};
template <class Epi, class Sched, bool ALIGN_EPI = false, bool SP2 = false>
__device__ __forceinline__ void gemm_phase(PG8_LAS unsigned char* lds, const Gemm g, const Sched& S, const Epi& E) {
    const int tid = tid_l(), wid = __builtin_amdgcn_readfirstlane(tid >> 6), lane = tid & 63, wr = wid >> 2, wc = wid & 3, fr = lane & 15, fq = lane >> 4;
    const int K = g.K, nt = K / BK;
    unsigned voffA[2], voffB[2];
#pragma unroll
    for (int i = 0; i < 2; ++i) { int R, C; stage_rc(tid * 16 + i * 8192, R, C); const int Rb = Epi::PERM ? ((R & ~31) + perm32(R & 31)) : R;
        voffA[i] = (unsigned)(R * g.lda + C) * 2u; voffB[i] = (unsigned)(Rb * K + C) * 2u; }
    const size_t kstep = (size_t)(BK * 2);
    const size_t hstepB = (size_t)HALF * K * 2, hstepA = (size_t)HALF * g.lda * 2;
    const size_t tstepA = 2 * hstepA, tstepB = 2 * hstepB;
    const unsigned ldsw = (unsigned)wid * 1024u;
    const int aoff = lds_byte(wr * 64 + fr, fq * 8), boff = lds_byte(wc * 32 + fr, fq * 8);
#define PG8_SA(b, h) (((b) * 2 + (h)) * HTB)
#define PG8_SB(b, h) ((4 + (b) * 2 + (h)) * HTB)
#define PG8_STAGE(bufoff, gbase, voff) do { _Pragma("unroll") for (int _i = 0; _i < 2; ++_i) \
        __builtin_amdgcn_global_load_lds((const unsigned*)((const char*)(gbase) + (voff)[_i]), (PG8_LAS unsigned*)(lds + (bufoff) + ldsw + _i * 8192), 16, 0, 0); } while (0)
#define PG8_LDA(dst, b, h) do { _Pragma("unroll") for (int m = 0; m < 4; ++m) _Pragma("unroll") for (int k = 0; k < 2; ++k) dst[m][k] = *(const PG8_LAS bf16x8*)(lds + PG8_SA(b, h) + aoff + m * 2048 + k * 1024); } while (0)
#define PG8_LDB(dst, b, h) do { _Pragma("unroll") for (int n = 0; n < 2; ++n) _Pragma("unroll") for (int k = 0; k < 2; ++k) dst[n][k] = *(const PG8_LAS bf16x8*)(lds + PG8_SB(b, h) + boff + n * 2048 + k * 1024); } while (0)
#define PG8_MMA(ai, bj, At, Bt) do { __builtin_amdgcn_s_setprio(1); _Pragma("unroll") for (int m = 0; m < 4; ++m) _Pragma("unroll") for (int n = 0; n < 2; ++n) _Pragma("unroll") for (int k = 0; k < 2; ++k) \
        acc[ai][bj][m][n] = __builtin_amdgcn_mfma_f32_16x16x32_bf16(Bt[n][k], At[m][k], acc[ai][bj][m][n], 0, 0, 0); __builtin_amdgcn_s_setprio(0); } while (0)
#define PG8_WAIT_V(n) asm volatile("s_waitcnt vmcnt(" #n ")" ::: "memory")
#define PG8_WAIT_L(n) asm volatile("s_waitcnt lgkmcnt(" #n ")" ::: "memory")
#define PG8_BAR __builtin_amdgcn_s_barrier()
#define PG8_SCHED __builtin_amdgcn_sched_barrier(0)
    Unit cur, nxt; int ui = 0;
    if (!S.next(0, cur)) return;
    f32x4 acc[2][2][4][2];
#pragma unroll
    for (int a = 0; a < 2; ++a)
#pragma unroll
        for (int b = 0; b < 2; ++b)
#pragma unroll
            for (int m = 0; m < 4; ++m)
#pragma unroll
                for (int n = 0; n < 2; ++n) acc[a][b][m][n] = (f32x4){0.f, 0.f, 0.f, 0.f};
    bf16x8 At[4][2], B0[2][2], B1[2][2];
    const char* cA = (const char*)g.A + (size_t)cur.pm * tstepA; const char* cB = (const char*)g.Bt + (size_t)cur.pn * tstepB;
    S.a_ready(cur);
    if constexpr (SP2) {
        PG8_STAGE(PG8_SB(0, 0), cB, voffB); PG8_STAGE(PG8_SB(0, 1), cB + hstepB, voffB); PG8_STAGE(PG8_SA(0, 0), cA, voffA); PG8_STAGE(PG8_SA(0, 1), cA + hstepA, voffA);
        if (wr == 1) PG8_BAR;
        PG8_WAIT_V(2); PG8_BAR;
        PG8_STAGE(PG8_SB(1, 0), cB + kstep, voffB); PG8_STAGE(PG8_SA(1, 0), cA + kstep, voffA); PG8_STAGE(PG8_SB(1, 1), cB + hstepB + kstep, voffB);
        PG8_WAIT_V(6); PG8_BAR;
    } else {
        PG8_STAGE(PG8_SB(0, 0), cB, voffB); PG8_STAGE(PG8_SA(0, 0), cA, voffA); PG8_STAGE(PG8_SB(0, 1), cB + hstepB, voffB); PG8_STAGE(PG8_SA(0, 1), cA + hstepA, voffA);
        if (wr == 1) PG8_BAR;
        PG8_WAIT_V(4); PG8_BAR;
        PG8_STAGE(PG8_SB(1, 0), cB + kstep, voffB); PG8_STAGE(PG8_SA(1, 0), cA + kstep, voffA); PG8_STAGE(PG8_SB(1, 1), cB + hstepB + kstep, voffB);
        PG8_WAIT_V(6); PG8_BAR;
    }
    for (;;) {
        const bool has_next = S.next(ui + 1, nxt);
        const char* nA = has_next ? (const char*)g.A + (size_t)nxt.pm * tstepA : cA; const char* nB = has_next ? (const char*)g.Bt + (size_t)nxt.pn * tstepB : cB;
        for (int t = 0; t < nt; t += 2) {
            const bool last = (t == nt - 2);
            const char* a1 = cA + (size_t)(t + 1) * kstep;
            const char* a2 = last ? nA : cA + (size_t)(t + 2) * kstep; const char* b2 = last ? nB : cB + (size_t)(t + 2) * kstep;
            const char* a3 = a2 + kstep; const char* b3 = b2 + kstep;
            if (last && has_next) S.a_ready(nxt);
            if constexpr (SP2) {
            PG8_LDB(B0, 0, 0); PG8_LDB(B1, 0, 1); PG8_SCHED; PG8_LDA(At, 0, 0); PG8_STAGE(PG8_SA(1, 1), a1 + hstepA, voffA);
            PG8_WAIT_V(8); PG8_WAIT_L(0); PG8_BAR; PG8_MMA(0, 0, At, B0); PG8_MMA(0, 1, At, B1); PG8_BAR; PG8_SCHED;
            PG8_LDA(At, 0, 1); PG8_STAGE(PG8_SB(0, 0), b2, voffB); PG8_STAGE(PG8_SB(0, 1), b2 + hstepB, voffB); PG8_STAGE(PG8_SA(0, 0), a2, voffA);
            PG8_WAIT_V(8); PG8_WAIT_L(0); PG8_BAR; PG8_MMA(1, 0, At, B0); PG8_MMA(1, 1, At, B1); PG8_BAR; PG8_SCHED;
            PG8_LDB(B0, 1, 0); PG8_LDB(B1, 1, 1); PG8_SCHED; PG8_LDA(At, 1, 0); PG8_STAGE(PG8_SA(0, 1), a2 + hstepA, voffA);
            PG8_WAIT_V(8); PG8_WAIT_L(0); PG8_BAR; PG8_MMA(0, 0, At, B0); PG8_MMA(0, 1, At, B1); PG8_BAR; PG8_SCHED;
            PG8_LDA(At, 1, 1); PG8_STAGE(PG8_SB(1, 0), b3, voffB); PG8_STAGE(PG8_SB(1, 1), b3 + hstepB, voffB); PG8_STAGE(PG8_SA(1, 0), a3, voffA);
            PG8_WAIT_V(8); PG8_WAIT_L(0); PG8_BAR; PG8_MMA(1, 0, At, B0); PG8_MMA(1, 1, At, B1); PG8_BAR; PG8_SCHED;
            } else {
            PG8_LDB(B0, 0, 0); PG8_SCHED; PG8_LDA(At, 0, 0); PG8_STAGE(PG8_SA(1, 1), a1 + hstepA, voffA);
            PG8_WAIT_L(8); PG8_BAR; PG8_WAIT_L(0); PG8_MMA(0, 0, At, B0); PG8_BAR; PG8_SCHED;
            PG8_LDB(B1, 0, 1); PG8_STAGE(PG8_SB(0, 0), b2, voffB);
            PG8_BAR; PG8_WAIT_L(0); PG8_MMA(0, 1, At, B1); PG8_BAR;
            PG8_LDA(At, 0, 1); PG8_STAGE(PG8_SA(0, 0), a2, voffA);
            PG8_BAR; PG8_WAIT_L(0); PG8_MMA(1, 0, At, B0); PG8_BAR; PG8_SCHED;
            PG8_STAGE(PG8_SB(0, 1), b2 + hstepB, voffB);
            PG8_WAIT_V(6); PG8_BAR; PG8_MMA(1, 1, At, B1); PG8_BAR;
            PG8_LDB(B0, 1, 0); PG8_SCHED; PG8_LDA(At, 1, 0); PG8_STAGE(PG8_SA(0, 1), a2 + hstepA, voffA);
            PG8_WAIT_L(8); PG8_BAR; PG8_WAIT_L(0); PG8_MMA(0, 0, At, B0); PG8_BAR; PG8_SCHED;
            PG8_LDB(B1, 1, 1); PG8_STAGE(PG8_SB(1, 0), b3, voffB);
            PG8_BAR; PG8_WAIT_L(0); PG8_MMA(0, 1, At, B1); PG8_BAR;
            PG8_LDA(At, 1, 1); PG8_STAGE(PG8_SA(1, 0), a3, voffA);
            PG8_BAR; PG8_WAIT_L(0); PG8_MMA(1, 0, At, B0); PG8_BAR; PG8_SCHED;
            PG8_STAGE(PG8_SB(1, 1), b3 + hstepB, voffB);
            PG8_WAIT_V(6); PG8_BAR; PG8_MMA(1, 1, At, B1); PG8_BAR;
            }
        }
        if constexpr (ALIGN_EPI) { if (wr == 0) PG8_BAR; }
        if constexpr (!Epi::AFTER_DRAIN) { E(acc, cur, wr, wc, fr, fq); S.done(cur); }
        if (!has_next) break;
#pragma unroll
        for (int a = 0; a < 2; ++a)
#pragma unroll
            for (int b = 0; b < 2; ++b)
#pragma unroll
                for (int m = 0; m < 4; ++m)
#pragma unroll
                    for (int n = 0; n < 2; ++n) acc[a][b][m][n] = (f32x4){0.f, 0.f, 0.f, 0.f};
        cur = nxt; cA = nA; cB = nB; ++ui;
        if constexpr (ALIGN_EPI) { if (wr == 1) PG8_BAR; }
    }
    PG8_WAIT_V(0);
    if constexpr (!ALIGN_EPI) { if (wr == 0) PG8_BAR; }
    PG8_BAR;
    if constexpr (Epi::AFTER_DRAIN) { E.fused(acc, cur, wr, wc, fr, fq, lds, wid, lane); S.done(cur); }
#undef PG8_SA
#undef PG8_SB
#undef PG8_STAGE
#undef PG8_LDA
#undef PG8_LDB
#undef PG8_MMA
#undef PG8_WAIT_V
#undef PG8_WAIT_L
#undef PG8_BAR
#undef PG8_SCHED
}
}
namespace att {
using bf16 = __hip_bfloat16;
constexpr int   D = 128, NW = 8, QBLK = 32, KVBLK = 64;
constexpr float SCALE = 0.088388347648318440f;
constexpr float THR = 8.f;
constexpr int SDEPTH = 2;
constexpr int LDQ = 1536, LDK = 1536, LDO = 1024;
constexpr size_t SHM_V = KVBLK * D * 2, SHM_K = KVBLK * D * 2, SHM_ATTN = 2 * SHM_V + 2 * SHM_K + NW * 64 * 4;
using bf16x8 = __attribute__((ext_vector_type(8))) short;
using s16x4  = __attribute__((ext_vector_type(4))) short;
using f32x16 = __attribute__((ext_vector_type(16))) float;
using f32x8  = __attribute__((ext_vector_type(8))) float;
using u32x4  = __attribute__((ext_vector_type(4))) unsigned;
#define KSWZ(row, colB) ((row) * 256 + ((colB) ^ (((row) & 7) << 4)))
#define SBAR() __builtin_amdgcn_sched_barrier(0)
__device__ __forceinline__ int crow(int r, int hi) { return (r & 3) + 8 * (r >> 2) + 4 * hi; }
__device__ __forceinline__ unsigned cvtpk(float lo, float hi) {
  unsigned r; asm volatile("v_cvt_pk_bf16_f32 %0, %1, %2" : "=v"(r) : "v"(lo), "v"(hi)); return r;
}
template <typename TIn> struct Stage;
template <> struct Stage<bf16>  { using T = bf16x8;
  __device__ static __forceinline__ T ld8(const bf16* p) { return *reinterpret_cast<const bf16x8*>(p); }
  __device__ static __forceinline__ bf16x8 tobf(T x) { return x; } };
template <> struct Stage<float> { using T = f32x8;
  __device__ static __forceinline__ T ld8(const float* p) { return *reinterpret_cast<const f32x8*>(p); }
  __device__ static __forceinline__ bf16x8 tobf(T x) {
    u32x4 w = {cvtpk(x[0], x[1]), cvtpk(x[2], x[3]), cvtpk(x[4], x[5]), cvtpk(x[6], x[7])}; return *reinterpret_cast<bf16x8*>(&w); } };

__device__ __forceinline__ void partialSM(f32x16& p0, f32x16& p1, float& m_reg, float& mn, float& alpha) {
  constexpr float C = SCALE * 1.4426950408889634f;
  float pmax = p0[0]; for (int r = 1; r < 16; ++r) pmax = fmaxf(pmax, p0[r]); for (int r = 0; r < 16; ++r) pmax = fmaxf(pmax, p1[r]);
  { auto rr = __builtin_amdgcn_permlane32_swap(__float_as_uint(pmax), __float_as_uint(pmax), false, false);
    pmax = fmaxf(__uint_as_float(rr[0]), __uint_as_float(rr[1])); }
  if (__builtin_expect(__all(pmax - m_reg <= THR / SCALE), 1)) { mn = m_reg; alpha = 1.f; }
  else { mn = fmaxf(m_reg, pmax); alpha = __builtin_amdgcn_exp2f((m_reg - mn) * C); m_reg = mn; }
  float mnC = -mn * C;
  for (int r = 0; r < 16; ++r) p0[r] = fmaf(p0[r], C, mnC); for (int r = 0; r < 16; ++r) p1[r] = fmaf(p1[r], C, mnC);
  for (int r = 0; r < 16; ++r) p0[r] = __builtin_amdgcn_exp2f(p0[r]);
}
__device__ __forceinline__ void finishSM(f32x16& p0, f32x16& p1, float alpha, float& l_reg, bf16x8& pa0, bf16x8& pa1, bf16x8& pa2, bf16x8& pa3) {
  for (int r = 0; r < 16; ++r) p1[r] = __builtin_amdgcn_exp2f(p1[r]);
  float ps = 0; for (int r = 0; r < 16; ++r) ps += p0[r]; for (int r = 0; r < 16; ++r) ps += p1[r];
  { auto rr = __builtin_amdgcn_permlane32_swap(__float_as_uint(ps), __float_as_uint(ps), false, false);
    ps = __uint_as_float(rr[0]) + __uint_as_float(rr[1]); }
  l_reg = l_reg * alpha + ps;
#define PK4(P, BASE, OUT) do { unsigned a0 = cvtpk(P[BASE + 0], P[BASE + 1]), a1 = cvtpk(P[BASE + 2], P[BASE + 3]);   \
    unsigned b0 = cvtpk(P[BASE + 4], P[BASE + 5]), b1 = cvtpk(P[BASE + 6], P[BASE + 7]);                              \
    auto r0 = __builtin_amdgcn_permlane32_swap(a0, b0, false, false); auto r1 = __builtin_amdgcn_permlane32_swap(a1, b1, false, false); \
    u32x4 w = {r0[0], r1[0], r0[1], r1[1]}; OUT = *reinterpret_cast<bf16x8*>(&w); } while (0)
  PK4(p0, 0, pa0); PK4(p0, 8, pa1); PK4(p1, 0, pa2); PK4(p1, 8, pa3);
#undef PK4
}
__device__ __forceinline__ void qkt(f32x16& p0, f32x16& p1, const bf16* Ks, const bf16x8* qr, int r32, int hi) {
  p0 = f32x16{}; p1 = f32x16{};
  for (int d0 = 0; d0 < 8; ++d0) { int cb = (d0 * 16 + hi * 8) * 2;
    bf16x8 b0 = *reinterpret_cast<const bf16x8*>((const char*)Ks + KSWZ(r32, cb));
    bf16x8 b1 = *reinterpret_cast<const bf16x8*>((const char*)Ks + KSWZ(32 + r32, cb));
    p0 = __builtin_amdgcn_mfma_f32_32x32x16_bf16(b0, qr[d0], p0, 0, 0, 0);
    p1 = __builtin_amdgcn_mfma_f32_32x32x16_bf16(b1, qr[d0], p1, 0, 0, 0); }
}
__device__ __forceinline__ int v_st(int k, int c) { const int kk = (k & ~0xC) | ((k & 4) << 1) | ((k & 8) >> 1); return ((kk >> 3) * 4 + (c >> 5)) * 512 + ((kk & 7) * 32 + (c & 31)) * 2; }
__device__ __forceinline__ int v_rd_base(int lane) { return ((lane & 3) << 3) | (((lane >> 2) & 3) << 6) | (((lane >> 4) & 1) << 5) | (((lane >> 5) & 1) << 8); }
constexpr int v_rd_off(int d0, int ks, int half) { return d0 * 512 + ks * 4096 + half * 2048; }
template <int OFF> __device__ __forceinline__ s16x4 tr_read(int vb) {
  s16x4 r; asm volatile("ds_read_b64_tr_b16 %0, %1 offset:%2" : "=&v"(r) : "v"(vb), "i"(OFF) : "memory"); return r;
}
template <int D0> __device__ __forceinline__ void pv_one(f32x16& od, int vb, bf16x8 pa0, bf16x8 pa1, bf16x8 pa2, bf16x8 pa3) {
  const s16x4 l0 = tr_read<v_rd_off(D0, 0, 0)>(vb), h0 = tr_read<v_rd_off(D0, 0, 1)>(vb), l1 = tr_read<v_rd_off(D0, 1, 0)>(vb), h1 = tr_read<v_rd_off(D0, 1, 1)>(vb);
  const s16x4 l2 = tr_read<v_rd_off(D0, 2, 0)>(vb), h2 = tr_read<v_rd_off(D0, 2, 1)>(vb), l3 = tr_read<v_rd_off(D0, 3, 0)>(vb), h3 = tr_read<v_rd_off(D0, 3, 1)>(vb);
  asm volatile("s_waitcnt lgkmcnt(0)" ::: "memory"); SBAR();
#define PK(L, H) (bf16x8){L[0], L[1], L[2], L[3], H[0], H[1], H[2], H[3]}
  od = __builtin_amdgcn_mfma_f32_32x32x16_bf16(pa0, PK(l0, h0), od, 0, 0, 0);
  od = __builtin_amdgcn_mfma_f32_32x32x16_bf16(pa1, PK(l1, h1), od, 0, 0, 0);
  od = __builtin_amdgcn_mfma_f32_32x32x16_bf16(pa2, PK(l2, h2), od, 0, 0, 0);
  od = __builtin_amdgcn_mfma_f32_32x32x16_bf16(pa3, PK(l3, h3), od, 0, 0, 0);
#undef PK
}
__device__ __forceinline__ void pv_d0(f32x16* o, int vb, bf16x8 pa0, bf16x8 pa1, bf16x8 pa2, bf16x8 pa3) {
  pv_one<0>(o[0], vb, pa0, pa1, pa2, pa3); pv_one<1>(o[1], vb, pa0, pa1, pa2, pa3); pv_one<2>(o[2], vb, pa0, pa1, pa2, pa3); pv_one<3>(o[3], vb, pa0, pa1, pa2, pa3);
}

template <typename TQ>
__device__ __forceinline__ void attn_dense_body(const TQ* __restrict__ Qb, const bf16* __restrict__ Kh, const bf16* __restrict__ Vh,
                                                bf16* __restrict__ Ob, int seq, char* lds) {
  using St = Stage<bf16>; using SQ = Stage<TQ>;
  const int tid = tid_l(), wid = tid >> 6, lane = tid & 63, r32 = lane & 31, hi = lane >> 5;
  bf16* V_lds = (bf16*)lds; bf16* K_lds = (bf16*)(lds + 2 * SHM_V);
  float* ws = (float*)(lds + 2 * SHM_V + 2 * SHM_K) + wid * 64; float* li_l = ws; float* al_l = ws + 32;
  float m_reg = -1e30f, l_reg = 0; f32x16 o[4] = {}; bf16x8 qr[8];
  const TQ* Qw = Qb + (long)(wid * QBLK + r32) * LDQ + hi * 8;
#pragma unroll
  for (int d0 = 0; d0 < 8; ++d0) qr[d0] = SQ::tobf(SQ::ld8(Qw + d0 * 16));
  const int sr = tid >> 4, sc = (tid & 15) * 8, vst0 = v_st(sr, sc), vst1 = v_st(32 + sr, sc);
  const int vb0 = (int)(uintptr_t)V_lds + v_rd_base(lane);
  struct { typename St::T vs0, vs1, ks0, ks1; } sr_[SDEPTH];
#define SLOAD(i, k0) do { sr_[i].vs0 = St::ld8(&Vh[(long)((k0) + sr) * LDK + sc]); sr_[i].vs1 = St::ld8(&Vh[(long)((k0) + 32 + sr) * LDK + sc]); \
    sr_[i].ks0 = St::ld8(&Kh[(long)((k0) + sr) * LDK + sc]); sr_[i].ks1 = St::ld8(&Kh[(long)((k0) + 32 + sr) * LDK + sc]); } while (0)
#define SWRITE(b, i) do { *(bf16x8*)((char*)V_lds + (b) * SHM_V + vst0) = St::tobf(sr_[i].vs0);          \
    *(bf16x8*)((char*)V_lds + (b) * SHM_V + vst1) = St::tobf(sr_[i].vs1); int kc = sc * 2;               \
    *(bf16x8*)((char*)K_lds + (b) * SHM_K + KSWZ(sr, kc)) = St::tobf(sr_[i].ks0);                       \
    *(bf16x8*)((char*)K_lds + (b) * SHM_K + KSWZ(32 + sr, kc)) = St::tobf(sr_[i].ks1); } while (0)
#define SWAIT() do { if constexpr (SDEPTH == 2) asm volatile("s_waitcnt vmcnt(4)" ::: "memory"); else asm volatile("s_waitcnt vmcnt(0)" ::: "memory"); } while (0)
#define RESC(a) do { if (__any((a) < 1.f)) { if (hi == 0) al_l[r32] = (a); asm volatile("s_waitcnt lgkmcnt(0)" ::: "memory"); \
    for (int d = 0; d < 4; ++d) for (int r = 0; r < 16; ++r) o[d][r] *= al_l[crow(r, hi)]; } } while (0)
  f32x16 pA0, pA1, pB0, pB1; float mnA, mnB, alA, alB; bf16x8 pa0, pa1, pa2, pa3; const int NT = seq / KVBLK;
  constexpr int SE = 0, SO = SDEPTH - 1;
  SLOAD(SE, 0); asm volatile("s_waitcnt vmcnt(0)" ::: "memory"); SWRITE(0, SE); __syncthreads();
  qkt(pA0, pA1, K_lds, qr, r32, hi); partialSM(pA0, pA1, m_reg, mnA, alA);
  SLOAD(SO, KVBLK); if constexpr (SDEPTH == 2) { if (2 < NT) SLOAD(SE, 2 * KVBLK); }
  SWAIT(); SWRITE(1, SO); __syncthreads();
  for (int j = 1; j + 1 < NT; j += 2) {
    SBAR(); qkt(pB0, pB1, (bf16*)((char*)K_lds + SHM_K), qr, r32, hi);
    finishSM(pA0, pA1, alA, l_reg, pa0, pa1, pa2, pa3); SBAR();
    SLOAD(SO, (j + SDEPTH) * KVBLK); SBAR();
    pv_d0(o, vb0, pa0, pa1, pa2, pa3); partialSM(pB0, pB1, m_reg, mnB, alB);
    __syncthreads(); SWAIT(); SWRITE(0, SE);
    RESC(alB); __syncthreads();
    SBAR(); qkt(pA0, pA1, K_lds, qr, r32, hi);
    finishSM(pB0, pB1, alB, l_reg, pa0, pa1, pa2, pa3); SBAR();
    if (SDEPTH == 1 || j + 3 < NT) SLOAD(SE, (j + 1 + SDEPTH) * KVBLK); SBAR();
    pv_d0(o, vb0 + (int)SHM_V, pa0, pa1, pa2, pa3); partialSM(pA0, pA1, m_reg, mnA, alA);
    __syncthreads(); SWAIT(); SWRITE(1, SO);
    RESC(alA); __syncthreads();
  }
  SBAR(); qkt(pB0, pB1, (bf16*)((char*)K_lds + SHM_K), qr, r32, hi);
  finishSM(pA0, pA1, alA, l_reg, pa0, pa1, pa2, pa3); SBAR();
  pv_d0(o, vb0, pa0, pa1, pa2, pa3); partialSM(pB0, pB1, m_reg, mnB, alB);
  __syncthreads(); RESC(alB);
  finishSM(pB0, pB1, alB, l_reg, pa0, pa1, pa2, pa3); SBAR();
  pv_d0(o, vb0 + (int)SHM_V, pa0, pa1, pa2, pa3);
  if (hi == 0) li_l[r32] = l_reg; asm volatile("s_waitcnt lgkmcnt(0)" ::: "memory");
  float rli[16];
#pragma unroll
  for (int r = 0; r < 16; ++r) rli[r] = __builtin_amdgcn_rcpf(li_l[crow(r, hi)]);
  bf16* Ow = Ob + (long)(wid * QBLK) * LDO;
#pragma unroll
  for (int r = 0; r < 16; ++r) { int orow = crow(r, hi);
    for (int d0 = 0; d0 < 4; ++d0) Ow[(long)orow * LDO + d0 * 32 + r32] = __float2bfloat16(o[d0][r] * rli[r]); }
#undef SLOAD
#undef SWRITE
#undef SWAIT
#undef RESC
}
}
#define LAS __attribute__((address_space(3)))
typedef unsigned short bf16_t;
typedef short bf16x8 __attribute__((ext_vector_type(8)));
typedef float f32x4 __attribute__((ext_vector_type(4)));
typedef float f32x16 __attribute__((ext_vector_type(16)));
typedef unsigned u32x4 __attribute__((ext_vector_type(4)));
typedef unsigned u32x2 __attribute__((ext_vector_type(2)));

constexpr int DM = 1024, NB = 8, SEQ = 4096, CTXL = 256, TPB = SEQ + CTXL, MT = NB * TPB, DFF = 2816, DEPTH = 4;
constexpr int NQKV = 1536, NGIN = 3328;
constexpr float EPS = 1e-6f;
constexpr int LDS_BYTES = 147456;
constexpr int NTHREADS = 512;

constexpr size_t MiB = 1u << 20;
constexpr size_t WS_MOD = 1 * MiB;
constexpr size_t WS_W1T = 3 * MiB;
constexpr size_t WS_W2T = WS_W1T + 88 * MiB;
constexpr size_t WS_WQKVT = WS_W2T + 44 * MiB;
constexpr size_t WS_WOAT = WS_WQKVT + 6 * MiB;
constexpr size_t WS_WGINT = WS_WOAT + 4 * MiB;
constexpr size_t WS_WGOT = WS_WGINT + 13 * MiB;
constexpr size_t WS_HRES = WS_WGOT + 4 * MiB;
constexpr size_t WS_U = WS_HRES + 136 * MiB;
constexpr size_t WS_Y = WS_U + 68 * MiB;
constexpr size_t WS_BIG = WS_Y + 68 * MiB;
constexpr size_t WS_ATTNO = WS_BIG + 102 * MiB;
constexpr size_t WS_END = WS_BIG + 221 * MiB;
static_assert((size_t)MT * NGIN * 2 <= 221 * MiB && (size_t)MT * DFF * 2 <= 221 * MiB && (size_t)MT * NQKV * 2 <= 102 * MiB, "ws map");

struct Args { const float* in[20]; float* out; unsigned char* ws; };
typedef const __attribute__((address_space(4))) Args* KA;
__device__ __forceinline__ KA kargs() { KA p = (KA)__builtin_amdgcn_kernarg_segment_ptr(); asm volatile("" : "+s"(p)); return p; }
enum { I_X = 0, I_C, I_CTX, I_CCTX, I_ADAW, I_ADAB, I_NPRE, I_NPOST, I_FW1, I_FW2, I_AQKV, I_AQG, I_AKG, I_AWO, I_GWIN, I_GWA1, I_GWA2, I_GBA, I_GOG, I_GWO };

__device__ __forceinline__ unsigned cvtpk(float lo, float hi) { return pg8::cvt_pk_bf16(lo, hi); }
__device__ __forceinline__ float bf_lo(unsigned w) { return __uint_as_float(w << 16); }
__device__ __forceinline__ float bf_hi(unsigned w) { return __uint_as_float(w & 0xffff0000u); }
__device__ __forceinline__ float bf_f(bf16_t h) { return __uint_as_float(((unsigned)h) << 16); }
__device__ __forceinline__ bf16_t f_bf(float f) { return (bf16_t)(cvtpk(f, 0.f) & 0xffffu); }
__device__ __forceinline__ float wave_sum(float v) {
#pragma unroll
    for (int o = 1; o < 64; o <<= 1) v += __shfl_xor(v, o);
    return v;
}
__device__ __forceinline__ float silu(float x) { return x / (1.0f + __expf(-x)); }

__device__ __forceinline__ void phase_mod(KA a, LAS unsigned char* lds) {
    LAS float* sv = (LAS float*)lds;
    LAS float* red = (LAS float*)(lds + 9 * 1024 * 4);
    const int tid = tid_l(), lane = tid & 63, wave = tid >> 6;
    const float* c = a->in[I_C]; const float* cc = a->in[I_CCTX];
    for (int i = tid; i < 9 * 1024; i += NTHREADS) { const int v = i >> 10, k = i & 1023; const float x = v < 8 ? c[v * 1024 + k] : cc[k]; sv[i] = silu(x); }
    __syncthreads();
    float* mod = (float*)(a->ws + WS_MOD);
    for (int it = blk_l(); it < DEPTH * 144; it += grd_l()) {
        const int L = it / 144, cgp = it % 144;
        const float* w = a->in[I_ADAW] + (size_t)L * 1024 * 9216 + cgp * 64 + lane;
        float acc[9];
#pragma unroll
        for (int v = 0; v < 9; ++v) acc[v] = 0.f;
        const int k0 = wave * 128;
#pragma unroll 8
        for (int k = 0; k < 128; ++k) { const float wv = w[(size_t)(k0 + k) * 9216];
#pragma unroll
            for (int v = 0; v < 9; ++v) acc[v] += sv[v * 1024 + k0 + k] * wv; }
#pragma unroll
        for (int v = 0; v < 9; ++v) red[(wave * 9 + v) * 64 + lane] = acc[v];
        __syncthreads();
        for (int i = tid; i < 576; i += NTHREADS) { const int v = i >> 6, l = i & 63; float s = 0.f;
#pragma unroll
            for (int w8 = 0; w8 < 8; ++w8) s += red[(w8 * 9 + v) * 64 + l];
            s += a->in[I_ADAB][L * 9216 + cgp * 64 + l];
            mod[(size_t)(L * 9 + v) * 9216 + cgp * 64 + l] = s; }
        __syncthreads();
    }
}

__device__ __forceinline__ unsigned pk2(float lo, float hi) { return cvtpk(lo, hi); }
__device__ __forceinline__ void tr_item(const float* W, int Nsrc, int srccol0, int k0, bf16_t* dst  , int K, LAS float* scr, int lane) {
#pragma unroll 8
    for (int i = 0; i < 32; ++i) { const int kk = 2 * i + (lane >> 5); scr[kk * 33 + (lane & 31)] = W[(size_t)(k0 + kk) * Nsrc + srccol0 + (lane & 31)]; }
    asm volatile("s_waitcnt lgkmcnt(0)" ::: "memory");
    const int c = lane & 7;
#pragma unroll
    for (int j = 0; j < 4; ++j) { const int n = (lane >> 3) + 8 * j; const LAS float* s = scr + (8 * c) * 33 + n;
        u32x4 o; o.x = pk2(s[0 * 33], s[1 * 33]); o.y = pk2(s[2 * 33], s[3 * 33]); o.z = pk2(s[4 * 33], s[5 * 33]); o.w = pk2(s[6 * 33], s[7 * 33]);
        *(u32x4*)(dst + (size_t)n * K + 8 * c) = o; }
    asm volatile("s_waitcnt lgkmcnt(0)" ::: "memory");
}
__device__ __forceinline__ void phase_weights(KA a, LAS unsigned char* lds) {
    const int tid = tid_l(), lane = tid & 63, wave = tid >> 6;
    LAS float* scr = (LAS float*)(lds + 65536 + wave * 8704);
    const int gw = blk_l() * 8 + wave, NGW = grd_l() * 8;
    constexpr int I_W1 = 176 * 16, I_W2 = 32 * 44, I_QKV = 48 * 16, I_SQ = 32 * 16, I_GIN = 96 * 16;
    constexpr int N1 = 8 * I_W1, N2 = 8 * I_W2, N3 = 2 * I_QKV, N4 = 2 * I_SQ, N5 = 2 * I_GIN, N6 = 2 * I_SQ;
    constexpr int NITEMS = N1 + N2 + N3 + N4 + N5 + N6;
    for (int it = gw; it < NITEMS; it += NGW) {
        int r = it;
        if (r < N1) { const int mat = r / I_W1, q = r % I_W1, ng = q / 16, kb = q % 16; const int pn = ng >> 3, r0 = (ng & 7) * 32;
            const int src = r0 < 128 ? 128 * pn + r0 : DFF + 128 * pn + (r0 - 128);
            tr_item(a->in[I_FW1] + (size_t)mat * 1024 * 5632, 5632, src, kb * 64, (bf16_t*)(a->ws + WS_W1T) + (size_t)mat * 5632 * 1024 + (size_t)(ng * 32) * 1024 + kb * 64, 1024, scr, lane); continue; }
        r -= N1;
        if (r < N2) { const int mat = r / I_W2, q = r % I_W2, ng = q / 44, kb = q % 44;
            tr_item(a->in[I_FW2] + (size_t)mat * 2816 * 1024, 1024, ng * 32, kb * 64, (bf16_t*)(a->ws + WS_W2T) + (size_t)mat * 1024 * 2816 + (size_t)(ng * 32) * 2816 + kb * 64, 2816, scr, lane); continue; }
        r -= N2;
        if (r < N3) { const int mat = r / I_QKV, q = r % I_QKV, ng = q / 16, kb = q % 16;
            tr_item(a->in[I_AQKV] + (size_t)mat * 1024 * 1536, 1536, ng * 32, kb * 64, (bf16_t*)(a->ws + WS_WQKVT) + (size_t)mat * 1536 * 1024 + (size_t)(ng * 32) * 1024 + kb * 64, 1024, scr, lane); continue; }
        r -= N3;
        if (r < N4) { const int mat = r / I_SQ, q = r % I_SQ, ng = q / 16, kb = q % 16;
            tr_item(a->in[I_AWO] + (size_t)mat * 1024 * 1024, 1024, ng * 32, kb * 64, (bf16_t*)(a->ws + WS_WOAT) + (size_t)mat * 1024 * 1024 + (size_t)(ng * 32) * 1024 + kb * 64, 1024, scr, lane); continue; }
        r -= N4;
        if (r < N5) { const int mat = r / I_GIN, q = r % I_GIN, ng = q / 16, kb = q % 16;
            tr_item(a->in[I_GWIN] + (size_t)mat * 1024 * 3072, 3072, ng * 32, kb * 64, (bf16_t*)(a->ws + WS_WGINT) + (size_t)mat * NGIN * 1024 + (size_t)(ng * 32) * 1024 + kb * 64, 1024, scr, lane); continue; }
        r -= N5;
        { const int mat = r / I_SQ, q = r % I_SQ, ng = q / 16, kb = q % 16;
            tr_item(a->in[I_GWO] + (size_t)mat * 1024 * 1024, 1024, ng * 32, kb * 64, (bf16_t*)(a->ws + WS_WGOT) + (size_t)mat * 1024 * 1024 + (size_t)(ng * 32) * 1024 + kb * 64, 1024, scr, lane); }
    }
    const int gt = blk_l() * NTHREADS + tid, NGT = grd_l() * NTHREADS;
    for (int i = gt; i < 2 * 256 * 128; i += NGT) {
        const int m = i / (256 * 128), q = i % (256 * 128), j = q / 128, k8 = (q % 128) * 8;
        float v[8];
#pragma unroll
        for (int e = 0; e < 8; ++e) v[e] = j < 32 ? a->in[I_GWA1][((size_t)(m * 2 + (j >> 4)) * 1024 + k8 + e) * 16 + (j & 15)] : 0.f;
        u32x4 o; o.x = pk2(v[0], v[1]); o.y = pk2(v[2], v[3]); o.z = pk2(v[4], v[5]); o.w = pk2(v[6], v[7]);
        *(u32x4*)((bf16_t*)(a->ws + WS_WGINT) + (size_t)m * NGIN * 1024 + (size_t)(3072 + j) * 1024 + k8) = o;
    }
}

template <bool FROM_INPUT>
__device__ __forceinline__ void row_pass(KA a, int Lpost, int jpost, float gs, int Lpre, int jpre, bool final_out) {
    const int tid = tid_l(), lane = tid & 63, wave = tid >> 6;
    const int gw = blk_l() * 8 + wave, NGW = grd_l() * 8;
    float* hres = (float*)(a->ws + WS_HRES); const float* mod = (const float*)(a->ws + WS_MOD);
    const bf16_t* Y = (const bf16_t*)(a->ws + WS_Y); bf16_t* U = (bf16_t*)(a->ws + WS_U);
    for (int r = gw; r < MT; r += NGW) {
        const int b = r / TPB, pos = r - b * TPB; const bool isctx = pos < CTXL; const int mi = isctx ? 8 : b;
        const float* src;
        if (FROM_INPUT) src = isctx ? a->in[I_CTX] + (size_t)(b * CTXL + pos) * DM : a->in[I_X] + (size_t)(b * SEQ + pos - CTXL) * DM;
        else src = hres + (size_t)r * DM;
        f32x4 h[4];
#pragma unroll
        for (int q = 0; q < 4; ++q) h[q] = *(const f32x4*)(src + 4 * lane + 256 * q);
        if (jpost >= 0) {
            f32x4 y[4]; float ss = 0.f;
#pragma unroll
            for (int q = 0; q < 4; ++q) { const u32x2 w = *(const u32x2*)(Y + (size_t)r * DM + 4 * lane + 256 * q);
                y[q] = (f32x4){bf_lo(w.x), bf_hi(w.x), bf_lo(w.y), bf_hi(w.y)}; ss += (y[q].x * y[q].x + y[q].y * y[q].y) + (y[q].z * y[q].z + y[q].w * y[q].w); }
            const float rstd = 1.0f / sqrtf(wave_sum(ss) * (1.0f / DM) + EPS);
            const float* gate = mod + (size_t)(Lpost * 9 + mi) * 9216 + (3 * jpost + 2) * 1024; const float* gp = a->in[I_NPOST] + (size_t)(Lpost * 3 + jpost) * DM;
#pragma unroll
            for (int q = 0; q < 4; ++q) { const f32x4 gt = *(const f32x4*)(gate + 4 * lane + 256 * q), gg = *(const f32x4*)(gp + 4 * lane + 256 * q);
                h[q] += gs * gt * (y[q] * rstd * gg); }
        }
        if (final_out) { if (!isctx) { float* o = a->out + (size_t)(b * SEQ + pos - CTXL) * DM;
#pragma unroll
                for (int q = 0; q < 4; ++q) *(f32x4*)(o + 4 * lane + 256 * q) = h[q]; } }
        else {
#pragma unroll
            for (int q = 0; q < 4; ++q) *(f32x4*)(hres + (size_t)r * DM + 4 * lane + 256 * q) = h[q]; }
        if (jpre >= 0) {
            float ss = 0.f;
#pragma unroll
            for (int q = 0; q < 4; ++q) ss += (h[q].x * h[q].x + h[q].y * h[q].y) + (h[q].z * h[q].z + h[q].w * h[q].w);
            const float rstd = 1.0f / sqrtf(wave_sum(ss) * (1.0f / DM) + EPS);
            const float* mb = mod + (size_t)(Lpre * 9 + mi) * 9216 + (3 * jpre) * 1024; const float* g = a->in[I_NPRE] + (size_t)(Lpre * 3 + jpre) * DM;
#pragma unroll
            for (int q = 0; q < 4; ++q) { const f32x4 sh = *(const f32x4*)(mb + 4 * lane + 256 * q), sc = *(const f32x4*)(mb + 1024 + 4 * lane + 256 * q), gg = *(const f32x4*)(g + 4 * lane + 256 * q);
                const f32x4 u = h[q] * rstd * gg * (1.0f + sc) + sh;
                u32x2 w; w.x = cvtpk(u.x, u.y); w.y = cvtpk(u.z, u.w); *(u32x2*)(U + (size_t)r * DM + 4 * lane + 256 * q) = w; }
        }
    }
}

__device__ __forceinline__ void phase_qknorm_rope(KA a, int m) {
    const int tid = tid_l(), lane = tid & 63, wave = tid >> 6;
    const int gw = blk_l() * 8 + wave, NGW = grd_l() * 8;
    bf16_t* QKV = (bf16_t*)(a->ws + WS_BIG);
    const int i = lane & 31, hl = lane >> 5, d1 = i + 64 * hl, d2 = d1 + 32;
    const float qg1 = a->in[I_AQG][m * 128 + d1], qg2 = a->in[I_AQG][m * 128 + d2], kg1 = a->in[I_AKG][m * 128 + d1], kg2 = a->in[I_AKG][m * 128 + d2];
    const float inv = exp2f(-(float)i * (13.287712379549449f / 32.0f));
    for (int r = gw; r < MT; r += NGW) {
        const int b = r / TPB, pos = r - b * TPB; const bool isctx = pos < CTXL;
        float cs = 1.f, sn = 0.f;
        if (!isctx) { const int t = pos - CTXL; const float p = (float)(hl ? (t & 63) : (t >> 6)); const float ang = p * inv; cs = cosf(ang); sn = sinf(ang); }
        bf16_t* row = QKV + (size_t)r * NQKV;
#pragma unroll
        for (int hd = 0; hd < 10; ++hd) {
            float x1 = bf_f(row[hd * 128 + d1]), x2 = bf_f(row[hd * 128 + d2]);
            const float rstd = 1.0f / sqrtf(wave_sum(x1 * x1 + x2 * x2) * (1.0f / 128.0f) + EPS);
            x1 *= rstd * (hd < 8 ? qg1 : kg1); x2 *= rstd * (hd < 8 ? qg2 : kg2);
            const float o1 = x1 * cs - x2 * sn, o2 = x2 * cs + x1 * sn;
            row[hd * 128 + d1] = f_bf(o1); row[hd * 128 + d2] = f_bf(o2);
        }
    }
}

__device__ __forceinline__ void phase_attention(KA a, char* lds) {
    const int G = grd_l(); const int bx = blk_l(); const int vcu = (G % 8 == 0) ? (bx % 8) * (G / 8) + bx / 8 : bx;
    const att::bf16* QKV = (const att::bf16*)(a->ws + WS_BIG); att::bf16* AO = (att::bf16*)(a->ws + WS_ATTNO);
    for (int u = vcu; u < 1024 + 64; u += G) {
        int b, h, q0, seq;
        if (u < 1024) { const int grp = u >> 6, within = u & 63; b = grp >> 1; h = (grp & 1) * 4 + (within >> 4); q0 = CTXL + (within & 15) * 256; seq = TPB; }
        else { const int cu = u - 1024; b = cu >> 3; h = cu & 7; q0 = 0; seq = CTXL; }
        const int kvh = h >> 2; const size_t rb = (size_t)b * TPB;
        att::attn_dense_body<att::bf16>(QKV + (rb + q0) * NQKV + h * 128, QKV + rb * NQKV + 1024 + kvh * 128, QKV + rb * NQKV + 1280 + kvh * 128, AO + (rb + q0) * DM + h * 128, seq, lds);
        __syncthreads();
    }
}

namespace gla {
constexpr int QD_OFF = 0, KI_OFF = 17408, KET_OFF = 34816, VT_OFF = 53248, STT_OFF = 62464, SC_OFF = 79872, DEC_OFF = 89088, TS_OFF = 89600, GSUM_OFF = 93696;
__device__ __forceinline__ int crow(int r, int hi) { return (r & 3) + 8 * (r >> 2) + 4 * hi; }
__device__ __forceinline__ int chunk_row0(int b, int dir, int c) { return b * TPB + (dir == 0 ? 64 * c : (c < 4 ? 64 * (3 - c) : CTXL + 64 * (67 - c))); }
}
__device__ __forceinline__ void phase_gla_scan(KA a, int m, LAS unsigned char* lds) {
    using namespace gla;
    const int tid = tid_l(), lane = tid & 63, wave = __builtin_amdgcn_readfirstlane(tid >> 6), r32 = lane & 31, hi = lane >> 5;
    const int G = grd_l(); const int bx = blk_l(); const int vcu = (G % 8 == 0) ? (bx % 8) * (G / 8) + bx / 8 : bx;
    const bf16_t* Gb = (const bf16_t*)(a->ws + WS_BIG);
    const int d = tid & 127, tg = tid >> 7, dv = tid & 63, tgv = tid >> 6;
    const int ti = (wave >> 1) & 1, tj = wave & 1, role = wave >> 2, sd = wave >> 1, sv = wave & 1;
    LAS float* ts = (LAS float*)(lds + TS_OFF); LAS float* gsum = (LAS float*)(lds + GSUM_OFF); LAS float* dec = (LAS float*)(lds + DEC_OFF);
    for (int item = vcu; item < 256; item += G) {
        const int vs = item & 3, dir = (item >> 2) & 1, h = (item >> 3) & 3, b = item >> 5;
        bf16_t* Oo = (bf16_t*)(a->ws + (dir == 0 ? WS_U : WS_Y));
        float w2[16];
#pragma unroll
        for (int r = 0; r < 16; ++r) w2[r] = a->in[I_GWA2][((size_t)(m * 2 + dir) * 16 + r) * 512 + h * 128 + d];
        const float bav = a->in[I_GBA][(size_t)(m * 2 + dir) * 512 + h * 128 + d];
        __syncthreads();
        for (int i = tid; i < 17408 / 4; i += NTHREADS) ((LAS unsigned*)(lds + STT_OFF))[i] = 0u;
        f32x16 st;
#pragma unroll
        for (int r = 0; r < 16; ++r) st[r] = 0.f;
        const int qcol = h * 128 + d, kcol = 512 + h * 128 + d, vcol = 1024 + h * 256 + vs * 64 + dv, tcol = 3072 + dir * 16 + 2 * (tid & 7);
        bf16_t qn[16], kn[16], vn[8]; unsigned tn;
#define GLA_LOAD(c) do { const bf16_t* gp = Gb + (size_t)chunk_row0(b, dir, (c)) * NGIN; \
            _Pragma("unroll") for (int ii = 0; ii < 16; ++ii) { qn[ii] = gp[(size_t)(16 * tg + ii) * NGIN + qcol]; kn[ii] = gp[(size_t)(16 * tg + ii) * NGIN + kcol]; } \
            _Pragma("unroll") for (int ii = 0; ii < 8; ++ii) vn[ii] = gp[(size_t)(8 * tgv + ii) * NGIN + vcol]; \
            tn = *(const unsigned*)(gp + (size_t)(tid >> 3) * NGIN + tcol); } while (0)
        GLA_LOAD(0);
        for (int c = 0; c < 68; ++c) {
            const int row0 = chunk_row0(b, dir, c);
            ts[tid * 2] = bf_lo(tn); ts[tid * 2 + 1] = bf_hi(tn);
            __syncthreads();
            float cum[16];
#pragma unroll
            for (int ii = 0; ii < 16; ++ii) { float x = bav;
#pragma unroll
                for (int r = 0; r < 16; ++r) x += ts[(16 * tg + ii) * 16 + r] * w2[r];
                cum[ii] = (fminf(x, 0.f) - __logf(1.0f + __expf(-fabsf(x)))) * (1.0f / 16.0f); }
            if (dir == 0) {
#pragma unroll
                for (int ii = 1; ii < 16; ++ii) cum[ii] += cum[ii - 1];
                gsum[tg * 128 + d] = cum[15];
            } else {
#pragma unroll
                for (int ii = 14; ii >= 0; --ii) cum[ii] += cum[ii + 1];
                gsum[tg * 128 + d] = cum[0];
            }
            __syncthreads();
            { const float s0 = gsum[d], s1 = gsum[128 + d], s2 = gsum[256 + d], s3 = gsum[384 + d];
              const float total = (s0 + s1) + (s2 + s3);
              float off;
              if (dir == 0) off = (tg > 0 ? s0 : 0.f) + (tg > 1 ? s1 : 0.f) + (tg > 2 ? s2 : 0.f);
              else off = (tg < 3 ? s3 : 0.f) + (tg < 2 ? s2 : 0.f) + (tg < 1 ? s1 : 0.f);
              unsigned kep[8];
#pragma unroll
              for (int ii = 0; ii < 16; ii += 2) {
                  const float c0 = cum[ii] + off, c1 = cum[ii + 1] + off;
                  const float q0 = bf_f(qn[ii]), q1 = bf_f(qn[ii + 1]), k0 = bf_f(kn[ii]), k1 = bf_f(kn[ii + 1]);
                  const int i0 = 16 * tg + ii;
                  *(LAS bf16_t*)(lds + QD_OFF + (i0 * 136 + d) * 2) = f_bf(q0 * 0.08838834764831845f * __expf(c0));
                  *(LAS bf16_t*)(lds + QD_OFF + ((i0 + 1) * 136 + d) * 2) = f_bf(q1 * 0.08838834764831845f * __expf(c1));
                  *(LAS bf16_t*)(lds + KI_OFF + (i0 * 136 + d) * 2) = f_bf(k0 * __expf(-c0));
                  *(LAS bf16_t*)(lds + KI_OFF + ((i0 + 1) * 136 + d) * 2) = f_bf(k1 * __expf(-c1));
                  kep[ii >> 1] = cvtpk(k0 * __expf(total - c0), k1 * __expf(total - c1));
              }
              *(LAS u32x4*)(lds + KET_OFF + (d * 72 + 16 * tg) * 2) = (u32x4){kep[0], kep[1], kep[2], kep[3]};
              *(LAS u32x4*)(lds + KET_OFF + (d * 72 + 16 * tg + 8) * 2) = (u32x4){kep[4], kep[5], kep[6], kep[7]};
              if (tg == 0) dec[d] = __expf(total);
              u32x4 vp; vp.x = (unsigned)vn[0] | ((unsigned)vn[1] << 16); vp.y = (unsigned)vn[2] | ((unsigned)vn[3] << 16); vp.z = (unsigned)vn[4] | ((unsigned)vn[5] << 16); vp.w = (unsigned)vn[6] | ((unsigned)vn[7] << 16);
              *(LAS u32x4*)(lds + VT_OFF + (dv * 72 + 8 * tgv) * 2) = vp;
            }
            __syncthreads();
            if (c + 1 < 68) GLA_LOAD(c + 1);
            f32x16 acc;
#pragma unroll
            for (int r = 0; r < 16; ++r) acc[r] = 0.f;
            { const int aoff = QD_OFF + ((32 * ti + r32) * 136 + 8 * hi) * 2;
              const int boff = (role == 0 ? KI_OFF : STT_OFF) + ((32 * tj + r32) * 136 + 8 * hi) * 2;
#pragma unroll
              for (int ks = 0; ks < 8; ++ks) { const bf16x8 av = *(const LAS bf16x8*)(lds + aoff + ks * 32), bv = *(const LAS bf16x8*)(lds + boff + ks * 32);
                  acc = __builtin_amdgcn_mfma_f32_32x32x16_bf16(av, bv, acc, 0, 0, 0); } }
            if (role == 0) {
#pragma unroll
                for (int r = 0; r < 16; ++r) { const int i = 32 * ti + crow(r, hi), j = 32 * tj + r32; const bool keep = dir == 0 ? (j <= i) : (j >= i);
                    *(LAS bf16_t*)(lds + SC_OFF + (i * 72 + j) * 2) = f_bf(keep ? acc[r] : 0.f); }
            }
            __syncthreads();
            if (role == 1) {
                const int aoff = SC_OFF + ((32 * ti + r32) * 72 + 8 * hi) * 2, boff = VT_OFF + ((32 * tj + r32) * 72 + 8 * hi) * 2;
#pragma unroll
                for (int ks = 0; ks < 4; ++ks) { const bf16x8 av = *(const LAS bf16x8*)(lds + aoff + ks * 32), bv = *(const LAS bf16x8*)(lds + boff + ks * 32);
                    acc = __builtin_amdgcn_mfma_f32_32x32x16_bf16(av, bv, acc, 0, 0, 0); }
                bf16_t* op = Oo + (size_t)(row0 + 32 * ti) * DM + h * 256 + vs * 64 + 32 * tj + r32;
#pragma unroll
                for (int r = 0; r < 16; ++r) op[(size_t)crow(r, hi) * DM] = f_bf(acc[r]);
            }
            {
#pragma unroll
              for (int r = 0; r < 16; ++r) st[r] *= dec[32 * sd + crow(r, hi)];
              const int aoff = KET_OFF + ((32 * sd + r32) * 72 + 8 * hi) * 2, boff = VT_OFF + ((32 * sv + r32) * 72 + 8 * hi) * 2;
#pragma unroll
              for (int ks = 0; ks < 4; ++ks) { const bf16x8 av = *(const LAS bf16x8*)(lds + aoff + ks * 32), bv = *(const LAS bf16x8*)(lds + boff + ks * 32);
                  st = __builtin_amdgcn_mfma_f32_32x32x16_bf16(av, bv, st, 0, 0, 0); }
#pragma unroll
              for (int r4 = 0; r4 < 4; ++r4) { u32x2 w; w.x = cvtpk(st[4 * r4], st[4 * r4 + 1]); w.y = cvtpk(st[4 * r4 + 2], st[4 * r4 + 3]);
                  *(LAS u32x2*)(lds + STT_OFF + ((32 * sv + r32) * 136 + 32 * sd + 8 * r4 + 4 * hi) * 2) = w; }
            }
        }
#undef GLA_LOAD
    }
}

__device__ __forceinline__ void phase_gla_readout(KA a, int m) {
    const int tid = tid_l(), lane = tid & 63, wave = tid >> 6;
    const int gw = blk_l() * 8 + wave, NGW = grd_l() * 8;
    const bf16_t* OF = (const bf16_t*)(a->ws + WS_U); const bf16_t* OB = (const bf16_t*)(a->ws + WS_Y); bf16_t* Gb = (bf16_t*)(a->ws + WS_BIG);
    const float* og = a->in[I_GOG] + (size_t)m * 1024;
    for (int r = gw; r < MT; r += NGW) {
#pragma unroll
        for (int q = 0; q < 4; ++q) {
            const int col = 4 * lane + 256 * q;
            const u32x2 wf = *(const u32x2*)(OF + (size_t)r * DM + col), wb = *(const u32x2*)(OB + (size_t)r * DM + col), wr = *(const u32x2*)(Gb + (size_t)r * NGIN + 2048 + col);
            f32x4 s = (f32x4){bf_lo(wf.x) + bf_lo(wb.x), bf_hi(wf.x) + bf_hi(wb.x), bf_lo(wf.y) + bf_lo(wb.y), bf_hi(wf.y) + bf_hi(wb.y)};
            const float ss = wave_sum((s.x * s.x + s.y * s.y) + (s.z * s.z + s.w * s.w));
            const float rstd = 1.0f / sqrtf(ss * (1.0f / 256.0f) + EPS);
            const f32x4 gg = *(const f32x4*)(og + col);
            const f32x4 rr = (f32x4){bf_lo(wr.x), bf_hi(wr.x), bf_lo(wr.y), bf_hi(wr.y)};
            f32x4 o = s * rstd * gg; o.x *= silu(rr.x); o.y *= silu(rr.y); o.z *= silu(rr.z); o.w *= silu(rr.w);
            u32x2 w; w.x = cvtpk(o.x, o.y); w.y = cvtpk(o.z, o.w);
            *(u32x2*)(Gb + (size_t)r * NGIN + 2048 + col) = w;
        }
    }
}

__global__ void __launch_bounds__(NTHREADS, 2) fwd_megakernel(Args unused_args) {
    extern __shared__ __attribute__((aligned(16))) unsigned char lds_raw[];
    LAS unsigned char* lds = (LAS unsigned char*)lds_raw;
    cg::grid_group grid = cg::this_grid();

#ifndef SKIP_MOD
    phase_mod(kargs(), lds);
#endif
#ifndef SKIP_W
    phase_weights(kargs(), lds);
#endif
    grid.sync();
    row_pass<true>(kargs(), 0, -1, 0.f, 0, 0, false);
    grid.sync();

    for (int sl = 0; sl < 3 * DEPTH; ++sl) {
        const int L = sl / 3, j = sl - 3 * L, m = L >> 1;
        if (j != 1) {
            unsigned char* ws = kargs()->ws; const int f = j >> 1;
            pg8::Gemm g1{(const bf16_t*)(ws + WS_U), (const bf16_t*)(ws + WS_W1T) + (size_t)(L * 2 + f) * 5632 * 1024, MT, 2 * DFF, DM, DM};
            pg8::StaticOrder S; S.init(MT, 2 * DFF, grd_l(), blk_l());
            pg8::EpiSwiglu E{(bf16_t*)(ws + WS_BIG), DFF};
#ifndef SKIP_G1
            pg8::gemm_phase<pg8::EpiSwiglu, pg8::StaticOrder, true, true>(lds, g1, S, E);
#endif
            grid.sync();
        } else {
            const bool attn = (L & 1) == 0;
            { unsigned char* ws = kargs()->ws;
              pg8::Gemm g1{(const bf16_t*)(ws + WS_U), attn ? (const bf16_t*)(ws + WS_WQKVT) + (size_t)m * NQKV * 1024 : (const bf16_t*)(ws + WS_WGINT) + (size_t)m * NGIN * 1024, MT, attn ? NQKV : NGIN, DM, DM};
              pg8::StaticOrder S; S.init(MT, g1.N, grd_l(), blk_l());
              pg8::EpiBf16s E{(bf16_t*)(ws + WS_BIG), g1.N};
#ifndef SKIP_GM
              pg8::gemm_phase<pg8::EpiBf16s, pg8::StaticOrder, true, true>(lds, g1, S, E);
#endif
 }
            grid.sync();
            if (attn) {
#ifndef SKIP_QK
                phase_qknorm_rope(kargs(), m);
#endif
                grid.sync();
#ifndef SKIP_ATT
                phase_attention(kargs(), (char*)lds_raw);
#endif
                grid.sync();
            } else {
#ifndef SKIP_GLA
                phase_gla_scan(kargs(), m, lds);
#endif
                grid.sync();
#ifndef SKIP_RO
                phase_gla_readout(kargs(), m);
#endif
                grid.sync();
            }
        }
        {
            unsigned char* ws = kargs()->ws;
            pg8::Gemm g2;
            if (j != 1) g2 = pg8::Gemm{(const bf16_t*)(ws + WS_BIG), (const bf16_t*)(ws + WS_W2T) + (size_t)(L * 2 + (j >> 1)) * 1024 * 2816, MT, DM, DFF, DFF};
            else if ((L & 1) == 0) g2 = pg8::Gemm{(const bf16_t*)(ws + WS_ATTNO), (const bf16_t*)(ws + WS_WOAT) + (size_t)m * 1024 * 1024, MT, DM, DM, DM};
            else g2 = pg8::Gemm{(const bf16_t*)(ws + WS_BIG) + 2048, (const bf16_t*)(ws + WS_WGOT) + (size_t)m * 1024 * 1024, MT, DM, DM, NGIN};
            pg8::StaticOrder S; S.init(MT, DM, grd_l(), blk_l());
            pg8::EpiBf16s E{(bf16_t*)(ws + WS_Y), DM};
#ifndef SKIP_G2
            pg8::gemm_phase<pg8::EpiBf16s, pg8::StaticOrder, true, true>(lds, g2, S, E);
#endif
            grid.sync();
        }
        const bool last = sl == 3 * DEPTH - 1;
        const int Ln = (j == 2) ? L + 1 : L, jn = (j == 2) ? 0 : j + 1;
        row_pass<false>(kargs(), L, j, j == 1 ? 1.0f : 0.5f, Ln, last ? -1 : jn, last);
        if (!last) grid.sync();
    }
}

extern "C" void kernel_launch(void* const* d_in, const int* in_sizes, int n_in, void* d_out, int out_size, void* d_ws, size_t ws_size, hipStream_t stream) {
    static int grid = 0;
    if (grid == 0) {
        if (n_in != 20 || out_size != NB * SEQ * DM || ws_size < WS_END) { fprintf(stderr, "kernel_launch: unexpected shapes: n_in %d out %d ws %zu (need %zu)\n", n_in, out_size, ws_size, (size_t)WS_END); grid = -1; return; }
        int dev = 0, cus = 0, per_cu = 0;
        (void)hipGetDevice(&dev);
        (void)hipDeviceGetAttribute(&cus, hipDeviceAttributeMultiprocessorCount, dev);
        (void)hipFuncSetAttribute((const void*)fwd_megakernel, hipFuncAttributeMaxDynamicSharedMemorySize, LDS_BYTES);
        (void)hipOccupancyMaxActiveBlocksPerMultiprocessor(&per_cu, (const void*)fwd_megakernel, NTHREADS, LDS_BYTES);
        if (per_cu < 1) per_cu = 1;
        grid = cus * per_cu;
        fprintf(stderr, "kernel_launch: grid %d (cus %d x %d), ws %zu\n", grid, cus, per_cu, ws_size);
    }
    if (grid < 0) return;
    Args a{};
    for (int i = 0; i < 20; ++i) a.in[i] = (const float*)d_in[i];
    a.out = (float*)d_out; a.ws = (unsigned char*)d_ws;
    void* args[] = {&a};
    hipError_t e = hipLaunchCooperativeKernel((const void*)fwd_megakernel, dim3(grid), dim3(NTHREADS), args, LDS_BYTES, stream);
    if (e != hipSuccess) fprintf(stderr, "kernel_launch: cooperative launch failed: %s (grid %d)\n", hipGetErrorString(e), grid);
}
```

```cpp
#include <hip/hip_runtime.h>
#include <hip/hip_cooperative_groups.h>
#include <hip/hip_bf16.h>
#include <cstdio>
#include <cstdint>
namespace cg = cooperative_groups;
__device__ __forceinline__ int tid_l() { int t = threadIdx.x; asm volatile("" : "+v"(t)); return t; }
__device__ __forceinline__ int blk_l() { int t = blockIdx.x; asm volatile("" : "+s"(t)); return t; }
__device__ __forceinline__ int grd_l() { int t = gridDim.x; asm volatile("" : "+s"(t)); return t; }
namespace pg8 {
#define PG8_LAS __attribute__((address_space(3)))
typedef unsigned short bf16_t;
typedef short bf16x8 __attribute__((ext_vector_type(8)));
typedef float f32x4 __attribute__((ext_vector_type(4)));
typedef unsigned u32x4 __attribute__((ext_vector_type(4)));
constexpr int BM = 256, BK = 64, HALF = 128, HTB = HALF * BK * 2  , STAGE_BYTES = 8 * HTB, NXCD = 8, WGM = 8;

__host__ __device__ __forceinline__ int lds_byte(int r, int c) { const int st = (r >> 4) * 2 + (c >> 5), rr = r & 15, cc = c & 31, ob = rr * 64 + cc * 2; return st * 1024 + (ob ^ (((ob >> 9) & 1) << 5)); }
__host__ __device__ __forceinline__ void stage_rc(int b, int& R, int& C) { const int st = b / 1024, sb = b % 1024, swz = sb ^ (((sb >> 9) & 1) << 5); R = (st >> 1) * 16 + swz / 64; C = (st & 1) * 32 + (swz % 64) / 2; }
__host__ __device__ __forceinline__ int perm32(int rho) { const int n = rho >> 4, i = rho & 15; return 8 * (i >> 2) + 4 * n + (i & 3); }

struct Unit { int pm, pn, kt0, nt, part, sig; };
struct Gemm { const bf16_t* A; const bf16_t* Bt; int M, N, K, lda, ldb; };

struct StaticOrder {
    int nM, nN, nwg, G, c, mode, ntfull; unsigned* sig;
    __host__ __device__ void init(int M, int N, int K, int G_, int c_, int mode_) { mode = mode_; nM = mode ? 128 : M / BM; nN = N / BM; nwg = nM * nN; G = G_; c = c_; ntfull = K / BK; sig = nullptr; }
    __host__ __device__ __forceinline__ bool next(int i, Unit& u) const {
        const long L = (long)i * G + c;
        int pm = 0, pn = 0, kt0 = 0, nt = ntfull, part = -1, sg = 0; bool ok = true;
        if (L >= nwg) {
            const int e = (int)(L - nwg);
            if (mode == 3) { ok = e < 8 * nN; pm = 17 * (e / nN); pn = e % nN; sg = 2; }
            else { ok = (mode == 1) && (e < 16 * nN); const int ct = e >> 1; pm = 17 * (ct / nN); pn = ct % nN; part = e & 1; nt = ntfull >> 1; kt0 = part * nt; }
        } else {
            int wgid = (int)L; { const int q = nwg / NXCD, r = nwg % NXCD, xcd = wgid % NXCD, off = wgid / NXCD; wgid = (xcd < r ? xcd * (q + 1) : r * (q + 1) + (xcd - r) * q) + off; }
            const int nig = WGM * nN, gid = wgid / nig, fm = gid * WGM, gsz = (nM - fm) < WGM ? (nM - fm) : WGM;
            pm = fm + ((wgid % nig) % gsz); pn = (wgid % nig) / gsz;
            if (mode) pm += (pm >> 4) + 1;
            sg = (mode >= 2 && L + G >= nwg) ? 1 : 0;
        }
        u.pm = pm; u.pn = pn; u.kt0 = kt0; u.nt = nt; u.part = part; u.sig = sg;
        return ok;
    }
    __device__ __forceinline__ void a_ready(const Unit&) const {}
    __device__ __forceinline__ void done(const Unit& u) const {
        if (sig != nullptr && u.sig != 0) {
            asm volatile("s_waitcnt vmcnt(0)" ::: "memory");
            __builtin_amdgcn_s_barrier(); asm volatile("" ::: "memory");
            if (threadIdx.x == 0) {
                __builtin_amdgcn_fence(__ATOMIC_RELEASE, "agent");
                asm volatile("s_waitcnt vmcnt(0)" ::: "memory");
                __hip_atomic_fetch_add(sig + (u.sig == 1 ? 0 : 64), 1u, __ATOMIC_RELAXED, __HIP_MEMORY_SCOPE_AGENT);
            }
        }
    }
};

typedef float f32x2c_t __attribute__((ext_vector_type(2))); typedef __bf16 bf16x2c_t __attribute__((ext_vector_type(2)));
__device__ __forceinline__ unsigned cvt_pk_bf16(float lo, float hi) { f32x2c_t v = {lo, hi}; bf16x2c_t b = __builtin_convertvector(v, bf16x2c_t); return __builtin_bit_cast(unsigned, b); }
typedef float f32x2 __attribute__((ext_vector_type(2)));
struct EpiBf16s {
    static constexpr bool PERM = true, AFTER_DRAIN = false;
    bf16_t* O; int ldc; float* P;
    __device__ __forceinline__ void operator()(const f32x4 (&acc)[2][2][4][2], const Unit& u, int wr, int wc, int fr, int fq) const {
        const int row0 = u.pm * BM + wr * 64 + fr; const int col0 = u.pn * BM + wc * 32 + 8 * fq;
        if (u.part >= 0) {
            float* pb = P + (size_t)u.part * 2048 * ldc + (size_t)((u.pm / 17) * BM + wr * 64 + fr) * ldc + col0;
#pragma unroll
            for (int ai = 0; ai < 2; ++ai)
#pragma unroll
                for (int m = 0; m < 4; ++m)
#pragma unroll
                    for (int bj = 0; bj < 2; ++bj) { float* rp = pb + (size_t)(ai * HALF + m * 16) * ldc + bj * HALF; *(f32x4*)rp = acc[ai][bj][m][0]; *(f32x4*)(rp + 4) = acc[ai][bj][m][1]; }
            return;
        }
#pragma unroll
        for (int ai = 0; ai < 2; ++ai)
#pragma unroll
            for (int m = 0; m < 4; ++m) { bf16_t* rowp = O + (size_t)(row0 + ai * HALF + m * 16) * ldc + col0;
#pragma unroll
                for (int bj = 0; bj < 2; ++bj) { const f32x4 v0 = acc[ai][bj][m][0], v1 = acc[ai][bj][m][1];
                    u32x4 w; w.x = cvt_pk_bf16(v0[0], v0[1]); w.y = cvt_pk_bf16(v0[2], v0[3]); w.z = cvt_pk_bf16(v1[0], v1[1]); w.w = cvt_pk_bf16(v1[2], v1[3]);
                    *(u32x4*)(rowp + bj * HALF) = w; } }
    }
};
__device__ __forceinline__ float silu_f(float g) { return g * __builtin_amdgcn_rcpf(1.0f + __expf(-g)); }
struct EpiSwiglu {
    static constexpr bool PERM = true, AFTER_DRAIN = false;
    bf16_t* H; int ldh;
    __device__ __forceinline__ void operator()(const f32x4 (&acc)[2][2][4][2], const Unit& u, int wr, int wc, int fr, int fq) const {
        const int row0 = u.pm * BM + wr * 64 + fr; const int col0 = u.pn * HALF + wc * 32 + 8 * fq;
#pragma unroll
        for (int ai = 0; ai < 2; ++ai)
#pragma unroll
            for (int m = 0; m < 4; ++m) { bf16_t* rowp = H + (size_t)(row0 + ai * HALF + m * 16) * ldh + col0;
                const f32x4 g0 = acc[ai][0][m][0], g1 = acc[ai][0][m][1], u0 = acc[ai][1][m][0], u1 = acc[ai][1][m][1];
                u32x4 w;
                w.x = cvt_pk_bf16(silu_f(g0[0]) * u0[0], silu_f(g0[1]) * u0[1]); w.y = cvt_pk_bf16(silu_f(g0[2]) * u0[2], silu_f(g0[3]) * u0[3]);
                w.z = cvt_pk_bf16(silu_f(g1[0]) * u1[0], silu_f(g1[1]) * u1[1]); w.w = cvt_pk_bf16(silu_f(g1[2]) * u1[2], silu_f(g1[3]) * u1[3]);
                *(u32x4*)rowp = w; }
    }
};
template <class Epi, class Sched, bool ALIGN_EPI = false, bool SP2 = false>
__device__ __forceinline__ void gemm_phase(PG8_LAS unsigned char* lds, const Gemm g, const Sched& S, const Epi& E) {
    const int tid = tid_l(), wid = __builtin_amdgcn_readfirstlane(tid >> 6), lane = tid & 63, wr = wid >> 2, wc = wid & 3, fr = lane & 15, fq = lane >> 4;
    unsigned voffA[2], voffB[2];
#pragma unroll
    for (int i = 0; i < 2; ++i) { int R, C; stage_rc(tid * 16 + i * 8192, R, C); const int Rb = Epi::PERM ? ((R & ~31) + perm32(R & 31)) : R;
        voffA[i] = (unsigned)(R * g.lda + C) * 2u; voffB[i] = (unsigned)(Rb * g.ldb + C) * 2u; }
    const size_t kstep = (size_t)(BK * 2);
    const size_t hstepB = (size_t)HALF * g.ldb * 2, hstepA = (size_t)HALF * g.lda * 2;
    const size_t tstepA = 2 * hstepA, tstepB = 2 * hstepB;
    const unsigned ldsw = (unsigned)wid * 1024u;
    const int aoff = lds_byte(wr * 64 + fr, fq * 8), boff = lds_byte(wc * 32 + fr, fq * 8);
#define PG8_SA(b, h) (((b) * 2 + (h)) * HTB)
#define PG8_SB(b, h) ((4 + (b) * 2 + (h)) * HTB)
#define PG8_STAGE(bufoff, gbase, voff) do { _Pragma("unroll") for (int _i = 0; _i < 2; ++_i) \
        __builtin_amdgcn_global_load_lds((const unsigned*)((const char*)(gbase) + (voff)[_i]), (PG8_LAS unsigned*)(lds + (bufoff) + ldsw + _i * 8192), 16, 0, 0); } while (0)
#define PG8_LDA(dst, b, h) do { _Pragma("unroll") for (int m = 0; m < 4; ++m) _Pragma("unroll") for (int k = 0; k < 2; ++k) dst[m][k] = *(const PG8_LAS bf16x8*)(lds + PG8_SA(b, h) + aoff + m * 2048 + k * 1024); } while (0)
#define PG8_LDB(dst, b, h) do { _Pragma("unroll") for (int n = 0; n < 2; ++n) _Pragma("unroll") for (int k = 0; k < 2; ++k) dst[n][k] = *(const PG8_LAS bf16x8*)(lds + PG8_SB(b, h) + boff + n * 2048 + k * 1024); } while (0)
#define PG8_MMA(ai, bj, At, Bt) do { __builtin_amdgcn_s_setprio(1); _Pragma("unroll") for (int m = 0; m < 4; ++m) _Pragma("unroll") for (int n = 0; n < 2; ++n) _Pragma("unroll") for (int k = 0; k < 2; ++k) \
        acc[ai][bj][m][n] = __builtin_amdgcn_mfma_f32_16x16x32_bf16(Bt[n][k], At[m][k], acc[ai][bj][m][n], 0, 0, 0); __builtin_amdgcn_s_setprio(0); } while (0)
#define PG8_WAIT_V(n) asm volatile("s_waitcnt vmcnt(" #n ")" ::: "memory")
#define PG8_WAIT_L(n) asm volatile("s_waitcnt lgkmcnt(" #n ")" ::: "memory")
#define PG8_BAR __builtin_amdgcn_s_barrier()
#define PG8_SCHED __builtin_amdgcn_sched_barrier(0)
    Unit cur, nxt; int ui = 0;
    if (!S.next(0, cur)) return;
    f32x4 acc[2][2][4][2];
#pragma unroll
    for (int a = 0; a < 2; ++a)
#pragma unroll
        for (int b = 0; b < 2; ++b)
#pragma unroll
            for (int m = 0; m < 4; ++m)
#pragma unroll
                for (int n = 0; n < 2; ++n) acc[a][b][m][n] = (f32x4){0.f, 0.f, 0.f, 0.f};
    bf16x8 At[4][2], B0[2][2], B1[2][2];
    const char* cA = (const char*)g.A + (size_t)cur.pm * tstepA + (size_t)cur.kt0 * kstep; const char* cB = (const char*)g.Bt + (size_t)cur.pn * tstepB + (size_t)cur.kt0 * kstep;
    S.a_ready(cur);
    if constexpr (SP2) {
        PG8_STAGE(PG8_SB(0, 0), cB, voffB); PG8_STAGE(PG8_SB(0, 1), cB + hstepB, voffB); PG8_STAGE(PG8_SA(0, 0), cA, voffA); PG8_STAGE(PG8_SA(0, 1), cA + hstepA, voffA);
        if (wr == 1) PG8_BAR;
        PG8_WAIT_V(2); PG8_BAR;
        PG8_STAGE(PG8_SB(1, 0), cB + kstep, voffB); PG8_STAGE(PG8_SA(1, 0), cA + kstep, voffA); PG8_STAGE(PG8_SB(1, 1), cB + hstepB + kstep, voffB);
        PG8_WAIT_V(6); PG8_BAR;
    } else {
        PG8_STAGE(PG8_SB(0, 0), cB, voffB); PG8_STAGE(PG8_SA(0, 0), cA, voffA); PG8_STAGE(PG8_SB(0, 1), cB + hstepB, voffB); PG8_STAGE(PG8_SA(0, 1), cA + hstepA, voffA);
        if (wr == 1) PG8_BAR;
        PG8_WAIT_V(4); PG8_BAR;
        PG8_STAGE(PG8_SB(1, 0), cB + kstep, voffB); PG8_STAGE(PG8_SA(1, 0), cA + kstep, voffA); PG8_STAGE(PG8_SB(1, 1), cB + hstepB + kstep, voffB);
        PG8_WAIT_V(6); PG8_BAR;
    }
    for (;;) {
        const bool has_next = S.next(ui + 1, nxt);
        const char* nA = has_next ? (const char*)g.A + (size_t)nxt.pm * tstepA + (size_t)nxt.kt0 * kstep : cA; const char* nB = has_next ? (const char*)g.Bt + (size_t)nxt.pn * tstepB + (size_t)nxt.kt0 * kstep : cB;
        const int nt = cur.nt;
        for (int t = 0; t < nt; t += 2) {
            const bool last = (t == nt - 2);
            const char* a1 = cA + (size_t)(t + 1) * kstep;
            const char* a2 = last ? nA : cA + (size_t)(t + 2) * kstep; const char* b2 = last ? nB : cB + (size_t)(t + 2) * kstep;
            const char* a3 = a2 + kstep; const char* b3 = b2 + kstep;
            if (last && has_next) S.a_ready(nxt);
            if constexpr (SP2) {
            PG8_LDB(B0, 0, 0); PG8_LDB(B1, 0, 1); PG8_SCHED; PG8_LDA(At, 0, 0); PG8_STAGE(PG8_SA(1, 1), a1 + hstepA, voffA);
            PG8_WAIT_V(8); PG8_WAIT_L(0); PG8_BAR; PG8_MMA(0, 0, At, B0); PG8_MMA(0, 1, At, B1); PG8_BAR; PG8_SCHED;
            PG8_LDA(At, 0, 1); PG8_STAGE(PG8_SB(0, 0), b2, voffB); PG8_STAGE(PG8_SB(0, 1), b2 + hstepB, voffB); PG8_STAGE(PG8_SA(0, 0), a2, voffA);
            PG8_WAIT_V(8); PG8_WAIT_L(0); PG8_BAR; PG8_MMA(1, 0, At, B0); PG8_MMA(1, 1, At, B1); PG8_BAR; PG8_SCHED;
            PG8_LDB(B0, 1, 0); PG8_LDB(B1, 1, 1); PG8_SCHED; PG8_LDA(At, 1, 0); PG8_STAGE(PG8_SA(0, 1), a2 + hstepA, voffA);
            PG8_WAIT_V(8); PG8_WAIT_L(0); PG8_BAR; PG8_MMA(0, 0, At, B0); PG8_MMA(0, 1, At, B1); PG8_BAR; PG8_SCHED;
            PG8_LDA(At, 1, 1); PG8_STAGE(PG8_SB(1, 0), b3, voffB); PG8_STAGE(PG8_SB(1, 1), b3 + hstepB, voffB); PG8_STAGE(PG8_SA(1, 0), a3, voffA);
            PG8_WAIT_V(8); PG8_WAIT_L(0); PG8_BAR; PG8_MMA(1, 0, At, B0); PG8_MMA(1, 1, At, B1); PG8_BAR; PG8_SCHED;
            } else {
            PG8_LDB(B0, 0, 0); PG8_SCHED; PG8_LDA(At, 0, 0); PG8_STAGE(PG8_SA(1, 1), a1 + hstepA, voffA);
            PG8_WAIT_L(8); PG8_BAR; PG8_WAIT_L(0); PG8_MMA(0, 0, At, B0); PG8_BAR; PG8_SCHED;
            PG8_LDB(B1, 0, 1); PG8_STAGE(PG8_SB(0, 0), b2, voffB);
            PG8_BAR; PG8_WAIT_L(0); PG8_MMA(0, 1, At, B1); PG8_BAR;
            PG8_LDA(At, 0, 1); PG8_STAGE(PG8_SA(0, 0), a2, voffA);
            PG8_BAR; PG8_WAIT_L(0); PG8_MMA(1, 0, At, B0); PG8_BAR; PG8_SCHED;
            PG8_STAGE(PG8_SB(0, 1), b2 + hstepB, voffB);
            PG8_WAIT_V(6); PG8_BAR; PG8_MMA(1, 1, At, B1); PG8_BAR;
            PG8_LDB(B0, 1, 0); PG8_SCHED; PG8_LDA(At, 1, 0); PG8_STAGE(PG8_SA(0, 1), a2 + hstepA, voffA);
            PG8_WAIT_L(8); PG8_BAR; PG8_WAIT_L(0); PG8_MMA(0, 0, At, B0); PG8_BAR; PG8_SCHED;
            PG8_LDB(B1, 1, 1); PG8_STAGE(PG8_SB(1, 0), b3, voffB);
            PG8_BAR; PG8_WAIT_L(0); PG8_MMA(0, 1, At, B1); PG8_BAR;
            PG8_LDA(At, 1, 1); PG8_STAGE(PG8_SA(1, 0), a3, voffA);
            PG8_BAR; PG8_WAIT_L(0); PG8_MMA(1, 0, At, B0); PG8_BAR; PG8_SCHED;
            PG8_STAGE(PG8_SB(1, 1), b3 + hstepB, voffB);
            PG8_WAIT_V(6); PG8_BAR; PG8_MMA(1, 1, At, B1); PG8_BAR;
            }
        }
        if constexpr (ALIGN_EPI) { if (wr == 0) PG8_BAR; }
        if constexpr (!Epi::AFTER_DRAIN) { E(acc, cur, wr, wc, fr, fq); S.done(cur); }
        if (!has_next) break;
#pragma unroll
        for (int a = 0; a < 2; ++a)
#pragma unroll
            for (int b = 0; b < 2; ++b)
#pragma unroll
                for (int m = 0; m < 4; ++m)
#pragma unroll
                    for (int n = 0; n < 2; ++n) acc[a][b][m][n] = (f32x4){0.f, 0.f, 0.f, 0.f};
        cur = nxt; cA = nA; cB = nB; ++ui;
        if constexpr (ALIGN_EPI) { if (wr == 1) PG8_BAR; }
    }
    PG8_WAIT_V(0);
    if constexpr (!ALIGN_EPI) { if (wr == 0) PG8_BAR; }
    PG8_BAR;
    if constexpr (Epi::AFTER_DRAIN) { E.fused(acc, cur, wr, wc, fr, fq, lds, wid, lane); S.done(cur); }
#undef PG8_SA
#undef PG8_SB
#undef PG8_STAGE
#undef PG8_LDA
#undef PG8_LDB
#undef PG8_MMA
#undef PG8_WAIT_V
#undef PG8_WAIT_L
#undef PG8_BAR
#undef PG8_SCHED
}
}
namespace att {
using bf16 = __hip_bfloat16;
constexpr int   D = 128, NW = 8, QBLK = 32, KVBLK = 64;
constexpr float SCALE = 0.088388347648318440f;
constexpr float THR = 8.f;
constexpr int SDEPTH = 2;
constexpr int LDQ = 1536, LDK = 1536, LDO = 1024;
constexpr size_t SHM_V = KVBLK * D * 2, SHM_K = KVBLK * D * 2, SHM_ATTN = 2 * SHM_V + 2 * SHM_K + NW * 64 * 4;
using bf16x8 = __attribute__((ext_vector_type(8))) short;
using s16x4  = __attribute__((ext_vector_type(4))) short;
using f32x16 = __attribute__((ext_vector_type(16))) float;
using f32x8  = __attribute__((ext_vector_type(8))) float;
using u32x4  = __attribute__((ext_vector_type(4))) unsigned;
#define KSWZ(row, colB) ((row) * 256 + ((colB) ^ (((row) & 7) << 4)))
#define SBAR() __builtin_amdgcn_sched_barrier(0)
__device__ __forceinline__ int crow(int r, int hi) { return (r & 3) + 8 * (r >> 2) + 4 * hi; }
__device__ __forceinline__ unsigned cvtpk(float lo, float hi) {
  unsigned r; asm volatile("v_cvt_pk_bf16_f32 %0, %1, %2" : "=v"(r) : "v"(lo), "v"(hi)); return r;
}
template <typename TIn> struct Stage;
template <> struct Stage<bf16>  { using T = bf16x8;
  __device__ static __forceinline__ T ld8(const bf16* p) { return *reinterpret_cast<const bf16x8*>(p); }
  __device__ static __forceinline__ bf16x8 tobf(T x) { return x; } };
template <> struct Stage<float> { using T = f32x8;
  __device__ static __forceinline__ T ld8(const float* p) { return *reinterpret_cast<const f32x8*>(p); }
  __device__ static __forceinline__ bf16x8 tobf(T x) {
    u32x4 w = {cvtpk(x[0], x[1]), cvtpk(x[2], x[3]), cvtpk(x[4], x[5]), cvtpk(x[6], x[7])}; return *reinterpret_cast<bf16x8*>(&w); } };

__device__ __forceinline__ void partialSM(f32x16& p0, f32x16& p1, float& m_reg, float& mn, float& alpha) {
  constexpr float C = SCALE * 1.4426950408889634f;
  float pmax = p0[0]; for (int r = 1; r < 16; ++r) pmax = fmaxf(pmax, p0[r]); for (int r = 0; r < 16; ++r) pmax = fmaxf(pmax, p1[r]);
  { auto rr = __builtin_amdgcn_permlane32_swap(__float_as_uint(pmax), __float_as_uint(pmax), false, false);
    pmax = fmaxf(__uint_as_float(rr[0]), __uint_as_float(rr[1])); }
  if (__builtin_expect(__all(pmax - m_reg <= THR / SCALE), 1)) { mn = m_reg; alpha = 1.f; }
  else { mn = fmaxf(m_reg, pmax); alpha = __builtin_amdgcn_exp2f((m_reg - mn) * C); m_reg = mn; }
  float mnC = -mn * C;
  for (int r = 0; r < 16; ++r) p0[r] = fmaf(p0[r], C, mnC); for (int r = 0; r < 16; ++r) p1[r] = fmaf(p1[r], C, mnC);
  for (int r = 0; r < 16; ++r) p0[r] = __builtin_amdgcn_exp2f(p0[r]);
}
__device__ __forceinline__ void finishSM(f32x16& p0, f32x16& p1, float alpha, float& l_reg, bf16x8& pa0, bf16x8& pa1, bf16x8& pa2, bf16x8& pa3) {
  for (int r = 0; r < 16; ++r) p1[r] = __builtin_amdgcn_exp2f(p1[r]);
  float ps = 0; for (int r = 0; r < 16; ++r) ps += p0[r]; for (int r = 0; r < 16; ++r) ps += p1[r];
  { auto rr = __builtin_amdgcn_permlane32_swap(__float_as_uint(ps), __float_as_uint(ps), false, false);
    ps = __uint_as_float(rr[0]) + __uint_as_float(rr[1]); }
  l_reg = l_reg * alpha + ps;
#define PK4(P, BASE, OUT) do { unsigned a0 = cvtpk(P[BASE + 0], P[BASE + 1]), a1 = cvtpk(P[BASE + 2], P[BASE + 3]);   \
    unsigned b0 = cvtpk(P[BASE + 4], P[BASE + 5]), b1 = cvtpk(P[BASE + 6], P[BASE + 7]);                              \
    auto r0 = __builtin_amdgcn_permlane32_swap(a0, b0, false, false); auto r1 = __builtin_amdgcn_permlane32_swap(a1, b1, false, false); \
    u32x4 w = {r0[0], r1[0], r0[1], r1[1]}; OUT = *reinterpret_cast<bf16x8*>(&w); } while (0)
  PK4(p0, 0, pa0); PK4(p0, 8, pa1); PK4(p1, 0, pa2); PK4(p1, 8, pa3);
#undef PK4
}
__device__ __forceinline__ void qkt(f32x16& p0, f32x16& p1, const bf16* Ks, const bf16x8* qr, int r32, int hi) {
  p0 = f32x16{}; p1 = f32x16{};
  for (int d0 = 0; d0 < 8; ++d0) { int cb = (d0 * 16 + hi * 8) * 2;
    bf16x8 b0 = *reinterpret_cast<const bf16x8*>((const char*)Ks + KSWZ(r32, cb));
    bf16x8 b1 = *reinterpret_cast<const bf16x8*>((const char*)Ks + KSWZ(32 + r32, cb));
    p0 = __builtin_amdgcn_mfma_f32_32x32x16_bf16(b0, qr[d0], p0, 0, 0, 0);
    p1 = __builtin_amdgcn_mfma_f32_32x32x16_bf16(b1, qr[d0], p1, 0, 0, 0); }
}
__device__ __forceinline__ int v_st(int k, int c) { const int kk = (k & ~0xC) | ((k & 4) << 1) | ((k & 8) >> 1); return ((kk >> 3) * 4 + (c >> 5)) * 512 + ((kk & 7) * 32 + (c & 31)) * 2; }
__device__ __forceinline__ int v_rd_base(int lane) { return ((lane & 3) << 3) | (((lane >> 2) & 3) << 6) | (((lane >> 4) & 1) << 5) | (((lane >> 5) & 1) << 8); }
constexpr int v_rd_off(int d0, int ks, int half) { return d0 * 512 + ks * 4096 + half * 2048; }
template <int OFF> __device__ __forceinline__ s16x4 tr_read(int vb) {
  s16x4 r; asm volatile("ds_read_b64_tr_b16 %0, %1 offset:%2" : "=&v"(r) : "v"(vb), "i"(OFF) : "memory"); return r;
}
template <int D0> __device__ __forceinline__ void pv_one(f32x16& od, int vb, bf16x8 pa0, bf16x8 pa1, bf16x8 pa2, bf16x8 pa3) {
  const s16x4 l0 = tr_read<v_rd_off(D0, 0, 0)>(vb), h0 = tr_read<v_rd_off(D0, 0, 1)>(vb), l1 = tr_read<v_rd_off(D0, 1, 0)>(vb), h1 = tr_read<v_rd_off(D0, 1, 1)>(vb);
  const s16x4 l2 = tr_read<v_rd_off(D0, 2, 0)>(vb), h2 = tr_read<v_rd_off(D0, 2, 1)>(vb), l3 = tr_read<v_rd_off(D0, 3, 0)>(vb), h3 = tr_read<v_rd_off(D0, 3, 1)>(vb);
  asm volatile("s_waitcnt lgkmcnt(0)" ::: "memory"); SBAR();
#define PK(L, H) (bf16x8){L[0], L[1], L[2], L[3], H[0], H[1], H[2], H[3]}
  od = __builtin_amdgcn_mfma_f32_32x32x16_bf16(pa0, PK(l0, h0), od, 0, 0, 0);
  od = __builtin_amdgcn_mfma_f32_32x32x16_bf16(pa1, PK(l1, h1), od, 0, 0, 0);
  od = __builtin_amdgcn_mfma_f32_32x32x16_bf16(pa2, PK(l2, h2), od, 0, 0, 0);
  od = __builtin_amdgcn_mfma_f32_32x32x16_bf16(pa3, PK(l3, h3), od, 0, 0, 0);
#undef PK
}
__device__ __forceinline__ void pv_d0(f32x16* o, int vb, bf16x8 pa0, bf16x8 pa1, bf16x8 pa2, bf16x8 pa3) {
  pv_one<0>(o[0], vb, pa0, pa1, pa2, pa3); pv_one<1>(o[1], vb, pa0, pa1, pa2, pa3); pv_one<2>(o[2], vb, pa0, pa1, pa2, pa3); pv_one<3>(o[3], vb, pa0, pa1, pa2, pa3);
}

template <typename TQ>
__device__ __forceinline__ void attn_dense_body(const TQ* __restrict__ Qb, const bf16* __restrict__ Kh, const bf16* __restrict__ Vh,
                                                bf16* __restrict__ Ob, int seq, char* lds) {
  using St = Stage<bf16>; using SQ = Stage<TQ>;
  const int tid = tid_l(), wid = tid >> 6, lane = tid & 63, r32 = lane & 31, hi = lane >> 5;
  bf16* V_lds = (bf16*)lds; bf16* K_lds = (bf16*)(lds + 2 * SHM_V);
  float* ws = (float*)(lds + 2 * SHM_V + 2 * SHM_K) + wid * 64; float* li_l = ws; float* al_l = ws + 32;
  float m_reg = -1e30f, l_reg = 0; f32x16 o[4] = {}; bf16x8 qr[8];
  const TQ* Qw = Qb + (long)(wid * QBLK + r32) * LDQ + hi * 8;
#pragma unroll
  for (int d0 = 0; d0 < 8; ++d0) qr[d0] = SQ::tobf(SQ::ld8(Qw + d0 * 16));
  const int sr = tid >> 4, sc = (tid & 15) * 8, vst0 = v_st(sr, sc), vst1 = v_st(32 + sr, sc);
  const int vb0 = (int)(uintptr_t)V_lds + v_rd_base(lane);
  struct { typename St::T vs0, vs1, ks0, ks1; } sr_[SDEPTH];
#define SLOAD(i, k0) do { sr_[i].vs0 = St::ld8(&Vh[(long)((k0) + sr) * LDK + sc]); sr_[i].vs1 = St::ld8(&Vh[(long)((k0) + 32 + sr) * LDK + sc]); \
    sr_[i].ks0 = St::ld8(&Kh[(long)((k0) + sr) * LDK + sc]); sr_[i].ks1 = St::ld8(&Kh[(long)((k0) + 32 + sr) * LDK + sc]); } while (0)
#define SWRITE(b, i) do { *(bf16x8*)((char*)V_lds + (b) * SHM_V + vst0) = St::tobf(sr_[i].vs0);          \
    *(bf16x8*)((char*)V_lds + (b) * SHM_V + vst1) = St::tobf(sr_[i].vs1); int kc = sc * 2;               \
    *(bf16x8*)((char*)K_lds + (b) * SHM_K + KSWZ(sr, kc)) = St::tobf(sr_[i].ks0);                       \
    *(bf16x8*)((char*)K_lds + (b) * SHM_K + KSWZ(32 + sr, kc)) = St::tobf(sr_[i].ks1); } while (0)
#define SWAIT() do { if constexpr (SDEPTH == 2) asm volatile("s_waitcnt vmcnt(4)" ::: "memory"); else asm volatile("s_waitcnt vmcnt(0)" ::: "memory"); } while (0)
#define RESC(a) do { if (__any((a) < 1.f)) { if (hi == 0) al_l[r32] = (a); asm volatile("s_waitcnt lgkmcnt(0)" ::: "memory"); \
    for (int d = 0; d < 4; ++d) for (int r = 0; r < 16; ++r) o[d][r] *= al_l[crow(r, hi)]; } } while (0)
  f32x16 pA0, pA1, pB0, pB1; float mnA, mnB, alA, alB; bf16x8 pa0, pa1, pa2, pa3; const int NT = seq / KVBLK;
  constexpr int SE = 0, SO = SDEPTH - 1;
  SLOAD(SE, 0); asm volatile("s_waitcnt vmcnt(0)" ::: "memory"); SWRITE(0, SE); __syncthreads();
  qkt(pA0, pA1, K_lds, qr, r32, hi); partialSM(pA0, pA1, m_reg, mnA, alA);
  SLOAD(SO, KVBLK); if constexpr (SDEPTH == 2) { if (2 < NT) SLOAD(SE, 2 * KVBLK); }
  SWAIT(); SWRITE(1, SO); __syncthreads();
  for (int j = 1; j + 1 < NT; j += 2) {
    SBAR(); qkt(pB0, pB1, (bf16*)((char*)K_lds + SHM_K), qr, r32, hi);
    finishSM(pA0, pA1, alA, l_reg, pa0, pa1, pa2, pa3); SBAR();
    SLOAD(SO, (j + SDEPTH) * KVBLK); SBAR();
    pv_d0(o, vb0, pa0, pa1, pa2, pa3); partialSM(pB0, pB1, m_reg, mnB, alB);
    __syncthreads(); SWAIT(); SWRITE(0, SE);
    RESC(alB); __syncthreads();
    SBAR(); qkt(pA0, pA1, K_lds, qr, r32, hi);
    finishSM(pB0, pB1, alB, l_reg, pa0, pa1, pa2, pa3); SBAR();
    if (SDEPTH == 1 || j + 3 < NT) SLOAD(SE, (j + 1 + SDEPTH) * KVBLK); SBAR();
    pv_d0(o, vb0 + (int)SHM_V, pa0, pa1, pa2, pa3); partialSM(pA0, pA1, m_reg, mnA, alA);
    __syncthreads(); SWAIT(); SWRITE(1, SO);
    RESC(alA); __syncthreads();
  }
  SBAR(); qkt(pB0, pB1, (bf16*)((char*)K_lds + SHM_K), qr, r32, hi);
  finishSM(pA0, pA1, alA, l_reg, pa0, pa1, pa2, pa3); SBAR();
  pv_d0(o, vb0, pa0, pa1, pa2, pa3); partialSM(pB0, pB1, m_reg, mnB, alB);
  __syncthreads(); RESC(alB);
  finishSM(pB0, pB1, alB, l_reg, pa0, pa1, pa2, pa3); SBAR();
  pv_d0(o, vb0 + (int)SHM_V, pa0, pa1, pa2, pa3);
  if (hi == 0) li_l[r32] = l_reg; asm volatile("s_waitcnt lgkmcnt(0)" ::: "memory");
  float rli[16];
#pragma unroll
  for (int r = 0; r < 16; ++r) rli[r] = __builtin_amdgcn_rcpf(li_l[crow(r, hi)]);
  bf16* Ow = Ob + (long)(wid * QBLK) * LDO;
#pragma unroll
  for (int r = 0; r < 16; ++r) { int orow = crow(r, hi);
    for (int d0 = 0; d0 < 4; ++d0) Ow[(long)orow * LDO + d0 * 32 + r32] = __float2bfloat16(o[d0][r] * rli[r]); }
#undef SLOAD
#undef SWRITE
#undef SWAIT
#undef RESC
}
}
#define LAS __attribute__((address_space(3)))
typedef unsigned short bf16_t;
typedef short bf16x8 __attribute__((ext_vector_type(8)));
typedef float f32x4 __attribute__((ext_vector_type(4)));
typedef float f32x16 __attribute__((ext_vector_type(16)));
typedef unsigned u32x4 __attribute__((ext_vector_type(4)));
typedef unsigned u32x2 __attribute__((ext_vector_type(2)));

constexpr int DM = 1024, NB = 8, SEQ = 4096, CTXL = 256, TPB = SEQ + CTXL, MT = NB * TPB, DFF = 2816, DEPTH = 4;
constexpr int NQKV = 1536, NGIN = 3328;
constexpr float EPS = 1e-6f;
constexpr int LDS_BYTES = 147456;
constexpr int NTHREADS = 512;

constexpr size_t MiB = 1u << 20;
constexpr size_t WS_MOD = 1 * MiB;
constexpr size_t WS_W1T = 3 * MiB;
constexpr size_t WS_W2T = WS_W1T + 88 * MiB;
constexpr size_t WS_WQKVT = WS_W2T + 44 * MiB;
constexpr size_t WS_WOAT = WS_WQKVT + 6 * MiB;
constexpr size_t WS_WGINT = WS_WOAT + 4 * MiB;
constexpr size_t WS_WGOT = WS_WGINT + 13 * MiB;
constexpr size_t WS_HRES = WS_WGOT + 4 * MiB;
constexpr size_t WS_U = WS_HRES + 136 * MiB;
constexpr size_t WS_Y = WS_U + 68 * MiB;
constexpr size_t WS_BIG = WS_Y + 68 * MiB;
constexpr size_t WS_ATTNO = WS_BIG + 102 * MiB;
constexpr size_t WS_END = WS_BIG + 221 * MiB;
constexpr size_t WS_PART_IN_OUT = 112 * MiB;
static_assert((size_t)MT * NGIN * 2 <= 221 * MiB && (size_t)MT * DFF * 2 <= 221 * MiB && (size_t)MT * NQKV * 2 <= 102 * MiB, "ws map");

struct Args { const float* in[20]; float* out; unsigned char* ws; };
typedef const __attribute__((address_space(4))) Args* KA;
__device__ __forceinline__ KA kargs() { KA p = (KA)__builtin_amdgcn_kernarg_segment_ptr(); asm volatile("" : "+s"(p)); return p; }
enum { I_X = 0, I_C, I_CTX, I_CCTX, I_ADAW, I_ADAB, I_NPRE, I_NPOST, I_FW1, I_FW2, I_AQKV, I_AQG, I_AKG, I_AWO, I_GWIN, I_GWA1, I_GWA2, I_GBA, I_GOG, I_GWO };

__device__ __forceinline__ unsigned cvtpk(float lo, float hi) { return pg8::cvt_pk_bf16(lo, hi); }
__device__ __forceinline__ float bf_lo(unsigned w) { return __uint_as_float(w << 16); }
__device__ __forceinline__ float bf_hi(unsigned w) { return __uint_as_float(w & 0xffff0000u); }
__device__ __forceinline__ float bf_f(bf16_t h) { return __uint_as_float(((unsigned)h) << 16); }
__device__ __forceinline__ bf16_t f_bf(float f) { return (bf16_t)(cvtpk(f, 0.f) & 0xffffu); }
__device__ __forceinline__ float wave_sum(float v) {
#pragma unroll
    for (int o = 1; o < 64; o <<= 1) v += __shfl_xor(v, o);
    return v;
}
__device__ __forceinline__ float silu(float x) { return x / (1.0f + __expf(-x)); }

__device__ __forceinline__ void phase_mod(KA a, LAS unsigned char* lds) {
    LAS float* sv = (LAS float*)lds;
    LAS float* red = (LAS float*)(lds + 9 * 1024 * 4);
    const int tid = tid_l(), lane = tid & 63, wave = tid >> 6;
    const float* c = a->in[I_C]; const float* cc = a->in[I_CCTX];
    for (int i = tid; i < 9 * 1024; i += NTHREADS) { const int v = i >> 10, k = i & 1023; const float x = v < 8 ? c[v * 1024 + k] : cc[k]; sv[i] = silu(x); }
    __syncthreads();
    float* mod = (float*)(a->ws + WS_MOD);
    for (int it = blk_l(); it < DEPTH * 144; it += grd_l()) {
        const int L = it / 144, cgp = it % 144;
        const float* w = a->in[I_ADAW] + (size_t)L * 1024 * 9216 + cgp * 64 + lane;
        float acc[9];
#pragma unroll
        for (int v = 0; v < 9; ++v) acc[v] = 0.f;
        const int k0 = wave * 128;
#pragma unroll 8
        for (int k = 0; k < 128; ++k) { const float wv = w[(size_t)(k0 + k) * 9216];
#pragma unroll
            for (int v = 0; v < 9; ++v) acc[v] += sv[v * 1024 + k0 + k] * wv; }
#pragma unroll
        for (int v = 0; v < 9; ++v) red[(wave * 9 + v) * 64 + lane] = acc[v];
        __syncthreads();
        for (int i = tid; i < 576; i += NTHREADS) { const int v = i >> 6, l = i & 63; float s = 0.f;
#pragma unroll
            for (int w8 = 0; w8 < 8; ++w8) s += red[(w8 * 9 + v) * 64 + l];
            s += a->in[I_ADAB][L * 9216 + cgp * 64 + l];
            mod[(size_t)(L * 9 + v) * 9216 + cgp * 64 + l] = s; }
        __syncthreads();
    }
}

__device__ __forceinline__ unsigned pk2(float lo, float hi) { return cvtpk(lo, hi); }
__device__ __forceinline__ void tr_item(const float* W, int Nsrc, int srccol0, int k0, bf16_t* dst  , int K, LAS float* scr, int lane) {
#pragma unroll 8
    for (int i = 0; i < 32; ++i) { const int kk = 2 * i + (lane >> 5); scr[kk * 33 + (lane & 31)] = W[(size_t)(k0 + kk) * Nsrc + srccol0 + (lane & 31)]; }
    asm volatile("s_waitcnt lgkmcnt(0)" ::: "memory");
    const int c = lane & 7;
#pragma unroll
    for (int j = 0; j < 4; ++j) { const int n = (lane >> 3) + 8 * j; const LAS float* s = scr + (8 * c) * 33 + n;
        u32x4 o; o.x = pk2(s[0 * 33], s[1 * 33]); o.y = pk2(s[2 * 33], s[3 * 33]); o.z = pk2(s[4 * 33], s[5 * 33]); o.w = pk2(s[6 * 33], s[7 * 33]);
        *(u32x4*)(dst + (size_t)n * K + 8 * c) = o; }
    asm volatile("s_waitcnt lgkmcnt(0)" ::: "memory");
}
__device__ __forceinline__ void phase_weights(KA a, LAS unsigned char* lds) {
    const int tid = tid_l(), lane = tid & 63, wave = tid >> 6;
    LAS float* scr = (LAS float*)(lds + 65536 + wave * 8704);
    const int gw = blk_l() * 8 + wave, NGW = grd_l() * 8;
    constexpr int I_W1 = 176 * 16, I_W2 = 32 * 44, I_QKV = 48 * 16, I_SQ = 32 * 16, I_GIN = 96 * 16;
    constexpr int N1 = 8 * I_W1, N2 = 8 * I_W2, N3 = 2 * I_QKV, N4 = 2 * I_SQ, N5 = 2 * I_GIN, N6 = 2 * I_SQ;
    constexpr int NITEMS = N1 + N2 + N3 + N4 + N5 + N6;
    for (int it = gw; it < NITEMS; it += NGW) {
        int r = it;
        if (r < N1) { const int mat = r / I_W1, q = r % I_W1, ng = q / 16, kb = q % 16; const int pn = ng >> 3, r0 = (ng & 7) * 32;
            const int src = r0 < 128 ? 128 * pn + r0 : DFF + 128 * pn + (r0 - 128);
            tr_item(a->in[I_FW1] + (size_t)mat * 1024 * 5632, 5632, src, kb * 64, (bf16_t*)(a->ws + WS_W1T) + (size_t)mat * 5632 * 1024 + (size_t)(ng * 32) * 1024 + kb * 64, 1024, scr, lane); continue; }
        r -= N1;
        if (r < N2) { const int mat = r / I_W2, q = r % I_W2, ng = q / 44, kb = q % 44;
            tr_item(a->in[I_FW2] + (size_t)mat * 2816 * 1024, 1024, ng * 32, kb * 64, (bf16_t*)(a->ws + WS_W2T) + (size_t)mat * 1024 * 2816 + (size_t)(ng * 32) * 2816 + kb * 64, 2816, scr, lane); continue; }
        r -= N2;
        if (r < N3) { const int mat = r / I_QKV, q = r % I_QKV, ng = q / 16, kb = q % 16;
            tr_item(a->in[I_AQKV] + (size_t)mat * 1024 * 1536, 1536, ng * 32, kb * 64, (bf16_t*)(a->ws + WS_WQKVT) + (size_t)mat * 1536 * 1024 + (size_t)(ng * 32) * 1024 + kb * 64, 1024, scr, lane); continue; }
        r -= N3;
        if (r < N4) { const int mat = r / I_SQ, q = r % I_SQ, ng = q / 16, kb = q % 16;
            tr_item(a->in[I_AWO] + (size_t)mat * 1024 * 1024, 1024, ng * 32, kb * 64, (bf16_t*)(a->ws + WS_WOAT) + (size_t)mat * 1024 * 1024 + (size_t)(ng * 32) * 1024 + kb * 64, 1024, scr, lane); continue; }
        r -= N4;
        if (r < N5) { const int mat = r / I_GIN, q = r % I_GIN, ng = q / 16, kb = q % 16;
            tr_item(a->in[I_GWIN] + (size_t)mat * 1024 * 3072, 3072, ng * 32, kb * 64, (bf16_t*)(a->ws + WS_WGINT) + (size_t)mat * NGIN * 1024 + (size_t)(ng * 32) * 1024 + kb * 64, 1024, scr, lane); continue; }
        r -= N5;
        { const int mat = r / I_SQ, q = r % I_SQ, ng = q / 16, kb = q % 16;
            tr_item(a->in[I_GWO] + (size_t)mat * 1024 * 1024, 1024, ng * 32, kb * 64, (bf16_t*)(a->ws + WS_WGOT) + (size_t)mat * 1024 * 1024 + (size_t)(ng * 32) * 1024 + kb * 64, 1024, scr, lane); }
    }
    const int gt = blk_l() * NTHREADS + tid, NGT = grd_l() * NTHREADS;
    for (int i = gt; i < 2 * 256 * 128; i += NGT) {
        const int m = i / (256 * 128), q = i % (256 * 128), j = q / 128, k8 = (q % 128) * 8;
        float v[8];
#pragma unroll
        for (int e = 0; e < 8; ++e) v[e] = j < 32 ? a->in[I_GWA1][((size_t)(m * 2 + (j >> 4)) * 1024 + k8 + e) * 16 + (j & 15)] : 0.f;
        u32x4 o; o.x = pk2(v[0], v[1]); o.y = pk2(v[2], v[3]); o.z = pk2(v[4], v[5]); o.w = pk2(v[6], v[7]);
        *(u32x4*)((bf16_t*)(a->ws + WS_WGINT) + (size_t)m * NGIN * 1024 + (size_t)(3072 + j) * 1024 + k8) = o;
    }
}

struct RowP { int Lpost, jpost; float gs; int Lpre, jpre; bool final_out; };
template <bool FROM_INPUT>
__device__ __forceinline__ void row_pair(KA a, const RowP p, int ra, int rb, bool ona, bool onb, int lane) {
    float* hres = (float*)(a->ws + WS_HRES); const float* mod = (const float*)(a->ws + WS_MOD);
    const bf16_t* Y = (const bf16_t*)(a->ws + WS_Y); bf16_t* U = (bf16_t*)(a->ws + WS_U);
    const float* gpost = a->in[I_NPOST] + (size_t)(p.Lpost * 3 + (p.jpost < 0 ? 0 : p.jpost)) * DM; const float* gpre = a->in[I_NPRE] + (size_t)(p.Lpre * 3 + (p.jpre < 0 ? 0 : p.jpre)) * DM;
    int rr[2] = {ra, rb}, bb[2], pp[2]; bool cx[2], on[2] = {ona, onb};
#pragma unroll
    for (int k = 0; k < 2; ++k) { bb[k] = rr[k] / TPB; pp[k] = rr[k] - bb[k] * TPB; cx[k] = pp[k] < CTXL; }
    f32x4 h[2][4], y[2][4];
#pragma unroll
    for (int k = 0; k < 2; ++k) {
        if (FROM_INPUT) { const float* src = cx[k] ? a->in[I_CTX] + (size_t)(bb[k] * CTXL + pp[k]) * DM : a->in[I_X] + (size_t)(bb[k] * SEQ + pp[k] - CTXL) * DM;
#pragma unroll
            for (int q = 0; q < 4; ++q) h[k][q] = *(const f32x4*)(src + 4 * lane + 256 * q); }
        else {
#pragma unroll
            for (int q = 0; q < 4; ++q) h[k][q] = *(const f32x4*)(hres + (size_t)rr[k] * DM + 4 * lane + 256 * q); }
        if (p.jpost >= 0) {
#pragma unroll
            for (int q = 0; q < 4; ++q) { const u32x2 w = *(const u32x2*)(Y + (size_t)rr[k] * DM + 4 * lane + 256 * q);
                y[k][q] = (f32x4){bf_lo(w.x), bf_hi(w.x), bf_lo(w.y), bf_hi(w.y)}; } }
    }
#pragma unroll
    for (int k = 0; k < 2; ++k) {
        const int mi = cx[k] ? 8 : bb[k];
        if (p.jpost >= 0) {
            float ss = 0.f;
#pragma unroll
            for (int q = 0; q < 4; ++q) ss += (y[k][q].x * y[k][q].x + y[k][q].y * y[k][q].y) + (y[k][q].z * y[k][q].z + y[k][q].w * y[k][q].w);
            const float rstd = 1.0f / sqrtf(wave_sum(ss) * (1.0f / DM) + EPS);
            const float* gate = mod + (size_t)(p.Lpost * 9 + mi) * 9216 + (3 * p.jpost + 2) * 1024;
#pragma unroll
            for (int q = 0; q < 4; ++q) { const f32x4 gt = *(const f32x4*)(gate + 4 * lane + 256 * q), gg = *(const f32x4*)(gpost + 4 * lane + 256 * q);
                h[k][q] += p.gs * gt * (y[k][q] * rstd * gg); }
        }
        if (on[k]) {
            if (p.final_out) { float* o = a->out + (size_t)(bb[k] * SEQ + pp[k] - CTXL) * DM;
#pragma unroll
                for (int q = 0; q < 4; ++q) *(f32x4*)(o + 4 * lane + 256 * q) = h[k][q]; }
            else {
#pragma unroll
                for (int q = 0; q < 4; ++q) *(f32x4*)(hres + (size_t)rr[k] * DM + 4 * lane + 256 * q) = h[k][q]; }
        }
        if (p.jpre >= 0) {
            float ss = 0.f;
#pragma unroll
            for (int q = 0; q < 4; ++q) ss += (h[k][q].x * h[k][q].x + h[k][q].y * h[k][q].y) + (h[k][q].z * h[k][q].z + h[k][q].w * h[k][q].w);
            const float rstd = 1.0f / sqrtf(wave_sum(ss) * (1.0f / DM) + EPS);
            const float* mb = mod + (size_t)(p.Lpre * 9 + mi) * 9216 + (3 * p.jpre) * 1024;
            if (on[k]) {
#pragma unroll
                for (int q = 0; q < 4; ++q) { const f32x4 sh = *(const f32x4*)(mb + 4 * lane + 256 * q), sc = *(const f32x4*)(mb + 1024 + 4 * lane + 256 * q), gg = *(const f32x4*)(gpre + 4 * lane + 256 * q);
                    const f32x4 u = h[k][q] * rstd * gg * (1.0f + sc) + sh;
                    u32x2 w; w.x = cvtpk(u.x, u.y); w.y = cvtpk(u.z, u.w); *(u32x2*)(U + (size_t)rr[k] * DM + 4 * lane + 256 * q) = w; } }
        }
    }
}
template <bool FROM_INPUT>
__device__ __forceinline__ void row_pass(KA a, const RowP p) {
    const int tid = tid_l(), lane = tid & 63, wave = tid >> 6;
    const int gw = blk_l() * 8 + wave, NGW = grd_l() * 8;
    for (int r0 = gw; r0 < MT; r0 += 2 * NGW) { const int r1 = r0 + NGW; const bool on1 = r1 < MT; row_pair<FROM_INPUT>(a, p, r0, on1 ? r1 : r0, true, on1, lane); }
}
__device__ __forceinline__ void row_pass_queue(KA a, const RowP p, unsigned* sig, unsigned need_lat, unsigned need_ctx, bool with_ctx, LAS unsigned char* lds) {
    const int tid = tid_l(), lane = tid & 63, wave = tid >> 6;
    volatile LAS unsigned* tk = (volatile LAS unsigned*)(lds + LDS_BYTES - 64 + 16);
    const unsigned nchunk = 512u + (with_ctx ? 32u : 0u);
    bool rdy_lat = false, rdy_ctx = false;
    for (;;) {
        if (tid == 0) tk[0] = __hip_atomic_fetch_add(sig + 128, 1u, __ATOMIC_RELAXED, __HIP_MEMORY_SCOPE_AGENT);
        __syncthreads();
        const unsigned t = tk[0];
        __syncthreads();
        if (t >= nchunk) break;
        const bool isc = t >= 512u;
        if (isc ? !rdy_ctx : !rdy_lat) {
            if (tid == 0) { unsigned* w = sig + (isc ? 64 : 0); const unsigned need = isc ? need_ctx : need_lat; unsigned sp = 0;
                while (__hip_atomic_load(w, __ATOMIC_RELAXED, __HIP_MEMORY_SCOPE_AGENT) < need) { __builtin_amdgcn_s_sleep(2); if (++sp > (1u << 22)) break; }
                __builtin_amdgcn_fence(__ATOMIC_ACQUIRE, "agent"); asm volatile("s_waitcnt vmcnt(0)" ::: "memory"); }
            __syncthreads();
            if (isc) rdy_ctx = true; else rdy_lat = true;
        }
        int rbase;
        if (!isc) { const int lr = (int)t * 64; rbase = (lr >> 12) * TPB + CTXL + (lr & 4095); }
        else { const int cr = ((int)t - 512) * 64; rbase = (cr >> 8) * TPB + (cr & 255); }
#pragma unroll 1
        for (int it = 0; it < 4; ++it) { const int r0 = rbase + wave * 8 + 2 * it; row_pair<false>(a, p, r0, r0 + 1, true, true, lane); }
    }
}

__device__ __forceinline__ void phase_qknorm_rope(KA a, int m) {
    const int tid = tid_l(), lane = tid & 63, wave = tid >> 6;
    const int gw = blk_l() * 8 + wave, NGW = grd_l() * 8;
    bf16_t* QKV = (bf16_t*)(a->ws + WS_BIG);
    const int i = lane & 31, hl = lane >> 5, d1 = i + 64 * hl, d2 = d1 + 32;
    const float qg1 = a->in[I_AQG][m * 128 + d1], qg2 = a->in[I_AQG][m * 128 + d2], kg1 = a->in[I_AKG][m * 128 + d1], kg2 = a->in[I_AKG][m * 128 + d2];
    const float inv = exp2f(-(float)i * (13.287712379549449f / 32.0f));
    for (int r = gw; r < MT; r += NGW) {
        const int b = r / TPB, pos = r - b * TPB; const bool isctx = pos < CTXL;
        float cs = 1.f, sn = 0.f;
        if (!isctx) { const int t = pos - CTXL; const float p = (float)(hl ? (t & 63) : (t >> 6)); const float ang = p * inv; cs = cosf(ang); sn = sinf(ang); }
        bf16_t* row = QKV + (size_t)r * NQKV;
#pragma unroll
        for (int hd = 0; hd < 10; ++hd) {
            float x1 = bf_f(row[hd * 128 + d1]), x2 = bf_f(row[hd * 128 + d2]);
            const float rstd = 1.0f / sqrtf(wave_sum(x1 * x1 + x2 * x2) * (1.0f / 128.0f) + EPS);
            x1 *= rstd * (hd < 8 ? qg1 : kg1); x2 *= rstd * (hd < 8 ? qg2 : kg2);
            const float o1 = x1 * cs - x2 * sn, o2 = x2 * cs + x1 * sn;
            row[hd * 128 + d1] = f_bf(o1); row[hd * 128 + d2] = f_bf(o2);
        }
    }
}

__device__ __forceinline__ void phase_attention(KA a, char* lds) {
    const int G = grd_l(); const int bx = blk_l(); const int vcu = (G % 8 == 0) ? (bx % 8) * (G / 8) + bx / 8 : bx;
    const att::bf16* QKV = (const att::bf16*)(a->ws + WS_BIG); att::bf16* AO = (att::bf16*)(a->ws + WS_ATTNO);
    for (int u = vcu; u < 1024 + 64; u += G) {
        int b, h, q0, seq;
        if (u < 1024) { const int grp = u >> 6, within = u & 63; b = grp >> 1; h = (grp & 1) * 4 + (within >> 4); q0 = CTXL + (within & 15) * 256; seq = TPB; }
        else { const int cu = u - 1024; b = cu >> 3; h = cu & 7; q0 = 0; seq = CTXL; }
        const int kvh = h >> 2; const size_t rb = (size_t)b * TPB;
        att::attn_dense_body<att::bf16>(QKV + (rb + q0) * NQKV + h * 128, QKV + rb * NQKV + 1024 + kvh * 128, QKV + rb * NQKV + 1280 + kvh * 128, AO + (rb + q0) * DM + h * 128, seq, lds);
        __syncthreads();
    }
}

namespace gla {
__device__ __forceinline__ int crow(int r, int hi) { return (r & 3) + 8 * (r >> 2) + 4 * hi; }
constexpr int QD_OFF = 0, KI_OFF = 17408, KET_OFF = 34816, VT_OFF = 53248  , SC_OFF = 90112, TS_OFF = 99328  , GSUM_OFF = 107520;
constexpr int STT_OFF = 0  , VTS_OFF = 34816  ;
constexpr size_t KET_BYTES = (size_t)2 * NB * 4 * 68 * 8192 * 2;
constexpr size_t SC_GOFF = KET_BYTES + (size_t)2 * NB * 4 * 68 * 128 * 4;
}
__device__ __forceinline__ void phase_gla_prep(KA a, int m, LAS unsigned char* lds) {
    using namespace gla;
    const int tid = tid_l(), lane = tid & 63, wave = __builtin_amdgcn_readfirstlane(tid >> 6), r32 = lane & 31, hi = lane >> 5;
    bf16_t* Gb = (bf16_t*)(a->ws + WS_BIG);
    const int d = tid & 127, tg = tid >> 7;
    LAS float* ts = (LAS float*)(lds + TS_OFF); LAS float* gsum = (LAS float*)(lds + GSUM_OFF);
    for (int item = blk_l(); item < NB * 4 * 68; item += grd_l()) {
        const int k = item % 68, h = (item / 68) & 3, b = item / 272;
        const int row0 = b * TPB + 64 * k;
        bf16_t* gp = Gb + (size_t)row0 * NGIN;
        bf16_t qn[16], kn[16];
#pragma unroll
        for (int ii = 0; ii < 16; ++ii) { qn[ii] = gp[(size_t)(16 * tg + ii) * NGIN + h * 128 + d]; kn[ii] = gp[(size_t)(16 * tg + ii) * NGIN + 512 + h * 128 + d]; }
        const u32x2 tw = *(const u32x2*)(gp + (size_t)(tid >> 3) * NGIN + 3072 + 4 * (tid & 7));
        __syncthreads();
        { const int e0 = 4 * (tid & 7), dr = e0 >> 4, r = e0 & 15; LAS float* tp = ts + dr * 1024 + (tid >> 3) * 16 + r;
          tp[0] = bf_lo(tw.x); tp[1] = bf_hi(tw.x); tp[2] = bf_lo(tw.y); tp[3] = bf_hi(tw.y); }
        __syncthreads();
        for (int dir = 0; dir < 2; ++dir) {
            float w2[16];
#pragma unroll
            for (int r = 0; r < 16; ++r) w2[r] = a->in[I_GWA2][((size_t)(m * 2 + dir) * 16 + r) * 512 + h * 128 + d];
            const float bav = a->in[I_GBA][(size_t)(m * 2 + dir) * 512 + h * 128 + d];
            float cum[16];
#pragma unroll
            for (int ii = 0; ii < 16; ++ii) { float x = bav;
#pragma unroll
                for (int r = 0; r < 16; ++r) x += ts[dir * 1024 + (16 * tg + ii) * 16 + r] * w2[r];
                cum[ii] = (fminf(x, 0.f) - __logf(1.0f + __expf(-fabsf(x)))) * (1.0f / 16.0f); }
            if (dir == 0) {
#pragma unroll
                for (int ii = 1; ii < 16; ++ii) cum[ii] += cum[ii - 1];
                gsum[tg * 128 + d] = cum[15];
            } else {
#pragma unroll
                for (int ii = 14; ii >= 0; --ii) cum[ii] += cum[ii + 1];
                gsum[tg * 128 + d] = cum[0];
            }
            __syncthreads();
            const size_t cidx = (size_t)((dir * NB + b) * 4 + h) * 68 + k;
            { const float s0 = gsum[d], s1 = gsum[128 + d], s2 = gsum[256 + d], s3 = gsum[384 + d];
              const float total = (s0 + s1) + (s2 + s3);
              float off;
              if (dir == 0) off = (tg > 0 ? s0 : 0.f) + (tg > 1 ? s1 : 0.f) + (tg > 2 ? s2 : 0.f);
              else off = (tg < 3 ? s3 : 0.f) + (tg < 2 ? s2 : 0.f) + (tg < 1 ? s1 : 0.f);
              unsigned kep[8];
              bf16_t* qdst = gp + (dir ? 512 : 0) + h * 128 + d;
#pragma unroll
              for (int ii = 0; ii < 16; ii += 2) {
                  const float c0 = cum[ii] + off, c1 = cum[ii + 1] + off;
                  const float q0 = bf_f(qn[ii]), q1 = bf_f(qn[ii + 1]), k0 = bf_f(kn[ii]), k1 = bf_f(kn[ii + 1]);
                  const int i0 = 16 * tg + ii;
                  const bf16_t qd0 = f_bf(q0 * 0.08838834764831845f * __expf(c0)), qd1 = f_bf(q1 * 0.08838834764831845f * __expf(c1));
                  *(LAS bf16_t*)(lds + QD_OFF + (i0 * 136 + d) * 2) = qd0;
                  *(LAS bf16_t*)(lds + QD_OFF + ((i0 + 1) * 136 + d) * 2) = qd1;
                  qdst[(size_t)i0 * NGIN] = qd0; qdst[(size_t)(i0 + 1) * NGIN] = qd1;
                  *(LAS bf16_t*)(lds + KI_OFF + (i0 * 136 + d) * 2) = f_bf(k0 * __expf(-c0));
                  *(LAS bf16_t*)(lds + KI_OFF + ((i0 + 1) * 136 + d) * 2) = f_bf(k1 * __expf(-c1));
                  kep[ii >> 1] = cvtpk(k0 * __expf(total - c0), k1 * __expf(total - c1));
              }
              bf16_t* ketg = (bf16_t*)a->out + cidx * 8192 + d * 64 + 16 * tg;
              *(u32x4*)ketg = (u32x4){kep[0], kep[1], kep[2], kep[3]};
              *(u32x4*)(ketg + 8) = (u32x4){kep[4], kep[5], kep[6], kep[7]};
              if (tg == 0) ((float*)((unsigned char*)a->out + KET_BYTES))[cidx * 128 + d] = __expf(total);
            }
            __syncthreads();
            if (wave < 4) {
                const int ti = (wave >> 1) & 1, tj = wave & 1;
                f32x16 acc;
#pragma unroll
                for (int r = 0; r < 16; ++r) acc[r] = 0.f;
                const int aoff = QD_OFF + ((32 * ti + r32) * 136 + 8 * hi) * 2, boff = KI_OFF + ((32 * tj + r32) * 136 + 8 * hi) * 2;
#pragma unroll
                for (int ks = 0; ks < 8; ++ks) { const bf16x8 av = *(const LAS bf16x8*)(lds + aoff + ks * 32), bv = *(const LAS bf16x8*)(lds + boff + ks * 32);
                    acc = __builtin_amdgcn_mfma_f32_32x32x16_bf16(av, bv, acc, 0, 0, 0); }
                bf16_t* scg = (bf16_t*)((unsigned char*)a->out + SC_GOFF) + cidx * 4096;
#pragma unroll
                for (int r = 0; r < 16; ++r) { const int i = 32 * ti + crow(r, hi), j = 32 * tj + r32; const bool keep = dir == 0 ? (j <= i) : (j >= i);
                    scg[i * 64 + j] = f_bf(keep ? acc[r] : 0.f); }
            }
            __syncthreads();
        }
    }
}
__device__ __forceinline__ void phase_gla_scan(KA a, int m, LAS unsigned char* lds) {
    using namespace gla;
    const int tid = tid_l(), lane = tid & 63, wave = __builtin_amdgcn_readfirstlane(tid >> 6), r32 = lane & 31, hi = lane >> 5;
    const int G = grd_l(); const int bx = blk_l(); const int vcu = (G % 8 == 0) ? (bx % 8) * (G / 8) + bx / 8 : bx;
    const bf16_t* Gb = (const bf16_t*)(a->ws + WS_BIG);
    const int dv = tid & 63, tgv = tid >> 6;
    const int ti = (wave >> 1) & 1, tj = wave & 1, role = wave >> 2, sd = wave >> 1, sv = wave & 1;
    for (int item = vcu; item < 256; item += G) {
        const int vs = item & 3, dir = (item >> 2) & 1, h = (item >> 3) & 3, b = item >> 5;
        bf16_t* Oo = (bf16_t*)(a->ws + (dir == 0 ? WS_U : WS_Y));
        const size_t cbase = (size_t)((dir * NB + b) * 4 + h) * 68;
        const bf16_t* ketb = (const bf16_t*)a->out + cbase * 8192 + (32 * sd + r32) * 64 + 8 * hi;
        const bf16_t* scb = (const bf16_t*)((const unsigned char*)a->out + SC_GOFF) + cbase * 4096 + (32 * ti + r32) * 64 + 8 * hi;
        const float* decb = (const float*)((const unsigned char*)a->out + KET_BYTES) + cbase * 128 + 32 * sd + 4 * hi;
        const int qcol = (dir ? 512 : 0) + h * 128 + 8 * hi, vcol = 1024 + h * 256 + vs * 64 + dv, ocol = h * 256 + vs * 64 + 32 * tj + r32;
        __syncthreads();
        for (int i = tid; i < 17408 / 4; i += NTHREADS) ((LAS unsigned*)(lds + STT_OFF))[i] = 0u;
        f32x16 st;
#pragma unroll
        for (int r = 0; r < 16; ++r) st[r] = 0.f;
        bf16x8 qa[8], ke[4], sa[4]; f32x4 dcv[4]; bf16_t vn[8];
#define GLA_K(c) (dir == 0 ? (c) : ((c) < 4 ? 3 - (c) : 71 - (c)))
#define GLA_ROW(c) ((size_t)b * TPB + 64 * GLA_K(c))
#define LD_QA(c) do { if (role == 1) { const size_t row_ = GLA_ROW(c); _Pragma("unroll") for (int ks = 0; ks < 8; ++ks) qa[ks] = *(const bf16x8*)(Gb + (row_ + 32 * ti + r32) * NGIN + qcol + 16 * ks); } } while (0)
#define LD_OIN(c) do { if (role == 1) { const int kk_ = GLA_K(c); _Pragma("unroll") for (int ks = 0; ks < 4; ++ks) sa[ks] = *(const bf16x8*)(scb + (size_t)kk_ * 4096 + 16 * ks); } } while (0)
#define LD_KE(c) do { const int kk_ = GLA_K(c); _Pragma("unroll") for (int ks = 0; ks < 4; ++ks) ke[ks] = *(const bf16x8*)(ketb + (size_t)kk_ * 8192 + 16 * ks); } while (0)
#define LD_DC(c) do { const int kk_ = GLA_K(c); _Pragma("unroll") for (int r4 = 0; r4 < 4; ++r4) dcv[r4] = *(const f32x4*)(decb + (size_t)kk_ * 128 + 8 * r4); } while (0)
#define LD_VN(c) do { const size_t row_ = GLA_ROW(c); _Pragma("unroll") for (int ii = 0; ii < 8; ++ii) vn[ii] = Gb[(row_ + 8 * tgv + ii) * NGIN + vcol]; } while (0)
        LD_VN(0); LD_QA(0); LD_OIN(0); LD_DC(0); LD_KE(0);
        for (int c = 0; c < 68; ++c) {
            const int p_ = c & 1; const size_t rowc_ = GLA_ROW(c); const bool more = c + 1 < 68;
            { u32x4 vp; vp.x = (unsigned)vn[0] | ((unsigned)vn[1] << 16); vp.y = (unsigned)vn[2] | ((unsigned)vn[3] << 16); vp.z = (unsigned)vn[4] | ((unsigned)vn[5] << 16); vp.w = (unsigned)vn[6] | ((unsigned)vn[7] << 16);
              *(LAS u32x4*)(lds + VTS_OFF + p_ * 9216 + (dv * 72 + 8 * tgv) * 2) = vp; }
            if (more) LD_VN(c + 1);
            __syncthreads();
            if (role == 1) {
                f32x16 acc;
#pragma unroll
                for (int r = 0; r < 16; ++r) acc[r] = 0.f;
                const int boff = STT_OFF + p_ * 17408 + ((32 * tj + r32) * 136 + 8 * hi) * 2;
#pragma unroll
                for (int ks = 0; ks < 8; ++ks) { const bf16x8 bv = *(const LAS bf16x8*)(lds + boff + ks * 32);
                    acc = __builtin_amdgcn_mfma_f32_32x32x16_bf16(qa[ks], bv, acc, 0, 0, 0); }
                if (more) LD_QA(c + 1);
                { const int voff = VTS_OFF + p_ * 9216 + ((32 * tj + r32) * 72 + 8 * hi) * 2;
#pragma unroll
                  for (int ks = 0; ks < 4; ++ks) { const bf16x8 bv = *(const LAS bf16x8*)(lds + voff + ks * 32);
                      acc = __builtin_amdgcn_mfma_f32_32x32x16_bf16(sa[ks], bv, acc, 0, 0, 0); } }
                if (more) LD_OIN(c + 1);
                bf16_t* op = Oo + (rowc_ + 32 * ti) * DM + ocol;
#pragma unroll
                for (int r = 0; r < 16; ++r) op[(size_t)crow(r, hi) * DM] = f_bf(acc[r]);
            }
            {
#pragma unroll
              for (int r = 0; r < 16; ++r) st[r] *= dcv[r >> 2][r & 3];
              if (more) LD_DC(c + 1);
              const int boff = VTS_OFF + p_ * 9216 + ((32 * sv + r32) * 72 + 8 * hi) * 2;
#pragma unroll
              for (int ks = 0; ks < 4; ++ks) { const bf16x8 bv = *(const LAS bf16x8*)(lds + boff + ks * 32);
                  st = __builtin_amdgcn_mfma_f32_32x32x16_bf16(ke[ks], bv, st, 0, 0, 0); }
              if (more) LD_KE(c + 1);
#pragma unroll
              for (int r4 = 0; r4 < 4; ++r4) { u32x2 w; w.x = cvtpk(st[4 * r4], st[4 * r4 + 1]); w.y = cvtpk(st[4 * r4 + 2], st[4 * r4 + 3]);
                  *(LAS u32x2*)(lds + STT_OFF + (p_ ^ 1) * 17408 + ((32 * sv + r32) * 136 + 32 * sd + 8 * r4 + 4 * hi) * 2) = w; }
            }
        }
#undef GLA_ROW
#undef LD_QA
#undef LD_OIN
#undef LD_KE
#undef LD_DC
#undef LD_VN
#undef GLA_K
    }
}

__device__ __forceinline__ void phase_gla_readout(KA a, int m, bool skip_ctx) {
    const int tid = tid_l(), lane = tid & 63, wave = tid >> 6;
    const int gw = blk_l() * 8 + wave, NGW = grd_l() * 8;
    const bf16_t* OF = (const bf16_t*)(a->ws + WS_U); const bf16_t* OB = (const bf16_t*)(a->ws + WS_Y); bf16_t* Gb = (bf16_t*)(a->ws + WS_BIG);
    const float* og = a->in[I_GOG] + (size_t)m * 1024;
    for (int r = gw; r < MT; r += NGW) {
        if (skip_ctx && (r % TPB) < CTXL) continue;
#pragma unroll
        for (int q = 0; q < 4; ++q) {
            const int col = 4 * lane + 256 * q;
            const u32x2 wf = *(const u32x2*)(OF + (size_t)r * DM + col), wb = *(const u32x2*)(OB + (size_t)r * DM + col), wr = *(const u32x2*)(Gb + (size_t)r * NGIN + 2048 + col);
            f32x4 s = (f32x4){bf_lo(wf.x) + bf_lo(wb.x), bf_hi(wf.x) + bf_hi(wb.x), bf_lo(wf.y) + bf_lo(wb.y), bf_hi(wf.y) + bf_hi(wb.y)};
            const float ss = wave_sum((s.x * s.x + s.y * s.y) + (s.z * s.z + s.w * s.w));
            const float rstd = 1.0f / sqrtf(ss * (1.0f / 256.0f) + EPS);
            const f32x4 gg = *(const f32x4*)(og + col);
            const f32x4 rr = (f32x4){bf_lo(wr.x), bf_hi(wr.x), bf_lo(wr.y), bf_hi(wr.y)};
            f32x4 o = s * rstd * gg; o.x *= silu(rr.x); o.y *= silu(rr.y); o.z *= silu(rr.z); o.w *= silu(rr.w);
            u32x2 w; w.x = cvtpk(o.x, o.y); w.y = cvtpk(o.z, o.w);
            *(u32x2*)(Gb + (size_t)r * NGIN + 2048 + col) = w;
        }
    }
}

__device__ __forceinline__ unsigned long long rt() { return __builtin_amdgcn_s_memrealtime(); }
#define XB_TMO      128
#define XB_XCNT(j)  (256  + 64 * (j))
#define XB_XSUB(j)  (1280 + 64 * (j))
#define XB_XGEN(j)  (2304 + 64 * (j))
#define XB_TOP      3328
#define XB_TOPGEN   3392
#define XCD_BAR_WORDS 3456
#define XB_SPIN_CAP (1u << 18)

__device__ __forceinline__ unsigned xb_ld(unsigned* p)              { return __hip_atomic_load(p, __ATOMIC_RELAXED, __HIP_MEMORY_SCOPE_AGENT); }
__device__ __forceinline__ unsigned xb_add(unsigned* p, unsigned v) { return __hip_atomic_fetch_add(p, v, __ATOMIC_RELAXED, __HIP_MEMORY_SCOPE_AGENT); }
__device__ __forceinline__ unsigned xb_xcc_id() { return (unsigned)__builtin_amdgcn_s_getreg((3 << 11) | 20) & 0xFu; }
#define XB_SPIN(cond, bar) do { unsigned _sp = 0; while (cond) { __builtin_amdgcn_s_sleep(1); \
    if ((++_sp & 255u) == 0u) { if (xb_ld(&(bar)[XB_TMO])) break; if (_sp > XB_SPIN_CAP) { atomicAdd(&(bar)[XB_TMO], 1u); break; } } } } while (0)

struct XcdBarrier {
    unsigned* bar; unsigned x;
    volatile LAS unsigned* st;
};

__device__ __forceinline__ XcdBarrier xcd_barrier_post(unsigned* bar, volatile LAS unsigned* st) {
    XcdBarrier b; b.bar = bar; b.x = xb_xcc_id(); b.st = st;
    if (threadIdx.x == 0) (void)xb_add(&bar[XB_XCNT(b.x)], 1u);
    return b;
}
__device__ __forceinline__ void xcd_barrier_complete(unsigned* bar, unsigned x, unsigned& nloc, unsigned& nx) {
    const unsigned G = gridDim.x * gridDim.y * gridDim.z;
    unsigned sum, cnt, mine, sp = 0u;
    for (;;) {
        sum = 0u; cnt = 0u; mine = 0u;
#pragma unroll
        for (unsigned j = 0; j < 16; ++j) { const unsigned c = xb_ld(&bar[XB_XCNT(j)]); sum += c; cnt += (c > 0u) ? 1u : 0u; mine = (j == x) ? c : mine; }
        if (sum == G) break;
        __builtin_amdgcn_s_sleep(1);
        if ((++sp & 255u) == 0u) { if (xb_ld(&bar[XB_TMO])) break; if (sp > XB_SPIN_CAP) { atomicAdd(&bar[XB_TMO], 1u); break; } }
    }
    nloc = mine > 0u ? mine : 1u; nx = cnt > 0u ? cnt : 1u;
}

__device__ __forceinline__ void xcd_barrier(const XcdBarrier& b) {
    asm volatile("s_waitcnt vmcnt(0)" ::: "memory");
    __syncthreads();
    if (threadIdx.x == 0) {
        unsigned* bar = b.bar;
        __builtin_amdgcn_s_waitcnt(0);
        unsigned nloc = b.st[0], nx = b.st[1];
        if (nloc == 0u) { xcd_barrier_complete(bar, b.x, nloc, nx); b.st[0] = nloc; b.st[1] = nx; }
        const unsigned old = xb_add(&bar[XB_XSUB(b.x)], 1u);
        const unsigned gen = old / nloc;
        if (old + 1u == (gen + 1u) * nloc) {
            __builtin_amdgcn_fence(__ATOMIC_RELEASE, "agent");
            asm volatile("s_waitcnt vmcnt(0)" ::: "memory");
            const unsigned og = xb_add(&bar[XB_TOP], 1u);
            const unsigned tg = og / nx;
            if (og + 1u == (tg + 1u) * nx) xb_add(&bar[XB_TOPGEN], 1u);
            else XB_SPIN(xb_ld(&bar[XB_TOPGEN]) == tg, bar);
            __builtin_amdgcn_fence(__ATOMIC_ACQUIRE, "agent");
            xb_add(&bar[XB_XGEN(b.x)], 1u);
            asm volatile("s_waitcnt vmcnt(0)" ::: "memory");
        } else {
            XB_SPIN(xb_ld(&bar[XB_XGEN(b.x)]) == gen, bar);
            __builtin_amdgcn_fence(__ATOMIC_ACQUIRE, "agent");
            asm volatile("s_waitcnt vmcnt(0)" ::: "memory");
        }
    }
    __syncthreads();
}

constexpr size_t WS_BAR = 4096;
constexpr size_t WS_DFLOW = 32768;
constexpr int LDS_BARW = LDS_BYTES - 64;
#define GSYNC() do { XcdBarrier b_; b_.bar = (unsigned*)(kargs()->ws + WS_BAR); b_.x = xb_xcc_id(); b_.st = (volatile LAS unsigned*)(lds + LDS_BARW); xcd_barrier(b_); } while (0)
__global__ void __launch_bounds__(NTHREADS, 2) fwd_megakernel(Args unused_args) {
    extern __shared__ __attribute__((aligned(16))) unsigned char lds_raw[];
    LAS unsigned char* lds = (LAS unsigned char*)lds_raw;
    cg::grid_group grid = cg::this_grid();
    if (threadIdx.x < 16) ((LAS unsigned*)(lds + LDS_BARW))[threadIdx.x] = 0u;
    __syncthreads();
    (void)xcd_barrier_post((unsigned*)(kargs()->ws + WS_BAR), (volatile LAS unsigned*)(lds + LDS_BARW));

#ifndef SKIP_MOD
    phase_mod(kargs(), lds);
#endif
#ifndef SKIP_W
    phase_weights(kargs(), lds);
#endif
    grid.sync();
    row_pass<true>(kargs(), RowP{0, -1, 0.f, 0, 0, false});
    GSYNC();

    for (int sl = 0; sl < 3 * DEPTH; ++sl) {
        const int L = sl / 3, j = sl - 3 * L, m = L >> 1;
        if (j != 1) {
            unsigned char* ws = kargs()->ws; const int f = j >> 1;
            pg8::Gemm g1{(const bf16_t*)(ws + WS_U), (const bf16_t*)(ws + WS_W1T) + (size_t)(L * 2 + f) * 5632 * 1024, MT, 2 * DFF, DM, DM, DM};
            pg8::StaticOrder S; S.init(MT, 2 * DFF, DM, grd_l(), blk_l(), sl == 3 * DEPTH - 1 ? 2 : 0);
            pg8::EpiSwiglu E{(bf16_t*)(ws + WS_BIG), DFF};
#ifndef SKIP_G1
            pg8::gemm_phase<pg8::EpiSwiglu, pg8::StaticOrder, true, true>(lds, g1, S, E);
#endif
            GSYNC();
        } else {
            const bool attn = (L & 1) == 0;
            { unsigned char* ws = kargs()->ws;
              pg8::Gemm g1{(const bf16_t*)(ws + WS_U), attn ? (const bf16_t*)(ws + WS_WQKVT) + (size_t)m * NQKV * 1024 : (const bf16_t*)(ws + WS_WGINT) + (size_t)m * NGIN * 1024, MT, attn ? NQKV : NGIN, DM, DM, DM};
              pg8::StaticOrder S; S.init(MT, g1.N, DM, grd_l(), blk_l(), 0);
              pg8::EpiBf16s E{(bf16_t*)(ws + WS_BIG), g1.N, nullptr};
#ifndef SKIP_GM
              pg8::gemm_phase<pg8::EpiBf16s, pg8::StaticOrder, true, true>(lds, g1, S, E);
#endif
 }
            GSYNC();
            if (attn) {
#ifndef SKIP_QK
                phase_qknorm_rope(kargs(), m);
#endif
                GSYNC();
#ifndef SKIP_ATT
                phase_attention(kargs(), (char*)lds_raw);
#endif
                GSYNC();
            } else {
                phase_gla_prep(kargs(), m, lds);
                GSYNC();
                phase_gla_scan(kargs(), m, lds);
                GSYNC();
#ifndef SKIP_RO
                phase_gla_readout(kargs(), m, sl >= 10);
#endif
                GSYNC();
            }
        }
        {
            unsigned char* ws = kargs()->ws;
            pg8::Gemm g2;
            if (j != 1) g2 = pg8::Gemm{(const bf16_t*)(ws + WS_BIG), (const bf16_t*)(ws + WS_W2T) + (size_t)(L * 2 + (j >> 1)) * 1024 * 2816, MT, DM, DFF, DFF, DFF};
            else if ((L & 1) == 0) g2 = pg8::Gemm{(const bf16_t*)(ws + WS_ATTNO), (const bf16_t*)(ws + WS_WOAT) + (size_t)m * 1024 * 1024, MT, DM, DM, DM, DM};
            else g2 = pg8::Gemm{(const bf16_t*)(ws + WS_BIG) + 2048, (const bf16_t*)(ws + WS_WGOT) + (size_t)m * 1024 * 1024, MT, DM, DM, NGIN, DM};
            pg8::StaticOrder S; S.init(MT, DM, g2.K, grd_l(), blk_l(), sl >= 10 ? 2 : 3); S.sig = (unsigned*)(ws + WS_DFLOW) + sl * 256;
            pg8::EpiBf16s E{(bf16_t*)(ws + WS_Y), DM, nullptr};
#ifndef SKIP_G2
            pg8::gemm_phase<pg8::EpiBf16s, pg8::StaticOrder, true, true>(lds, g2, S, E);
#endif
        }
        const bool last = sl == 3 * DEPTH - 1;
        const int Ln = (j == 2) ? L + 1 : L, jn = (j == 2) ? 0 : j + 1;
        { KA a_ = kargs(); const int G_ = grd_l();
          row_pass_queue(a_, RowP{L, j, j == 1 ? 1.0f : 0.5f, Ln, last ? -1 : jn, last}, (unsigned*)(a_->ws + WS_DFLOW) + sl * 256, (unsigned)(G_ < 512 ? G_ : 512), 32u, sl < 10, lds); }
        if (!last) GSYNC();
    }
}

extern "C" void kernel_launch(void* const* d_in, const int* in_sizes, int n_in, void* d_out, int out_size, void* d_ws, size_t ws_size, hipStream_t stream) {
    static int grid = 0;
    if (grid == 0) {
        if (n_in != 20 || out_size != NB * SEQ * DM || ws_size < WS_END) { fprintf(stderr, "kernel_launch: unexpected shapes: n_in %d out %d ws %zu (need %zu)\n", n_in, out_size, ws_size, (size_t)WS_END); grid = -1; return; }
        int dev = 0, cus = 0, per_cu = 0;
        (void)hipGetDevice(&dev);
        (void)hipDeviceGetAttribute(&cus, hipDeviceAttributeMultiprocessorCount, dev);
        (void)hipFuncSetAttribute((const void*)fwd_megakernel, hipFuncAttributeMaxDynamicSharedMemorySize, LDS_BYTES);
        (void)hipOccupancyMaxActiveBlocksPerMultiprocessor(&per_cu, (const void*)fwd_megakernel, NTHREADS, LDS_BYTES);
        if (per_cu < 1) per_cu = 1;
        grid = cus * per_cu;
        fprintf(stderr, "kernel_launch: grid %d (cus %d x %d), ws %zu\n", grid, cus, per_cu, ws_size);
    }
    if (grid < 0) return;
    (void)hipMemsetAsync(d_ws, 0, 65536, stream);
    Args a{};
    for (int i = 0; i < 20; ++i) a.in[i] = (const float*)d_in[i];
    a.out = (float*)d_out; a.ws = (unsigned char*)d_ws;
    void* args[] = {&a};
    hipError_t e = hipLaunchCooperativeKernel((const void*)fwd_megakernel, dim3(grid), dim3(NTHREADS), args, LDS_BYTES, stream);
    if (e != hipSuccess) fprintf(stderr, "kernel_launch: cooperative launch failed: %s (grid %d)\n", hipGetErrorString(e), grid);
}
```

```cpp
#include <hip/hip_runtime.h>
#include <hip/hip_cooperative_groups.h>
#include <hip/hip_bf16.h>
#include <cstdio>
#include <cstdint>
namespace cg = cooperative_groups;
__device__ __forceinline__ int tid_l() { int t = threadIdx.x; asm volatile("" : "+v"(t)); return t; }
__device__ __forceinline__ int blk_l() { int t = blockIdx.x; asm volatile("" : "+s"(t)); return t; }
__device__ __forceinline__ int grd_l() { int t = gridDim.x; asm volatile("" : "+s"(t)); return t; }
namespace pg8 {
#define PG8_LAS __attribute__((address_space(3)))
typedef unsigned short bf16_t;
typedef short bf16x8 __attribute__((ext_vector_type(8)));
typedef float f32x4 __attribute__((ext_vector_type(4)));
typedef unsigned u32x4 __attribute__((ext_vector_type(4)));
constexpr int BM = 256, BK = 64, HALF = 128, HTB = HALF * BK * 2  , STAGE_BYTES = 8 * HTB, NXCD = 8, WGM = 8;

__host__ __device__ __forceinline__ int lds_byte(int r, int c) { const int st = (r >> 4) * 2 + (c >> 5), rr = r & 15, cc = c & 31, ob = rr * 64 + cc * 2; return st * 1024 + (ob ^ (((ob >> 9) & 1) << 5)); }
__host__ __device__ __forceinline__ void stage_rc(int b, int& R, int& C) { const int st = b / 1024, sb = b % 1024, swz = sb ^ (((sb >> 9) & 1) << 5); R = (st >> 1) * 16 + swz / 64; C = (st & 1) * 32 + (swz % 64) / 2; }
__host__ __device__ __forceinline__ int perm32(int rho) { const int n = rho >> 4, i = rho & 15; return 8 * (i >> 2) + 4 * n + (i & 3); }

struct Unit { int pm, pn, kt0, nt, part, sig; };
struct Gemm { const bf16_t* A; const bf16_t* Bt; int M, N, K, lda, ldb; };

struct StaticOrder {
    int nM, nN, nwg, G, c, mode, ntfull; unsigned* sig;
    __host__ __device__ void init(int M, int N, int K, int G_, int c_, int mode_) { mode = mode_; nM = mode ? 128 : M / BM; nN = N / BM; nwg = nM * nN; G = G_; c = c_; ntfull = K / BK; sig = nullptr; }
    __host__ __device__ __forceinline__ bool next(int i, Unit& u) const {
        const long L = (long)i * G + c;
        int pm = 0, pn = 0, kt0 = 0, nt = ntfull, part = -1, sg = 0; bool ok = true;
        if (L >= nwg) {
            const int e = (int)(L - nwg);
            if (mode == 3) { ok = e < 8 * nN; pm = 17 * (e / nN); pn = e % nN; sg = 2; }
            else { ok = (mode == 1) && (e < 16 * nN); const int ct = e >> 1; pm = 17 * (ct / nN); pn = ct % nN; part = e & 1; nt = ntfull >> 1; kt0 = part * nt; }
        } else {
            int wgid = (int)L; { const int q = nwg / NXCD, r = nwg % NXCD, xcd = wgid % NXCD, off = wgid / NXCD; wgid = (xcd < r ? xcd * (q + 1) : r * (q + 1) + (xcd - r) * q) + off; }
            const int nig = WGM * nN, gid = wgid / nig, fm = gid * WGM, gsz = (nM - fm) < WGM ? (nM - fm) : WGM;
            pm = fm + ((wgid % nig) % gsz); pn = (wgid % nig) / gsz;
            if (mode) pm += (pm >> 4) + 1;
            sg = (mode >= 2 && L + G >= nwg) ? 1 : 0;
        }
        u.pm = pm; u.pn = pn; u.kt0 = kt0; u.nt = nt; u.part = part; u.sig = sg;
        return ok;
    }
    __device__ __forceinline__ void a_ready(const Unit&) const {}
    __device__ __forceinline__ void done(const Unit& u) const {
        if (sig != nullptr && u.sig != 0) {
            asm volatile("s_waitcnt vmcnt(0)" ::: "memory");
            __builtin_amdgcn_s_barrier(); asm volatile("" ::: "memory");
            if (threadIdx.x == 0) {
                __builtin_amdgcn_fence(__ATOMIC_RELEASE, "agent");
                asm volatile("s_waitcnt vmcnt(0)" ::: "memory");
                __hip_atomic_fetch_add(sig + (u.sig == 1 ? 0 : 64), 1u, __ATOMIC_RELAXED, __HIP_MEMORY_SCOPE_AGENT);
            }
        }
    }
};

typedef float f32x2c_t __attribute__((ext_vector_type(2))); typedef __bf16 bf16x2c_t __attribute__((ext_vector_type(2)));
__device__ __forceinline__ unsigned cvt_pk_bf16(float lo, float hi) { f32x2c_t v = {lo, hi}; bf16x2c_t b = __builtin_convertvector(v, bf16x2c_t); return __builtin_bit_cast(unsigned, b); }
typedef float f32x2 __attribute__((ext_vector_type(2)));
struct EpiBf16s {
    static constexpr bool PERM = true, AFTER_DRAIN = false;
    bf16_t* O; int ldc; float* P;
    __device__ __forceinline__ void operator()(const f32x4 (&acc)[2][2][4][2], const Unit& u, int wr, int wc, int fr, int fq) const {
        const int row0 = u.pm * BM + wr * 64 + fr; const int col0 = u.pn * BM + wc * 32 + 8 * fq;
        if (u.part >= 0) {
            float* pb = P + (size_t)u.part * 2048 * ldc + (size_t)((u.pm / 17) * BM + wr * 64 + fr) * ldc + col0;
#pragma unroll
            for (int ai = 0; ai < 2; ++ai)
#pragma unroll
                for (int m = 0; m < 4; ++m)
#pragma unroll
                    for (int bj = 0; bj < 2; ++bj) { float* rp = pb + (size_t)(ai * HALF + m * 16) * ldc + bj * HALF; *(f32x4*)rp = acc[ai][bj][m][0]; *(f32x4*)(rp + 4) = acc[ai][bj][m][1]; }
            return;
        }
#pragma unroll
        for (int ai = 0; ai < 2; ++ai)
#pragma unroll
            for (int m = 0; m < 4; ++m) { bf16_t* rowp = O + (size_t)(row0 + ai * HALF + m * 16) * ldc + col0;
#pragma unroll
                for (int bj = 0; bj < 2; ++bj) { const f32x4 v0 = acc[ai][bj][m][0], v1 = acc[ai][bj][m][1];
                    u32x4 w; w.x = cvt_pk_bf16(v0[0], v0[1]); w.y = cvt_pk_bf16(v0[2], v0[3]); w.z = cvt_pk_bf16(v1[0], v1[1]); w.w = cvt_pk_bf16(v1[2], v1[3]);
                    *(u32x4*)(rowp + bj * HALF) = w; } }
    }
};
__device__ __forceinline__ float silu_f(float g) { return g * __builtin_amdgcn_rcpf(1.0f + __expf(-g)); }
struct EpiSwiglu {
    static constexpr bool PERM = true, AFTER_DRAIN = false;
    bf16_t* H; int ldh;
    __device__ __forceinline__ void operator()(const f32x4 (&acc)[2][2][4][2], const Unit& u, int wr, int wc, int fr, int fq) const {
        const int row0 = u.pm * BM + wr * 64 + fr; const int col0 = u.pn * HALF + wc * 32 + 8 * fq;
#pragma unroll
        for (int ai = 0; ai < 2; ++ai)
#pragma unroll
            for (int m = 0; m < 4; ++m) { bf16_t* rowp = H + (size_t)(row0 + ai * HALF + m * 16) * ldh + col0;
                const f32x4 g0 = acc[ai][0][m][0], g1 = acc[ai][0][m][1], u0 = acc[ai][1][m][0], u1 = acc[ai][1][m][1];
                u32x4 w;
                w.x = cvt_pk_bf16(silu_f(g0[0]) * u0[0], silu_f(g0[1]) * u0[1]); w.y = cvt_pk_bf16(silu_f(g0[2]) * u0[2], silu_f(g0[3]) * u0[3]);
                w.z = cvt_pk_bf16(silu_f(g1[0]) * u1[0], silu_f(g1[1]) * u1[1]); w.w = cvt_pk_bf16(silu_f(g1[2]) * u1[2], silu_f(g1[3]) * u1[3]);
                *(u32x4*)rowp = w; }
    }
};
__device__ __forceinline__ void rowstats_run(float* xbuf  , unsigned* cnt  , const f32x4 (&v)[2][2][4][2], const Unit& u, int wr, int wc, int fr, int fq, PG8_LAS unsigned char* xl, int wid, int lane) {
        PG8_LAS float* P = (PG8_LAS float*)xl;
        PG8_LAS float* S = (PG8_LAS float*)(xl + 4096);
#pragma unroll
        for (int ai = 0; ai < 2; ++ai)
#pragma unroll
            for (int m = 0; m < 4; ++m) {
                float s = 0.f;
#pragma unroll
                for (int bj = 0; bj < 2; ++bj)
#pragma unroll
                    for (int n = 0; n < 2; ++n) { const f32x4 x = v[ai][bj][m][n]; s += (x[0] * x[0] + x[1] * x[1]) + (x[2] * x[2] + x[3] * x[3]); }
                s += __shfl_xor(s, 16); s += __shfl_xor(s, 32);
                if (fq == 0) P[(ai * HALF + wr * 64 + m * 16 + fr) * 4 + wc] = s;
            }
        asm volatile("s_waitcnt lgkmcnt(0)" ::: "memory"); __builtin_amdgcn_s_barrier(); asm volatile("" ::: "memory");
        const int row = wid * 32 + (lane & 31);
        if (lane < 32) {
            const float t = (P[row * 4 + 0] + P[row * 4 + 1]) + (P[row * 4 + 2] + P[row * 4 + 3]);
            __hip_atomic_store(xbuf + ((size_t)(u.pm * BM + row) * 4 + u.pn), t, __ATOMIC_RELAXED, __HIP_MEMORY_SCOPE_AGENT);
        }
        asm volatile("s_waitcnt vmcnt(0)" ::: "memory");
        if (lane == 0) __hip_atomic_fetch_add(cnt + 64 * u.pm, 1u, __ATOMIC_RELAXED, __HIP_MEMORY_SCOPE_AGENT);
        if (wid == 0) {
            unsigned sp = 0;
            while ((unsigned)__builtin_amdgcn_readfirstlane(__hip_atomic_load(cnt + 64 * u.pm, __ATOMIC_RELAXED, __HIP_MEMORY_SCOPE_AGENT)) < 32u) { __builtin_amdgcn_s_sleep(1); if (++sp > (1u << 22)) break; }
            __builtin_amdgcn_fence(__ATOMIC_ACQUIRE, "agent");
        }
        asm volatile("s_waitcnt vmcnt(0) lgkmcnt(0)" ::: "memory"); __builtin_amdgcn_s_barrier(); asm volatile("" ::: "memory");
        if (lane < 32) {
            const float* slot = xbuf + (size_t)(u.pm * BM + row) * 4; float t = 0.f;
#pragma unroll
            for (int k = 0; k < 4; ++k) t += __hip_atomic_load(slot + k, __ATOMIC_RELAXED, __HIP_MEMORY_SCOPE_AGENT);
            S[row] = t;
        }
        asm volatile("s_waitcnt vmcnt(0) lgkmcnt(0)" ::: "memory"); __builtin_amdgcn_s_barrier(); asm volatile("" ::: "memory");
    }

template <class Epi, class Sched, bool ALIGN_EPI = false, bool SP2 = false>
__device__ __forceinline__ void gemm_phase(PG8_LAS unsigned char* lds, const Gemm g, const Sched& S, const Epi& E) {
    const int tid = tid_l(), wid = __builtin_amdgcn_readfirstlane(tid >> 6), lane = tid & 63, wr = wid >> 2, wc = wid & 3, fr = lane & 15, fq = lane >> 4;
    unsigned voffA[2], voffB[2];
#pragma unroll
    for (int i = 0; i < 2; ++i) { int R, C; stage_rc(tid * 16 + i * 8192, R, C); const int Rb = Epi::PERM ? ((R & ~31) + perm32(R & 31)) : R;
        voffA[i] = (unsigned)(R * g.lda + C) * 2u; voffB[i] = (unsigned)(Rb * g.ldb + C) * 2u; }
    const size_t kstep = (size_t)(BK * 2);
    const size_t hstepB = (size_t)HALF * g.ldb * 2, hstepA = (size_t)HALF * g.lda * 2;
    const size_t tstepA = 2 * hstepA, tstepB = 2 * hstepB;
    const unsigned ldsw = (unsigned)wid * 1024u;
    const int aoff = lds_byte(wr * 64 + fr, fq * 8), boff = lds_byte(wc * 32 + fr, fq * 8);
#define PG8_SA(b, h) (((b) * 2 + (h)) * HTB)
#define PG8_SB(b, h) ((4 + (b) * 2 + (h)) * HTB)
#define PG8_STAGE(bufoff, gbase, voff) do { _Pragma("unroll") for (int _i = 0; _i < 2; ++_i) \
        __builtin_amdgcn_global_load_lds((const unsigned*)((const char*)(gbase) + (voff)[_i]), (PG8_LAS unsigned*)(lds + (bufoff) + ldsw + _i * 8192), 16, 0, 0); } while (0)
#define PG8_LDA(dst, b, h) do { _Pragma("unroll") for (int m = 0; m < 4; ++m) _Pragma("unroll") for (int k = 0; k < 2; ++k) dst[m][k] = *(const PG8_LAS bf16x8*)(lds + PG8_SA(b, h) + aoff + m * 2048 + k * 1024); } while (0)
#define PG8_LDB(dst, b, h) do { _Pragma("unroll") for (int n = 0; n < 2; ++n) _Pragma("unroll") for (int k = 0; k < 2; ++k) dst[n][k] = *(const PG8_LAS bf16x8*)(lds + PG8_SB(b, h) + boff + n * 2048 + k * 1024); } while (0)
#define PG8_MMA(ai, bj, At, Bt) do { __builtin_amdgcn_s_setprio(1); _Pragma("unroll") for (int m = 0; m < 4; ++m) _Pragma("unroll") for (int n = 0; n < 2; ++n) _Pragma("unroll") for (int k = 0; k < 2; ++k) \
        acc[ai][bj][m][n] = __builtin_amdgcn_mfma_f32_16x16x32_bf16(Bt[n][k], At[m][k], acc[ai][bj][m][n], 0, 0, 0); __builtin_amdgcn_s_setprio(0); } while (0)
#define PG8_WAIT_V(n) asm volatile("s_waitcnt vmcnt(" #n ")" ::: "memory")
#define PG8_WAIT_L(n) asm volatile("s_waitcnt lgkmcnt(" #n ")" ::: "memory")
#define PG8_BAR __builtin_amdgcn_s_barrier()
#define PG8_SCHED __builtin_amdgcn_sched_barrier(0)
    Unit cur, nxt; int ui = 0;
    if (!S.next(0, cur)) return;
    f32x4 acc[2][2][4][2];
#pragma unroll
    for (int a = 0; a < 2; ++a)
#pragma unroll
        for (int b = 0; b < 2; ++b)
#pragma unroll
            for (int m = 0; m < 4; ++m)
#pragma unroll
                for (int n = 0; n < 2; ++n) acc[a][b][m][n] = (f32x4){0.f, 0.f, 0.f, 0.f};
    bf16x8 At[4][2], B0[2][2], B1[2][2];
    const char* cA = (const char*)g.A + (size_t)cur.pm * tstepA + (size_t)cur.kt0 * kstep; const char* cB = (const char*)g.Bt + (size_t)cur.pn * tstepB + (size_t)cur.kt0 * kstep;
    S.a_ready(cur);
    if constexpr (SP2) {
        PG8_STAGE(PG8_SB(0, 0), cB, voffB); PG8_STAGE(PG8_SB(0, 1), cB + hstepB, voffB); PG8_STAGE(PG8_SA(0, 0), cA, voffA); PG8_STAGE(PG8_SA(0, 1), cA + hstepA, voffA);
        if (wr == 1) PG8_BAR;
        PG8_WAIT_V(2); PG8_BAR;
        PG8_STAGE(PG8_SB(1, 0), cB + kstep, voffB); PG8_STAGE(PG8_SA(1, 0), cA + kstep, voffA); PG8_STAGE(PG8_SB(1, 1), cB + hstepB + kstep, voffB);
        PG8_WAIT_V(6); PG8_BAR;
    } else {
        PG8_STAGE(PG8_SB(0, 0), cB, voffB); PG8_STAGE(PG8_SA(0, 0), cA, voffA); PG8_STAGE(PG8_SB(0, 1), cB + hstepB, voffB); PG8_STAGE(PG8_SA(0, 1), cA + hstepA, voffA);
        if (wr == 1) PG8_BAR;
        PG8_WAIT_V(4); PG8_BAR;
        PG8_STAGE(PG8_SB(1, 0), cB + kstep, voffB); PG8_STAGE(PG8_SA(1, 0), cA + kstep, voffA); PG8_STAGE(PG8_SB(1, 1), cB + hstepB + kstep, voffB);
        PG8_WAIT_V(6); PG8_BAR;
    }
    for (;;) {
        const bool has_next = S.next(ui + 1, nxt);
        const char* nA = has_next ? (const char*)g.A + (size_t)nxt.pm * tstepA + (size_t)nxt.kt0 * kstep : cA; const char* nB = has_next ? (const char*)g.Bt + (size_t)nxt.pn * tstepB + (size_t)nxt.kt0 * kstep : cB;
        const int nt = cur.nt;
        for (int t = 0; t < nt; t += 2) {
            const bool last = (t == nt - 2);
            const char* a1 = cA + (size_t)(t + 1) * kstep;
            const char* a2 = last ? nA : cA + (size_t)(t + 2) * kstep; const char* b2 = last ? nB : cB + (size_t)(t + 2) * kstep;
            const char* a3 = a2 + kstep; const char* b3 = b2 + kstep;
            if (last && has_next) S.a_ready(nxt);
            if constexpr (SP2) {
            PG8_LDB(B0, 0, 0); PG8_LDB(B1, 0, 1); PG8_SCHED; PG8_LDA(At, 0, 0); PG8_STAGE(PG8_SA(1, 1), a1 + hstepA, voffA);
            PG8_WAIT_V(8); PG8_WAIT_L(0); PG8_BAR; PG8_MMA(0, 0, At, B0); PG8_MMA(0, 1, At, B1); PG8_BAR; PG8_SCHED;
            PG8_LDA(At, 0, 1); PG8_STAGE(PG8_SB(0, 0), b2, voffB); PG8_STAGE(PG8_SB(0, 1), b2 + hstepB, voffB); PG8_STAGE(PG8_SA(0, 0), a2, voffA);
            PG8_WAIT_V(8); PG8_WAIT_L(0); PG8_BAR; PG8_MMA(1, 0, At, B0); PG8_MMA(1, 1, At, B1); PG8_BAR; PG8_SCHED;
            PG8_LDB(B0, 1, 0); PG8_LDB(B1, 1, 1); PG8_SCHED; PG8_LDA(At, 1, 0); PG8_STAGE(PG8_SA(0, 1), a2 + hstepA, voffA);
            PG8_WAIT_V(8); PG8_WAIT_L(0); PG8_BAR; PG8_MMA(0, 0, At, B0); PG8_MMA(0, 1, At, B1); PG8_BAR; PG8_SCHED;
            PG8_LDA(At, 1, 1); PG8_STAGE(PG8_SB(1, 0), b3, voffB); PG8_STAGE(PG8_SB(1, 1), b3 + hstepB, voffB); PG8_STAGE(PG8_SA(1, 0), a3, voffA);
            PG8_WAIT_V(8); PG8_WAIT_L(0); PG8_BAR; PG8_MMA(1, 0, At, B0); PG8_MMA(1, 1, At, B1); PG8_BAR; PG8_SCHED;
            } else {
            PG8_LDB(B0, 0, 0); PG8_SCHED; PG8_LDA(At, 0, 0); PG8_STAGE(PG8_SA(1, 1), a1 + hstepA, voffA);
            PG8_WAIT_L(8); PG8_BAR; PG8_WAIT_L(0); PG8_MMA(0, 0, At, B0); PG8_BAR; PG8_SCHED;
            PG8_LDB(B1, 0, 1); PG8_STAGE(PG8_SB(0, 0), b2, voffB);
            PG8_BAR; PG8_WAIT_L(0); PG8_MMA(0, 1, At, B1); PG8_BAR;
            PG8_LDA(At, 0, 1); PG8_STAGE(PG8_SA(0, 0), a2, voffA);
            PG8_BAR; PG8_WAIT_L(0); PG8_MMA(1, 0, At, B0); PG8_BAR; PG8_SCHED;
            PG8_STAGE(PG8_SB(0, 1), b2 + hstepB, voffB);
            PG8_WAIT_V(6); PG8_BAR; PG8_MMA(1, 1, At, B1); PG8_BAR;
            PG8_LDB(B0, 1, 0); PG8_SCHED; PG8_LDA(At, 1, 0); PG8_STAGE(PG8_SA(0, 1), a2 + hstepA, voffA);
            PG8_WAIT_L(8); PG8_BAR; PG8_WAIT_L(0); PG8_MMA(0, 0, At, B0); PG8_BAR; PG8_SCHED;
            PG8_LDB(B1, 1, 1); PG8_STAGE(PG8_SB(1, 0), b3, voffB);
            PG8_BAR; PG8_WAIT_L(0); PG8_MMA(0, 1, At, B1); PG8_BAR;
            PG8_LDA(At, 1, 1); PG8_STAGE(PG8_SA(1, 0), a3, voffA);
            PG8_BAR; PG8_WAIT_L(0); PG8_MMA(1, 0, At, B0); PG8_BAR; PG8_SCHED;
            PG8_STAGE(PG8_SB(1, 1), b3 + hstepB, voffB);
            PG8_WAIT_V(6); PG8_BAR; PG8_MMA(1, 1, At, B1); PG8_BAR;
            }
        }
        if constexpr (ALIGN_EPI) { if (wr == 0) PG8_BAR; }
        if constexpr (!Epi::AFTER_DRAIN) { E(acc, cur, wr, wc, fr, fq); S.done(cur); }
        if (!has_next) break;
#pragma unroll
        for (int a = 0; a < 2; ++a)
#pragma unroll
            for (int b = 0; b < 2; ++b)
#pragma unroll
                for (int m = 0; m < 4; ++m)
#pragma unroll
                    for (int n = 0; n < 2; ++n) acc[a][b][m][n] = (f32x4){0.f, 0.f, 0.f, 0.f};
        cur = nxt; cA = nA; cB = nB; ++ui;
        if constexpr (ALIGN_EPI) { if (wr == 1) PG8_BAR; }
    }
    PG8_WAIT_V(0);
    if constexpr (!ALIGN_EPI) { if (wr == 0) PG8_BAR; }
    PG8_BAR;
    if constexpr (Epi::AFTER_DRAIN) { E.fused(acc, cur, wr, wc, fr, fq, lds, wid, lane); S.done(cur); }
#undef PG8_SA
#undef PG8_SB
#undef PG8_STAGE
#undef PG8_LDA
#undef PG8_LDB
#undef PG8_MMA
#undef PG8_WAIT_V
#undef PG8_WAIT_L
#undef PG8_BAR
#undef PG8_SCHED
}
}
namespace att {
using bf16 = __hip_bfloat16;
constexpr int   D = 128, NW = 8, QBLK = 32, KVBLK = 64;
constexpr float SCALE = 0.088388347648318440f;
constexpr float THR = 8.f;
constexpr int SDEPTH = 2;
constexpr int LDQ = 1536, LDK = 1536, LDO = 1024;
constexpr size_t SHM_V = KVBLK * D * 2, SHM_K = KVBLK * D * 2, SHM_ATTN = 2 * SHM_V + 2 * SHM_K + NW * 64 * 4;
using bf16x8 = __attribute__((ext_vector_type(8))) short;
using s16x4  = __attribute__((ext_vector_type(4))) short;
using f32x16 = __attribute__((ext_vector_type(16))) float;
using f32x8  = __attribute__((ext_vector_type(8))) float;
using u32x4  = __attribute__((ext_vector_type(4))) unsigned;
#define KSWZ(row, colB) ((row) * 256 + ((colB) ^ (((row) & 7) << 4)))
#define SBAR() __builtin_amdgcn_sched_barrier(0)
__device__ __forceinline__ int crow(int r, int hi) { return (r & 3) + 8 * (r >> 2) + 4 * hi; }
__device__ __forceinline__ unsigned cvtpk(float lo, float hi) {
  unsigned r; asm volatile("v_cvt_pk_bf16_f32 %0, %1, %2" : "=v"(r) : "v"(lo), "v"(hi)); return r;
}
template <typename TIn> struct Stage;
template <> struct Stage<bf16>  { using T = bf16x8;
  __device__ static __forceinline__ T ld8(const bf16* p) { return *reinterpret_cast<const bf16x8*>(p); }
  __device__ static __forceinline__ bf16x8 tobf(T x) { return x; } };
template <> struct Stage<float> { using T = f32x8;
  __device__ static __forceinline__ T ld8(const float* p) { return *reinterpret_cast<const f32x8*>(p); }
  __device__ static __forceinline__ bf16x8 tobf(T x) {
    u32x4 w = {cvtpk(x[0], x[1]), cvtpk(x[2], x[3]), cvtpk(x[4], x[5]), cvtpk(x[6], x[7])}; return *reinterpret_cast<bf16x8*>(&w); } };

__device__ __forceinline__ void partialSM(f32x16& p0, f32x16& p1, float& m_reg, float& mn, float& alpha) {
  constexpr float C = SCALE * 1.4426950408889634f;
  float pmax = p0[0]; for (int r = 1; r < 16; ++r) pmax = fmaxf(pmax, p0[r]); for (int r = 0; r < 16; ++r) pmax = fmaxf(pmax, p1[r]);
  { auto rr = __builtin_amdgcn_permlane32_swap(__float_as_uint(pmax), __float_as_uint(pmax), false, false);
    pmax = fmaxf(__uint_as_float(rr[0]), __uint_as_float(rr[1])); }
  if (__builtin_expect(__all(pmax - m_reg <= THR / SCALE), 1)) { mn = m_reg; alpha = 1.f; }
  else { mn = fmaxf(m_reg, pmax); alpha = __builtin_amdgcn_exp2f((m_reg - mn) * C); m_reg = mn; }
  float mnC = -mn * C;
  for (int r = 0; r < 16; ++r) p0[r] = fmaf(p0[r], C, mnC); for (int r = 0; r < 16; ++r) p1[r] = fmaf(p1[r], C, mnC);
  for (int r = 0; r < 16; ++r) p0[r] = __builtin_amdgcn_exp2f(p0[r]);
}
__device__ __forceinline__ void finishSM(f32x16& p0, f32x16& p1, float alpha, float& l_reg, bf16x8& pa0, bf16x8& pa1, bf16x8& pa2, bf16x8& pa3) {
  for (int r = 0; r < 16; ++r) p1[r] = __builtin_amdgcn_exp2f(p1[r]);
  float ps = 0; for (int r = 0; r < 16; ++r) ps += p0[r]; for (int r = 0; r < 16; ++r) ps += p1[r];
  { auto rr = __builtin_amdgcn_permlane32_swap(__float_as_uint(ps), __float_as_uint(ps), false, false);
    ps = __uint_as_float(rr[0]) + __uint_as_float(rr[1]); }
  l_reg = l_reg * alpha + ps;
#define PK4(P, BASE, OUT) do { unsigned a0 = cvtpk(P[BASE + 0], P[BASE + 1]), a1 = cvtpk(P[BASE + 2], P[BASE + 3]);   \
    unsigned b0 = cvtpk(P[BASE + 4], P[BASE + 5]), b1 = cvtpk(P[BASE + 6], P[BASE + 7]);                              \
    auto r0 = __builtin_amdgcn_permlane32_swap(a0, b0, false, false); auto r1 = __builtin_amdgcn_permlane32_swap(a1, b1, false, false); \
    u32x4 w = {r0[0], r1[0], r0[1], r1[1]}; OUT = *reinterpret_cast<bf16x8*>(&w); } while (0)
  PK4(p0, 0, pa0); PK4(p0, 8, pa1); PK4(p1, 0, pa2); PK4(p1, 8, pa3);
#undef PK4
}
__device__ __forceinline__ void qkt(f32x16& p0, f32x16& p1, const bf16* Ks, const bf16x8* qr, int r32, int hi) {
  p0 = f32x16{}; p1 = f32x16{};
  for (int d0 = 0; d0 < 8; ++d0) { int cb = (d0 * 16 + hi * 8) * 2;
    bf16x8 b0 = *reinterpret_cast<const bf16x8*>((const char*)Ks + KSWZ(r32, cb));
    bf16x8 b1 = *reinterpret_cast<const bf16x8*>((const char*)Ks + KSWZ(32 + r32, cb));
    p0 = __builtin_amdgcn_mfma_f32_32x32x16_bf16(b0, qr[d0], p0, 0, 0, 0);
    p1 = __builtin_amdgcn_mfma_f32_32x32x16_bf16(b1, qr[d0], p1, 0, 0, 0); }
}
__device__ __forceinline__ int v_st(int k, int c) { const int kk = (k & ~0xC) | ((k & 4) << 1) | ((k & 8) >> 1); return ((kk >> 3) * 4 + (c >> 5)) * 512 + ((kk & 7) * 32 + (c & 31)) * 2; }
__device__ __forceinline__ int v_rd_base(int lane) { return ((lane & 3) << 3) | (((lane >> 2) & 3) << 6) | (((lane >> 4) & 1) << 5) | (((lane >> 5) & 1) << 8); }
constexpr int v_rd_off(int d0, int ks, int half) { return d0 * 512 + ks * 4096 + half * 2048; }
template <int OFF> __device__ __forceinline__ s16x4 tr_read(int vb) {
  s16x4 r; asm volatile("ds_read_b64_tr_b16 %0, %1 offset:%2" : "=&v"(r) : "v"(vb), "i"(OFF) : "memory"); return r;
}
template <int D0> __device__ __forceinline__ void pv_one(f32x16& od, int vb, bf16x8 pa0, bf16x8 pa1, bf16x8 pa2, bf16x8 pa3) {
  const s16x4 l0 = tr_read<v_rd_off(D0, 0, 0)>(vb), h0 = tr_read<v_rd_off(D0, 0, 1)>(vb), l1 = tr_read<v_rd_off(D0, 1, 0)>(vb), h1 = tr_read<v_rd_off(D0, 1, 1)>(vb);
  const s16x4 l2 = tr_read<v_rd_off(D0, 2, 0)>(vb), h2 = tr_read<v_rd_off(D0, 2, 1)>(vb), l3 = tr_read<v_rd_off(D0, 3, 0)>(vb), h3 = tr_read<v_rd_off(D0, 3, 1)>(vb);
  asm volatile("s_waitcnt lgkmcnt(0)" ::: "memory"); SBAR();
#define PK(L, H) (bf16x8){L[0], L[1], L[2], L[3], H[0], H[1], H[2], H[3]}
  od = __builtin_amdgcn_mfma_f32_32x32x16_bf16(pa0, PK(l0, h0), od, 0, 0, 0);
  od = __builtin_amdgcn_mfma_f32_32x32x16_bf16(pa1, PK(l1, h1), od, 0, 0, 0);
  od = __builtin_amdgcn_mfma_f32_32x32x16_bf16(pa2, PK(l2, h2), od, 0, 0, 0);
  od = __builtin_amdgcn_mfma_f32_32x32x16_bf16(pa3, PK(l3, h3), od, 0, 0, 0);
#undef PK
}
__device__ __forceinline__ void pv_d0(f32x16* o, int vb, bf16x8 pa0, bf16x8 pa1, bf16x8 pa2, bf16x8 pa3) {
  pv_one<0>(o[0], vb, pa0, pa1, pa2, pa3); pv_one<1>(o[1], vb, pa0, pa1, pa2, pa3); pv_one<2>(o[2], vb, pa0, pa1, pa2, pa3); pv_one<3>(o[3], vb, pa0, pa1, pa2, pa3);
}

template <typename TQ>
__device__ __forceinline__ void attn_dense_body(const TQ* __restrict__ Qb, const bf16* __restrict__ Kh, const bf16* __restrict__ Vh,
                                                bf16* __restrict__ Ob, int seq, char* lds) {
  using St = Stage<bf16>; using SQ = Stage<TQ>;
  const int tid = tid_l(), wid = tid >> 6, lane = tid & 63, r32 = lane & 31, hi = lane >> 5;
  bf16* V_lds = (bf16*)lds; bf16* K_lds = (bf16*)(lds + 2 * SHM_V);
  float* ws = (float*)(lds + 2 * SHM_V + 2 * SHM_K) + wid * 64; float* li_l = ws; float* al_l = ws + 32;
  float m_reg = -1e30f, l_reg = 0; f32x16 o[4] = {}; bf16x8 qr[8];
  const TQ* Qw = Qb + (long)(wid * QBLK + r32) * LDQ + hi * 8;
#pragma unroll
  for (int d0 = 0; d0 < 8; ++d0) qr[d0] = SQ::tobf(SQ::ld8(Qw + d0 * 16));
  const int sr = tid >> 4, sc = (tid & 15) * 8, vst0 = v_st(sr, sc), vst1 = v_st(32 + sr, sc);
  const int vb0 = (int)(uintptr_t)V_lds + v_rd_base(lane);
  struct { typename St::T vs0, vs1, ks0, ks1; } sr_[SDEPTH];
#define SLOAD(i, k0) do { sr_[i].vs0 = St::ld8(&Vh[(long)((k0) + sr) * LDK + sc]); sr_[i].vs1 = St::ld8(&Vh[(long)((k0) + 32 + sr) * LDK + sc]); \
    sr_[i].ks0 = St::ld8(&Kh[(long)((k0) + sr) * LDK + sc]); sr_[i].ks1 = St::ld8(&Kh[(long)((k0) + 32 + sr) * LDK + sc]); } while (0)
#define SWRITE(b, i) do { *(bf16x8*)((char*)V_lds + (b) * SHM_V + vst0) = St::tobf(sr_[i].vs0);          \
    *(bf16x8*)((char*)V_lds + (b) * SHM_V + vst1) = St::tobf(sr_[i].vs1); int kc = sc * 2;               \
    *(bf16x8*)((char*)K_lds + (b) * SHM_K + KSWZ(sr, kc)) = St::tobf(sr_[i].ks0);                       \
    *(bf16x8*)((char*)K_lds + (b) * SHM_K + KSWZ(32 + sr, kc)) = St::tobf(sr_[i].ks1); } while (0)
#define SWAIT() do { if constexpr (SDEPTH == 2) asm volatile("s_waitcnt vmcnt(4)" ::: "memory"); else asm volatile("s_waitcnt vmcnt(0)" ::: "memory"); } while (0)
#define RESC(a) do { if (__any((a) < 1.f)) { if (hi == 0) al_l[r32] = (a); asm volatile("s_waitcnt lgkmcnt(0)" ::: "memory"); \
    for (int d = 0; d < 4; ++d) for (int r = 0; r < 16; ++r) o[d][r] *= al_l[crow(r, hi)]; } } while (0)
  f32x16 pA0, pA1, pB0, pB1; float mnA, mnB, alA, alB; bf16x8 pa0, pa1, pa2, pa3; const int NT = seq / KVBLK;
  constexpr int SE = 0, SO = SDEPTH - 1;
  SLOAD(SE, 0); asm volatile("s_waitcnt vmcnt(0)" ::: "memory"); SWRITE(0, SE); __syncthreads();
  qkt(pA0, pA1, K_lds, qr, r32, hi); partialSM(pA0, pA1, m_reg, mnA, alA);
  SLOAD(SO, KVBLK); if constexpr (SDEPTH == 2) { if (2 < NT) SLOAD(SE, 2 * KVBLK); }
  SWAIT(); SWRITE(1, SO); __syncthreads();
  for (int j = 1; j + 1 < NT; j += 2) {
    SBAR(); qkt(pB0, pB1, (bf16*)((char*)K_lds + SHM_K), qr, r32, hi);
    finishSM(pA0, pA1, alA, l_reg, pa0, pa1, pa2, pa3); SBAR();
    SLOAD(SO, (j + SDEPTH) * KVBLK); SBAR();
    pv_d0(o, vb0, pa0, pa1, pa2, pa3); partialSM(pB0, pB1, m_reg, mnB, alB);
    __syncthreads(); SWAIT(); SWRITE(0, SE);
    RESC(alB); __syncthreads();
    SBAR(); qkt(pA0, pA1, K_lds, qr, r32, hi);
    finishSM(pB0, pB1, alB, l_reg, pa0, pa1, pa2, pa3); SBAR();
    if (SDEPTH == 1 || j + 3 < NT) SLOAD(SE, (j + 1 + SDEPTH) * KVBLK); SBAR();
    pv_d0(o, vb0 + (int)SHM_V, pa0, pa1, pa2, pa3); partialSM(pA0, pA1, m_reg, mnA, alA);
    __syncthreads(); SWAIT(); SWRITE(1, SO);
    RESC(alA); __syncthreads();
  }
  SBAR(); qkt(pB0, pB1, (bf16*)((char*)K_lds + SHM_K), qr, r32, hi);
  finishSM(pA0, pA1, alA, l_reg, pa0, pa1, pa2, pa3); SBAR();
  pv_d0(o, vb0, pa0, pa1, pa2, pa3); partialSM(pB0, pB1, m_reg, mnB, alB);
  __syncthreads(); RESC(alB);
  finishSM(pB0, pB1, alB, l_reg, pa0, pa1, pa2, pa3); SBAR();
  pv_d0(o, vb0 + (int)SHM_V, pa0, pa1, pa2, pa3);
  if (hi == 0) li_l[r32] = l_reg; asm volatile("s_waitcnt lgkmcnt(0)" ::: "memory");
  float rli[16];
#pragma unroll
  for (int r = 0; r < 16; ++r) rli[r] = __builtin_amdgcn_rcpf(li_l[crow(r, hi)]);
  bf16* Ow = Ob + (long)(wid * QBLK) * LDO;
#pragma unroll
  for (int r = 0; r < 16; ++r) { int orow = crow(r, hi);
    for (int d0 = 0; d0 < 4; ++d0) Ow[(long)orow * LDO + d0 * 32 + r32] = __float2bfloat16(o[d0][r] * rli[r]); }
#undef SLOAD
#undef SWRITE
#undef SWAIT
#undef RESC
}
}
#define LAS __attribute__((address_space(3)))
typedef unsigned short bf16_t;
typedef short bf16x8 __attribute__((ext_vector_type(8)));
typedef float f32x4 __attribute__((ext_vector_type(4)));
typedef float f32x16 __attribute__((ext_vector_type(16)));
typedef unsigned u32x4 __attribute__((ext_vector_type(4)));
typedef unsigned u32x2 __attribute__((ext_vector_type(2)));

constexpr int DM = 1024, NB = 8, SEQ = 4096, CTXL = 256, TPB = SEQ + CTXL, MT = NB * TPB, DFF = 2816, DEPTH = 4;
constexpr int NQKV = 1536, NGIN = 3328;
constexpr float EPS = 1e-6f;
constexpr int LDS_BYTES = 147456;
constexpr int NTHREADS = 512;

constexpr size_t MiB = 1u << 20;
constexpr size_t WS_MOD = 1 * MiB;
constexpr size_t WS_W1T = 3 * MiB;
constexpr size_t WS_W2T = WS_W1T + 88 * MiB;
constexpr size_t WS_WQKVT = WS_W2T + 44 * MiB;
constexpr size_t WS_WOAT = WS_WQKVT + 6 * MiB;
constexpr size_t WS_WGINT = WS_WOAT + 4 * MiB;
constexpr size_t WS_WGOT = WS_WGINT + 13 * MiB;
constexpr size_t WS_HRES = WS_WGOT + 4 * MiB;
constexpr size_t WS_U = WS_HRES + 136 * MiB;
constexpr size_t WS_Y = WS_U + 68 * MiB;
constexpr size_t WS_BIG = WS_Y + 68 * MiB;
constexpr size_t WS_ATTNO = WS_BIG + 102 * MiB;
constexpr size_t WS_END = WS_BIG + 221 * MiB;
constexpr size_t WS_PART_IN_OUT = 112 * MiB;
static_assert((size_t)MT * NGIN * 2 <= 221 * MiB && (size_t)MT * DFF * 2 <= 221 * MiB && (size_t)MT * NQKV * 2 <= 102 * MiB, "ws map");

struct Args { const float* in[20]; float* out; unsigned char* ws; };
typedef const __attribute__((address_space(4))) Args* KA;
__device__ __forceinline__ KA kargs() { KA p = (KA)__builtin_amdgcn_kernarg_segment_ptr(); asm volatile("" : "+s"(p)); return p; }
enum { I_X = 0, I_C, I_CTX, I_CCTX, I_ADAW, I_ADAB, I_NPRE, I_NPOST, I_FW1, I_FW2, I_AQKV, I_AQG, I_AKG, I_AWO, I_GWIN, I_GWA1, I_GWA2, I_GBA, I_GOG, I_GWO };

__device__ __forceinline__ unsigned cvtpk(float lo, float hi) { return pg8::cvt_pk_bf16(lo, hi); }
__device__ __forceinline__ float bf_lo(unsigned w) { return __uint_as_float(w << 16); }
__device__ __forceinline__ float bf_hi(unsigned w) { return __uint_as_float(w & 0xffff0000u); }
__device__ __forceinline__ float bf_f(bf16_t h) { return __uint_as_float(((unsigned)h) << 16); }
__device__ __forceinline__ bf16_t f_bf(float f) { return (bf16_t)(cvtpk(f, 0.f) & 0xffffu); }
__device__ __forceinline__ float wave_sum(float v) {
#pragma unroll
    for (int o = 1; o < 64; o <<= 1) v += __shfl_xor(v, o);
    return v;
}
__device__ __forceinline__ float silu(float x) { return x / (1.0f + __expf(-x)); }

__device__ __forceinline__ void phase_mod(KA a, LAS unsigned char* lds) {
    LAS float* sv = (LAS float*)lds;
    LAS float* red = (LAS float*)(lds + 9 * 1024 * 4);
    const int tid = tid_l(), lane = tid & 63, wave = tid >> 6;
    const float* c = a->in[I_C]; const float* cc = a->in[I_CCTX];
    for (int i = tid; i < 9 * 1024; i += NTHREADS) { const int v = i >> 10, k = i & 1023; const float x = v < 8 ? c[v * 1024 + k] : cc[k]; sv[i] = silu(x); }
    __syncthreads();
    float* mod = (float*)(a->ws + WS_MOD);
    for (int it = blk_l(); it < DEPTH * 144; it += grd_l()) {
        const int L = it / 144, cgp = it % 144;
        const float* w = a->in[I_ADAW] + (size_t)L * 1024 * 9216 + cgp * 64 + lane;
        float acc[9];
#pragma unroll
        for (int v = 0; v < 9; ++v) acc[v] = 0.f;
        const int k0 = wave * 128;
#pragma unroll 8
        for (int k = 0; k < 128; ++k) { const float wv = w[(size_t)(k0 + k) * 9216];
#pragma unroll
            for (int v = 0; v < 9; ++v) acc[v] += sv[v * 1024 + k0 + k] * wv; }
#pragma unroll
        for (int v = 0; v < 9; ++v) red[(wave * 9 + v) * 64 + lane] = acc[v];
        __syncthreads();
        for (int i = tid; i < 576; i += NTHREADS) { const int v = i >> 6, l = i & 63; float s = 0.f;
#pragma unroll
            for (int w8 = 0; w8 < 8; ++w8) s += red[(w8 * 9 + v) * 64 + l];
            s += a->in[I_ADAB][L * 9216 + cgp * 64 + l];
            mod[(size_t)(L * 9 + v) * 9216 + cgp * 64 + l] = s; }
        __syncthreads();
    }
}

__device__ __forceinline__ unsigned pk2(float lo, float hi) { return cvtpk(lo, hi); }
__device__ __forceinline__ void tr_item(const float* W, int Nsrc, int srccol0, int k0, bf16_t* dst  , int K, LAS float* scr, int lane) {
#pragma unroll 8
    for (int i = 0; i < 32; ++i) { const int kk = 2 * i + (lane >> 5); scr[kk * 33 + (lane & 31)] = W[(size_t)(k0 + kk) * Nsrc + srccol0 + (lane & 31)]; }
    asm volatile("s_waitcnt lgkmcnt(0)" ::: "memory");
    const int c = lane & 7;
#pragma unroll
    for (int j = 0; j < 4; ++j) { const int n = (lane >> 3) + 8 * j; const LAS float* s = scr + (8 * c) * 33 + n;
        u32x4 o; o.x = pk2(s[0 * 33], s[1 * 33]); o.y = pk2(s[2 * 33], s[3 * 33]); o.z = pk2(s[4 * 33], s[5 * 33]); o.w = pk2(s[6 * 33], s[7 * 33]);
        *(u32x4*)(dst + (size_t)n * K + 8 * c) = o; }
    asm volatile("s_waitcnt lgkmcnt(0)" ::: "memory");
}
__device__ __forceinline__ void phase_weights(KA a, LAS unsigned char* lds) {
    const int tid = tid_l(), lane = tid & 63, wave = tid >> 6;
    LAS float* scr = (LAS float*)(lds + 65536 + wave * 8704);
    const int gw = blk_l() * 8 + wave, NGW = grd_l() * 8;
    constexpr int I_W1 = 176 * 16, I_W2 = 32 * 44, I_QKV = 48 * 16, I_SQ = 32 * 16, I_GIN = 96 * 16;
    constexpr int N1 = 8 * I_W1, N2 = 8 * I_W2, N3 = 2 * I_QKV, N4 = 2 * I_SQ, N5 = 2 * I_GIN, N6 = 2 * I_SQ;
    constexpr int NITEMS = N1 + N2 + N3 + N4 + N5 + N6;
    for (int it = gw; it < NITEMS; it += NGW) {
        int r = it;
        if (r < N1) { const int mat = r / I_W1, q = r % I_W1, ng = q / 16, kb = q % 16; const int pn = ng >> 3, r0 = (ng & 7) * 32;
            const int src = r0 < 128 ? 128 * pn + r0 : DFF + 128 * pn + (r0 - 128);
            tr_item(a->in[I_FW1] + (size_t)mat * 1024 * 5632, 5632, src, kb * 64, (bf16_t*)(a->ws + WS_W1T) + (size_t)mat * 5632 * 1024 + (size_t)(ng * 32) * 1024 + kb * 64, 1024, scr, lane); continue; }
        r -= N1;
        if (r < N2) { const int mat = r / I_W2, q = r % I_W2, ng = q / 44, kb = q % 44;
            tr_item(a->in[I_FW2] + (size_t)mat * 2816 * 1024, 1024, ng * 32, kb * 64, (bf16_t*)(a->ws + WS_W2T) + (size_t)mat * 1024 * 2816 + (size_t)(ng * 32) * 2816 + kb * 64, 2816, scr, lane); continue; }
        r -= N2;
        if (r < N3) { const int mat = r / I_QKV, q = r % I_QKV, ng = q / 16, kb = q % 16;
            tr_item(a->in[I_AQKV] + (size_t)mat * 1024 * 1536, 1536, ng * 32, kb * 64, (bf16_t*)(a->ws + WS_WQKVT) + (size_t)mat * 1536 * 1024 + (size_t)(ng * 32) * 1024 + kb * 64, 1024, scr, lane); continue; }
        r -= N3;
        if (r < N4) { const int mat = r / I_SQ, q = r % I_SQ, ng = q / 16, kb = q % 16;
            tr_item(a->in[I_AWO] + (size_t)mat * 1024 * 1024, 1024, ng * 32, kb * 64, (bf16_t*)(a->ws + WS_WOAT) + (size_t)mat * 1024 * 1024 + (size_t)(ng * 32) * 1024 + kb * 64, 1024, scr, lane); continue; }
        r -= N4;
        if (r < N5) { const int mat = r / I_GIN, q = r % I_GIN, ng = q / 16, kb = q % 16;
            tr_item(a->in[I_GWIN] + (size_t)mat * 1024 * 3072, 3072, ng * 32, kb * 64, (bf16_t*)(a->ws + WS_WGINT) + (size_t)mat * NGIN * 1024 + (size_t)(ng * 32) * 1024 + kb * 64, 1024, scr, lane); continue; }
        r -= N5;
        { const int mat = r / I_SQ, q = r % I_SQ, ng = q / 16, kb = q % 16;
            tr_item(a->in[I_GWO] + (size_t)mat * 1024 * 1024, 1024, ng * 32, kb * 64, (bf16_t*)(a->ws + WS_WGOT) + (size_t)mat * 1024 * 1024 + (size_t)(ng * 32) * 1024 + kb * 64, 1024, scr, lane); }
    }
    const int gt = blk_l() * NTHREADS + tid, NGT = grd_l() * NTHREADS;
    for (int i = gt; i < 2 * 256 * 128; i += NGT) {
        const int m = i / (256 * 128), q = i % (256 * 128), j = q / 128, k8 = (q % 128) * 8;
        float v[8];
#pragma unroll
        for (int e = 0; e < 8; ++e) v[e] = j < 32 ? a->in[I_GWA1][((size_t)(m * 2 + (j >> 4)) * 1024 + k8 + e) * 16 + (j & 15)] : 0.f;
        u32x4 o; o.x = pk2(v[0], v[1]); o.y = pk2(v[2], v[3]); o.z = pk2(v[4], v[5]); o.w = pk2(v[6], v[7]);
        *(u32x4*)((bf16_t*)(a->ws + WS_WGINT) + (size_t)m * NGIN * 1024 + (size_t)(3072 + j) * 1024 + k8) = o;
    }
}

struct RowP { int Lpost, jpost; float gs; int Lpre, jpre; bool final_out; };
template <bool FROM_INPUT>
__device__ __forceinline__ void row_pair(KA a, const RowP p, int ra, int rb, bool ona, bool onb, int lane) {
    bf16_t* hres = (bf16_t*)(a->ws + WS_HRES); const float* mod = (const float*)(a->ws + WS_MOD);
    const bf16_t* Y = (const bf16_t*)(a->ws + WS_Y); bf16_t* U = (bf16_t*)(a->ws + WS_U);
    const float* gpost = a->in[I_NPOST] + (size_t)(p.Lpost * 3 + (p.jpost < 0 ? 0 : p.jpost)) * DM; const float* gpre = a->in[I_NPRE] + (size_t)(p.Lpre * 3 + (p.jpre < 0 ? 0 : p.jpre)) * DM;
    int rr[2] = {ra, rb}, bb[2], pp[2]; bool cx[2], on[2] = {ona, onb};
#pragma unroll
    for (int k = 0; k < 2; ++k) { bb[k] = rr[k] / TPB; pp[k] = rr[k] - bb[k] * TPB; cx[k] = pp[k] < CTXL; }
    f32x4 h[2][4], y[2][4];
#pragma unroll
    for (int k = 0; k < 2; ++k) {
        if (FROM_INPUT) { const float* src = cx[k] ? a->in[I_CTX] + (size_t)(bb[k] * CTXL + pp[k]) * DM : a->in[I_X] + (size_t)(bb[k] * SEQ + pp[k] - CTXL) * DM;
#pragma unroll
            for (int q = 0; q < 4; ++q) h[k][q] = *(const f32x4*)(src + 4 * lane + 256 * q); }
        else {
#pragma unroll
            for (int q = 0; q < 4; ++q) { const u32x2 w = *(const u32x2*)(hres + (size_t)rr[k] * DM + 4 * lane + 256 * q); h[k][q] = (f32x4){bf_lo(w.x), bf_hi(w.x), bf_lo(w.y), bf_hi(w.y)}; } }
        if (p.jpost >= 0) {
#pragma unroll
            for (int q = 0; q < 4; ++q) { const u32x2 w = *(const u32x2*)(Y + (size_t)rr[k] * DM + 4 * lane + 256 * q);
                y[k][q] = (f32x4){bf_lo(w.x), bf_hi(w.x), bf_lo(w.y), bf_hi(w.y)}; } }
    }
#pragma unroll
    for (int k = 0; k < 2; ++k) {
        const int mi = cx[k] ? 8 : bb[k];
        if (p.jpost >= 0) {
            float ss = 0.f;
#pragma unroll
            for (int q = 0; q < 4; ++q) ss += (y[k][q].x * y[k][q].x + y[k][q].y * y[k][q].y) + (y[k][q].z * y[k][q].z + y[k][q].w * y[k][q].w);
            const float rstd = 1.0f / sqrtf(wave_sum(ss) * (1.0f / DM) + EPS);
            const float* gate = mod + (size_t)(p.Lpost * 9 + mi) * 9216 + (3 * p.jpost + 2) * 1024;
#pragma unroll
            for (int q = 0; q < 4; ++q) { const f32x4 gt = *(const f32x4*)(gate + 4 * lane + 256 * q), gg = *(const f32x4*)(gpost + 4 * lane + 256 * q);
                h[k][q] += p.gs * gt * (y[k][q] * rstd * gg); }
        }
        if (on[k]) {
            if (p.final_out) { float* o = a->out + (size_t)(bb[k] * SEQ + pp[k] - CTXL) * DM;
#pragma unroll
                for (int q = 0; q < 4; ++q) *(f32x4*)(o + 4 * lane + 256 * q) = h[k][q]; }
            else {
#pragma unroll
                for (int q = 0; q < 4; ++q) { u32x2 w; w.x = cvtpk(h[k][q].x, h[k][q].y); w.y = cvtpk(h[k][q].z, h[k][q].w); *(u32x2*)(hres + (size_t)rr[k] * DM + 4 * lane + 256 * q) = w; } }
        }
        if (p.jpre >= 0) {
            float ss = 0.f;
#pragma unroll
            for (int q = 0; q < 4; ++q) ss += (h[k][q].x * h[k][q].x + h[k][q].y * h[k][q].y) + (h[k][q].z * h[k][q].z + h[k][q].w * h[k][q].w);
            const float rstd = 1.0f / sqrtf(wave_sum(ss) * (1.0f / DM) + EPS);
            const float* mb = mod + (size_t)(p.Lpre * 9 + mi) * 9216 + (3 * p.jpre) * 1024;
            if (on[k]) {
#pragma unroll
                for (int q = 0; q < 4; ++q) { const f32x4 sh = *(const f32x4*)(mb + 4 * lane + 256 * q), sc = *(const f32x4*)(mb + 1024 + 4 * lane + 256 * q), gg = *(const f32x4*)(gpre + 4 * lane + 256 * q);
                    const f32x4 u = h[k][q] * rstd * gg * (1.0f + sc) + sh;
                    u32x2 w; w.x = cvtpk(u.x, u.y); w.y = cvtpk(u.z, u.w); *(u32x2*)(U + (size_t)rr[k] * DM + 4 * lane + 256 * q) = w; } }
        }
    }
}
template <bool FROM_INPUT>
__device__ __forceinline__ void row_pass(KA a, const RowP p) {
    const int tid = tid_l(), lane = tid & 63, wave = tid >> 6;
    const int gw = blk_l() * 8 + wave, NGW = grd_l() * 8;
    for (int r0 = gw; r0 < MT; r0 += 2 * NGW) { const int r1 = r0 + NGW; const bool on1 = r1 < MT; row_pair<FROM_INPUT>(a, p, r0, on1 ? r1 : r0, true, on1, lane); }
}
__device__ __forceinline__ void row_pass_queue(KA a, const RowP p, unsigned* sig, unsigned need_lat, unsigned need_ctx, bool with_ctx, LAS unsigned char* lds) {
    const int tid = tid_l(), lane = tid & 63, wave = tid >> 6;
    volatile LAS unsigned* tk = (volatile LAS unsigned*)(lds + LDS_BYTES - 64 + 16);
    const unsigned nchunk = 512u + (with_ctx ? 32u : 0u);
    bool rdy_lat = false, rdy_ctx = false;
    for (;;) {
        if (tid == 0) tk[0] = __hip_atomic_fetch_add(sig + 128, 1u, __ATOMIC_RELAXED, __HIP_MEMORY_SCOPE_AGENT);
        __syncthreads();
        const unsigned t = tk[0];
        __syncthreads();
        if (t >= nchunk) break;
        const bool isc = t >= 512u;
        if (isc ? !rdy_ctx : !rdy_lat) {
            if (tid == 0) { unsigned* w = sig + (isc ? 64 : 0); const unsigned need = isc ? need_ctx : need_lat; unsigned sp = 0;
                while (__hip_atomic_load(w, __ATOMIC_RELAXED, __HIP_MEMORY_SCOPE_AGENT) < need) { __builtin_amdgcn_s_sleep(2); if (++sp > (1u << 22)) break; }
                __builtin_amdgcn_fence(__ATOMIC_ACQUIRE, "agent"); asm volatile("s_waitcnt vmcnt(0)" ::: "memory"); }
            __syncthreads();
            if (isc) rdy_ctx = true; else rdy_lat = true;
        }
        int rbase;
        if (!isc) { const int lr = (int)t * 64; rbase = (lr >> 12) * TPB + CTXL + (lr & 4095); }
        else { const int cr = ((int)t - 512) * 64; rbase = (cr >> 8) * TPB + (cr & 255); }
#pragma unroll 1
        for (int it = 0; it < 4; ++it) { const int r0 = rbase + wave * 8 + 2 * it; row_pair<false>(a, p, r0, r0 + 1, true, true, lane); }
    }
}

__device__ __forceinline__ void phase_qknorm_rope(KA a, int m) {
    const int tid = tid_l(), lane = tid & 63, wave = tid >> 6;
    const int gw = blk_l() * 8 + wave, NGW = grd_l() * 8;
    bf16_t* QKV = (bf16_t*)(a->ws + WS_BIG);
    const int i = lane & 31, hl = lane >> 5, d1 = i + 64 * hl, d2 = d1 + 32;
    const float qg1 = a->in[I_AQG][m * 128 + d1], qg2 = a->in[I_AQG][m * 128 + d2], kg1 = a->in[I_AKG][m * 128 + d1], kg2 = a->in[I_AKG][m * 128 + d2];
    const float inv = exp2f(-(float)i * (13.287712379549449f / 32.0f));
    for (int r = gw; r < MT; r += NGW) {
        const int b = r / TPB, pos = r - b * TPB; const bool isctx = pos < CTXL;
        float cs = 1.f, sn = 0.f;
        if (!isctx) { const int t = pos - CTXL; const float p = (float)(hl ? (t & 63) : (t >> 6)); const float ang = p * inv; cs = cosf(ang); sn = sinf(ang); }
        bf16_t* row = QKV + (size_t)r * NQKV;
#pragma unroll
        for (int hd = 0; hd < 10; ++hd) {
            float x1 = bf_f(row[hd * 128 + d1]), x2 = bf_f(row[hd * 128 + d2]);
            const float rstd = 1.0f / sqrtf(wave_sum(x1 * x1 + x2 * x2) * (1.0f / 128.0f) + EPS);
            x1 *= rstd * (hd < 8 ? qg1 : kg1); x2 *= rstd * (hd < 8 ? qg2 : kg2);
            const float o1 = x1 * cs - x2 * sn, o2 = x2 * cs + x1 * sn;
            row[hd * 128 + d1] = f_bf(o1); row[hd * 128 + d2] = f_bf(o2);
        }
    }
}

__device__ __forceinline__ void phase_attention(KA a, char* lds) {
    const int G = grd_l(); const int bx = blk_l(); const int vcu = (G % 8 == 0) ? (bx % 8) * (G / 8) + bx / 8 : bx;
    const att::bf16* QKV = (const att::bf16*)(a->ws + WS_BIG); att::bf16* AO = (att::bf16*)(a->ws + WS_ATTNO);
    for (int u = vcu; u < 1024 + 64; u += G) {
        int b, h, q0, seq;
        if (u < 1024) { const int grp = u >> 6, within = u & 63; b = grp >> 1; h = (grp & 1) * 4 + (within >> 4); q0 = CTXL + (within & 15) * 256; seq = TPB; }
        else { const int cu = u - 1024; b = cu >> 3; h = cu & 7; q0 = 0; seq = CTXL; }
        const int kvh = h >> 2; const size_t rb = (size_t)b * TPB;
        att::attn_dense_body<att::bf16>(QKV + (rb + q0) * NQKV + h * 128, QKV + rb * NQKV + 1024 + kvh * 128, QKV + rb * NQKV + 1280 + kvh * 128, AO + (rb + q0) * DM + h * 128, seq, lds);
        __syncthreads();
    }
}

namespace gla {
__device__ __forceinline__ int crow(int r, int hi) { return (r & 3) + 8 * (r >> 2) + 4 * hi; }
constexpr int QD_OFF = 0, KI_OFF = 17408, KET_OFF = 34816, VT_OFF = 53248  , SC_OFF = 90112, TS_OFF = 99328  , GSUM_OFF = 107520;
constexpr int STT_OFF = 0  , VTS_OFF = 34816  ;
constexpr size_t KET_BYTES = (size_t)2 * NB * 4 * 68 * 8192 * 2;
constexpr size_t SC_GOFF = KET_BYTES + (size_t)2 * NB * 4 * 68 * 128 * 4;
}
__device__ __forceinline__ void phase_gla_prep(KA a, int m, LAS unsigned char* lds) {
    using namespace gla;
    const int tid = tid_l(), lane = tid & 63, wave = __builtin_amdgcn_readfirstlane(tid >> 6), r32 = lane & 31, hi = lane >> 5;
    bf16_t* Gb = (bf16_t*)(a->ws + WS_BIG);
    const int d = tid & 127, tg = tid >> 7;
    LAS float* ts = (LAS float*)(lds + TS_OFF); LAS float* gsum = (LAS float*)(lds + GSUM_OFF);
    for (int item = blk_l(); item < NB * 4 * 68; item += grd_l()) {
        const int k = item % 68, h = (item / 68) & 3, b = item / 272;
        const int row0 = b * TPB + 64 * k;
        bf16_t* gp = Gb + (size_t)row0 * NGIN;
        bf16_t qn[16], kn[16];
#pragma unroll
        for (int ii = 0; ii < 16; ++ii) { qn[ii] = gp[(size_t)(16 * tg + ii) * NGIN + h * 128 + d]; kn[ii] = gp[(size_t)(16 * tg + ii) * NGIN + 512 + h * 128 + d]; }
        const u32x2 tw = *(const u32x2*)(gp + (size_t)(tid >> 3) * NGIN + 3072 + 4 * (tid & 7));
        __syncthreads();
        { const int e0 = 4 * (tid & 7), dr = e0 >> 4, r = e0 & 15; LAS float* tp = ts + dr * 1024 + (tid >> 3) * 16 + r;
          tp[0] = bf_lo(tw.x); tp[1] = bf_hi(tw.x); tp[2] = bf_lo(tw.y); tp[3] = bf_hi(tw.y); }
        __syncthreads();
        for (int dir = 0; dir < 2; ++dir) {
            float w2[16];
#pragma unroll
            for (int r = 0; r < 16; ++r) w2[r] = a->in[I_GWA2][((size_t)(m * 2 + dir) * 16 + r) * 512 + h * 128 + d];
            const float bav = a->in[I_GBA][(size_t)(m * 2 + dir) * 512 + h * 128 + d];
            float cum[16];
#pragma unroll
            for (int ii = 0; ii < 16; ++ii) { float x = bav;
#pragma unroll
                for (int r = 0; r < 16; ++r) x += ts[dir * 1024 + (16 * tg + ii) * 16 + r] * w2[r];
                cum[ii] = (fminf(x, 0.f) - __logf(1.0f + __expf(-fabsf(x)))) * (1.0f / 16.0f); }
            if (dir == 0) {
#pragma unroll
                for (int ii = 1; ii < 16; ++ii) cum[ii] += cum[ii - 1];
                gsum[tg * 128 + d] = cum[15];
            } else {
#pragma unroll
                for (int ii = 14; ii >= 0; --ii) cum[ii] += cum[ii + 1];
                gsum[tg * 128 + d] = cum[0];
            }
            __syncthreads();
            const size_t cidx = (size_t)((dir * NB + b) * 4 + h) * 68 + k;
            { const float s0 = gsum[d], s1 = gsum[128 + d], s2 = gsum[256 + d], s3 = gsum[384 + d];
              const float total = (s0 + s1) + (s2 + s3);
              float off;
              if (dir == 0) off = (tg > 0 ? s0 : 0.f) + (tg > 1 ? s1 : 0.f) + (tg > 2 ? s2 : 0.f);
              else off = (tg < 3 ? s3 : 0.f) + (tg < 2 ? s2 : 0.f) + (tg < 1 ? s1 : 0.f);
              unsigned kep[8];
              bf16_t* qdst = gp + (dir ? 512 : 0) + h * 128 + d;
#pragma unroll
              for (int ii = 0; ii < 16; ii += 2) {
                  const float c0 = cum[ii] + off, c1 = cum[ii + 1] + off;
                  const float q0 = bf_f(qn[ii]), q1 = bf_f(qn[ii + 1]), k0 = bf_f(kn[ii]), k1 = bf_f(kn[ii + 1]);
                  const int i0 = 16 * tg + ii;
                  const bf16_t qd0 = f_bf(q0 * 0.08838834764831845f * __expf(c0)), qd1 = f_bf(q1 * 0.08838834764831845f * __expf(c1));
                  *(LAS bf16_t*)(lds + QD_OFF + (i0 * 136 + d) * 2) = qd0;
                  *(LAS bf16_t*)(lds + QD_OFF + ((i0 + 1) * 136 + d) * 2) = qd1;
                  qdst[(size_t)i0 * NGIN] = qd0; qdst[(size_t)(i0 + 1) * NGIN] = qd1;
                  *(LAS bf16_t*)(lds + KI_OFF + (i0 * 136 + d) * 2) = f_bf(k0 * __expf(-c0));
                  *(LAS bf16_t*)(lds + KI_OFF + ((i0 + 1) * 136 + d) * 2) = f_bf(k1 * __expf(-c1));
                  kep[ii >> 1] = cvtpk(k0 * __expf(total - c0), k1 * __expf(total - c1));
              }
              bf16_t* ketg = (bf16_t*)a->out + cidx * 8192 + d * 64 + 16 * tg;
              *(u32x4*)ketg = (u32x4){kep[0], kep[1], kep[2], kep[3]};
              *(u32x4*)(ketg + 8) = (u32x4){kep[4], kep[5], kep[6], kep[7]};
              if (tg == 0) ((float*)((unsigned char*)a->out + KET_BYTES))[cidx * 128 + d] = __expf(total);
            }
            __syncthreads();
            if (wave < 4) {
                const int ti = (wave >> 1) & 1, tj = wave & 1;
                f32x16 acc;
#pragma unroll
                for (int r = 0; r < 16; ++r) acc[r] = 0.f;
                const int aoff = QD_OFF + ((32 * ti + r32) * 136 + 8 * hi) * 2, boff = KI_OFF + ((32 * tj + r32) * 136 + 8 * hi) * 2;
#pragma unroll
                for (int ks = 0; ks < 8; ++ks) { const bf16x8 av = *(const LAS bf16x8*)(lds + aoff + ks * 32), bv = *(const LAS bf16x8*)(lds + boff + ks * 32);
                    acc = __builtin_amdgcn_mfma_f32_32x32x16_bf16(av, bv, acc, 0, 0, 0); }
                bf16_t* scg = (bf16_t*)((unsigned char*)a->out + SC_GOFF) + cidx * 4096;
#pragma unroll
                for (int r = 0; r < 16; ++r) { const int i = 32 * ti + crow(r, hi), j = 32 * tj + r32; const bool keep = dir == 0 ? (j <= i) : (j >= i);
                    scg[i * 64 + j] = f_bf(keep ? acc[r] : 0.f); }
            }
            __syncthreads();
        }
    }
}
__device__ __forceinline__ void phase_gla_scan(KA a, int m, LAS unsigned char* lds) {
    using namespace gla;
    const int tid = tid_l(), lane = tid & 63, wave = __builtin_amdgcn_readfirstlane(tid >> 6), r32 = lane & 31, hi = lane >> 5;
    const int G = grd_l(); const int bx = blk_l(); const int vcu = (G % 8 == 0) ? (bx % 8) * (G / 8) + bx / 8 : bx;
    const bf16_t* Gb = (const bf16_t*)(a->ws + WS_BIG);
    const int dv = tid & 63, tgv = tid >> 6;
    const int ti = (wave >> 1) & 1, tj = wave & 1, role = wave >> 2, sd = wave >> 1, sv = wave & 1;
    for (int item = vcu; item < 256; item += G) {
        const int vs = item & 3, dir = (item >> 2) & 1, h = (item >> 3) & 3, b = item >> 5;
        bf16_t* Oo = (bf16_t*)(a->ws + (dir == 0 ? WS_U : WS_Y));
        const size_t cbase = (size_t)((dir * NB + b) * 4 + h) * 68;
        const bf16_t* ketb = (const bf16_t*)a->out + cbase * 8192 + (32 * sd + r32) * 64 + 8 * hi;
        const bf16_t* scb = (const bf16_t*)((const unsigned char*)a->out + SC_GOFF) + cbase * 4096 + (32 * ti + r32) * 64 + 8 * hi;
        const float* decb = (const float*)((const unsigned char*)a->out + KET_BYTES) + cbase * 128 + 32 * sd + 4 * hi;
        const int qcol = (dir ? 512 : 0) + h * 128 + 8 * hi, vcol = 1024 + h * 256 + vs * 64 + dv, ocol = h * 256 + vs * 64 + 32 * tj + r32;
        __syncthreads();
        for (int i = tid; i < 17408 / 4; i += NTHREADS) ((LAS unsigned*)(lds + STT_OFF))[i] = 0u;
        f32x16 st;
#pragma unroll
        for (int r = 0; r < 16; ++r) st[r] = 0.f;
        bf16x8 qa[8], ke[4], sa[4]; f32x4 dcv[4]; bf16_t vn[8];
#define GLA_K(c) (dir == 0 ? (c) : ((c) < 4 ? 3 - (c) : 71 - (c)))
#define GLA_ROW(c) ((size_t)b * TPB + 64 * GLA_K(c))
#define LD_QA(c) do { if (role == 1) { const size_t row_ = GLA_ROW(c); _Pragma("unroll") for (int ks = 0; ks < 8; ++ks) qa[ks] = *(const bf16x8*)(Gb + (row_ + 32 * ti + r32) * NGIN + qcol + 16 * ks); } } while (0)
#define LD_OIN(c) do { if (role == 1) { const int kk_ = GLA_K(c); _Pragma("unroll") for (int ks = 0; ks < 4; ++ks) sa[ks] = *(const bf16x8*)(scb + (size_t)kk_ * 4096 + 16 * ks); } } while (0)
#define LD_KE(c) do { const int kk_ = GLA_K(c); _Pragma("unroll") for (int ks = 0; ks < 4; ++ks) ke[ks] = *(const bf16x8*)(ketb + (size_t)kk_ * 8192 + 16 * ks); } while (0)
#define LD_DC(c) do { const int kk_ = GLA_K(c); _Pragma("unroll") for (int r4 = 0; r4 < 4; ++r4) dcv[r4] = *(const f32x4*)(decb + (size_t)kk_ * 128 + 8 * r4); } while (0)
#define LD_VN(c) do { const size_t row_ = GLA_ROW(c); _Pragma("unroll") for (int ii = 0; ii < 8; ++ii) vn[ii] = Gb[(row_ + 8 * tgv + ii) * NGIN + vcol]; } while (0)
        LD_VN(0); LD_QA(0); LD_OIN(0); LD_DC(0); LD_KE(0);
        for (int c = 0; c < 68; ++c) {
            const int p_ = c & 1; const size_t rowc_ = GLA_ROW(c); const bool more = c + 1 < 68;
            { u32x4 vp; vp.x = (unsigned)vn[0] | ((unsigned)vn[1] << 16); vp.y = (unsigned)vn[2] | ((unsigned)vn[3] << 16); vp.z = (unsigned)vn[4] | ((unsigned)vn[5] << 16); vp.w = (unsigned)vn[6] | ((unsigned)vn[7] << 16);
              *(LAS u32x4*)(lds + VTS_OFF + p_ * 9216 + (dv * 72 + 8 * tgv) * 2) = vp; }
            if (more) LD_VN(c + 1);
            __syncthreads();
            if (role == 1) {
                f32x16 acc;
#pragma unroll
                for (int r = 0; r < 16; ++r) acc[r] = 0.f;
                const int boff = STT_OFF + p_ * 17408 + ((32 * tj + r32) * 136 + 8 * hi) * 2;
#pragma unroll
                for (int ks = 0; ks < 8; ++ks) { const bf16x8 bv = *(const LAS bf16x8*)(lds + boff + ks * 32);
                    acc = __builtin_amdgcn_mfma_f32_32x32x16_bf16(qa[ks], bv, acc, 0, 0, 0); }
                if (more) LD_QA(c + 1);
                { const int voff = VTS_OFF + p_ * 9216 + ((32 * tj + r32) * 72 + 8 * hi) * 2;
#pragma unroll
                  for (int ks = 0; ks < 4; ++ks) { const bf16x8 bv = *(const LAS bf16x8*)(lds + voff + ks * 32);
                      acc = __builtin_amdgcn_mfma_f32_32x32x16_bf16(sa[ks], bv, acc, 0, 0, 0); } }
                if (more) LD_OIN(c + 1);
                bf16_t* op = Oo + (rowc_ + 32 * ti) * DM + ocol;
#pragma unroll
                for (int r = 0; r < 16; ++r) op[(size_t)crow(r, hi) * DM] = f_bf(acc[r]);
            }
            {
#pragma unroll
              for (int r = 0; r < 16; ++r) st[r] *= dcv[r >> 2][r & 3];
              if (more) LD_DC(c + 1);
              const int boff = VTS_OFF + p_ * 9216 + ((32 * sv + r32) * 72 + 8 * hi) * 2;
#pragma unroll
              for (int ks = 0; ks < 4; ++ks) { const bf16x8 bv = *(const LAS bf16x8*)(lds + boff + ks * 32);
                  st = __builtin_amdgcn_mfma_f32_32x32x16_bf16(ke[ks], bv, st, 0, 0, 0); }
              if (more) LD_KE(c + 1);
#pragma unroll
              for (int r4 = 0; r4 < 4; ++r4) { u32x2 w; w.x = cvtpk(st[4 * r4], st[4 * r4 + 1]); w.y = cvtpk(st[4 * r4 + 2], st[4 * r4 + 3]);
                  *(LAS u32x2*)(lds + STT_OFF + (p_ ^ 1) * 17408 + ((32 * sv + r32) * 136 + 32 * sd + 8 * r4 + 4 * hi) * 2) = w; }
            }
        }
#undef GLA_ROW
#undef LD_QA
#undef LD_OIN
#undef LD_KE
#undef LD_DC
#undef LD_VN
#undef GLA_K
    }
}

__device__ __forceinline__ void phase_gla_readout(KA a, int m, bool skip_ctx) {
    const int tid = tid_l(), lane = tid & 63, wave = tid >> 6;
    const int gw = blk_l() * 8 + wave, NGW = grd_l() * 8;
    const bf16_t* OF = (const bf16_t*)(a->ws + WS_U); const bf16_t* OB = (const bf16_t*)(a->ws + WS_Y); bf16_t* Gb = (bf16_t*)(a->ws + WS_BIG);
    const float* og = a->in[I_GOG] + (size_t)m * 1024;
    for (int r = gw; r < MT; r += NGW) {
        if (skip_ctx && (r % TPB) < CTXL) continue;
#pragma unroll
        for (int q = 0; q < 4; ++q) {
            const int col = 4 * lane + 256 * q;
            const u32x2 wf = *(const u32x2*)(OF + (size_t)r * DM + col), wb = *(const u32x2*)(OB + (size_t)r * DM + col), wr = *(const u32x2*)(Gb + (size_t)r * NGIN + 2048 + col);
            f32x4 s = (f32x4){bf_lo(wf.x) + bf_lo(wb.x), bf_hi(wf.x) + bf_hi(wb.x), bf_lo(wf.y) + bf_lo(wb.y), bf_hi(wf.y) + bf_hi(wb.y)};
            const float ss = wave_sum((s.x * s.x + s.y * s.y) + (s.z * s.z + s.w * s.w));
            const float rstd = 1.0f / sqrtf(ss * (1.0f / 256.0f) + EPS);
            const f32x4 gg = *(const f32x4*)(og + col);
            const f32x4 rr = (f32x4){bf_lo(wr.x), bf_hi(wr.x), bf_lo(wr.y), bf_hi(wr.y)};
            f32x4 o = s * rstd * gg; o.x *= silu(rr.x); o.y *= silu(rr.y); o.z *= silu(rr.z); o.w *= silu(rr.w);
            u32x2 w; w.x = cvtpk(o.x, o.y); w.y = cvtpk(o.z, o.w);
            *(u32x2*)(Gb + (size_t)r * NGIN + 2048 + col) = w;
        }
    }
}

__device__ __forceinline__ unsigned long long rt() { return __builtin_amdgcn_s_memrealtime(); }
#define XB_TMO      128
#define XB_XCNT(j)  (256  + 64 * (j))
#define XB_XSUB(j)  (1280 + 64 * (j))
#define XB_XGEN(j)  (2304 + 64 * (j))
#define XB_TOP      3328
#define XB_TOPGEN   3392
#define XCD_BAR_WORDS 3456
#define XB_SPIN_CAP (1u << 18)

__device__ __forceinline__ unsigned xb_ld(unsigned* p)              { return __hip_atomic_load(p, __ATOMIC_RELAXED, __HIP_MEMORY_SCOPE_AGENT); }
__device__ __forceinline__ unsigned xb_add(unsigned* p, unsigned v) { return __hip_atomic_fetch_add(p, v, __ATOMIC_RELAXED, __HIP_MEMORY_SCOPE_AGENT); }
__device__ __forceinline__ unsigned xb_xcc_id() { return (unsigned)__builtin_amdgcn_s_getreg((3 << 11) | 20) & 0xFu; }
#define XB_SPIN(cond, bar) do { unsigned _sp = 0; while (cond) { __builtin_amdgcn_s_sleep(1); \
    if ((++_sp & 255u) == 0u) { if (xb_ld(&(bar)[XB_TMO])) break; if (_sp > XB_SPIN_CAP) { atomicAdd(&(bar)[XB_TMO], 1u); break; } } } } while (0)

struct XcdBarrier {
    unsigned* bar; unsigned x;
    volatile LAS unsigned* st;
};

__device__ __forceinline__ XcdBarrier xcd_barrier_post(unsigned* bar, volatile LAS unsigned* st) {
    XcdBarrier b; b.bar = bar; b.x = xb_xcc_id(); b.st = st;
    if (threadIdx.x == 0) (void)xb_add(&bar[XB_XCNT(b.x)], 1u);
    return b;
}
__device__ __forceinline__ void xcd_barrier_complete(unsigned* bar, unsigned x, unsigned& nloc, unsigned& nx) {
    const unsigned G = gridDim.x * gridDim.y * gridDim.z;
    unsigned sum, cnt, mine, sp = 0u;
    for (;;) {
        sum = 0u; cnt = 0u; mine = 0u;
#pragma unroll
        for (unsigned j = 0; j < 16; ++j) { const unsigned c = xb_ld(&bar[XB_XCNT(j)]); sum += c; cnt += (c > 0u) ? 1u : 0u; mine = (j == x) ? c : mine; }
        if (sum == G) break;
        __builtin_amdgcn_s_sleep(1);
        if ((++sp & 255u) == 0u) { if (xb_ld(&bar[XB_TMO])) break; if (sp > XB_SPIN_CAP) { atomicAdd(&bar[XB_TMO], 1u); break; } }
    }
    nloc = mine > 0u ? mine : 1u; nx = cnt > 0u ? cnt : 1u;
}

__device__ __forceinline__ void xcd_barrier(const XcdBarrier& b) {
    asm volatile("s_waitcnt vmcnt(0)" ::: "memory");
    __syncthreads();
    if (threadIdx.x == 0) {
        unsigned* bar = b.bar;
        __builtin_amdgcn_s_waitcnt(0);
        unsigned nloc = b.st[0], nx = b.st[1];
        if (nloc == 0u) { xcd_barrier_complete(bar, b.x, nloc, nx); b.st[0] = nloc; b.st[1] = nx; }
        const unsigned old = xb_add(&bar[XB_XSUB(b.x)], 1u);
        const unsigned gen = old / nloc;
        if (old + 1u == (gen + 1u) * nloc) {
            __builtin_amdgcn_fence(__ATOMIC_RELEASE, "agent");
            asm volatile("s_waitcnt vmcnt(0)" ::: "memory");
            const unsigned og = xb_add(&bar[XB_TOP], 1u);
            const unsigned tg = og / nx;
            if (og + 1u == (tg + 1u) * nx) xb_add(&bar[XB_TOPGEN], 1u);
            else XB_SPIN(xb_ld(&bar[XB_TOPGEN]) == tg, bar);
            __builtin_amdgcn_fence(__ATOMIC_ACQUIRE, "agent");
            xb_add(&bar[XB_XGEN(b.x)], 1u);
            asm volatile("s_waitcnt vmcnt(0)" ::: "memory");
        } else {
            XB_SPIN(xb_ld(&bar[XB_XGEN(b.x)]) == gen, bar);
            __builtin_amdgcn_fence(__ATOMIC_ACQUIRE, "agent");
            asm volatile("s_waitcnt vmcnt(0)" ::: "memory");
        }
    }
    __syncthreads();
}

constexpr size_t WS_BAR = 4096;
constexpr size_t WS_XCNT = 65536;
constexpr size_t WS_XBUF = WS_HRES + 68 * MiB;
constexpr size_t WS_DFLOW = 32768;
constexpr int LDS_BARW = LDS_BYTES - 64;
#define GSYNC() do { XcdBarrier b_; b_.bar = (unsigned*)(kargs()->ws + WS_BAR); b_.x = xb_xcc_id(); b_.st = (volatile LAS unsigned*)(lds + LDS_BARW); xcd_barrier(b_); } while (0)
struct EpiRow {
    static constexpr bool PERM = true, AFTER_DRAIN = false;
    int sl; LAS unsigned char* xl;
    __device__ __forceinline__ void operator()(f32x4 (&acc)[2][2][4][2], const pg8::Unit& u, int wr, int wc, int fr, int fq) const {
        KA a_ = kargs(); unsigned char* ws = a_->ws;
        const int L = sl / 3, jpost = sl - 3 * L; const bool lastsl = sl == 3 * DEPTH - 1;
        const int Ln = (jpost == 2) ? L + 1 : L, jn = (jpost == 2) ? 0 : jpost + 1, jpre = lastsl ? -1 : jn, final_out = lastsl ? 1 : 0;
        const float gs = jpost == 1 ? 1.0f : 0.5f;
        bf16_t* hres = (bf16_t*)(ws + WS_HRES); bf16_t* U = (bf16_t*)(ws + WS_U); float* out = a_->out;
        const float* modL_post = (const float*)(ws + WS_MOD) + (size_t)L * 9 * 9216; const float* modL_pre = (const float*)(ws + WS_MOD) + (size_t)(lastsl ? L : Ln) * 9 * 9216;
        const float* gpost = a_->in[I_NPOST] + (size_t)(L * 3 + jpost) * DM; const float* gpre = a_->in[I_NPRE] + (size_t)((lastsl ? L : Ln) * 3 + (lastsl ? 0 : jn)) * DM;
        unsigned* cn1 = (unsigned*)(ws + WS_XCNT) + (size_t)(sl * 2) * 136 * 64; unsigned* cn2 = cn1 + 136 * 64;
        float* xb1 = (float*)(ws + WS_XBUF); float* xb2 = (float*)(ws + WS_XBUF + MiB);
        const int tid = threadIdx.x, wid = __builtin_amdgcn_readfirstlane(tid >> 6), lane = tid & 63;
        const int bidx = u.pm / 17, isctx = (u.pm - 17 * bidx) == 0, mi = isctx ? 8 : bidx;
        const int col0 = u.pn * 256 + wc * 32 + 8 * fq, row0 = u.pm * 256 + wr * 64 + fr, rl0 = wr * 64 + fr;
        const LAS float* S = (const LAS float*)(xl + 4096);
        pg8::rowstats_run(xb1, cn1, acc, u, wr, wc, fr, fq, xl, wid, lane);
        {
            const float* gate = modL_post + (size_t)mi * 9216 + (3 * jpost + 2) * 1024 + col0;
            f32x4 gt[2][2], gp[2][2];
#pragma unroll
            for (int bj = 0; bj < 2; ++bj)
#pragma unroll
                for (int n = 0; n < 2; ++n) { gt[bj][n] = *(const f32x4*)(gate + bj * 128 + 4 * n) * gs; gp[bj][n] = *(const f32x4*)(gpost + col0 + bj * 128 + 4 * n); gt[bj][n] = gt[bj][n] * gp[bj][n]; }
#pragma unroll
            for (int ai = 0; ai < 2; ++ai)
#pragma unroll
                for (int m = 0; m < 4; ++m) {
                    const int rl = rl0 + ai * 128 + m * 16; const size_t roff = (size_t)(row0 + ai * 128 + m * 16) * 1024 + col0;
                    const float rstd = 1.0f / sqrtf(S[rl] * (1.0f / 1024.0f) + 1e-6f);
#pragma unroll
                    for (int bj = 0; bj < 2; ++bj) {
                        const u32x4 hw = *(const u32x4*)(hres + roff + bj * 128);
                        const f32x4 h0 = {__uint_as_float(hw.x << 16), __uint_as_float(hw.x & 0xffff0000u), __uint_as_float(hw.y << 16), __uint_as_float(hw.y & 0xffff0000u)};
                        const f32x4 h1 = {__uint_as_float(hw.z << 16), __uint_as_float(hw.z & 0xffff0000u), __uint_as_float(hw.w << 16), __uint_as_float(hw.w & 0xffff0000u)};
                        const f32x4 n0 = h0 + gt[bj][0] * (acc[ai][bj][m][0] * rstd), n1 = h1 + gt[bj][1] * (acc[ai][bj][m][1] * rstd);
                        acc[ai][bj][m][0] = n0; acc[ai][bj][m][1] = n1;
                        if (final_out) { float* op = out + (size_t)(bidx * 4096 + (u.pm - 17 * bidx - 1) * 256 + wr * 64 + fr + ai * 128 + m * 16) * 1024 + col0 + bj * 128; *(f32x4*)op = n0; *(f32x4*)(op + 4) = n1; }
                        else { u32x4 w; w.x = cvtpk(n0[0], n0[1]); w.y = cvtpk(n0[2], n0[3]); w.z = cvtpk(n1[0], n1[1]); w.w = cvtpk(n1[2], n1[3]); *(u32x4*)(hres + roff + bj * 128) = w; }
                    }
                }
        }
        if (jpre < 0) return;
        pg8::rowstats_run(xb2, cn2, acc, u, wr, wc, fr, fq, xl, wid, lane);
        {
            const float* mb = modL_pre + (size_t)mi * 9216 + (3 * jpre) * 1024 + col0;
            f32x4 sh[2][2], sc[2][2];
#pragma unroll
            for (int bj = 0; bj < 2; ++bj)
#pragma unroll
                for (int n = 0; n < 2; ++n) { sh[bj][n] = *(const f32x4*)(mb + bj * 128 + 4 * n); sc[bj][n] = (1.0f + *(const f32x4*)(mb + 1024 + bj * 128 + 4 * n)) * *(const f32x4*)(gpre + col0 + bj * 128 + 4 * n); }
#pragma unroll
            for (int ai = 0; ai < 2; ++ai)
#pragma unroll
                for (int m = 0; m < 4; ++m) {
                    const int rl = rl0 + ai * 128 + m * 16; const size_t roff = (size_t)(row0 + ai * 128 + m * 16) * 1024 + col0;
                    const float rstd = 1.0f / sqrtf(S[rl] * (1.0f / 1024.0f) + 1e-6f);
#pragma unroll
                    for (int bj = 0; bj < 2; ++bj) {
                        const f32x4 u0 = acc[ai][bj][m][0] * rstd * sc[bj][0] + sh[bj][0], u1 = acc[ai][bj][m][1] * rstd * sc[bj][1] + sh[bj][1];
                        u32x4 w; w.x = cvtpk(u0[0], u0[1]); w.y = cvtpk(u0[2], u0[3]); w.z = cvtpk(u1[0], u1[1]); w.w = cvtpk(u1[2], u1[3]);
                        *(u32x4*)(U + roff + bj * 128) = w;
                    }
                }
        }
    }
};

__global__ void __launch_bounds__(NTHREADS, 2) fwd_megakernel(Args unused_args) {
    extern __shared__ __attribute__((aligned(16))) unsigned char lds_raw[];
    LAS unsigned char* lds = (LAS unsigned char*)lds_raw;
    cg::grid_group grid = cg::this_grid();
    if (threadIdx.x < 16) ((LAS unsigned*)(lds + LDS_BARW))[threadIdx.x] = 0u;
    __syncthreads();
    (void)xcd_barrier_post((unsigned*)(kargs()->ws + WS_BAR), (volatile LAS unsigned*)(lds + LDS_BARW));

#ifndef SKIP_MOD
    phase_mod(kargs(), lds);
#endif
#ifndef SKIP_W
    phase_weights(kargs(), lds);
#endif
    grid.sync();
    row_pass<true>(kargs(), RowP{0, -1, 0.f, 0, 0, false});
    GSYNC();

    for (int sl = 0; sl < 3 * DEPTH; ++sl) {
        const int L = sl / 3, j = sl - 3 * L, m = L >> 1;
        if (j != 1) {
            unsigned char* ws = kargs()->ws; const int f = j >> 1;
            pg8::Gemm g1{(const bf16_t*)(ws + WS_U), (const bf16_t*)(ws + WS_W1T) + (size_t)(L * 2 + f) * 5632 * 1024, MT, 2 * DFF, DM, DM, DM};
            pg8::StaticOrder S; S.init(MT, 2 * DFF, DM, grd_l(), blk_l(), sl == 3 * DEPTH - 1 ? 2 : 0);
            pg8::EpiSwiglu E{(bf16_t*)(ws + WS_BIG), DFF};
#ifndef SKIP_G1
            pg8::gemm_phase<pg8::EpiSwiglu, pg8::StaticOrder, true, true>(lds, g1, S, E);
#endif
            GSYNC();
        } else {
            const bool attn = (L & 1) == 0;
            { unsigned char* ws = kargs()->ws;
              pg8::Gemm g1{(const bf16_t*)(ws + WS_U), attn ? (const bf16_t*)(ws + WS_WQKVT) + (size_t)m * NQKV * 1024 : (const bf16_t*)(ws + WS_WGINT) + (size_t)m * NGIN * 1024, MT, attn ? NQKV : NGIN, DM, DM, DM};
              pg8::StaticOrder S; S.init(MT, g1.N, DM, grd_l(), blk_l(), 0);
              pg8::EpiBf16s E{(bf16_t*)(ws + WS_BIG), g1.N, nullptr};
#ifndef SKIP_GM
              pg8::gemm_phase<pg8::EpiBf16s, pg8::StaticOrder, true, true>(lds, g1, S, E);
#endif
 }
            GSYNC();
            if (attn) {
#ifndef SKIP_QK
                phase_qknorm_rope(kargs(), m);
#endif
                GSYNC();
#ifndef SKIP_ATT
                phase_attention(kargs(), (char*)lds_raw);
#endif
                GSYNC();
            } else {
                phase_gla_prep(kargs(), m, lds);
                GSYNC();
                phase_gla_scan(kargs(), m, lds);
                GSYNC();
#ifndef SKIP_RO
                phase_gla_readout(kargs(), m, sl >= 10);
#endif
                GSYNC();
            }
        }
        {
            unsigned char* ws = kargs()->ws;
            pg8::Gemm g2;
            if (j != 1) g2 = pg8::Gemm{(const bf16_t*)(ws + WS_BIG), (const bf16_t*)(ws + WS_W2T) + (size_t)(L * 2 + (j >> 1)) * 1024 * 2816, MT, DM, DFF, DFF, DFF};
            else if ((L & 1) == 0) g2 = pg8::Gemm{(const bf16_t*)(ws + WS_ATTNO), (const bf16_t*)(ws + WS_WOAT) + (size_t)m * 1024 * 1024, MT, DM, DM, DM, DM};
            else g2 = pg8::Gemm{(const bf16_t*)(ws + WS_BIG) + 2048, (const bf16_t*)(ws + WS_WGOT) + (size_t)m * 1024 * 1024, MT, DM, DM, NGIN, DM};
            pg8::StaticOrder S; S.init(MT, DM, g2.K, grd_l(), blk_l(), sl >= 10 ? 2 : 3);
            EpiRow E{sl, lds + 131072};
#ifndef SKIP_G2
            pg8::gemm_phase<EpiRow, pg8::StaticOrder, true, true>(lds, g2, S, E);
#endif
        }
        const bool last = sl == 3 * DEPTH - 1;
        if (!last) GSYNC();
    }
}

extern "C" void kernel_launch(void* const* d_in, const int* in_sizes, int n_in, void* d_out, int out_size, void* d_ws, size_t ws_size, hipStream_t stream) {
    static int grid = 0;
    if (grid == 0) {
        if (n_in != 20 || out_size != NB * SEQ * DM || ws_size < WS_END) { fprintf(stderr, "kernel_launch: unexpected shapes: n_in %d out %d ws %zu (need %zu)\n", n_in, out_size, ws_size, (size_t)WS_END); grid = -1; return; }
        int dev = 0, cus = 0, per_cu = 0;
        (void)hipGetDevice(&dev);
        (void)hipDeviceGetAttribute(&cus, hipDeviceAttributeMultiprocessorCount, dev);
        (void)hipFuncSetAttribute((const void*)fwd_megakernel, hipFuncAttributeMaxDynamicSharedMemorySize, LDS_BYTES);
        (void)hipOccupancyMaxActiveBlocksPerMultiprocessor(&per_cu, (const void*)fwd_megakernel, NTHREADS, LDS_BYTES);
        if (per_cu < 1) per_cu = 1;
        grid = cus * per_cu;
        fprintf(stderr, "kernel_launch: grid %d (cus %d x %d), ws %zu\n", grid, cus, per_cu, ws_size);
    }
    if (grid < 0) return;
    (void)hipMemsetAsync(d_ws, 0, 1 * MiB, stream);
    Args a{};
    for (int i = 0; i < 20; ++i) a.in[i] = (const float*)d_in[i];
    a.out = (float*)d_out; a.ws = (unsigned char*)d_ws;
    void* args[] = {&a};
    hipError_t e = hipLaunchCooperativeKernel((const void*)fwd_megakernel, dim3(grid), dim3(NTHREADS), args, LDS_BYTES, stream);
    if (e != hipSuccess) fprintf(stderr, "kernel_launch: cooperative launch failed: %s (grid %d)\n", hipGetErrorString(e), grid);
}
```

```cpp
#include <hip/hip_runtime.h>
#include <hip/hip_cooperative_groups.h>
#include <hip/hip_bf16.h>
#include <cstdio>
#include <cstdint>
namespace cg = cooperative_groups;
__device__ __forceinline__ int tid_l() { int t = threadIdx.x; asm volatile("" : "+v"(t)); return t; }
__device__ __forceinline__ int blk_l() { int t = blockIdx.x; asm volatile("" : "+s"(t)); return t; }
__device__ __forceinline__ int grd_l() { int t = gridDim.x; asm volatile("" : "+s"(t)); return t; }
namespace pg8 {
#define PG8_LAS __attribute__((address_space(3)))
typedef unsigned short bf16_t;
typedef short bf16x8 __attribute__((ext_vector_type(8)));
typedef float f32x4 __attribute__((ext_vector_type(4)));
typedef unsigned u32x4 __attribute__((ext_vector_type(4)));
constexpr int BM = 256, BK = 64, HALF = 128, HTB = HALF * BK * 2  , STAGE_BYTES = 8 * HTB, NXCD = 8, WGM = 8;

__host__ __device__ __forceinline__ int lds_byte(int r, int c) { const int st = (r >> 4) * 2 + (c >> 5), rr = r & 15, cc = c & 31, ob = rr * 64 + cc * 2; return st * 1024 + (ob ^ (((ob >> 9) & 1) << 5)); }
__host__ __device__ __forceinline__ void stage_rc(int b, int& R, int& C) { const int st = b / 1024, sb = b % 1024, swz = sb ^ (((sb >> 9) & 1) << 5); R = (st >> 1) * 16 + swz / 64; C = (st & 1) * 32 + (swz % 64) / 2; }
__host__ __device__ __forceinline__ int perm32(int rho) { const int n = rho >> 4, i = rho & 15; return 8 * (i >> 2) + 4 * n + (i & 3); }

struct Unit { int pm, pn, kt0, nt, part, sig; };
struct Gemm { const bf16_t* A; const bf16_t* Bt; int M, N, K, lda, ldb; };

struct StaticOrder {
    int nM, nN, nwg, G, c, mode, ntfull; unsigned* sig;
    __host__ __device__ void init(int M, int N, int K, int G_, int c_, int mode_) { mode = mode_; nM = mode ? 128 : M / BM; nN = N / BM; nwg = nM * nN; G = G_; c = c_; ntfull = K / BK; sig = nullptr; }
    __host__ __device__ __forceinline__ bool next(int i, Unit& u) const {
        const long L = (long)i * G + c;
        int pm = 0, pn = 0, kt0 = 0, nt = ntfull, part = -1, sg = 0; bool ok = true;
        if (L >= nwg) {
            const int e = (int)(L - nwg);
            if (mode == 3) { ok = e < 8 * nN; pm = 17 * (e / nN); pn = e % nN; sg = 2; }
            else { ok = (mode == 1) && (e < 16 * nN); const int ct = e >> 1; pm = 17 * (ct / nN); pn = ct % nN; part = e & 1; nt = ntfull >> 1; kt0 = part * nt; }
        } else {
            int wgid = (int)L; { const int q = nwg / NXCD, r = nwg % NXCD, xcd = wgid % NXCD, off = wgid / NXCD; wgid = (xcd < r ? xcd * (q + 1) : r * (q + 1) + (xcd - r) * q) + off; }
            const int nig = WGM * nN, gid = wgid / nig, fm = gid * WGM, gsz = (nM - fm) < WGM ? (nM - fm) : WGM;
            pm = fm + ((wgid % nig) % gsz); pn = (wgid % nig) / gsz;
            if (mode) pm += (pm >> 4) + 1;
            sg = (mode >= 2 && L + G >= nwg) ? 1 : 0;
        }
        u.pm = pm; u.pn = pn; u.kt0 = kt0; u.nt = nt; u.part = part; u.sig = sg;
        return ok;
    }
    __device__ __forceinline__ void a_ready(const Unit&) const {}
    __device__ __forceinline__ void done(const Unit& u) const {
        if (sig != nullptr && u.sig != 0) {
            asm volatile("s_waitcnt vmcnt(0)" ::: "memory");
            __builtin_amdgcn_s_barrier(); asm volatile("" ::: "memory");
            if (threadIdx.x == 0) {
                __builtin_amdgcn_fence(__ATOMIC_RELEASE, "agent");
                asm volatile("s_waitcnt vmcnt(0)" ::: "memory");
                __hip_atomic_fetch_add(sig + (u.sig == 1 ? 0 : 64), 1u, __ATOMIC_RELAXED, __HIP_MEMORY_SCOPE_AGENT);
            }
        }
    }
};

typedef float f32x2c_t __attribute__((ext_vector_type(2))); typedef __bf16 bf16x2c_t __attribute__((ext_vector_type(2)));
__device__ __forceinline__ unsigned cvt_pk_bf16(float lo, float hi) { f32x2c_t v = {lo, hi}; bf16x2c_t b = __builtin_convertvector(v, bf16x2c_t); return __builtin_bit_cast(unsigned, b); }
typedef float f32x2 __attribute__((ext_vector_type(2)));
struct EpiBf16s {
    static constexpr bool PERM = true, AFTER_DRAIN = false;
    bf16_t* O; int ldc; float* P;
    __device__ __forceinline__ void operator()(const f32x4 (&acc)[2][2][4][2], const Unit& u, int wr, int wc, int fr, int fq) const {
        const int row0 = u.pm * BM + wr * 64 + fr; const int col0 = u.pn * BM + wc * 32 + 8 * fq;
        if (u.part >= 0) {
            float* pb = P + (size_t)u.part * 2048 * ldc + (size_t)((u.pm / 17) * BM + wr * 64 + fr) * ldc + col0;
#pragma unroll
            for (int ai = 0; ai < 2; ++ai)
#pragma unroll
                for (int m = 0; m < 4; ++m)
#pragma unroll
                    for (int bj = 0; bj < 2; ++bj) { float* rp = pb + (size_t)(ai * HALF + m * 16) * ldc + bj * HALF; *(f32x4*)rp = acc[ai][bj][m][0]; *(f32x4*)(rp + 4) = acc[ai][bj][m][1]; }
            return;
        }
#pragma unroll
        for (int ai = 0; ai < 2; ++ai)
#pragma unroll
            for (int m = 0; m < 4; ++m) { bf16_t* rowp = O + (size_t)(row0 + ai * HALF + m * 16) * ldc + col0;
#pragma unroll
                for (int bj = 0; bj < 2; ++bj) { const f32x4 v0 = acc[ai][bj][m][0], v1 = acc[ai][bj][m][1];
                    u32x4 w; w.x = cvt_pk_bf16(v0[0], v0[1]); w.y = cvt_pk_bf16(v0[2], v0[3]); w.z = cvt_pk_bf16(v1[0], v1[1]); w.w = cvt_pk_bf16(v1[2], v1[3]);
                    *(u32x4*)(rowp + bj * HALF) = w; } }
    }
};
__device__ __forceinline__ float silu_f(float g) { return g * __builtin_amdgcn_rcpf(1.0f + __expf(-g)); }
struct EpiSwiglu {
    static constexpr bool PERM = true, AFTER_DRAIN = false;
    bf16_t* H; int ldh;
    __device__ __forceinline__ void operator()(const f32x4 (&acc)[2][2][4][2], const Unit& u, int wr, int wc, int fr, int fq) const {
        const int row0 = u.pm * BM + wr * 64 + fr; const int col0 = u.pn * HALF + wc * 32 + 8 * fq;
#pragma unroll
        for (int ai = 0; ai < 2; ++ai)
#pragma unroll
            for (int m = 0; m < 4; ++m) { bf16_t* rowp = H + (size_t)(row0 + ai * HALF + m * 16) * ldh + col0;
                const f32x4 g0 = acc[ai][0][m][0], g1 = acc[ai][0][m][1], u0 = acc[ai][1][m][0], u1 = acc[ai][1][m][1];
                u32x4 w;
                w.x = cvt_pk_bf16(silu_f(g0[0]) * u0[0], silu_f(g0[1]) * u0[1]); w.y = cvt_pk_bf16(silu_f(g0[2]) * u0[2], silu_f(g0[3]) * u0[3]);
                w.z = cvt_pk_bf16(silu_f(g1[0]) * u1[0], silu_f(g1[1]) * u1[1]); w.w = cvt_pk_bf16(silu_f(g1[2]) * u1[2], silu_f(g1[3]) * u1[3]);
                *(u32x4*)rowp = w; }
    }
};
__device__ __forceinline__ void rowstats_run(float* xbuf  , unsigned* cnt  , const f32x4 (&v)[2][2][4][2], const Unit& u, int wr, int wc, int fr, int fq, PG8_LAS unsigned char* xl, int wid, int lane) {
        PG8_LAS float* P = (PG8_LAS float*)xl;
        PG8_LAS float* S = (PG8_LAS float*)(xl + 4096);
#pragma unroll
        for (int ai = 0; ai < 2; ++ai)
#pragma unroll
            for (int m = 0; m < 4; ++m) {
                float s = 0.f;
#pragma unroll
                for (int bj = 0; bj < 2; ++bj)
#pragma unroll
                    for (int n = 0; n < 2; ++n) { const f32x4 x = v[ai][bj][m][n]; s += (x[0] * x[0] + x[1] * x[1]) + (x[2] * x[2] + x[3] * x[3]); }
                s += __shfl_xor(s, 16); s += __shfl_xor(s, 32);
                if (fq == 0) P[(ai * HALF + wr * 64 + m * 16 + fr) * 4 + wc] = s;
            }
        asm volatile("s_waitcnt lgkmcnt(0)" ::: "memory"); __builtin_amdgcn_s_barrier(); asm volatile("" ::: "memory");
        const int row = wid * 32 + (lane & 31);
        if (lane < 32) {
            const float t = (P[row * 4 + 0] + P[row * 4 + 1]) + (P[row * 4 + 2] + P[row * 4 + 3]);
            __hip_atomic_store(xbuf + ((size_t)(u.pm * BM + row) * 4 + u.pn), t, __ATOMIC_RELAXED, __HIP_MEMORY_SCOPE_AGENT);
        }
        asm volatile("s_waitcnt vmcnt(0)" ::: "memory");
        if (lane == 0) __hip_atomic_fetch_add(cnt + 64 * u.pm, 1u, __ATOMIC_RELAXED, __HIP_MEMORY_SCOPE_AGENT);
        if (wid == 0) {
            unsigned sp = 0;
            while ((unsigned)__builtin_amdgcn_readfirstlane(__hip_atomic_load(cnt + 64 * u.pm, __ATOMIC_RELAXED, __HIP_MEMORY_SCOPE_AGENT)) < 32u) { __builtin_amdgcn_s_sleep(1); if (++sp > (1u << 22)) break; }
            __builtin_amdgcn_fence(__ATOMIC_ACQUIRE, "agent");
        }
        asm volatile("s_waitcnt vmcnt(0) lgkmcnt(0)" ::: "memory"); __builtin_amdgcn_s_barrier(); asm volatile("" ::: "memory");
        if (lane < 32) {
            const float* slot = xbuf + (size_t)(u.pm * BM + row) * 4; float t = 0.f;
#pragma unroll
            for (int k = 0; k < 4; ++k) t += __hip_atomic_load(slot + k, __ATOMIC_RELAXED, __HIP_MEMORY_SCOPE_AGENT);
            S[row] = t;
        }
        asm volatile("s_waitcnt vmcnt(0) lgkmcnt(0)" ::: "memory"); __builtin_amdgcn_s_barrier(); asm volatile("" ::: "memory");
    }

template <class Epi, class Sched, bool ALIGN_EPI = false, bool SP2 = false>
__device__ __forceinline__ void gemm_phase(PG8_LAS unsigned char* lds, const Gemm g, const Sched& S, const Epi& E) {
    const int tid = tid_l(), wid = __builtin_amdgcn_readfirstlane(tid >> 6), lane = tid & 63, wr = wid >> 2, wc = wid & 3, fr = lane & 15, fq = lane >> 4;
    unsigned voffA[2], voffB[2];
#pragma unroll
    for (int i = 0; i < 2; ++i) { int R, C; stage_rc(tid * 16 + i * 8192, R, C); const int Rb = Epi::PERM ? ((R & ~31) + perm32(R & 31)) : R;
        voffA[i] = (unsigned)(R * g.lda + C) * 2u; voffB[i] = (unsigned)(Rb * g.ldb + C) * 2u; }
    const size_t kstep = (size_t)(BK * 2);
    const size_t hstepB = (size_t)HALF * g.ldb * 2, hstepA = (size_t)HALF * g.lda * 2;
    const size_t tstepA = 2 * hstepA, tstepB = 2 * hstepB;
    const unsigned ldsw = (unsigned)wid * 1024u;
    const int aoff = lds_byte(wr * 64 + fr, fq * 8), boff = lds_byte(wc * 32 + fr, fq * 8);
#define PG8_SA(b, h) (((b) * 2 + (h)) * HTB)
#define PG8_SB(b, h) ((4 + (b) * 2 + (h)) * HTB)
#define PG8_STAGE(bufoff, gbase, voff) do { _Pragma("unroll") for (int _i = 0; _i < 2; ++_i) \
        __builtin_amdgcn_global_load_lds((const unsigned*)((const char*)(gbase) + (voff)[_i]), (PG8_LAS unsigned*)(lds + (bufoff) + ldsw + _i * 8192), 16, 0, 0); } while (0)
#define PG8_LDA(dst, b, h) do { _Pragma("unroll") for (int m = 0; m < 4; ++m) _Pragma("unroll") for (int k = 0; k < 2; ++k) dst[m][k] = *(const PG8_LAS bf16x8*)(lds + PG8_SA(b, h) + aoff + m * 2048 + k * 1024); } while (0)
#define PG8_LDB(dst, b, h) do { _Pragma("unroll") for (int n = 0; n < 2; ++n) _Pragma("unroll") for (int k = 0; k < 2; ++k) dst[n][k] = *(const PG8_LAS bf16x8*)(lds + PG8_SB(b, h) + boff + n * 2048 + k * 1024); } while (0)
#define PG8_MMA(ai, bj, At, Bt) do { __builtin_amdgcn_s_setprio(1); _Pragma("unroll") for (int m = 0; m < 4; ++m) _Pragma("unroll") for (int n = 0; n < 2; ++n) _Pragma("unroll") for (int k = 0; k < 2; ++k) \
        acc[ai][bj][m][n] = __builtin_amdgcn_mfma_f32_16x16x32_bf16(Bt[n][k], At[m][k], acc[ai][bj][m][n], 0, 0, 0); __builtin_amdgcn_s_setprio(0); } while (0)
#define PG8_WAIT_V(n) asm volatile("s_waitcnt vmcnt(" #n ")" ::: "memory")
#define PG8_WAIT_L(n) asm volatile("s_waitcnt lgkmcnt(" #n ")" ::: "memory")
#define PG8_BAR __builtin_amdgcn_s_barrier()
#define PG8_SCHED __builtin_amdgcn_sched_barrier(0)
    Unit cur, nxt; int ui = 0;
    if (!S.next(0, cur)) return;
    f32x4 acc[2][2][4][2];
#pragma unroll
    for (int a = 0; a < 2; ++a)
#pragma unroll
        for (int b = 0; b < 2; ++b)
#pragma unroll
            for (int m = 0; m < 4; ++m)
#pragma unroll
                for (int n = 0; n < 2; ++n) acc[a][b][m][n] = (f32x4){0.f, 0.f, 0.f, 0.f};
    bf16x8 At[4][2], B0[2][2], B1[2][2];
    const char* cA = (const char*)g.A + (size_t)cur.pm * tstepA + (size_t)cur.kt0 * kstep; const char* cB = (const char*)g.Bt + (size_t)cur.pn * tstepB + (size_t)cur.kt0 * kstep;
    S.a_ready(cur);
    if constexpr (SP2) {
        PG8_STAGE(PG8_SB(0, 0), cB, voffB); PG8_STAGE(PG8_SB(0, 1), cB + hstepB, voffB); PG8_STAGE(PG8_SA(0, 0), cA, voffA); PG8_STAGE(PG8_SA(0, 1), cA + hstepA, voffA);
        if (wr == 1) PG8_BAR;
        PG8_WAIT_V(2); PG8_BAR;
        PG8_STAGE(PG8_SB(1, 0), cB + kstep, voffB); PG8_STAGE(PG8_SA(1, 0), cA + kstep, voffA); PG8_STAGE(PG8_SB(1, 1), cB + hstepB + kstep, voffB);
        PG8_WAIT_V(6); PG8_BAR;
    } else {
        PG8_STAGE(PG8_SB(0, 0), cB, voffB); PG8_STAGE(PG8_SA(0, 0), cA, voffA); PG8_STAGE(PG8_SB(0, 1), cB + hstepB, voffB); PG8_STAGE(PG8_SA(0, 1), cA + hstepA, voffA);
        if (wr == 1) PG8_BAR;
        PG8_WAIT_V(4); PG8_BAR;
        PG8_STAGE(PG8_SB(1, 0), cB + kstep, voffB); PG8_STAGE(PG8_SA(1, 0), cA + kstep, voffA); PG8_STAGE(PG8_SB(1, 1), cB + hstepB + kstep, voffB);
        PG8_WAIT_V(6); PG8_BAR;
    }
    for (;;) {
        const bool has_next = S.next(ui + 1, nxt);
        const char* nA = has_next ? (const char*)g.A + (size_t)nxt.pm * tstepA + (size_t)nxt.kt0 * kstep : cA; const char* nB = has_next ? (const char*)g.Bt + (size_t)nxt.pn * tstepB + (size_t)nxt.kt0 * kstep : cB;
        const int nt = cur.nt;
        for (int t = 0; t < nt; t += 2) {
            const bool last = (t == nt - 2);
            const char* a1 = cA + (size_t)(t + 1) * kstep;
            const char* a2 = last ? nA : cA + (size_t)(t + 2) * kstep; const char* b2 = last ? nB : cB + (size_t)(t + 2) * kstep;
            const char* a3 = a2 + kstep; const char* b3 = b2 + kstep;
            if (last && has_next) S.a_ready(nxt);
            if constexpr (SP2) {
            PG8_LDB(B0, 0, 0); PG8_LDB(B1, 0, 1); PG8_SCHED; PG8_LDA(At, 0, 0); PG8_STAGE(PG8_SA(1, 1), a1 + hstepA, voffA);
            PG8_WAIT_V(8); PG8_WAIT_L(0); PG8_BAR; PG8_MMA(0, 0, At, B0); PG8_MMA(0, 1, At, B1); PG8_BAR; PG8_SCHED;
            PG8_LDA(At, 0, 1); PG8_STAGE(PG8_SB(0, 0), b2, voffB); PG8_STAGE(PG8_SB(0, 1), b2 + hstepB, voffB); PG8_STAGE(PG8_SA(0, 0), a2, voffA);
            PG8_WAIT_V(8); PG8_WAIT_L(0); PG8_BAR; PG8_MMA(1, 0, At, B0); PG8_MMA(1, 1, At, B1); PG8_BAR; PG8_SCHED;
            PG8_LDB(B0, 1, 0); PG8_LDB(B1, 1, 1); PG8_SCHED; PG8_LDA(At, 1, 0); PG8_STAGE(PG8_SA(0, 1), a2 + hstepA, voffA);
            PG8_WAIT_V(8); PG8_WAIT_L(0); PG8_BAR; PG8_MMA(0, 0, At, B0); PG8_MMA(0, 1, At, B1); PG8_BAR; PG8_SCHED;
            PG8_LDA(At, 1, 1); PG8_STAGE(PG8_SB(1, 0), b3, voffB); PG8_STAGE(PG8_SB(1, 1), b3 + hstepB, voffB); PG8_STAGE(PG8_SA(1, 0), a3, voffA);
            PG8_WAIT_V(8); PG8_WAIT_L(0); PG8_BAR; PG8_MMA(1, 0, At, B0); PG8_MMA(1, 1, At, B1); PG8_BAR; PG8_SCHED;
            } else {
            PG8_LDB(B0, 0, 0); PG8_SCHED; PG8_LDA(At, 0, 0); PG8_STAGE(PG8_SA(1, 1), a1 + hstepA, voffA);
            PG8_WAIT_L(8); PG8_BAR; PG8_WAIT_L(0); PG8_MMA(0, 0, At, B0); PG8_BAR; PG8_SCHED;
            PG8_LDB(B1, 0, 1); PG8_STAGE(PG8_SB(0, 0), b2, voffB);
            PG8_BAR; PG8_WAIT_L(0); PG8_MMA(0, 1, At, B1); PG8_BAR;
            PG8_LDA(At, 0, 1); PG8_STAGE(PG8_SA(0, 0), a2, voffA);
            PG8_BAR; PG8_WAIT_L(0); PG8_MMA(1, 0, At, B0); PG8_BAR; PG8_SCHED;
            PG8_STAGE(PG8_SB(0, 1), b2 + hstepB, voffB);
            PG8_WAIT_V(6); PG8_BAR; PG8_MMA(1, 1, At, B1); PG8_BAR;
            PG8_LDB(B0, 1, 0); PG8_SCHED; PG8_LDA(At, 1, 0); PG8_STAGE(PG8_SA(0, 1), a2 + hstepA, voffA);
            PG8_WAIT_L(8); PG8_BAR; PG8_WAIT_L(0); PG8_MMA(0, 0, At, B0); PG8_BAR; PG8_SCHED;
            PG8_LDB(B1, 1, 1); PG8_STAGE(PG8_SB(1, 0), b3, voffB);
            PG8_BAR; PG8_WAIT_L(0); PG8_MMA(0, 1, At, B1); PG8_BAR;
            PG8_LDA(At, 1, 1); PG8_STAGE(PG8_SA(1, 0), a3, voffA);
            PG8_BAR; PG8_WAIT_L(0); PG8_MMA(1, 0, At, B0); PG8_BAR; PG8_SCHED;
            PG8_STAGE(PG8_SB(1, 1), b3 + hstepB, voffB);
            PG8_WAIT_V(6); PG8_BAR; PG8_MMA(1, 1, At, B1); PG8_BAR;
            }
        }
        if constexpr (ALIGN_EPI) { if (wr == 0) PG8_BAR; }
        if constexpr (!Epi::AFTER_DRAIN) { E(acc, cur, wr, wc, fr, fq); S.done(cur); }
        if (!has_next) break;
#pragma unroll
        for (int a = 0; a < 2; ++a)
#pragma unroll
            for (int b = 0; b < 2; ++b)
#pragma unroll
                for (int m = 0; m < 4; ++m)
#pragma unroll
                    for (int n = 0; n < 2; ++n) acc[a][b][m][n] = (f32x4){0.f, 0.f, 0.f, 0.f};
        cur = nxt; cA = nA; cB = nB; ++ui;
        if constexpr (ALIGN_EPI) { if (wr == 1) PG8_BAR; }
    }
    PG8_WAIT_V(0);
    if constexpr (!ALIGN_EPI) { if (wr == 0) PG8_BAR; }
    PG8_BAR;
    if constexpr (Epi::AFTER_DRAIN) { E.fused(acc, cur, wr, wc, fr, fq, lds, wid, lane); S.done(cur); }
#undef PG8_SA
#undef PG8_SB
#undef PG8_STAGE
#undef PG8_LDA
#undef PG8_LDB
#undef PG8_MMA
#undef PG8_WAIT_V
#undef PG8_WAIT_L
#undef PG8_BAR
#undef PG8_SCHED
}
}
namespace att {
using bf16 = __hip_bfloat16;
constexpr int   D = 128, NW = 8, QBLK = 32, KVBLK = 64;
constexpr float SCALE = 0.088388347648318440f;
constexpr float THR = 8.f;
constexpr int SDEPTH = 2;
constexpr int LDQ = 1536, LDK = 1536, LDO = 1024;
constexpr size_t SHM_V = KVBLK * D * 2, SHM_K = KVBLK * D * 2, SHM_ATTN = 2 * SHM_V + 2 * SHM_K + NW * 64 * 4;
using bf16x8 = __attribute__((ext_vector_type(8))) short;
using s16x4  = __attribute__((ext_vector_type(4))) short;
using f32x16 = __attribute__((ext_vector_type(16))) float;
using f32x8  = __attribute__((ext_vector_type(8))) float;
using u32x4  = __attribute__((ext_vector_type(4))) unsigned;
#define KSWZ(row, colB) ((row) * 256 + ((colB) ^ (((row) & 7) << 4)))
#define SBAR() __builtin_amdgcn_sched_barrier(0)
__device__ __forceinline__ int crow(int r, int hi) { return (r & 3) + 8 * (r >> 2) + 4 * hi; }
__device__ __forceinline__ unsigned cvtpk(float lo, float hi) {
  unsigned r; asm volatile("v_cvt_pk_bf16_f32 %0, %1, %2" : "=v"(r) : "v"(lo), "v"(hi)); return r;
}
template <typename TIn> struct Stage;
template <> struct Stage<bf16>  { using T = bf16x8;
  __device__ static __forceinline__ T ld8(const bf16* p) { return *reinterpret_cast<const bf16x8*>(p); }
  __device__ static __forceinline__ bf16x8 tobf(T x) { return x; } };
template <> struct Stage<float> { using T = f32x8;
  __device__ static __forceinline__ T ld8(const float* p) { return *reinterpret_cast<const f32x8*>(p); }
  __device__ static __forceinline__ bf16x8 tobf(T x) {
    u32x4 w = {cvtpk(x[0], x[1]), cvtpk(x[2], x[3]), cvtpk(x[4], x[5]), cvtpk(x[6], x[7])}; return *reinterpret_cast<bf16x8*>(&w); } };

__device__ __forceinline__ void partialSM(f32x16& p0, f32x16& p1, float& m_reg, float& mn, float& alpha) {
  constexpr float C = SCALE * 1.4426950408889634f;
  float pmax = p0[0]; for (int r = 1; r < 16; ++r) pmax = fmaxf(pmax, p0[r]); for (int r = 0; r < 16; ++r) pmax = fmaxf(pmax, p1[r]);
  { auto rr = __builtin_amdgcn_permlane32_swap(__float_as_uint(pmax), __float_as_uint(pmax), false, false);
    pmax = fmaxf(__uint_as_float(rr[0]), __uint_as_float(rr[1])); }
  if (__builtin_expect(__all(pmax - m_reg <= THR / SCALE), 1)) { mn = m_reg; alpha = 1.f; }
  else { mn = fmaxf(m_reg, pmax); alpha = __builtin_amdgcn_exp2f((m_reg - mn) * C); m_reg = mn; }
  float mnC = -mn * C;
  for (int r = 0; r < 16; ++r) p0[r] = fmaf(p0[r], C, mnC); for (int r = 0; r < 16; ++r) p1[r] = fmaf(p1[r], C, mnC);
  for (int r = 0; r < 16; ++r) p0[r] = __builtin_amdgcn_exp2f(p0[r]);
}
__device__ __forceinline__ void finishSM(f32x16& p0, f32x16& p1, float alpha, float& l_reg, bf16x8& pa0, bf16x8& pa1, bf16x8& pa2, bf16x8& pa3) {
  for (int r = 0; r < 16; ++r) p1[r] = __builtin_amdgcn_exp2f(p1[r]);
  float ps = 0; for (int r = 0; r < 16; ++r) ps += p0[r]; for (int r = 0; r < 16; ++r) ps += p1[r];
  { auto rr = __builtin_amdgcn_permlane32_swap(__float_as_uint(ps), __float_as_uint(ps), false, false);
    ps = __uint_as_float(rr[0]) + __uint_as_float(rr[1]); }
  l_reg = l_reg * alpha + ps;
#define PK4(P, BASE, OUT) do { unsigned a0 = cvtpk(P[BASE + 0], P[BASE + 1]), a1 = cvtpk(P[BASE + 2], P[BASE + 3]);   \
    unsigned b0 = cvtpk(P[BASE + 4], P[BASE + 5]), b1 = cvtpk(P[BASE + 6], P[BASE + 7]);                              \
    auto r0 = __builtin_amdgcn_permlane32_swap(a0, b0, false, false); auto r1 = __builtin_amdgcn_permlane32_swap(a1, b1, false, false); \
    u32x4 w = {r0[0], r1[0], r0[1], r1[1]}; OUT = *reinterpret_cast<bf16x8*>(&w); } while (0)
  PK4(p0, 0, pa0); PK4(p0, 8, pa1); PK4(p1, 0, pa2); PK4(p1, 8, pa3);
#undef PK4
}
__device__ __forceinline__ void qkt(f32x16& p0, f32x16& p1, const bf16* Ks, const bf16x8* qr, int r32, int hi) {
  p0 = f32x16{}; p1 = f32x16{};
  for (int d0 = 0; d0 < 8; ++d0) { int cb = (d0 * 16 + hi * 8) * 2;
    bf16x8 b0 = *reinterpret_cast<const bf16x8*>((const char*)Ks + KSWZ(r32, cb));
    bf16x8 b1 = *reinterpret_cast<const bf16x8*>((const char*)Ks + KSWZ(32 + r32, cb));
    p0 = __builtin_amdgcn_mfma_f32_32x32x16_bf16(b0, qr[d0], p0, 0, 0, 0);
    p1 = __builtin_amdgcn_mfma_f32_32x32x16_bf16(b1, qr[d0], p1, 0, 0, 0); }
}
__device__ __forceinline__ int v_st(int k, int c) { const int kk = (k & ~0xC) | ((k & 4) << 1) | ((k & 8) >> 1); return ((kk >> 3) * 4 + (c >> 5)) * 512 + ((kk & 7) * 32 + (c & 31)) * 2; }
__device__ __forceinline__ int v_rd_base(int lane) { return ((lane & 3) << 3) | (((lane >> 2) & 3) << 6) | (((lane >> 4) & 1) << 5) | (((lane >> 5) & 1) << 8); }
constexpr int v_rd_off(int d0, int ks, int half) { return d0 * 512 + ks * 4096 + half * 2048; }
template <int OFF> __device__ __forceinline__ s16x4 tr_read(int vb) {
  s16x4 r; asm volatile("ds_read_b64_tr_b16 %0, %1 offset:%2" : "=&v"(r) : "v"(vb), "i"(OFF) : "memory"); return r;
}
template <int D0> __device__ __forceinline__ void pv_one(f32x16& od, int vb, bf16x8 pa0, bf16x8 pa1, bf16x8 pa2, bf16x8 pa3) {
  const s16x4 l0 = tr_read<v_rd_off(D0, 0, 0)>(vb), h0 = tr_read<v_rd_off(D0, 0, 1)>(vb), l1 = tr_read<v_rd_off(D0, 1, 0)>(vb), h1 = tr_read<v_rd_off(D0, 1, 1)>(vb);
  const s16x4 l2 = tr_read<v_rd_off(D0, 2, 0)>(vb), h2 = tr_read<v_rd_off(D0, 2, 1)>(vb), l3 = tr_read<v_rd_off(D0, 3, 0)>(vb), h3 = tr_read<v_rd_off(D0, 3, 1)>(vb);
  asm volatile("s_waitcnt lgkmcnt(0)" ::: "memory"); SBAR();
#define PK(L, H) (bf16x8){L[0], L[1], L[2], L[3], H[0], H[1], H[2], H[3]}
  od = __builtin_amdgcn_mfma_f32_32x32x16_bf16(pa0, PK(l0, h0), od, 0, 0, 0);
  od = __builtin_amdgcn_mfma_f32_32x32x16_bf16(pa1, PK(l1, h1), od, 0, 0, 0);
  od = __builtin_amdgcn_mfma_f32_32x32x16_bf16(pa2, PK(l2, h2), od, 0, 0, 0);
  od = __builtin_amdgcn_mfma_f32_32x32x16_bf16(pa3, PK(l3, h3), od, 0, 0, 0);
#undef PK
}
__device__ __forceinline__ void pv_d0(f32x16* o, int vb, bf16x8 pa0, bf16x8 pa1, bf16x8 pa2, bf16x8 pa3) {
  pv_one<0>(o[0], vb, pa0, pa1, pa2, pa3); pv_one<1>(o[1], vb, pa0, pa1, pa2, pa3); pv_one<2>(o[2], vb, pa0, pa1, pa2, pa3); pv_one<3>(o[3], vb, pa0, pa1, pa2, pa3);
}

template <typename TQ>
__device__ __forceinline__ void attn_dense_body(const TQ* __restrict__ Qb, const bf16* __restrict__ Kh, const bf16* __restrict__ Vh,
                                                bf16* __restrict__ Ob, int seq, char* lds) {
  using St = Stage<bf16>; using SQ = Stage<TQ>;
  const int tid = tid_l(), wid = tid >> 6, lane = tid & 63, r32 = lane & 31, hi = lane >> 5;
  bf16* V_lds = (bf16*)lds; bf16* K_lds = (bf16*)(lds + 2 * SHM_V);
  float* ws = (float*)(lds + 2 * SHM_V + 2 * SHM_K) + wid * 64; float* li_l = ws; float* al_l = ws + 32;
  float m_reg = -1e30f, l_reg = 0; f32x16 o[4] = {}; bf16x8 qr[8];
  const TQ* Qw = Qb + (long)(wid * QBLK + r32) * LDQ + hi * 8;
#pragma unroll
  for (int d0 = 0; d0 < 8; ++d0) qr[d0] = SQ::tobf(SQ::ld8(Qw + d0 * 16));
  const int sr = tid >> 4, sc = (tid & 15) * 8, vst0 = v_st(sr, sc), vst1 = v_st(32 + sr, sc);
  const int vb0 = (int)(uintptr_t)V_lds + v_rd_base(lane);
  struct { typename St::T vs0, vs1, ks0, ks1; } sr_[SDEPTH];
#define SLOAD(i, k0) do { sr_[i].vs0 = St::ld8(&Vh[(long)((k0) + sr) * LDK + sc]); sr_[i].vs1 = St::ld8(&Vh[(long)((k0) + 32 + sr) * LDK + sc]); \
    sr_[i].ks0 = St::ld8(&Kh[(long)((k0) + sr) * LDK + sc]); sr_[i].ks1 = St::ld8(&Kh[(long)((k0) + 32 + sr) * LDK + sc]); } while (0)
#define SWRITE(b, i) do { *(bf16x8*)((char*)V_lds + (b) * SHM_V + vst0) = St::tobf(sr_[i].vs0);          \
    *(bf16x8*)((char*)V_lds + (b) * SHM_V + vst1) = St::tobf(sr_[i].vs1); int kc = sc * 2;               \
    *(bf16x8*)((char*)K_lds + (b) * SHM_K + KSWZ(sr, kc)) = St::tobf(sr_[i].ks0);                       \
    *(bf16x8*)((char*)K_lds + (b) * SHM_K + KSWZ(32 + sr, kc)) = St::tobf(sr_[i].ks1); } while (0)
#define SWAIT() do { if constexpr (SDEPTH == 2) asm volatile("s_waitcnt vmcnt(4)" ::: "memory"); else asm volatile("s_waitcnt vmcnt(0)" ::: "memory"); } while (0)
#define RESC(a) do { if (__any((a) < 1.f)) { if (hi == 0) al_l[r32] = (a); asm volatile("s_waitcnt lgkmcnt(0)" ::: "memory"); \
    for (int d = 0; d < 4; ++d) for (int r = 0; r < 16; ++r) o[d][r] *= al_l[crow(r, hi)]; } } while (0)
  f32x16 pA0, pA1, pB0, pB1; float mnA, mnB, alA, alB; bf16x8 pa0, pa1, pa2, pa3; const int NT = seq / KVBLK;
  constexpr int SE = 0, SO = SDEPTH - 1;
  SLOAD(SE, 0); asm volatile("s_waitcnt vmcnt(0)" ::: "memory"); SWRITE(0, SE); __syncthreads();
  qkt(pA0, pA1, K_lds, qr, r32, hi); partialSM(pA0, pA1, m_reg, mnA, alA);
  SLOAD(SO, KVBLK); if constexpr (SDEPTH == 2) { if (2 < NT) SLOAD(SE, 2 * KVBLK); }
  SWAIT(); SWRITE(1, SO); __syncthreads();
  for (int j = 1; j + 1 < NT; j += 2) {
    SBAR(); qkt(pB0, pB1, (bf16*)((char*)K_lds + SHM_K), qr, r32, hi);
    finishSM(pA0, pA1, alA, l_reg, pa0, pa1, pa2, pa3); SBAR();
    SLOAD(SO, (j + SDEPTH) * KVBLK); SBAR();
    pv_d0(o, vb0, pa0, pa1, pa2, pa3); partialSM(pB0, pB1, m_reg, mnB, alB);
    __syncthreads(); SWAIT(); SWRITE(0, SE);
    RESC(alB); __syncthreads();
    SBAR(); qkt(pA0, pA1, K_lds, qr, r32, hi);
    finishSM(pB0, pB1, alB, l_reg, pa0, pa1, pa2, pa3); SBAR();
    if (SDEPTH == 1 || j + 3 < NT) SLOAD(SE, (j + 1 + SDEPTH) * KVBLK); SBAR();
    pv_d0(o, vb0 + (int)SHM_V, pa0, pa1, pa2, pa3); partialSM(pA0, pA1, m_reg, mnA, alA);
    __syncthreads(); SWAIT(); SWRITE(1, SO);
    RESC(alA); __syncthreads();
  }
  SBAR(); qkt(pB0, pB1, (bf16*)((char*)K_lds + SHM_K), qr, r32, hi);
  finishSM(pA0, pA1, alA, l_reg, pa0, pa1, pa2, pa3); SBAR();
  pv_d0(o, vb0, pa0, pa1, pa2, pa3); partialSM(pB0, pB1, m_reg, mnB, alB);
  __syncthreads(); RESC(alB);
  finishSM(pB0, pB1, alB, l_reg, pa0, pa1, pa2, pa3); SBAR();
  pv_d0(o, vb0 + (int)SHM_V, pa0, pa1, pa2, pa3);
  if (hi == 0) li_l[r32] = l_reg; asm volatile("s_waitcnt lgkmcnt(0)" ::: "memory");
  float rli[16];
#pragma unroll
  for (int r = 0; r < 16; ++r) rli[r] = __builtin_amdgcn_rcpf(li_l[crow(r, hi)]);
  bf16* Ow = Ob + (long)(wid * QBLK) * LDO;
#pragma unroll
  for (int r = 0; r < 16; ++r) { int orow = crow(r, hi);
    for (int d0 = 0; d0 < 4; ++d0) Ow[(long)orow * LDO + d0 * 32 + r32] = __float2bfloat16(o[d0][r] * rli[r]); }
#undef SLOAD
#undef SWRITE
#undef SWAIT
#undef RESC
}
}
#define LAS __attribute__((address_space(3)))
typedef unsigned short bf16_t;
typedef short bf16x8 __attribute__((ext_vector_type(8)));
typedef float f32x4 __attribute__((ext_vector_type(4)));
typedef float f32x16 __attribute__((ext_vector_type(16)));
typedef unsigned u32x4 __attribute__((ext_vector_type(4)));
typedef unsigned u32x2 __attribute__((ext_vector_type(2)));

constexpr int DM = 1024, NB = 8, SEQ = 4096, CTXL = 256, TPB = SEQ + CTXL, MT = NB * TPB, DFF = 2816, DEPTH = 4;
constexpr int NQKV = 1536, NGIN = 3328;
constexpr float EPS = 1e-6f;
constexpr int LDS_BYTES = 147456;
constexpr int NTHREADS = 512;

constexpr size_t MiB = 1u << 20;
constexpr size_t WS_MOD = 1 * MiB;
constexpr size_t WS_W1T = 3 * MiB;
constexpr size_t WS_W2T = WS_W1T + 88 * MiB;
constexpr size_t WS_WQKVT = WS_W2T + 44 * MiB;
constexpr size_t WS_WOAT = WS_WQKVT + 6 * MiB;
constexpr size_t WS_WGINT = WS_WOAT + 4 * MiB;
constexpr size_t WS_WGOT = WS_WGINT + 13 * MiB;
constexpr size_t WS_HRES = WS_WGOT + 4 * MiB;
constexpr size_t WS_U = WS_HRES + 136 * MiB;
constexpr size_t WS_Y = WS_U + 68 * MiB;
constexpr size_t WS_BIG = WS_Y + 68 * MiB;
constexpr size_t WS_ATTNO = WS_BIG + 102 * MiB;
constexpr size_t WS_END = WS_BIG + 221 * MiB;
constexpr size_t WS_PART_IN_OUT = 112 * MiB;
static_assert((size_t)MT * NGIN * 2 <= 221 * MiB && (size_t)MT * DFF * 2 <= 221 * MiB && (size_t)MT * NQKV * 2 <= 102 * MiB, "ws map");

struct Args { const float* in[20]; float* out; unsigned char* ws; };
typedef const __attribute__((address_space(4))) Args* KA;
__device__ __forceinline__ KA kargs() { KA p = (KA)__builtin_amdgcn_kernarg_segment_ptr(); asm volatile("" : "+s"(p)); return p; }
enum { I_X = 0, I_C, I_CTX, I_CCTX, I_ADAW, I_ADAB, I_NPRE, I_NPOST, I_FW1, I_FW2, I_AQKV, I_AQG, I_AKG, I_AWO, I_GWIN, I_GWA1, I_GWA2, I_GBA, I_GOG, I_GWO };

__device__ __forceinline__ unsigned cvtpk(float lo, float hi) { return pg8::cvt_pk_bf16(lo, hi); }
__device__ __forceinline__ float bf_lo(unsigned w) { return __uint_as_float(w << 16); }
__device__ __forceinline__ float bf_hi(unsigned w) { return __uint_as_float(w & 0xffff0000u); }
__device__ __forceinline__ float bf_f(bf16_t h) { return __uint_as_float(((unsigned)h) << 16); }
__device__ __forceinline__ bf16_t f_bf(float f) { return (bf16_t)(cvtpk(f, 0.f) & 0xffffu); }
__device__ __forceinline__ float wave_sum(float v) {
#pragma unroll
    for (int o = 1; o < 64; o <<= 1) v += __shfl_xor(v, o);
    return v;
}
__device__ __forceinline__ float silu(float x) { return x / (1.0f + __expf(-x)); }

__device__ __forceinline__ void phase_mod(KA a, LAS unsigned char* lds) {
    LAS float* sv = (LAS float*)lds;
    LAS float* red = (LAS float*)(lds + 9 * 1024 * 4);
    const int tid = tid_l(), lane = tid & 63, wave = tid >> 6;
    const float* c = a->in[I_C]; const float* cc = a->in[I_CCTX];
    for (int i = tid; i < 9 * 1024; i += NTHREADS) { const int v = i >> 10, k = i & 1023; const float x = v < 8 ? c[v * 1024 + k] : cc[k]; sv[i] = silu(x); }
    __syncthreads();
    float* mod = (float*)(a->ws + WS_MOD);
    for (int it = blk_l(); it < DEPTH * 144; it += grd_l()) {
        const int L = it / 144, cgp = it % 144;
        const float* w = a->in[I_ADAW] + (size_t)L * 1024 * 9216 + cgp * 64 + lane;
        float acc[9];
#pragma unroll
        for (int v = 0; v < 9; ++v) acc[v] = 0.f;
        const int k0 = wave * 128;
#pragma unroll 8
        for (int k = 0; k < 128; ++k) { const float wv = w[(size_t)(k0 + k) * 9216];
#pragma unroll
            for (int v = 0; v < 9; ++v) acc[v] += sv[v * 1024 + k0 + k] * wv; }
#pragma unroll
        for (int v = 0; v < 9; ++v) red[(wave * 9 + v) * 64 + lane] = acc[v];
        __syncthreads();
        for (int i = tid; i < 576; i += NTHREADS) { const int v = i >> 6, l = i & 63; float s = 0.f;
#pragma unroll
            for (int w8 = 0; w8 < 8; ++w8) s += red[(w8 * 9 + v) * 64 + l];
            s += a->in[I_ADAB][L * 9216 + cgp * 64 + l];
            mod[(size_t)(L * 9 + v) * 9216 + cgp * 64 + l] = s; }
        __syncthreads();
    }
}

__device__ __forceinline__ unsigned pk2(float lo, float hi) { return cvtpk(lo, hi); }
__device__ __forceinline__ void tr_item(const float* W, int Nsrc, int srccol0, int k0, bf16_t* dst  , int K, LAS float* scr, int lane) {
#pragma unroll 8
    for (int i = 0; i < 32; ++i) { const int kk = 2 * i + (lane >> 5); scr[kk * 33 + (lane & 31)] = W[(size_t)(k0 + kk) * Nsrc + srccol0 + (lane & 31)]; }
    asm volatile("s_waitcnt lgkmcnt(0)" ::: "memory");
    const int c = lane & 7;
#pragma unroll
    for (int j = 0; j < 4; ++j) { const int n = (lane >> 3) + 8 * j; const LAS float* s = scr + (8 * c) * 33 + n;
        u32x4 o; o.x = pk2(s[0 * 33], s[1 * 33]); o.y = pk2(s[2 * 33], s[3 * 33]); o.z = pk2(s[4 * 33], s[5 * 33]); o.w = pk2(s[6 * 33], s[7 * 33]);
        *(u32x4*)(dst + (size_t)n * K + 8 * c) = o; }
    asm volatile("s_waitcnt lgkmcnt(0)" ::: "memory");
}
__device__ __forceinline__ void phase_weights(KA a, LAS unsigned char* lds) {
    const int tid = tid_l(), lane = tid & 63, wave = tid >> 6;
    LAS float* scr = (LAS float*)(lds + 65536 + wave * 8704);
    const int gw = blk_l() * 8 + wave, NGW = grd_l() * 8;
    constexpr int I_W1 = 176 * 16, I_W2 = 32 * 44, I_QKV = 48 * 16, I_SQ = 32 * 16, I_GIN = 96 * 16;
    constexpr int N1 = 8 * I_W1, N2 = 8 * I_W2, N3 = 2 * I_QKV, N4 = 2 * I_SQ, N5 = 2 * I_GIN, N6 = 2 * I_SQ;
    constexpr int NITEMS = N1 + N2 + N3 + N4 + N5 + N6;
    for (int it = gw; it < NITEMS; it += NGW) {
        int r = it;
        if (r < N1) { const int mat = r / I_W1, q = r % I_W1, ng = q / 16, kb = q % 16; const int pn = ng >> 3, r0 = (ng & 7) * 32;
            const int src = r0 < 128 ? 128 * pn + r0 : DFF + 128 * pn + (r0 - 128);
            tr_item(a->in[I_FW1] + (size_t)mat * 1024 * 5632, 5632, src, kb * 64, (bf16_t*)(a->ws + WS_W1T) + (size_t)mat * 5632 * 1024 + (size_t)(ng * 32) * 1024 + kb * 64, 1024, scr, lane); continue; }
        r -= N1;
        if (r < N2) { const int mat = r / I_W2, q = r % I_W2, ng = q / 44, kb = q % 44;
            tr_item(a->in[I_FW2] + (size_t)mat * 2816 * 1024, 1024, ng * 32, kb * 64, (bf16_t*)(a->ws + WS_W2T) + (size_t)mat * 1024 * 2816 + (size_t)(ng * 32) * 2816 + kb * 64, 2816, scr, lane); continue; }
        r -= N2;
        if (r < N3) { const int mat = r / I_QKV, q = r % I_QKV, ng = q / 16, kb = q % 16;
            tr_item(a->in[I_AQKV] + (size_t)mat * 1024 * 1536, 1536, ng * 32, kb * 64, (bf16_t*)(a->ws + WS_WQKVT) + (size_t)mat * 1536 * 1024 + (size_t)(ng * 32) * 1024 + kb * 64, 1024, scr, lane); continue; }
        r -= N3;
        if (r < N4) { const int mat = r / I_SQ, q = r % I_SQ, ng = q / 16, kb = q % 16;
            tr_item(a->in[I_AWO] + (size_t)mat * 1024 * 1024, 1024, ng * 32, kb * 64, (bf16_t*)(a->ws + WS_WOAT) + (size_t)mat * 1024 * 1024 + (size_t)(ng * 32) * 1024 + kb * 64, 1024, scr, lane); continue; }
        r -= N4;
        if (r < N5) { const int mat = r / I_GIN, q = r % I_GIN, ng = q / 16, kb = q % 16;
            tr_item(a->in[I_GWIN] + (size_t)mat * 1024 * 3072, 3072, ng * 32, kb * 64, (bf16_t*)(a->ws + WS_WGINT) + (size_t)mat * NGIN * 1024 + (size_t)(ng * 32) * 1024 + kb * 64, 1024, scr, lane); continue; }
        r -= N5;
        { const int mat = r / I_SQ, q = r % I_SQ, ng = q / 16, kb = q % 16;
            tr_item(a->in[I_GWO] + (size_t)mat * 1024 * 1024, 1024, ng * 32, kb * 64, (bf16_t*)(a->ws + WS_WGOT) + (size_t)mat * 1024 * 1024 + (size_t)(ng * 32) * 1024 + kb * 64, 1024, scr, lane); }
    }
    const int gt = blk_l() * NTHREADS + tid, NGT = grd_l() * NTHREADS;
    for (int i = gt; i < 2 * 256 * 128; i += NGT) {
        const int m = i / (256 * 128), q = i % (256 * 128), j = q / 128, k8 = (q % 128) * 8;
        float v[8];
#pragma unroll
        for (int e = 0; e < 8; ++e) v[e] = j < 32 ? a->in[I_GWA1][((size_t)(m * 2 + (j >> 4)) * 1024 + k8 + e) * 16 + (j & 15)] : 0.f;
        u32x4 o; o.x = pk2(v[0], v[1]); o.y = pk2(v[2], v[3]); o.z = pk2(v[4], v[5]); o.w = pk2(v[6], v[7]);
        *(u32x4*)((bf16_t*)(a->ws + WS_WGINT) + (size_t)m * NGIN * 1024 + (size_t)(3072 + j) * 1024 + k8) = o;
    }
}

struct RowP { int Lpost, jpost; float gs; int Lpre, jpre; bool final_out; };
template <bool FROM_INPUT>
__device__ __forceinline__ void row_pair(KA a, const RowP p, int ra, int rb, bool ona, bool onb, int lane) {
    bf16_t* hres = (bf16_t*)(a->ws + WS_HRES); const float* mod = (const float*)(a->ws + WS_MOD);
    const bf16_t* Y = (const bf16_t*)(a->ws + WS_Y); bf16_t* U = (bf16_t*)(a->ws + WS_U);
    const float* gpost = a->in[I_NPOST] + (size_t)(p.Lpost * 3 + (p.jpost < 0 ? 0 : p.jpost)) * DM; const float* gpre = a->in[I_NPRE] + (size_t)(p.Lpre * 3 + (p.jpre < 0 ? 0 : p.jpre)) * DM;
    int rr[2] = {ra, rb}, bb[2], pp[2]; bool cx[2], on[2] = {ona, onb};
#pragma unroll
    for (int k = 0; k < 2; ++k) { bb[k] = rr[k] / TPB; pp[k] = rr[k] - bb[k] * TPB; cx[k] = pp[k] < CTXL; }
    f32x4 h[2][4], y[2][4];
#pragma unroll
    for (int k = 0; k < 2; ++k) {
        if (FROM_INPUT) { const float* src = cx[k] ? a->in[I_CTX] + (size_t)(bb[k] * CTXL + pp[k]) * DM : a->in[I_X] + (size_t)(bb[k] * SEQ + pp[k] - CTXL) * DM;
#pragma unroll
            for (int q = 0; q < 4; ++q) h[k][q] = *(const f32x4*)(src + 4 * lane + 256 * q); }
        else {
#pragma unroll
            for (int q = 0; q < 4; ++q) { const u32x2 w = *(const u32x2*)(hres + (size_t)rr[k] * DM + 4 * lane + 256 * q); h[k][q] = (f32x4){bf_lo(w.x), bf_hi(w.x), bf_lo(w.y), bf_hi(w.y)}; } }
        if (p.jpost >= 0) {
#pragma unroll
            for (int q = 0; q < 4; ++q) { const u32x2 w = *(const u32x2*)(Y + (size_t)rr[k] * DM + 4 * lane + 256 * q);
                y[k][q] = (f32x4){bf_lo(w.x), bf_hi(w.x), bf_lo(w.y), bf_hi(w.y)}; } }
    }
#pragma unroll
    for (int k = 0; k < 2; ++k) {
        const int mi = cx[k] ? 8 : bb[k];
        if (p.jpost >= 0) {
            float ss = 0.f;
#pragma unroll
            for (int q = 0; q < 4; ++q) ss += (y[k][q].x * y[k][q].x + y[k][q].y * y[k][q].y) + (y[k][q].z * y[k][q].z + y[k][q].w * y[k][q].w);
            const float rstd = 1.0f / sqrtf(wave_sum(ss) * (1.0f / DM) + EPS);
            const float* gate = mod + (size_t)(p.Lpost * 9 + mi) * 9216 + (3 * p.jpost + 2) * 1024;
#pragma unroll
            for (int q = 0; q < 4; ++q) { const f32x4 gt = *(const f32x4*)(gate + 4 * lane + 256 * q), gg = *(const f32x4*)(gpost + 4 * lane + 256 * q);
                h[k][q] += p.gs * gt * (y[k][q] * rstd * gg); }
        }
        if (on[k]) {
            if (p.final_out) { float* o = a->out + (size_t)(bb[k] * SEQ + pp[k] - CTXL) * DM;
#pragma unroll
                for (int q = 0; q < 4; ++q) *(f32x4*)(o + 4 * lane + 256 * q) = h[k][q]; }
            else {
#pragma unroll
                for (int q = 0; q < 4; ++q) { u32x2 w; w.x = cvtpk(h[k][q].x, h[k][q].y); w.y = cvtpk(h[k][q].z, h[k][q].w); *(u32x2*)(hres + (size_t)rr[k] * DM + 4 * lane + 256 * q) = w; } }
        }
        if (p.jpre >= 0) {
            float ss = 0.f;
#pragma unroll
            for (int q = 0; q < 4; ++q) ss += (h[k][q].x * h[k][q].x + h[k][q].y * h[k][q].y) + (h[k][q].z * h[k][q].z + h[k][q].w * h[k][q].w);
            const float rstd = 1.0f / sqrtf(wave_sum(ss) * (1.0f / DM) + EPS);
            const float* mb = mod + (size_t)(p.Lpre * 9 + mi) * 9216 + (3 * p.jpre) * 1024;
            if (on[k]) {
#pragma unroll
                for (int q = 0; q < 4; ++q) { const f32x4 sh = *(const f32x4*)(mb + 4 * lane + 256 * q), sc = *(const f32x4*)(mb + 1024 + 4 * lane + 256 * q), gg = *(const f32x4*)(gpre + 4 * lane + 256 * q);
                    const f32x4 u = h[k][q] * rstd * gg * (1.0f + sc) + sh;
                    u32x2 w; w.x = cvtpk(u.x, u.y); w.y = cvtpk(u.z, u.w); *(u32x2*)(U + (size_t)rr[k] * DM + 4 * lane + 256 * q) = w; } }
        }
    }
}
template <bool FROM_INPUT>
__device__ __forceinline__ void row_pass(KA a, const RowP p) {
    const int tid = tid_l(), lane = tid & 63, wave = tid >> 6;
    const int gw = blk_l() * 8 + wave, NGW = grd_l() * 8;
    for (int r0 = gw; r0 < MT; r0 += 2 * NGW) { const int r1 = r0 + NGW; const bool on1 = r1 < MT; row_pair<FROM_INPUT>(a, p, r0, on1 ? r1 : r0, true, on1, lane); }
}
__device__ __forceinline__ void row_pass_queue(KA a, const RowP p, unsigned* sig, unsigned need_lat, unsigned need_ctx, bool with_ctx, LAS unsigned char* lds) {
    const int tid = tid_l(), lane = tid & 63, wave = tid >> 6;
    volatile LAS unsigned* tk = (volatile LAS unsigned*)(lds + LDS_BYTES - 64 + 16);
    const unsigned nchunk = 512u + (with_ctx ? 32u : 0u);
    bool rdy_lat = false, rdy_ctx = false;
    for (;;) {
        if (tid == 0) tk[0] = __hip_atomic_fetch_add(sig + 128, 1u, __ATOMIC_RELAXED, __HIP_MEMORY_SCOPE_AGENT);
        __syncthreads();
        const unsigned t = tk[0];
        __syncthreads();
        if (t >= nchunk) break;
        const bool isc = t >= 512u;
        if (isc ? !rdy_ctx : !rdy_lat) {
            if (tid == 0) { unsigned* w = sig + (isc ? 64 : 0); const unsigned need = isc ? need_ctx : need_lat; unsigned sp = 0;
                while (__hip_atomic_load(w, __ATOMIC_RELAXED, __HIP_MEMORY_SCOPE_AGENT) < need) { __builtin_amdgcn_s_sleep(2); if (++sp > (1u << 22)) break; }
                __builtin_amdgcn_fence(__ATOMIC_ACQUIRE, "agent"); asm volatile("s_waitcnt vmcnt(0)" ::: "memory"); }
            __syncthreads();
            if (isc) rdy_ctx = true; else rdy_lat = true;
        }
        int rbase;
        if (!isc) { const int lr = (int)t * 64; rbase = (lr >> 12) * TPB + CTXL + (lr & 4095); }
        else { const int cr = ((int)t - 512) * 64; rbase = (cr >> 8) * TPB + (cr & 255); }
#pragma unroll 1
        for (int it = 0; it < 4; ++it) { const int r0 = rbase + wave * 8 + 2 * it; row_pair<false>(a, p, r0, r0 + 1, true, true, lane); }
    }
}

__device__ __forceinline__ void phase_qknorm_rope(KA a, int m) {
    const int tid = tid_l(), lane = tid & 63, wave = tid >> 6;
    const int gw = blk_l() * 8 + wave, NGW = grd_l() * 8;
    bf16_t* QKV = (bf16_t*)(a->ws + WS_BIG);
    const int i = lane & 31, hl = lane >> 5, d1 = i + 64 * hl, d2 = d1 + 32;
    const float qg1 = a->in[I_AQG][m * 128 + d1], qg2 = a->in[I_AQG][m * 128 + d2], kg1 = a->in[I_AKG][m * 128 + d1], kg2 = a->in[I_AKG][m * 128 + d2];
    const float inv = exp2f(-(float)i * (13.287712379549449f / 32.0f));
    for (int r = gw; r < MT; r += NGW) {
        const int b = r / TPB, pos = r - b * TPB; const bool isctx = pos < CTXL;
        float cs = 1.f, sn = 0.f;
        if (!isctx) { const int t = pos - CTXL; const float p = (float)(hl ? (t & 63) : (t >> 6)); const float ang = p * inv; cs = cosf(ang); sn = sinf(ang); }
        bf16_t* row = QKV + (size_t)r * NQKV;
#pragma unroll
        for (int hd = 0; hd < 10; ++hd) {
            float x1 = bf_f(row[hd * 128 + d1]), x2 = bf_f(row[hd * 128 + d2]);
            const float rstd = 1.0f / sqrtf(wave_sum(x1 * x1 + x2 * x2) * (1.0f / 128.0f) + EPS);
            x1 *= rstd * (hd < 8 ? qg1 : kg1); x2 *= rstd * (hd < 8 ? qg2 : kg2);
            const float o1 = x1 * cs - x2 * sn, o2 = x2 * cs + x1 * sn;
            row[hd * 128 + d1] = f_bf(o1); row[hd * 128 + d2] = f_bf(o2);
        }
    }
}

__device__ __forceinline__ void phase_attention(KA a, char* lds) {
    const int G = grd_l(); const int bx = blk_l(); const int vcu = (G % 8 == 0) ? (bx % 8) * (G / 8) + bx / 8 : bx;
    const att::bf16* QKV = (const att::bf16*)(a->ws + WS_BIG); att::bf16* AO = (att::bf16*)(a->ws + WS_ATTNO);
    for (int u = vcu; u < 1024 + 64; u += G) {
        int b, h, q0, seq;
        if (u < 1024) { const int grp = u >> 6, within = u & 63; b = grp >> 1; h = (grp & 1) * 4 + (within >> 4); q0 = CTXL + (within & 15) * 256; seq = TPB; }
        else { const int cu = u - 1024; b = cu >> 3; h = cu & 7; q0 = 0; seq = CTXL; }
        const int kvh = h >> 2; const size_t rb = (size_t)b * TPB;
        att::attn_dense_body<att::bf16>(QKV + (rb + q0) * NQKV + h * 128, QKV + rb * NQKV + 1024 + kvh * 128, QKV + rb * NQKV + 1280 + kvh * 128, AO + (rb + q0) * DM + h * 128, seq, lds);
        __syncthreads();
    }
}

namespace gla {
__device__ __forceinline__ int crow(int r, int hi) { return (r & 3) + 8 * (r >> 2) + 4 * hi; }
constexpr int QD_OFF = 0, KI_OFF = 17408, KET_OFF = 34816, VT_OFF = 53248  , SC_OFF = 90112, TS_OFF = 99328  , GSUM_OFF = 107520;
constexpr int STT_OFF = 0  , VTS_OFF = 34816  ;
constexpr size_t KET_BYTES = (size_t)2 * NB * 4 * 68 * 8192 * 2;
constexpr size_t SC_GOFF = KET_BYTES + (size_t)2 * NB * 4 * 68 * 128 * 4;
}
__device__ __forceinline__ void phase_gla_prep(KA a, int m, LAS unsigned char* lds) {
    using namespace gla;
    const int tid = tid_l(), lane = tid & 63, wave = __builtin_amdgcn_readfirstlane(tid >> 6), r32 = lane & 31, hi = lane >> 5;
    bf16_t* Gb = (bf16_t*)(a->ws + WS_BIG);
    const int d = tid & 127, tg = tid >> 7;
    LAS float* ts = (LAS float*)(lds + TS_OFF); LAS float* gsum = (LAS float*)(lds + GSUM_OFF);
    for (int item = blk_l(); item < NB * 4 * 68; item += grd_l()) {
        const int k = item % 68, h = (item / 68) & 3, b = item / 272;
        const int row0 = b * TPB + 64 * k;
        bf16_t* gp = Gb + (size_t)row0 * NGIN;
        bf16_t qn[16], kn[16];
#pragma unroll
        for (int ii = 0; ii < 16; ++ii) { qn[ii] = gp[(size_t)(16 * tg + ii) * NGIN + h * 128 + d]; kn[ii] = gp[(size_t)(16 * tg + ii) * NGIN + 512 + h * 128 + d]; }
        const u32x2 tw = *(const u32x2*)(gp + (size_t)(tid >> 3) * NGIN + 3072 + 4 * (tid & 7));
        __syncthreads();
        { const int e0 = 4 * (tid & 7), dr = e0 >> 4, r = e0 & 15; LAS float* tp = ts + dr * 1024 + (tid >> 3) * 16 + r;
          tp[0] = bf_lo(tw.x); tp[1] = bf_hi(tw.x); tp[2] = bf_lo(tw.y); tp[3] = bf_hi(tw.y); }
        __syncthreads();
        for (int dir = 0; dir < 2; ++dir) {
            float w2[16];
#pragma unroll
            for (int r = 0; r < 16; ++r) w2[r] = a->in[I_GWA2][((size_t)(m * 2 + dir) * 16 + r) * 512 + h * 128 + d];
            const float bav = a->in[I_GBA][(size_t)(m * 2 + dir) * 512 + h * 128 + d];
            float cum[16];
#pragma unroll
            for (int ii = 0; ii < 16; ++ii) { float x = bav;
#pragma unroll
                for (int r = 0; r < 16; ++r) x += ts[dir * 1024 + (16 * tg + ii) * 16 + r] * w2[r];
                cum[ii] = (fminf(x, 0.f) - __logf(1.0f + __expf(-fabsf(x)))) * (1.0f / 16.0f); }
            if (dir == 0) {
#pragma unroll
                for (int ii = 1; ii < 16; ++ii) cum[ii] += cum[ii - 1];
                gsum[tg * 128 + d] = cum[15];
            } else {
#pragma unroll
                for (int ii = 14; ii >= 0; --ii) cum[ii] += cum[ii + 1];
                gsum[tg * 128 + d] = cum[0];
            }
            __syncthreads();
            const size_t cidx = (size_t)((dir * NB + b) * 4 + h) * 68 + k;
            { const float s0 = gsum[d], s1 = gsum[128 + d], s2 = gsum[256 + d], s3 = gsum[384 + d];
              const float total = (s0 + s1) + (s2 + s3);
              float off;
              if (dir == 0) off = (tg > 0 ? s0 : 0.f) + (tg > 1 ? s1 : 0.f) + (tg > 2 ? s2 : 0.f);
              else off = (tg < 3 ? s3 : 0.f) + (tg < 2 ? s2 : 0.f) + (tg < 1 ? s1 : 0.f);
              unsigned kep[8];
              bf16_t* qdst = gp + (dir ? 512 : 0) + h * 128 + d;
#pragma unroll
              for (int ii = 0; ii < 16; ii += 2) {
                  const float c0 = cum[ii] + off, c1 = cum[ii + 1] + off;
                  const float q0 = bf_f(qn[ii]), q1 = bf_f(qn[ii + 1]), k0 = bf_f(kn[ii]), k1 = bf_f(kn[ii + 1]);
                  const int i0 = 16 * tg + ii;
                  const bf16_t qd0 = f_bf(q0 * 0.08838834764831845f * __expf(c0)), qd1 = f_bf(q1 * 0.08838834764831845f * __expf(c1));
                  *(LAS bf16_t*)(lds + QD_OFF + (i0 * 136 + d) * 2) = qd0;
                  *(LAS bf16_t*)(lds + QD_OFF + ((i0 + 1) * 136 + d) * 2) = qd1;
                  qdst[(size_t)i0 * NGIN] = qd0; qdst[(size_t)(i0 + 1) * NGIN] = qd1;
                  *(LAS bf16_t*)(lds + KI_OFF + (i0 * 136 + d) * 2) = f_bf(k0 * __expf(-c0));
                  *(LAS bf16_t*)(lds + KI_OFF + ((i0 + 1) * 136 + d) * 2) = f_bf(k1 * __expf(-c1));
                  kep[ii >> 1] = cvtpk(k0 * __expf(total - c0), k1 * __expf(total - c1));
              }
              bf16_t* ketg = (bf16_t*)a->out + cidx * 8192 + d * 64 + 16 * tg;
              *(u32x4*)ketg = (u32x4){kep[0], kep[1], kep[2], kep[3]};
              *(u32x4*)(ketg + 8) = (u32x4){kep[4], kep[5], kep[6], kep[7]};
              if (tg == 0) ((float*)((unsigned char*)a->out + KET_BYTES))[cidx * 128 + d] = __expf(total);
            }
            __syncthreads();
            if (wave < 4) {
                const int ti = (wave >> 1) & 1, tj = wave & 1;
                f32x16 acc;
#pragma unroll
                for (int r = 0; r < 16; ++r) acc[r] = 0.f;
                const int aoff = QD_OFF + ((32 * ti + r32) * 136 + 8 * hi) * 2, boff = KI_OFF + ((32 * tj + r32) * 136 + 8 * hi) * 2;
#pragma unroll
                for (int ks = 0; ks < 8; ++ks) { const bf16x8 av = *(const LAS bf16x8*)(lds + aoff + ks * 32), bv = *(const LAS bf16x8*)(lds + boff + ks * 32);
                    acc = __builtin_amdgcn_mfma_f32_32x32x16_bf16(av, bv, acc, 0, 0, 0); }
                bf16_t* scg = (bf16_t*)((unsigned char*)a->out + SC_GOFF) + cidx * 4096;
#pragma unroll
                for (int r = 0; r < 16; ++r) { const int i = 32 * ti + crow(r, hi), j = 32 * tj + r32; const bool keep = dir == 0 ? (j <= i) : (j >= i);
                    scg[i * 64 + j] = f_bf(keep ? acc[r] : 0.f); }
            }
            __syncthreads();
        }
    }
}
__device__ __forceinline__ void phase_gla_scan(KA a, int m, LAS unsigned char* lds) {
    using namespace gla;
    const int tid = tid_l(), lane = tid & 63, wave = __builtin_amdgcn_readfirstlane(tid >> 6), r32 = lane & 31, hi = lane >> 5;
    const int G = grd_l(); const int bx = blk_l(); const int vcu = (G % 8 == 0) ? (bx % 8) * (G / 8) + bx / 8 : bx;
    const bf16_t* Gb = (const bf16_t*)(a->ws + WS_BIG);
    const int dv = tid & 63, tgv = tid >> 6;
    const int ti = (wave >> 1) & 1, tj = wave & 1, role = wave >> 2, sd = wave >> 1, sv = wave & 1;
    for (int item = vcu; item < 256; item += G) {
        const int vs = item & 3, dir = (item >> 2) & 1, h = (item >> 3) & 3, b = item >> 5;
        bf16_t* Oo = (bf16_t*)(a->ws + (dir == 0 ? WS_U : WS_Y));
        const size_t cbase = (size_t)((dir * NB + b) * 4 + h) * 68;
        const bf16_t* ketb = (const bf16_t*)a->out + cbase * 8192 + (32 * sd + r32) * 64 + 8 * hi;
        const bf16_t* scb = (const bf16_t*)((const unsigned char*)a->out + SC_GOFF) + cbase * 4096 + (32 * ti + r32) * 64 + 8 * hi;
        const float* decb = (const float*)((const unsigned char*)a->out + KET_BYTES) + cbase * 128 + 32 * sd + 4 * hi;
        const int qcol = (dir ? 512 : 0) + h * 128 + 8 * hi, vcol = 1024 + h * 256 + vs * 64 + dv, ocol = h * 256 + vs * 64 + 32 * tj + r32;
        __syncthreads();
        for (int i = tid; i < 17408 / 4; i += NTHREADS) ((LAS unsigned*)(lds + STT_OFF))[i] = 0u;
        f32x16 st;
#pragma unroll
        for (int r = 0; r < 16; ++r) st[r] = 0.f;
        bf16x8 qa[8], ke[4], sa[4]; f32x4 dcv[4]; bf16_t vn[8];
#define GLA_K(c) (dir == 0 ? (c) : ((c) < 4 ? 3 - (c) : 71 - (c)))
#define GLA_ROW(c) ((size_t)b * TPB + 64 * GLA_K(c))
#define LD_QA(c) do { if (role == 1) { const size_t row_ = GLA_ROW(c); _Pragma("unroll") for (int ks = 0; ks < 8; ++ks) qa[ks] = *(const bf16x8*)(Gb + (row_ + 32 * ti + r32) * NGIN + qcol + 16 * ks); } } while (0)
#define LD_OIN(c) do { if (role == 1) { const int kk_ = GLA_K(c); _Pragma("unroll") for (int ks = 0; ks < 4; ++ks) sa[ks] = *(const bf16x8*)(scb + (size_t)kk_ * 4096 + 16 * ks); } } while (0)
#define LD_KE(c) do { const int kk_ = GLA_K(c); _Pragma("unroll") for (int ks = 0; ks < 4; ++ks) ke[ks] = *(const bf16x8*)(ketb + (size_t)kk_ * 8192 + 16 * ks); } while (0)
#define LD_DC(c) do { const int kk_ = GLA_K(c); _Pragma("unroll") for (int r4 = 0; r4 < 4; ++r4) dcv[r4] = *(const f32x4*)(decb + (size_t)kk_ * 128 + 8 * r4); } while (0)
#define LD_VN(c) do { const size_t row_ = GLA_ROW(c); _Pragma("unroll") for (int ii = 0; ii < 8; ++ii) vn[ii] = Gb[(row_ + 8 * tgv + ii) * NGIN + vcol]; } while (0)
        LD_VN(0); LD_QA(0); LD_OIN(0); LD_DC(0); LD_KE(0);
        for (int c = 0; c < 68; ++c) {
            const int p_ = c & 1; const size_t rowc_ = GLA_ROW(c); const bool more = c + 1 < 68;
            { u32x4 vp; vp.x = (unsigned)vn[0] | ((unsigned)vn[1] << 16); vp.y = (unsigned)vn[2] | ((unsigned)vn[3] << 16); vp.z = (unsigned)vn[4] | ((unsigned)vn[5] << 16); vp.w = (unsigned)vn[6] | ((unsigned)vn[7] << 16);
              *(LAS u32x4*)(lds + VTS_OFF + p_ * 9216 + (dv * 72 + 8 * tgv) * 2) = vp; }
            if (more) LD_VN(c + 1);
            __syncthreads();
            if (role == 1) {
                f32x16 acc;
#pragma unroll
                for (int r = 0; r < 16; ++r) acc[r] = 0.f;
                const int boff = STT_OFF + p_ * 17408 + ((32 * tj + r32) * 136 + 8 * hi) * 2;
#pragma unroll
                for (int ks = 0; ks < 8; ++ks) { const bf16x8 bv = *(const LAS bf16x8*)(lds + boff + ks * 32);
                    acc = __builtin_amdgcn_mfma_f32_32x32x16_bf16(qa[ks], bv, acc, 0, 0, 0); }
                if (more) LD_QA(c + 1);
                { const int voff = VTS_OFF + p_ * 9216 + ((32 * tj + r32) * 72 + 8 * hi) * 2;
#pragma unroll
                  for (int ks = 0; ks < 4; ++ks) { const bf16x8 bv = *(const LAS bf16x8*)(lds + voff + ks * 32);
                      acc = __builtin_amdgcn_mfma_f32_32x32x16_bf16(sa[ks], bv, acc, 0, 0, 0); } }
                if (more) LD_OIN(c + 1);
                bf16_t* op = Oo + (rowc_ + 32 * ti) * DM + ocol;
#pragma unroll
                for (int r = 0; r < 16; ++r) op[(size_t)crow(r, hi) * DM] = f_bf(acc[r]);
            }
            {
#pragma unroll
              for (int r = 0; r < 16; ++r) st[r] *= dcv[r >> 2][r & 3];
              if (more) LD_DC(c + 1);
              const int boff = VTS_OFF + p_ * 9216 + ((32 * sv + r32) * 72 + 8 * hi) * 2;
#pragma unroll
              for (int ks = 0; ks < 4; ++ks) { const bf16x8 bv = *(const LAS bf16x8*)(lds + boff + ks * 32);
                  st = __builtin_amdgcn_mfma_f32_32x32x16_bf16(ke[ks], bv, st, 0, 0, 0); }
              if (more) LD_KE(c + 1);
#pragma unroll
              for (int r4 = 0; r4 < 4; ++r4) { u32x2 w; w.x = cvtpk(st[4 * r4], st[4 * r4 + 1]); w.y = cvtpk(st[4 * r4 + 2], st[4 * r4 + 3]);
                  *(LAS u32x2*)(lds + STT_OFF + (p_ ^ 1) * 17408 + ((32 * sv + r32) * 136 + 32 * sd + 8 * r4 + 4 * hi) * 2) = w; }
            }
        }
#undef GLA_ROW
#undef LD_QA
#undef LD_OIN
#undef LD_KE
#undef LD_DC
#undef LD_VN
#undef GLA_K
    }
}

__device__ __forceinline__ void phase_gla_readout(KA a, int m, bool skip_ctx) {
    const int tid = tid_l(), lane = tid & 63, wave = tid >> 6;
    const int gw = blk_l() * 8 + wave, NGW = grd_l() * 8;
    const bf16_t* OF = (const bf16_t*)(a->ws + WS_U); const bf16_t* OB = (const bf16_t*)(a->ws + WS_Y); bf16_t* Gb = (bf16_t*)(a->ws + WS_BIG);
    const float* og = a->in[I_GOG] + (size_t)m * 1024;
    for (int r = gw; r < MT; r += NGW) {
        if (skip_ctx && (r % TPB) < CTXL) continue;
#pragma unroll
        for (int q = 0; q < 4; ++q) {
            const int col = 4 * lane + 256 * q;
            const u32x2 wf = *(const u32x2*)(OF + (size_t)r * DM + col), wb = *(const u32x2*)(OB + (size_t)r * DM + col), wr = *(const u32x2*)(Gb + (size_t)r * NGIN + 2048 + col);
            f32x4 s = (f32x4){bf_lo(wf.x) + bf_lo(wb.x), bf_hi(wf.x) + bf_hi(wb.x), bf_lo(wf.y) + bf_lo(wb.y), bf_hi(wf.y) + bf_hi(wb.y)};
            const float ss = wave_sum((s.x * s.x + s.y * s.y) + (s.z * s.z + s.w * s.w));
            const float rstd = 1.0f / sqrtf(ss * (1.0f / 256.0f) + EPS);
            const f32x4 gg = *(const f32x4*)(og + col);
            const f32x4 rr = (f32x4){bf_lo(wr.x), bf_hi(wr.x), bf_lo(wr.y), bf_hi(wr.y)};
            f32x4 o = s * rstd * gg; o.x *= silu(rr.x); o.y *= silu(rr.y); o.z *= silu(rr.z); o.w *= silu(rr.w);
            u32x2 w; w.x = cvtpk(o.x, o.y); w.y = cvtpk(o.z, o.w);
            *(u32x2*)(Gb + (size_t)r * NGIN + 2048 + col) = w;
        }
    }
}

__device__ __forceinline__ unsigned long long rt() { return __builtin_amdgcn_s_memrealtime(); }
#define XB_TMO      128
#define XB_XCNT(j)  (256  + 64 * (j))
#define XB_XSUB(j)  (1280 + 64 * (j))
#define XB_XGEN(j)  (2304 + 64 * (j))
#define XB_TOP      3328
#define XB_TOPGEN   3392
#define XCD_BAR_WORDS 3456
#define XB_SPIN_CAP (1u << 18)

__device__ __forceinline__ unsigned xb_ld(unsigned* p)              { return __hip_atomic_load(p, __ATOMIC_RELAXED, __HIP_MEMORY_SCOPE_AGENT); }
__device__ __forceinline__ unsigned xb_add(unsigned* p, unsigned v) { return __hip_atomic_fetch_add(p, v, __ATOMIC_RELAXED, __HIP_MEMORY_SCOPE_AGENT); }
__device__ __forceinline__ unsigned xb_xcc_id() { return (unsigned)__builtin_amdgcn_s_getreg((3 << 11) | 20) & 0xFu; }
#define XB_SPIN(cond, bar) do { unsigned _sp = 0; while (cond) { __builtin_amdgcn_s_sleep(1); \
    if ((++_sp & 255u) == 0u) { if (xb_ld(&(bar)[XB_TMO])) break; if (_sp > XB_SPIN_CAP) { atomicAdd(&(bar)[XB_TMO], 1u); break; } } } } while (0)

struct XcdBarrier {
    unsigned* bar; unsigned x;
    volatile LAS unsigned* st;
};

__device__ __forceinline__ XcdBarrier xcd_barrier_post(unsigned* bar, volatile LAS unsigned* st) {
    XcdBarrier b; b.bar = bar; b.x = xb_xcc_id(); b.st = st;
    if (threadIdx.x == 0) (void)xb_add(&bar[XB_XCNT(b.x)], 1u);
    return b;
}
__device__ __forceinline__ void xcd_barrier_complete(unsigned* bar, unsigned x, unsigned& nloc, unsigned& nx) {
    const unsigned G = gridDim.x * gridDim.y * gridDim.z;
    unsigned sum, cnt, mine, sp = 0u;
    for (;;) {
        sum = 0u; cnt = 0u; mine = 0u;
#pragma unroll
        for (unsigned j = 0; j < 16; ++j) { const unsigned c = xb_ld(&bar[XB_XCNT(j)]); sum += c; cnt += (c > 0u) ? 1u : 0u; mine = (j == x) ? c : mine; }
        if (sum == G) break;
        __builtin_amdgcn_s_sleep(1);
        if ((++sp & 255u) == 0u) { if (xb_ld(&bar[XB_TMO])) break; if (sp > XB_SPIN_CAP) { atomicAdd(&bar[XB_TMO], 1u); break; } }
    }
    nloc = mine > 0u ? mine : 1u; nx = cnt > 0u ? cnt : 1u;
}

__device__ __forceinline__ void xcd_barrier(const XcdBarrier& b) {
    asm volatile("s_waitcnt vmcnt(0)" ::: "memory");
    __syncthreads();
    if (threadIdx.x == 0) {
        unsigned* bar = b.bar;
        __builtin_amdgcn_s_waitcnt(0);
        unsigned nloc = b.st[0], nx = b.st[1];
        if (nloc == 0u) { xcd_barrier_complete(bar, b.x, nloc, nx); b.st[0] = nloc; b.st[1] = nx; }
        const unsigned old = xb_add(&bar[XB_XSUB(b.x)], 1u);
        const unsigned gen = old / nloc;
        if (old + 1u == (gen + 1u) * nloc) {
            __builtin_amdgcn_fence(__ATOMIC_RELEASE, "agent");
            asm volatile("s_waitcnt vmcnt(0)" ::: "memory");
            const unsigned og = xb_add(&bar[XB_TOP], 1u);
            const unsigned tg = og / nx;
            if (og + 1u == (tg + 1u) * nx) xb_add(&bar[XB_TOPGEN], 1u);
            else XB_SPIN(xb_ld(&bar[XB_TOPGEN]) == tg, bar);
            __builtin_amdgcn_fence(__ATOMIC_ACQUIRE, "agent");
            xb_add(&bar[XB_XGEN(b.x)], 1u);
            asm volatile("s_waitcnt vmcnt(0)" ::: "memory");
        } else {
            XB_SPIN(xb_ld(&bar[XB_XGEN(b.x)]) == gen, bar);
            __builtin_amdgcn_fence(__ATOMIC_ACQUIRE, "agent");
            asm volatile("s_waitcnt vmcnt(0)" ::: "memory");
        }
    }
    __syncthreads();
}

constexpr size_t WS_BAR = 4096;
constexpr size_t WS_XCNT = 65536;
constexpr size_t WS_XBUF = WS_HRES + 68 * MiB;
constexpr size_t WS_DFLOW = 32768;
constexpr int LDS_BARW = LDS_BYTES - 64;
#define GSYNC() do { XcdBarrier b_; b_.bar = (unsigned*)(kargs()->ws + WS_BAR); b_.x = xb_xcc_id(); b_.st = (volatile LAS unsigned*)(lds + LDS_BARW); xcd_barrier(b_); } while (0)
struct EpiRow {
    static constexpr bool PERM = true, AFTER_DRAIN = false;
    int sl; LAS unsigned char* xl;
    __device__ __forceinline__ void operator()(f32x4 (&acc)[2][2][4][2], const pg8::Unit& u, int wr, int wc, int fr, int fq) const {
        KA a_ = kargs(); unsigned char* ws = a_->ws;
        const int L = sl / 3, jpost = sl - 3 * L; const bool lastsl = sl == 3 * DEPTH - 1;
        const int Ln = (jpost == 2) ? L + 1 : L, jn = (jpost == 2) ? 0 : jpost + 1, jpre = lastsl ? -1 : jn, final_out = lastsl ? 1 : 0;
        const float gs = jpost == 1 ? 1.0f : 0.5f;
        bf16_t* hres = (bf16_t*)(ws + WS_HRES); bf16_t* U = (bf16_t*)(ws + WS_U); float* out = a_->out;
        const float* modL_post = (const float*)(ws + WS_MOD) + (size_t)L * 9 * 9216; const float* modL_pre = (const float*)(ws + WS_MOD) + (size_t)(lastsl ? L : Ln) * 9 * 9216;
        const float* gpost = a_->in[I_NPOST] + (size_t)(L * 3 + jpost) * DM; const float* gpre = a_->in[I_NPRE] + (size_t)((lastsl ? L : Ln) * 3 + (lastsl ? 0 : jn)) * DM;
        unsigned* cn1 = (unsigned*)(ws + WS_XCNT) + (size_t)(sl * 2) * 136 * 64; unsigned* cn2 = cn1 + 136 * 64;
        float* xb1 = (float*)(ws + WS_XBUF); float* xb2 = (float*)(ws + WS_XBUF + MiB);
        const int tid = threadIdx.x, wid = __builtin_amdgcn_readfirstlane(tid >> 6), lane = tid & 63;
        const int bidx = u.pm / 17, isctx = (u.pm - 17 * bidx) == 0, mi = isctx ? 8 : bidx;
        const int col0 = u.pn * 256 + wc * 32 + 8 * fq, row0 = u.pm * 256 + wr * 64 + fr, rl0 = wr * 64 + fr;
        const LAS float* S = (const LAS float*)(xl + 4096);
        pg8::rowstats_run(xb1, cn1, acc, u, wr, wc, fr, fq, xl, wid, lane);
        {
            const float* gate = modL_post + (size_t)mi * 9216 + (3 * jpost + 2) * 1024 + col0;
            f32x4 gt[2][2], gp[2][2];
#pragma unroll
            for (int bj = 0; bj < 2; ++bj)
#pragma unroll
                for (int n = 0; n < 2; ++n) { gt[bj][n] = *(const f32x4*)(gate + bj * 128 + 4 * n) * gs; gp[bj][n] = *(const f32x4*)(gpost + col0 + bj * 128 + 4 * n); gt[bj][n] = gt[bj][n] * gp[bj][n]; }
#pragma unroll
            for (int ai = 0; ai < 2; ++ai)
#pragma unroll
                for (int m = 0; m < 4; ++m) {
                    const int rl = rl0 + ai * 128 + m * 16; const size_t roff = (size_t)(row0 + ai * 128 + m * 16) * 1024 + col0;
                    const float rstd = 1.0f / sqrtf(S[rl] * (1.0f / 1024.0f) + 1e-6f);
#pragma unroll
                    for (int bj = 0; bj < 2; ++bj) {
                        const u32x4 hw = *(const u32x4*)(hres + roff + bj * 128);
                        const f32x4 h0 = {__uint_as_float(hw.x << 16), __uint_as_float(hw.x & 0xffff0000u), __uint_as_float(hw.y << 16), __uint_as_float(hw.y & 0xffff0000u)};
                        const f32x4 h1 = {__uint_as_float(hw.z << 16), __uint_as_float(hw.z & 0xffff0000u), __uint_as_float(hw.w << 16), __uint_as_float(hw.w & 0xffff0000u)};
                        const f32x4 n0 = h0 + gt[bj][0] * (acc[ai][bj][m][0] * rstd), n1 = h1 + gt[bj][1] * (acc[ai][bj][m][1] * rstd);
                        acc[ai][bj][m][0] = n0; acc[ai][bj][m][1] = n1;
                        if (final_out) { float* op = out + (size_t)(bidx * 4096 + (u.pm - 17 * bidx - 1) * 256 + wr * 64 + fr + ai * 128 + m * 16) * 1024 + col0 + bj * 128; *(f32x4*)op = n0; *(f32x4*)(op + 4) = n1; }
                        else { u32x4 w; w.x = cvtpk(n0[0], n0[1]); w.y = cvtpk(n0[2], n0[3]); w.z = cvtpk(n1[0], n1[1]); w.w = cvtpk(n1[2], n1[3]); *(u32x4*)(hres + roff + bj * 128) = w; }
                    }
                }
        }
        if (jpre < 0) return;
        pg8::rowstats_run(xb2, cn2, acc, u, wr, wc, fr, fq, xl, wid, lane);
        {
            const float* mb = modL_pre + (size_t)mi * 9216 + (3 * jpre) * 1024 + col0;
            f32x4 sh[2][2], sc[2][2];
#pragma unroll
            for (int bj = 0; bj < 2; ++bj)
#pragma unroll
                for (int n = 0; n < 2; ++n) { sh[bj][n] = *(const f32x4*)(mb + bj * 128 + 4 * n); sc[bj][n] = (1.0f + *(const f32x4*)(mb + 1024 + bj * 128 + 4 * n)) * *(const f32x4*)(gpre + col0 + bj * 128 + 4 * n); }
#pragma unroll
            for (int ai = 0; ai < 2; ++ai)
#pragma unroll
                for (int m = 0; m < 4; ++m) {
                    const int rl = rl0 + ai * 128 + m * 16; const size_t roff = (size_t)(row0 + ai * 128 + m * 16) * 1024 + col0;
                    const float rstd = 1.0f / sqrtf(S[rl] * (1.0f / 1024.0f) + 1e-6f);
#pragma unroll
                    for (int bj = 0; bj < 2; ++bj) {
                        const f32x4 u0 = acc[ai][bj][m][0] * rstd * sc[bj][0] + sh[bj][0], u1 = acc[ai][bj][m][1] * rstd * sc[bj][1] + sh[bj][1];
                        u32x4 w; w.x = cvtpk(u0[0], u0[1]); w.y = cvtpk(u0[2], u0[3]); w.z = cvtpk(u1[0], u1[1]); w.w = cvtpk(u1[2], u1[3]);
                        *(u32x4*)(U + roff + bj * 128) = w;
                    }
                }
        }
    }
};

__global__ void __launch_bounds__(NTHREADS, 2) fwd_megakernel(Args unused_args) {
    extern __shared__ __attribute__((aligned(16))) unsigned char lds_raw[];
    LAS unsigned char* lds = (LAS unsigned char*)lds_raw;
    cg::grid_group grid = cg::this_grid();
    if (threadIdx.x < 16) ((LAS unsigned*)(lds + LDS_BARW))[threadIdx.x] = 0u;
    __syncthreads();
    (void)xcd_barrier_post((unsigned*)(kargs()->ws + WS_BAR), (volatile LAS unsigned*)(lds + LDS_BARW));

#ifndef SKIP_MOD
    phase_mod(kargs(), lds);
#endif
#ifndef SKIP_W
    phase_weights(kargs(), lds);
#endif
    grid.sync();
    row_pass<true>(kargs(), RowP{0, -1, 0.f, 0, 0, false});
    GSYNC();

    for (int sl = 0; sl < 3 * DEPTH; ++sl) {
        const int L = sl / 3, j = sl - 3 * L, m = L >> 1;
        if (j != 1) {
            unsigned char* ws = kargs()->ws; const int f = j >> 1;
            pg8::Gemm g1{(const bf16_t*)(ws + WS_U), (const bf16_t*)(ws + WS_W1T) + (size_t)(L * 2 + f) * 5632 * 1024, MT, 2 * DFF, DM, DM, DM};
            pg8::StaticOrder S; S.init(MT, 2 * DFF, DM, grd_l(), blk_l(), sl == 3 * DEPTH - 1 ? 2 : 0);
            pg8::EpiSwiglu E{(bf16_t*)(ws + WS_BIG), DFF};
#ifndef SKIP_G1
            pg8::gemm_phase<pg8::EpiSwiglu, pg8::StaticOrder, true, true>(lds, g1, S, E);
#endif
            GSYNC();
        } else {
            const bool attn = (L & 1) == 0;
            { unsigned char* ws = kargs()->ws;
              pg8::Gemm g1{(const bf16_t*)(ws + WS_U), attn ? (const bf16_t*)(ws + WS_WQKVT) + (size_t)m * NQKV * 1024 : (const bf16_t*)(ws + WS_WGINT) + (size_t)m * NGIN * 1024, MT, attn ? NQKV : NGIN, DM, DM, DM};
              pg8::StaticOrder S; S.init(MT, g1.N, DM, grd_l(), blk_l(), 0);
              pg8::EpiBf16s E{(bf16_t*)(ws + WS_BIG), g1.N, nullptr};
#ifndef SKIP_GM
              pg8::gemm_phase<pg8::EpiBf16s, pg8::StaticOrder, true, true>(lds, g1, S, E);
#endif
 }
            GSYNC();
            if (attn) {
#ifndef SKIP_QK
                phase_qknorm_rope(kargs(), m);
#endif
                GSYNC();
#ifndef SKIP_ATT
                phase_attention(kargs(), (char*)lds_raw);
#endif
                GSYNC();
            } else {
                phase_gla_prep(kargs(), m, lds);
                GSYNC();
                phase_gla_scan(kargs(), m, lds);
                GSYNC();
#ifndef SKIP_RO
                phase_gla_readout(kargs(), m, sl >= 10);
#endif
                GSYNC();
            }
        }
        {
            unsigned char* ws = kargs()->ws;
            pg8::Gemm g2;
            if (j != 1) g2 = pg8::Gemm{(const bf16_t*)(ws + WS_BIG), (const bf16_t*)(ws + WS_W2T) + (size_t)(L * 2 + (j >> 1)) * 1024 * 2816, MT, DM, DFF, DFF, DFF};
            else if ((L & 1) == 0) g2 = pg8::Gemm{(const bf16_t*)(ws + WS_ATTNO), (const bf16_t*)(ws + WS_WOAT) + (size_t)m * 1024 * 1024, MT, DM, DM, DM, DM};
            else g2 = pg8::Gemm{(const bf16_t*)(ws + WS_BIG) + 2048, (const bf16_t*)(ws + WS_WGOT) + (size_t)m * 1024 * 1024, MT, DM, DM, NGIN, DM};
            pg8::StaticOrder S; S.init(MT, DM, g2.K, grd_l(), blk_l(), sl >= 10 ? 2 : 3);
            EpiRow E{sl, lds + 131072};
#ifndef SKIP_G2
            pg8::gemm_phase<EpiRow, pg8::StaticOrder, true, true>(lds, g2, S, E);
#endif
        }
        const bool last = sl == 3 * DEPTH - 1;
        if (!last) GSYNC();
    }
}

extern "C" void kernel_launch(void* const* d_in, const int* in_sizes, int n_in, void* d_out, int out_size, void* d_ws, size_t ws_size, hipStream_t stream) {
    static int grid = 0;
    if (grid == 0) {
        if (n_in != 20 || out_size != NB * SEQ * DM || ws_size < WS_END) { fprintf(stderr, "kernel_launch: unexpected shapes: n_in %d out %d ws %zu (need %zu)\n", n_in, out_size, ws_size, (size_t)WS_END); grid = -1; return; }
        int dev = 0, cus = 0, per_cu = 0;
        (void)hipGetDevice(&dev);
        (void)hipDeviceGetAttribute(&cus, hipDeviceAttributeMultiprocessorCount, dev);
        (void)hipFuncSetAttribute((const void*)fwd_megakernel, hipFuncAttributeMaxDynamicSharedMemorySize, LDS_BYTES);
        (void)hipOccupancyMaxActiveBlocksPerMultiprocessor(&per_cu, (const void*)fwd_megakernel, NTHREADS, LDS_BYTES);
        if (per_cu < 1) per_cu = 1;
        grid = cus * per_cu;
        if (grid > 256) grid = 256;
        if (grid < 256) { fprintf(stderr, "kernel_launch: %d co-resident workgroups < 256: this build needs 256; nothing launched\n", grid); grid = -1; return; }
        fprintf(stderr, "kernel_launch: grid %d (cus %d x %d), ws %zu\n", grid, cus, per_cu, ws_size);
    }
    if (grid < 0) return;
    (void)hipMemsetAsync(d_ws, 0, 1 * MiB, stream);
    Args a{};
    for (int i = 0; i < 20; ++i) a.in[i] = (const float*)d_in[i];
    a.out = (float*)d_out; a.ws = (unsigned char*)d_ws;
    void* args[] = {&a};
    hipError_t e = hipLaunchCooperativeKernel((const void*)fwd_megakernel, dim3(grid), dim3(NTHREADS), args, LDS_BYTES, stream);
    if (e != hipSuccess) fprintf(stderr, "kernel_launch: cooperative launch failed: %s (grid %d)\n", hipGetErrorString(e), grid);
}
```

```cpp
#include <hip/hip_runtime.h>
#include <hip/hip_cooperative_groups.h>
#include <hip/hip_bf16.h>
#include <cstdio>
#include <cstdint>
namespace cg = cooperative_groups;
__device__ __forceinline__ int tid_l() { int t = threadIdx.x; asm volatile("" : "+v"(t)); return t; }
__device__ __forceinline__ int blk_l() { int t = blockIdx.x; asm volatile("" : "+s"(t)); return t; }
__device__ __forceinline__ int grd_l() { int t = gridDim.x; asm volatile("" : "+s"(t)); return t; }
namespace pg8 {
#define PG8_LAS __attribute__((address_space(3)))
typedef unsigned short bf16_t;
typedef short bf16x8 __attribute__((ext_vector_type(8)));
typedef float f32x4 __attribute__((ext_vector_type(4)));
typedef unsigned u32x4 __attribute__((ext_vector_type(4)));
constexpr int BM = 256, BK = 64, HALF = 128, HTB = HALF * BK * 2  , STAGE_BYTES = 8 * HTB, NXCD = 8, WGM = 8;

__host__ __device__ __forceinline__ int lds_byte(int r, int c) { const int st = (r >> 4) * 2 + (c >> 5), rr = r & 15, cc = c & 31, ob = rr * 64 + cc * 2; return st * 1024 + (ob ^ (((ob >> 9) & 1) << 5)); }
__host__ __device__ __forceinline__ void stage_rc(int b, int& R, int& C) { const int st = b / 1024, sb = b % 1024, swz = sb ^ (((sb >> 9) & 1) << 5); R = (st >> 1) * 16 + swz / 64; C = (st & 1) * 32 + (swz % 64) / 2; }
__host__ __device__ __forceinline__ int perm32(int rho) { const int n = rho >> 4, i = rho & 15; return 8 * (i >> 2) + 4 * n + (i & 3); }

struct Unit { int pm, pn, kt0, nt, part, sig; };
struct Gemm { const bf16_t* A; const bf16_t* Bt; int M, N, K, lda, ldb; };

struct StaticOrder {
    int nM, nN, nwg, G, c, mode, ntfull; unsigned* sig;
    __host__ __device__ void init(int M, int N, int K, int G_, int c_, int mode_) { mode = mode_; nM = mode ? 128 : M / BM; nN = N / BM; nwg = nM * nN; G = G_; c = c_; ntfull = K / BK; sig = nullptr; }
    __host__ __device__ __forceinline__ bool next(int i, Unit& u) const {
        const long L = (long)i * G + c;
        int pm = 0, pn = 0, kt0 = 0, nt = ntfull, part = -1, sg = 0; bool ok = true;
        if (L >= nwg) {
            const int e = (int)(L - nwg);
            if (mode == 3) { ok = e < 8 * nN; pm = 17 * (e / nN); pn = e % nN; sg = 2; }
            else { ok = (mode == 1) && (e < 16 * nN); const int ct = e >> 1; pm = 17 * (ct / nN); pn = ct % nN; part = e & 1; nt = ntfull >> 1; kt0 = part * nt; }
        } else {
            int wgid = (int)L; { const int q = nwg / NXCD, r = nwg % NXCD, xcd = wgid % NXCD, off = wgid / NXCD; wgid = (xcd < r ? xcd * (q + 1) : r * (q + 1) + (xcd - r) * q) + off; }
            const int nig = WGM * nN, gid = wgid / nig, fm = gid * WGM, gsz = (nM - fm) < WGM ? (nM - fm) : WGM;
            pm = fm + ((wgid % nig) % gsz); pn = (wgid % nig) / gsz;
            if (mode) pm += (pm >> 4) + 1;
            sg = (mode >= 2 && L + G >= nwg) ? 1 : 0;
        }
        u.pm = pm; u.pn = pn; u.kt0 = kt0; u.nt = nt; u.part = part; u.sig = sg;
        return ok;
    }
    __device__ __forceinline__ void a_ready(const Unit&) const {}
    __device__ __forceinline__ void done(const Unit& u) const {
        if (sig != nullptr && u.sig != 0) {
            asm volatile("s_waitcnt vmcnt(0)" ::: "memory");
            __builtin_amdgcn_s_barrier(); asm volatile("" ::: "memory");
            if (threadIdx.x == 0) {
                __builtin_amdgcn_fence(__ATOMIC_RELEASE, "agent");
                asm volatile("s_waitcnt vmcnt(0)" ::: "memory");
                __hip_atomic_fetch_add(sig + (u.sig == 1 ? 0 : 64), 1u, __ATOMIC_RELAXED, __HIP_MEMORY_SCOPE_AGENT);
            }
        }
    }
};

typedef float f32x2c_t __attribute__((ext_vector_type(2))); typedef __bf16 bf16x2c_t __attribute__((ext_vector_type(2)));
__device__ __forceinline__ unsigned cvt_pk_bf16(float lo, float hi) { f32x2c_t v = {lo, hi}; bf16x2c_t b = __builtin_convertvector(v, bf16x2c_t); return __builtin_bit_cast(unsigned, b); }
typedef float f32x2 __attribute__((ext_vector_type(2)));
struct EpiBf16s {
    static constexpr bool PERM = true, AFTER_DRAIN = false;
    bf16_t* O; int ldc; float* P;
    __device__ __forceinline__ void operator()(const f32x4 (&acc)[2][2][4][2], const Unit& u, int wr, int wc, int fr, int fq) const {
        const int row0 = u.pm * BM + wr * 64 + fr; const int col0 = u.pn * BM + wc * 32 + 8 * fq;
        if (u.part >= 0) {
            float* pb = P + (size_t)u.part * 2048 * ldc + (size_t)((u.pm / 17) * BM + wr * 64 + fr) * ldc + col0;
#pragma unroll
            for (int ai = 0; ai < 2; ++ai)
#pragma unroll
                for (int m = 0; m < 4; ++m)
#pragma unroll
                    for (int bj = 0; bj < 2; ++bj) { float* rp = pb + (size_t)(ai * HALF + m * 16) * ldc + bj * HALF; *(f32x4*)rp = acc[ai][bj][m][0]; *(f32x4*)(rp + 4) = acc[ai][bj][m][1]; }
            return;
        }
#pragma unroll
        for (int ai = 0; ai < 2; ++ai)
#pragma unroll
            for (int m = 0; m < 4; ++m) { bf16_t* rowp = O + (size_t)(row0 + ai * HALF + m * 16) * ldc + col0;
#pragma unroll
                for (int bj = 0; bj < 2; ++bj) { const f32x4 v0 = acc[ai][bj][m][0], v1 = acc[ai][bj][m][1];
                    u32x4 w; w.x = cvt_pk_bf16(v0[0], v0[1]); w.y = cvt_pk_bf16(v0[2], v0[3]); w.z = cvt_pk_bf16(v1[0], v1[1]); w.w = cvt_pk_bf16(v1[2], v1[3]);
                    *(u32x4*)(rowp + bj * HALF) = w; } }
    }
};
__device__ __forceinline__ float silu_f(float g) { return g * __builtin_amdgcn_rcpf(1.0f + __expf(-g)); }
struct EpiSwiglu {
    static constexpr bool PERM = true, AFTER_DRAIN = false;
    bf16_t* H; int ldh;
    __device__ __forceinline__ void operator()(const f32x4 (&acc)[2][2][4][2], const Unit& u, int wr, int wc, int fr, int fq) const {
        const int row0 = u.pm * BM + wr * 64 + fr; const int col0 = u.pn * HALF + wc * 32 + 8 * fq;
#pragma unroll
        for (int ai = 0; ai < 2; ++ai)
#pragma unroll
            for (int m = 0; m < 4; ++m) { bf16_t* rowp = H + (size_t)(row0 + ai * HALF + m * 16) * ldh + col0;
                const f32x4 g0 = acc[ai][0][m][0], g1 = acc[ai][0][m][1], u0 = acc[ai][1][m][0], u1 = acc[ai][1][m][1];
                u32x4 w;
                w.x = cvt_pk_bf16(silu_f(g0[0]) * u0[0], silu_f(g0[1]) * u0[1]); w.y = cvt_pk_bf16(silu_f(g0[2]) * u0[2], silu_f(g0[3]) * u0[3]);
                w.z = cvt_pk_bf16(silu_f(g1[0]) * u1[0], silu_f(g1[1]) * u1[1]); w.w = cvt_pk_bf16(silu_f(g1[2]) * u1[2], silu_f(g1[3]) * u1[3]);
                *(u32x4*)rowp = w; }
    }
};
__device__ __forceinline__ void rowstats_run(float* xbuf  , unsigned* cnt  , const f32x4 (&v)[2][2][4][2], const Unit& u, int wr, int wc, int fr, int fq, PG8_LAS unsigned char* xl, int wid, int lane) {
        PG8_LAS float* P = (PG8_LAS float*)xl;
        PG8_LAS float* S = (PG8_LAS float*)(xl + 4096);
#pragma unroll
        for (int ai = 0; ai < 2; ++ai)
#pragma unroll
            for (int m = 0; m < 4; ++m) {
                float s = 0.f;
#pragma unroll
                for (int bj = 0; bj < 2; ++bj)
#pragma unroll
                    for (int n = 0; n < 2; ++n) { const f32x4 x = v[ai][bj][m][n]; s += (x[0] * x[0] + x[1] * x[1]) + (x[2] * x[2] + x[3] * x[3]); }
                s += __shfl_xor(s, 16); s += __shfl_xor(s, 32);
                if (fq == 0) P[(ai * HALF + wr * 64 + m * 16 + fr) * 4 + wc] = s;
            }
        asm volatile("s_waitcnt lgkmcnt(0)" ::: "memory"); __builtin_amdgcn_s_barrier(); asm volatile("" ::: "memory");
        const int row = wid * 32 + (lane & 31);
        if (lane < 32) {
            const float t = (P[row * 4 + 0] + P[row * 4 + 1]) + (P[row * 4 + 2] + P[row * 4 + 3]);
            __hip_atomic_store(xbuf + ((size_t)(u.pm * BM + row) * 4 + u.pn), t, __ATOMIC_RELAXED, __HIP_MEMORY_SCOPE_AGENT);
        }
        asm volatile("s_waitcnt vmcnt(0)" ::: "memory");
        if (lane == 0) __hip_atomic_fetch_add(cnt + 64 * u.pm, 1u, __ATOMIC_RELAXED, __HIP_MEMORY_SCOPE_AGENT);
        if (wid == 0) {
            unsigned sp = 0;
            while ((unsigned)__builtin_amdgcn_readfirstlane(__hip_atomic_load(cnt + 64 * u.pm, __ATOMIC_RELAXED, __HIP_MEMORY_SCOPE_AGENT)) < 32u) { __builtin_amdgcn_s_sleep(1); if (++sp > (1u << 22)) break; }
            __builtin_amdgcn_fence(__ATOMIC_ACQUIRE, "agent");
        }
        asm volatile("s_waitcnt vmcnt(0) lgkmcnt(0)" ::: "memory"); __builtin_amdgcn_s_barrier(); asm volatile("" ::: "memory");
        if (lane < 32) {
            const float* slot = xbuf + (size_t)(u.pm * BM + row) * 4; float t = 0.f;
#pragma unroll
            for (int k = 0; k < 4; ++k) t += __hip_atomic_load(slot + k, __ATOMIC_RELAXED, __HIP_MEMORY_SCOPE_AGENT);
            S[row] = t;
        }
        asm volatile("s_waitcnt vmcnt(0) lgkmcnt(0)" ::: "memory"); __builtin_amdgcn_s_barrier(); asm volatile("" ::: "memory");
    }

template <class Epi, class Sched, bool ALIGN_EPI = false, bool SP2 = false>
__device__ __forceinline__ void gemm_phase(PG8_LAS unsigned char* lds, const Gemm g, const Sched& S, const Epi& E) {
    const int tid = tid_l(), wid = __builtin_amdgcn_readfirstlane(tid >> 6), lane = tid & 63, wr = wid >> 2, wc = wid & 3, fr = lane & 15, fq = lane >> 4;
    unsigned voffA[2], voffB[2];
#pragma unroll
    for (int i = 0; i < 2; ++i) { int R, C; stage_rc(tid * 16 + i * 8192, R, C); const int Rb = Epi::PERM ? ((R & ~31) + perm32(R & 31)) : R;
        voffA[i] = (unsigned)(R * g.lda + C) * 2u; voffB[i] = (unsigned)(Rb * g.ldb + C) * 2u; }
    const size_t kstep = (size_t)(BK * 2);
    const size_t hstepB = (size_t)HALF * g.ldb * 2, hstepA = (size_t)HALF * g.lda * 2;
    const size_t tstepA = 2 * hstepA, tstepB = 2 * hstepB;
    const unsigned ldsw = (unsigned)wid * 1024u;
    const int aoff = lds_byte(wr * 64 + fr, fq * 8), boff = lds_byte(wc * 32 + fr, fq * 8);
#define PG8_SA(b, h) (((b) * 2 + (h)) * HTB)
#define PG8_SB(b, h) ((4 + (b) * 2 + (h)) * HTB)
#define PG8_STAGE(bufoff, gbase, voff) do { _Pragma("unroll") for (int _i = 0; _i < 2; ++_i) \
        __builtin_amdgcn_global_load_lds((const unsigned*)((const char*)(gbase) + (voff)[_i]), (PG8_LAS unsigned*)(lds + (bufoff) + ldsw + _i * 8192), 16, 0, 0); } while (0)
#define PG8_LDA(dst, b, h) do { _Pragma("unroll") for (int m = 0; m < 4; ++m) _Pragma("unroll") for (int k = 0; k < 2; ++k) dst[m][k] = *(const PG8_LAS bf16x8*)(lds + PG8_SA(b, h) + aoff + m * 2048 + k * 1024); } while (0)
#define PG8_LDB(dst, b, h) do { _Pragma("unroll") for (int n = 0; n < 2; ++n) _Pragma("unroll") for (int k = 0; k < 2; ++k) dst[n][k] = *(const PG8_LAS bf16x8*)(lds + PG8_SB(b, h) + boff + n * 2048 + k * 1024); } while (0)
#define PG8_MMA(ai, bj, At, Bt) do { __builtin_amdgcn_s_setprio(1); _Pragma("unroll") for (int m = 0; m < 4; ++m) _Pragma("unroll") for (int n = 0; n < 2; ++n) _Pragma("unroll") for (int k = 0; k < 2; ++k) \
        acc[ai][bj][m][n] = __builtin_amdgcn_mfma_f32_16x16x32_bf16(Bt[n][k], At[m][k], acc[ai][bj][m][n], 0, 0, 0); __builtin_amdgcn_s_setprio(0); } while (0)
#define PG8_WAIT_V(n) asm volatile("s_waitcnt vmcnt(" #n ")" ::: "memory")
#define PG8_WAIT_L(n) asm volatile("s_waitcnt lgkmcnt(" #n ")" ::: "memory")
#define PG8_BAR __builtin_amdgcn_s_barrier()
#define PG8_SCHED __builtin_amdgcn_sched_barrier(0)
    Unit cur, nxt; int ui = 0;
    if (!S.next(0, cur)) return;
    f32x4 acc[2][2][4][2];
#pragma unroll
    for (int a = 0; a < 2; ++a)
#pragma unroll
        for (int b = 0; b < 2; ++b)
#pragma unroll
            for (int m = 0; m < 4; ++m)
#pragma unroll
                for (int n = 0; n < 2; ++n) acc[a][b][m][n] = (f32x4){0.f, 0.f, 0.f, 0.f};
    bf16x8 At[4][2], B0[2][2], B1[2][2];
    const char* cA = (const char*)g.A + (size_t)cur.pm * tstepA + (size_t)cur.kt0 * kstep; const char* cB = (const char*)g.Bt + (size_t)cur.pn * tstepB + (size_t)cur.kt0 * kstep;
    S.a_ready(cur);
    if constexpr (SP2) {
        PG8_STAGE(PG8_SB(0, 0), cB, voffB); PG8_STAGE(PG8_SB(0, 1), cB + hstepB, voffB); PG8_STAGE(PG8_SA(0, 0), cA, voffA); PG8_STAGE(PG8_SA(0, 1), cA + hstepA, voffA);
        if (wr == 1) PG8_BAR;
        PG8_WAIT_V(2); PG8_BAR;
        PG8_STAGE(PG8_SB(1, 0), cB + kstep, voffB); PG8_STAGE(PG8_SA(1, 0), cA + kstep, voffA); PG8_STAGE(PG8_SB(1, 1), cB + hstepB + kstep, voffB);
        PG8_WAIT_V(6); PG8_BAR;
    } else {
        PG8_STAGE(PG8_SB(0, 0), cB, voffB); PG8_STAGE(PG8_SA(0, 0), cA, voffA); PG8_STAGE(PG8_SB(0, 1), cB + hstepB, voffB); PG8_STAGE(PG8_SA(0, 1), cA + hstepA, voffA);
        if (wr == 1) PG8_BAR;
        PG8_WAIT_V(4); PG8_BAR;
        PG8_STAGE(PG8_SB(1, 0), cB + kstep, voffB); PG8_STAGE(PG8_SA(1, 0), cA + kstep, voffA); PG8_STAGE(PG8_SB(1, 1), cB + hstepB + kstep, voffB);
        PG8_WAIT_V(6); PG8_BAR;
    }
    for (;;) {
        const bool has_next = S.next(ui + 1, nxt);
        const char* nA = has_next ? (const char*)g.A + (size_t)nxt.pm * tstepA + (size_t)nxt.kt0 * kstep : cA; const char* nB = has_next ? (const char*)g.Bt + (size_t)nxt.pn * tstepB + (size_t)nxt.kt0 * kstep : cB;
        const int nt = cur.nt;
        for (int t = 0; t < nt; t += 2) {
            const bool last = (t == nt - 2);
            const char* a1 = cA + (size_t)(t + 1) * kstep;
            const char* a2 = last ? nA : cA + (size_t)(t + 2) * kstep; const char* b2 = last ? nB : cB + (size_t)(t + 2) * kstep;
            const char* a3 = a2 + kstep; const char* b3 = b2 + kstep;
            if (last && has_next) S.a_ready(nxt);
            if constexpr (SP2) {
            PG8_LDB(B0, 0, 0); PG8_LDB(B1, 0, 1); PG8_SCHED; PG8_LDA(At, 0, 0); PG8_STAGE(PG8_SA(1, 1), a1 + hstepA, voffA);
            PG8_WAIT_V(8); PG8_WAIT_L(0); PG8_BAR; PG8_MMA(0, 0, At, B0); PG8_MMA(0, 1, At, B1); PG8_BAR; PG8_SCHED;
            PG8_LDA(At, 0, 1); PG8_STAGE(PG8_SB(0, 0), b2, voffB); PG8_STAGE(PG8_SB(0, 1), b2 + hstepB, voffB); PG8_STAGE(PG8_SA(0, 0), a2, voffA);
            PG8_WAIT_V(8); PG8_WAIT_L(0); PG8_BAR; PG8_MMA(1, 0, At, B0); PG8_MMA(1, 1, At, B1); PG8_BAR; PG8_SCHED;
            PG8_LDB(B0, 1, 0); PG8_LDB(B1, 1, 1); PG8_SCHED; PG8_LDA(At, 1, 0); PG8_STAGE(PG8_SA(0, 1), a2 + hstepA, voffA);
            PG8_WAIT_V(8); PG8_WAIT_L(0); PG8_BAR; PG8_MMA(0, 0, At, B0); PG8_MMA(0, 1, At, B1); PG8_BAR; PG8_SCHED;
            PG8_LDA(At, 1, 1); PG8_STAGE(PG8_SB(1, 0), b3, voffB); PG8_STAGE(PG8_SB(1, 1), b3 + hstepB, voffB); PG8_STAGE(PG8_SA(1, 0), a3, voffA);
            PG8_WAIT_V(8); PG8_WAIT_L(0); PG8_BAR; PG8_MMA(1, 0, At, B0); PG8_MMA(1, 1, At, B1); PG8_BAR; PG8_SCHED;
            } else {
            PG8_LDB(B0, 0, 0); PG8_SCHED; PG8_LDA(At, 0, 0); PG8_STAGE(PG8_SA(1, 1), a1 + hstepA, voffA);
            PG8_WAIT_L(8); PG8_BAR; PG8_WAIT_L(0); PG8_MMA(0, 0, At, B0); PG8_BAR; PG8_SCHED;
            PG8_LDB(B1, 0, 1); PG8_STAGE(PG8_SB(0, 0), b2, voffB);
            PG8_BAR; PG8_WAIT_L(0); PG8_MMA(0, 1, At, B1); PG8_BAR;
            PG8_LDA(At, 0, 1); PG8_STAGE(PG8_SA(0, 0), a2, voffA);
            PG8_BAR; PG8_WAIT_L(0); PG8_MMA(1, 0, At, B0); PG8_BAR; PG8_SCHED;
            PG8_STAGE(PG8_SB(0, 1), b2 + hstepB, voffB);
            PG8_WAIT_V(6); PG8_BAR; PG8_MMA(1, 1, At, B1); PG8_BAR;
            PG8_LDB(B0, 1, 0); PG8_SCHED; PG8_LDA(At, 1, 0); PG8_STAGE(PG8_SA(0, 1), a2 + hstepA, voffA);
            PG8_WAIT_L(8); PG8_BAR; PG8_WAIT_L(0); PG8_MMA(0, 0, At, B0); PG8_BAR; PG8_SCHED;
            PG8_LDB(B1, 1, 1); PG8_STAGE(PG8_SB(1, 0), b3, voffB);
            PG8_BAR; PG8_WAIT_L(0); PG8_MMA(0, 1, At, B1); PG8_BAR;
            PG8_LDA(At, 1, 1); PG8_STAGE(PG8_SA(1, 0), a3, voffA);
            PG8_BAR; PG8_WAIT_L(0); PG8_MMA(1, 0, At, B0); PG8_BAR; PG8_SCHED;
            PG8_STAGE(PG8_SB(1, 1), b3 + hstepB, voffB);
            PG8_WAIT_V(6); PG8_BAR; PG8_MMA(1, 1, At, B1); PG8_BAR;
            }
        }
        if constexpr (ALIGN_EPI) { if (wr == 0) PG8_BAR; }
        if constexpr (!Epi::AFTER_DRAIN) { E(acc, cur, wr, wc, fr, fq); S.done(cur); }
        if (!has_next) break;
#pragma unroll
        for (int a = 0; a < 2; ++a)
#pragma unroll
            for (int b = 0; b < 2; ++b)
#pragma unroll
                for (int m = 0; m < 4; ++m)
#pragma unroll
                    for (int n = 0; n < 2; ++n) acc[a][b][m][n] = (f32x4){0.f, 0.f, 0.f, 0.f};
        cur = nxt; cA = nA; cB = nB; ++ui;
        if constexpr (ALIGN_EPI) { if (wr == 1) PG8_BAR; }
    }
    PG8_WAIT_V(0);
    if constexpr (!ALIGN_EPI) { if (wr == 0) PG8_BAR; }
    PG8_BAR;
    if constexpr (Epi::AFTER_DRAIN) { E.fused(acc, cur, wr, wc, fr, fq, lds, wid, lane); S.done(cur); }
#undef PG8_SA
#undef PG8_SB
#undef PG8_STAGE
#undef PG8_LDA
#undef PG8_LDB
#undef PG8_MMA
#undef PG8_WAIT_V
#undef PG8_WAIT_L
#undef PG8_BAR
#undef PG8_SCHED
}
}
namespace att {
using bf16 = __hip_bfloat16;
constexpr int   D = 128, NW = 8, QBLK = 32, KVBLK = 64;
constexpr float SCALE = 0.088388347648318440f;
constexpr float THR = 8.f;
constexpr int SDEPTH = 2;
constexpr int LDQ = 1536, LDK = 1536, LDO = 1024;
constexpr size_t SHM_V = KVBLK * D * 2, SHM_K = KVBLK * D * 2, SHM_ATTN = 2 * SHM_V + 2 * SHM_K + NW * 64 * 4;
using bf16x8 = __attribute__((ext_vector_type(8))) short;
using s16x4  = __attribute__((ext_vector_type(4))) short;
using f32x16 = __attribute__((ext_vector_type(16))) float;
using f32x8  = __attribute__((ext_vector_type(8))) float;
using u32x4  = __attribute__((ext_vector_type(4))) unsigned;
#define KSWZ(row, colB) ((row) * 256 + ((colB) ^ (((row) & 7) << 4)))
#define SBAR() __builtin_amdgcn_sched_barrier(0)
__device__ __forceinline__ int crow(int r, int hi) { return (r & 3) + 8 * (r >> 2) + 4 * hi; }
__device__ __forceinline__ unsigned cvtpk(float lo, float hi) {
  unsigned r; asm volatile("v_cvt_pk_bf16_f32 %0, %1, %2" : "=v"(r) : "v"(lo), "v"(hi)); return r;
}
template <typename TIn> struct Stage;
template <> struct Stage<bf16>  { using T = bf16x8;
  __device__ static __forceinline__ T ld8(const bf16* p) { return *reinterpret_cast<const bf16x8*>(p); }
  __device__ static __forceinline__ bf16x8 tobf(T x) { return x; } };
template <> struct Stage<float> { using T = f32x8;
  __device__ static __forceinline__ T ld8(const float* p) { return *reinterpret_cast<const f32x8*>(p); }
  __device__ static __forceinline__ bf16x8 tobf(T x) {
    u32x4 w = {cvtpk(x[0], x[1]), cvtpk(x[2], x[3]), cvtpk(x[4], x[5]), cvtpk(x[6], x[7])}; return *reinterpret_cast<bf16x8*>(&w); } };

__device__ __forceinline__ void partialSM(f32x16& p0, f32x16& p1, float& m_reg, float& mn, float& alpha) {
  constexpr float C = SCALE * 1.4426950408889634f;
  float pmax = p0[0]; for (int r = 1; r < 16; ++r) pmax = fmaxf(pmax, p0[r]); for (int r = 0; r < 16; ++r) pmax = fmaxf(pmax, p1[r]);
  { auto rr = __builtin_amdgcn_permlane32_swap(__float_as_uint(pmax), __float_as_uint(pmax), false, false);
    pmax = fmaxf(__uint_as_float(rr[0]), __uint_as_float(rr[1])); }
  if (__builtin_expect(__all(pmax - m_reg <= THR / SCALE), 1)) { mn = m_reg; alpha = 1.f; }
  else { mn = fmaxf(m_reg, pmax); alpha = __builtin_amdgcn_exp2f((m_reg - mn) * C); m_reg = mn; }
  float mnC = -mn * C;
  for (int r = 0; r < 16; ++r) p0[r] = fmaf(p0[r], C, mnC); for (int r = 0; r < 16; ++r) p1[r] = fmaf(p1[r], C, mnC);
  for (int r = 0; r < 16; ++r) p0[r] = __builtin_amdgcn_exp2f(p0[r]);
}
__device__ __forceinline__ void finishSM(f32x16& p0, f32x16& p1, float alpha, float& l_reg, bf16x8& pa0, bf16x8& pa1, bf16x8& pa2, bf16x8& pa3) {
  for (int r = 0; r < 16; ++r) p1[r] = __builtin_amdgcn_exp2f(p1[r]);
  float ps = 0; for (int r = 0; r < 16; ++r) ps += p0[r]; for (int r = 0; r < 16; ++r) ps += p1[r];
  { auto rr = __builtin_amdgcn_permlane32_swap(__float_as_uint(ps), __float_as_uint(ps), false, false);
    ps = __uint_as_float(rr[0]) + __uint_as_float(rr[1]); }
  l_reg = l_reg * alpha + ps;
#define PK4(P, BASE, OUT) do { unsigned a0 = cvtpk(P[BASE + 0], P[BASE + 1]), a1 = cvtpk(P[BASE + 2], P[BASE + 3]);   \
    unsigned b0 = cvtpk(P[BASE + 4], P[BASE + 5]), b1 = cvtpk(P[BASE + 6], P[BASE + 7]);                              \
    auto r0 = __builtin_amdgcn_permlane32_swap(a0, b0, false, false); auto r1 = __builtin_amdgcn_permlane32_swap(a1, b1, false, false); \
    u32x4 w = {r0[0], r1[0], r0[1], r1[1]}; OUT = *reinterpret_cast<bf16x8*>(&w); } while (0)
  PK4(p0, 0, pa0); PK4(p0, 8, pa1); PK4(p1, 0, pa2); PK4(p1, 8, pa3);
#undef PK4
}
__device__ __forceinline__ void qkt(f32x16& p0, f32x16& p1, const bf16* Ks, const bf16x8* qr, int r32, int hi) {
  p0 = f32x16{}; p1 = f32x16{};
  for (int d0 = 0; d0 < 8; ++d0) { int cb = (d0 * 16 + hi * 8) * 2;
    bf16x8 b0 = *reinterpret_cast<const bf16x8*>((const char*)Ks + KSWZ(r32, cb));
    bf16x8 b1 = *reinterpret_cast<const bf16x8*>((const char*)Ks + KSWZ(32 + r32, cb));
    p0 = __builtin_amdgcn_mfma_f32_32x32x16_bf16(b0, qr[d0], p0, 0, 0, 0);
    p1 = __builtin_amdgcn_mfma_f32_32x32x16_bf16(b1, qr[d0], p1, 0, 0, 0); }
}
__device__ __forceinline__ int v_st(int k, int c) { const int kk = (k & ~0xC) | ((k & 4) << 1) | ((k & 8) >> 1); return ((kk >> 3) * 4 + (c >> 5)) * 512 + ((kk & 7) * 32 + (c & 31)) * 2; }
__device__ __forceinline__ int v_rd_base(int lane) { return ((lane & 3) << 3) | (((lane >> 2) & 3) << 6) | (((lane >> 4) & 1) << 5) | (((lane >> 5) & 1) << 8); }
constexpr int v_rd_off(int d0, int ks, int half) { return d0 * 512 + ks * 4096 + half * 2048; }
template <int OFF> __device__ __forceinline__ s16x4 tr_read(int vb) {
  s16x4 r; asm volatile("ds_read_b64_tr_b16 %0, %1 offset:%2" : "=&v"(r) : "v"(vb), "i"(OFF) : "memory"); return r;
}
template <int D0> __device__ __forceinline__ void pv_one(f32x16& od, int vb, bf16x8 pa0, bf16x8 pa1, bf16x8 pa2, bf16x8 pa3) {
  const s16x4 l0 = tr_read<v_rd_off(D0, 0, 0)>(vb), h0 = tr_read<v_rd_off(D0, 0, 1)>(vb), l1 = tr_read<v_rd_off(D0, 1, 0)>(vb), h1 = tr_read<v_rd_off(D0, 1, 1)>(vb);
  const s16x4 l2 = tr_read<v_rd_off(D0, 2, 0)>(vb), h2 = tr_read<v_rd_off(D0, 2, 1)>(vb), l3 = tr_read<v_rd_off(D0, 3, 0)>(vb), h3 = tr_read<v_rd_off(D0, 3, 1)>(vb);
  asm volatile("s_waitcnt lgkmcnt(0)" ::: "memory"); SBAR();
#define PK(L, H) (bf16x8){L[0], L[1], L[2], L[3], H[0], H[1], H[2], H[3]}
  od = __builtin_amdgcn_mfma_f32_32x32x16_bf16(pa0, PK(l0, h0), od, 0, 0, 0);
  od = __builtin_amdgcn_mfma_f32_32x32x16_bf16(pa1, PK(l1, h1), od, 0, 0, 0);
  od = __builtin_amdgcn_mfma_f32_32x32x16_bf16(pa2, PK(l2, h2), od, 0, 0, 0);
  od = __builtin_amdgcn_mfma_f32_32x32x16_bf16(pa3, PK(l3, h3), od, 0, 0, 0);
#undef PK
}
__device__ __forceinline__ void pv_d0(f32x16* o, int vb, bf16x8 pa0, bf16x8 pa1, bf16x8 pa2, bf16x8 pa3) {
  pv_one<0>(o[0], vb, pa0, pa1, pa2, pa3); pv_one<1>(o[1], vb, pa0, pa1, pa2, pa3); pv_one<2>(o[2], vb, pa0, pa1, pa2, pa3); pv_one<3>(o[3], vb, pa0, pa1, pa2, pa3);
}

template <typename TQ>
__device__ __forceinline__ void attn_dense_body(const TQ* __restrict__ Qb, const bf16* __restrict__ Kh, const bf16* __restrict__ Vh,
                                                bf16* __restrict__ Ob, int seq, char* lds) {
  using St = Stage<bf16>; using SQ = Stage<TQ>;
  const int tid = tid_l(), wid = tid >> 6, lane = tid & 63, r32 = lane & 31, hi = lane >> 5;
  bf16* V_lds = (bf16*)lds; bf16* K_lds = (bf16*)(lds + 2 * SHM_V);
  float* ws = (float*)(lds + 2 * SHM_V + 2 * SHM_K) + wid * 64; float* li_l = ws; float* al_l = ws + 32;
  float m_reg = -1e30f, l_reg = 0; f32x16 o[4] = {}; bf16x8 qr[8];
  const TQ* Qw = Qb + (long)(wid * QBLK + r32) * LDQ + hi * 8;
#pragma unroll
  for (int d0 = 0; d0 < 8; ++d0) qr[d0] = SQ::tobf(SQ::ld8(Qw + d0 * 16));
  const int sr = tid >> 4, sc = (tid & 15) * 8, vst0 = v_st(sr, sc), vst1 = v_st(32 + sr, sc);
  const int vb0 = (int)(uintptr_t)V_lds + v_rd_base(lane);
  struct { typename St::T vs0, vs1, ks0, ks1; } sr_[SDEPTH];
#define SLOAD(i, k0) do { sr_[i].vs0 = St::ld8(&Vh[(long)((k0) + sr) * LDK + sc]); sr_[i].vs1 = St::ld8(&Vh[(long)((k0) + 32 + sr) * LDK + sc]); \
    sr_[i].ks0 = St::ld8(&Kh[(long)((k0) + sr) * LDK + sc]); sr_[i].ks1 = St::ld8(&Kh[(long)((k0) + 32 + sr) * LDK + sc]); } while (0)
#define SWRITE(b, i) do { *(bf16x8*)((char*)V_lds + (b) * SHM_V + vst0) = St::tobf(sr_[i].vs0);          \
    *(bf16x8*)((char*)V_lds + (b) * SHM_V + vst1) = St::tobf(sr_[i].vs1); int kc = sc * 2;               \
    *(bf16x8*)((char*)K_lds + (b) * SHM_K + KSWZ(sr, kc)) = St::tobf(sr_[i].ks0);                       \
    *(bf16x8*)((char*)K_lds + (b) * SHM_K + KSWZ(32 + sr, kc)) = St::tobf(sr_[i].ks1); } while (0)
#define SWAIT() do { if constexpr (SDEPTH == 2) asm volatile("s_waitcnt vmcnt(4)" ::: "memory"); else asm volatile("s_waitcnt vmcnt(0)" ::: "memory"); } while (0)
#define RESC(a) do { if (__any((a) < 1.f)) { if (hi == 0) al_l[r32] = (a); asm volatile("s_waitcnt lgkmcnt(0)" ::: "memory"); \
    for (int d = 0; d < 4; ++d) for (int r = 0; r < 16; ++r) o[d][r] *= al_l[crow(r, hi)]; } } while (0)
  f32x16 pA0, pA1, pB0, pB1; float mnA, mnB, alA, alB; bf16x8 pa0, pa1, pa2, pa3; const int NT = seq / KVBLK;
  constexpr int SE = 0, SO = SDEPTH - 1;
  SLOAD(SE, 0); asm volatile("s_waitcnt vmcnt(0)" ::: "memory"); SWRITE(0, SE); __syncthreads();
  qkt(pA0, pA1, K_lds, qr, r32, hi); partialSM(pA0, pA1, m_reg, mnA, alA);
  SLOAD(SO, KVBLK); if constexpr (SDEPTH == 2) { if (2 < NT) SLOAD(SE, 2 * KVBLK); }
  SWAIT(); SWRITE(1, SO); __syncthreads();
  for (int j = 1; j + 1 < NT; j += 2) {
    SBAR(); qkt(pB0, pB1, (bf16*)((char*)K_lds + SHM_K), qr, r32, hi);
    finishSM(pA0, pA1, alA, l_reg, pa0, pa1, pa2, pa3); SBAR();
    SLOAD(SO, (j + SDEPTH) * KVBLK); SBAR();
    pv_d0(o, vb0, pa0, pa1, pa2, pa3); partialSM(pB0, pB1, m_reg, mnB, alB);
    __syncthreads(); SWAIT(); SWRITE(0, SE);
    RESC(alB); __syncthreads();
    SBAR(); qkt(pA0, pA1, K_lds, qr, r32, hi);
    finishSM(pB0, pB1, alB, l_reg, pa0, pa1, pa2, pa3); SBAR();
    if (SDEPTH == 1 || j + 3 < NT) SLOAD(SE, (j + 1 + SDEPTH) * KVBLK); SBAR();
    pv_d0(o, vb0 + (int)SHM_V, pa0, pa1, pa2, pa3); partialSM(pA0, pA1, m_reg, mnA, alA);
    __syncthreads(); SWAIT(); SWRITE(1, SO);
    RESC(alA); __syncthreads();
  }
  SBAR(); qkt(pB0, pB1, (bf16*)((char*)K_lds + SHM_K), qr, r32, hi);
  finishSM(pA0, pA1, alA, l_reg, pa0, pa1, pa2, pa3); SBAR();
  pv_d0(o, vb0, pa0, pa1, pa2, pa3); partialSM(pB0, pB1, m_reg, mnB, alB);
  __syncthreads(); RESC(alB);
  finishSM(pB0, pB1, alB, l_reg, pa0, pa1, pa2, pa3); SBAR();
  pv_d0(o, vb0 + (int)SHM_V, pa0, pa1, pa2, pa3);
  if (hi == 0) li_l[r32] = l_reg; asm volatile("s_waitcnt lgkmcnt(0)" ::: "memory");
  float rli[16];
#pragma unroll
  for (int r = 0; r < 16; ++r) rli[r] = __builtin_amdgcn_rcpf(li_l[crow(r, hi)]);
  bf16* Ow = Ob + (long)(wid * QBLK) * LDO;
#pragma unroll
  for (int r = 0; r < 16; ++r) { int orow = crow(r, hi);
    for (int d0 = 0; d0 < 4; ++d0) Ow[(long)orow * LDO + d0 * 32 + r32] = __float2bfloat16(o[d0][r] * rli[r]); }
#undef SLOAD
#undef SWRITE
#undef SWAIT
#undef RESC
}
}
#define LAS __attribute__((address_space(3)))
typedef unsigned short bf16_t;
typedef short bf16x8 __attribute__((ext_vector_type(8)));
typedef float f32x4 __attribute__((ext_vector_type(4)));
typedef float f32x16 __attribute__((ext_vector_type(16)));
typedef unsigned u32x4 __attribute__((ext_vector_type(4)));
typedef unsigned u32x2 __attribute__((ext_vector_type(2)));

constexpr int DM = 1024, NB = 8, SEQ = 4096, CTXL = 256, TPB = SEQ + CTXL, MT = NB * TPB, DFF = 2816, DEPTH = 4;
constexpr int NQKV = 1536, NGIN = 3328;
constexpr float EPS = 1e-6f;
constexpr int LDS_BYTES = 147456;
constexpr int NTHREADS = 512;

constexpr size_t MiB = 1u << 20;
constexpr size_t WS_MOD = 1 * MiB;
constexpr size_t WS_W1T = 3 * MiB;
constexpr size_t WS_W2T = WS_W1T + 88 * MiB;
constexpr size_t WS_WQKVT = WS_W2T + 44 * MiB;
constexpr size_t WS_WOAT = WS_WQKVT + 6 * MiB;
constexpr size_t WS_WGINT = WS_WOAT + 4 * MiB;
constexpr size_t WS_WGOT = WS_WGINT + 13 * MiB;
constexpr size_t WS_HRES = WS_WGOT + 4 * MiB;
constexpr size_t WS_U = WS_HRES + 136 * MiB;
constexpr size_t WS_Y = WS_U + 68 * MiB;
constexpr size_t WS_BIG = WS_Y + 68 * MiB;
constexpr size_t WS_ATTNO = WS_BIG + 102 * MiB;
constexpr size_t WS_END = WS_BIG + 221 * MiB;
constexpr size_t WS_PART_IN_OUT = 112 * MiB;
static_assert((size_t)MT * NGIN * 2 <= 221 * MiB && (size_t)MT * DFF * 2 <= 221 * MiB && (size_t)MT * NQKV * 2 <= 102 * MiB, "ws map");

struct Args { const float* in[20]; float* out; unsigned char* ws; };
typedef const __attribute__((address_space(4))) Args* KA;
__device__ __forceinline__ KA kargs() { KA p = (KA)__builtin_amdgcn_kernarg_segment_ptr(); asm volatile("" : "+s"(p)); return p; }
enum { I_X = 0, I_C, I_CTX, I_CCTX, I_ADAW, I_ADAB, I_NPRE, I_NPOST, I_FW1, I_FW2, I_AQKV, I_AQG, I_AKG, I_AWO, I_GWIN, I_GWA1, I_GWA2, I_GBA, I_GOG, I_GWO };

__device__ __forceinline__ unsigned cvtpk(float lo, float hi) { return pg8::cvt_pk_bf16(lo, hi); }
__device__ __forceinline__ float bf_lo(unsigned w) { return __uint_as_float(w << 16); }
__device__ __forceinline__ float bf_hi(unsigned w) { return __uint_as_float(w & 0xffff0000u); }
__device__ __forceinline__ float bf_f(bf16_t h) { return __uint_as_float(((unsigned)h) << 16); }
__device__ __forceinline__ bf16_t f_bf(float f) { return (bf16_t)(cvtpk(f, 0.f) & 0xffffu); }
__device__ __forceinline__ float wave_sum(float v) {
#pragma unroll
    for (int o = 1; o < 64; o <<= 1) v += __shfl_xor(v, o);
    return v;
}
__device__ __forceinline__ float silu(float x) { return x / (1.0f + __expf(-x)); }

__device__ __forceinline__ void phase_mod(KA a, LAS unsigned char* lds) {
    LAS float* sv = (LAS float*)lds;
    LAS float* red = (LAS float*)(lds + 9 * 1024 * 4);
    const int tid = tid_l(), lane = tid & 63, wave = tid >> 6;
    const float* c = a->in[I_C]; const float* cc = a->in[I_CCTX];
    for (int i = tid; i < 9 * 1024; i += NTHREADS) { const int v = i >> 10, k = i & 1023; const float x = v < 8 ? c[v * 1024 + k] : cc[k]; sv[i] = silu(x); }
    __syncthreads();
    float* mod = (float*)(a->ws + WS_MOD);
    for (int it = blk_l(); it < DEPTH * 144; it += grd_l()) {
        const int L = it / 144, cgp = it % 144;
        const float* w = a->in[I_ADAW] + (size_t)L * 1024 * 9216 + cgp * 64 + lane;
        float acc[9];
#pragma unroll
        for (int v = 0; v < 9; ++v) acc[v] = 0.f;
        const int k0 = wave * 128;
#pragma unroll 8
        for (int k = 0; k < 128; ++k) { const float wv = w[(size_t)(k0 + k) * 9216];
#pragma unroll
            for (int v = 0; v < 9; ++v) acc[v] += sv[v * 1024 + k0 + k] * wv; }
#pragma unroll
        for (int v = 0; v < 9; ++v) red[(wave * 9 + v) * 64 + lane] = acc[v];
        __syncthreads();
        for (int i = tid; i < 576; i += NTHREADS) { const int v = i >> 6, l = i & 63; float s = 0.f;
#pragma unroll
            for (int w8 = 0; w8 < 8; ++w8) s += red[(w8 * 9 + v) * 64 + l];
            s += a->in[I_ADAB][L * 9216 + cgp * 64 + l];
            mod[(size_t)(L * 9 + v) * 9216 + cgp * 64 + l] = s; }
        __syncthreads();
    }
}

__device__ __forceinline__ unsigned pk2(float lo, float hi) { return cvtpk(lo, hi); }
__device__ __forceinline__ void tr_item(const float* W, int Nsrc, int srccol_l  , int k0, bf16_t* dst  , int K, LAS float* scr, int lane) {
#pragma unroll 8
    for (int i = 0; i < 32; ++i) { const int kk = 2 * i + (lane >> 5); scr[kk * 33 + (lane & 31)] = W[(size_t)(k0 + kk) * Nsrc + srccol_l]; }
    asm volatile("s_waitcnt lgkmcnt(0)" ::: "memory");
    const int c = lane & 7;
#pragma unroll
    for (int j = 0; j < 4; ++j) { const int n = (lane >> 3) + 8 * j; const LAS float* s = scr + (8 * c) * 33 + n;
        u32x4 o; o.x = pk2(s[0 * 33], s[1 * 33]); o.y = pk2(s[2 * 33], s[3 * 33]); o.z = pk2(s[4 * 33], s[5 * 33]); o.w = pk2(s[6 * 33], s[7 * 33]);
        *(u32x4*)(dst + (size_t)n * K + 8 * c) = o; }
    asm volatile("s_waitcnt lgkmcnt(0)" ::: "memory");
}
__device__ __forceinline__ void convert_layer(KA a, LAS unsigned char* lds, int L, int bfirst) {
    const int tid = tid_l(), lane = tid & 63, wave = tid >> 6;
    LAS float* scr = (LAS float*)(lds + 65536 + wave * 8704);
    const int gw = (blk_l() - bfirst) * 8 + wave, NGW = (grd_l() - bfirst) * 8;
    constexpr int I_W1 = 176 * 16, I_W2 = 32 * 44, I_QKV = 48 * 16, I_SQ = 32 * 16, I_GIN = 96 * 16;
    const bool attn = (L & 1) == 0; const int mx = L >> 1;
    const int N1 = 2 * I_W1, N2 = 2 * I_W2, N3 = attn ? I_QKV : I_GIN, N4 = I_SQ;
    const int NITEMS = N1 + N2 + N3 + N4;
    for (int it = gw; it < NITEMS; it += NGW) {
        int r = it;
        if (r < N1) { const int mat = 2 * L + r / I_W1, q = r % I_W1, ng = q / 16, kb = q % 16; const int pn = ng >> 3, r0 = (ng & 7) * 32;
            const int src = r0 < 128 ? 128 * pn + r0 : DFF + 128 * pn + (r0 - 128);
            tr_item(a->in[I_FW1] + (size_t)mat * 1024 * 5632, 5632, src + (lane & 31), kb * 64, (bf16_t*)(a->ws + WS_W1T) + (size_t)mat * 5632 * 1024 + (size_t)(ng * 32) * 1024 + kb * 64, 1024, scr, lane); continue; }
        r -= N1;
        if (r < N2) { const int mat = 2 * L + r / I_W2, q = r % I_W2, ng = q / 44, kb = q % 44;
            tr_item(a->in[I_FW2] + (size_t)mat * 2816 * 1024, 1024, ng * 32 + (lane & 31), kb * 64, (bf16_t*)(a->ws + WS_W2T) + (size_t)mat * 1024 * 2816 + (size_t)(ng * 32) * 2816 + kb * 64, 2816, scr, lane); continue; }
        r -= N2;
        if (r < N3) {
            if (attn) { const int ng = r / 16, kb = r % 16;
                int qsrc = ng * 32 + (lane & 31);
                if (ng < 40) { const int l = lane & 31, wcc = ng & 3, xi = wcc * 16 + (l >> 3) * 4 + (l & 3), x = xi < 32 ? xi : xi + 32; qsrc = (ng >> 2) * 128 + x + 32 * ((l >> 2) & 1); }
                tr_item(a->in[I_AQKV] + (size_t)mx * 1024 * 1536, 1536, qsrc, kb * 64, (bf16_t*)(a->ws + WS_WQKVT) + (size_t)mx * 1536 * 1024 + (size_t)(ng * 32) * 1024 + kb * 64, 1024, scr, lane); }
            else { const int ng = r / 16, kb = r % 16;
                tr_item(a->in[I_GWIN] + (size_t)mx * 1024 * 3072, 3072, ng * 32 + (lane & 31), kb * 64, (bf16_t*)(a->ws + WS_WGINT) + (size_t)mx * NGIN * 1024 + (size_t)(ng * 32) * 1024 + kb * 64, 1024, scr, lane); }
            continue; }
        r -= N3;
        { const int ng = r / 16, kb = r % 16;
            if (attn) tr_item(a->in[I_AWO] + (size_t)mx * 1024 * 1024, 1024, ng * 32 + (lane & 31), kb * 64, (bf16_t*)(a->ws + WS_WOAT) + (size_t)mx * 1024 * 1024 + (size_t)(ng * 32) * 1024 + kb * 64, 1024, scr, lane);
            else tr_item(a->in[I_GWO] + (size_t)mx * 1024 * 1024, 1024, ng * 32 + (lane & 31), kb * 64, (bf16_t*)(a->ws + WS_WGOT) + (size_t)mx * 1024 * 1024 + (size_t)(ng * 32) * 1024 + kb * 64, 1024, scr, lane); }
    }
    if (!attn) {
        const int gt = (blk_l() - bfirst) * NTHREADS + tid, NGT = (grd_l() - bfirst) * NTHREADS;
        for (int i = gt; i < 256 * 128; i += NGT) {
            const int jj = i / 128, k8 = (i % 128) * 8;
            float v[8];
#pragma unroll
            for (int e = 0; e < 8; ++e) v[e] = jj < 32 ? a->in[I_GWA1][((size_t)(mx * 2 + (jj >> 4)) * 1024 + k8 + e) * 16 + (jj & 15)] : 0.f;
            u32x4 o; o.x = pk2(v[0], v[1]); o.y = pk2(v[2], v[3]); o.z = pk2(v[4], v[5]); o.w = pk2(v[6], v[7]);
            *(u32x4*)((bf16_t*)(a->ws + WS_WGINT) + (size_t)mx * NGIN * 1024 + (size_t)(3072 + jj) * 1024 + k8) = o;
        }
    }
}

struct RowP { int Lpost, jpost; float gs; int Lpre, jpre; bool final_out; };
template <bool FROM_INPUT>
__device__ __forceinline__ void row_pair(KA a, const RowP p, int ra, int rb, bool ona, bool onb, int lane) {
    bf16_t* hres = (bf16_t*)(a->ws + WS_HRES); const float* mod = (const float*)(a->ws + WS_MOD);
    const bf16_t* Y = (const bf16_t*)(a->ws + WS_Y); bf16_t* U = (bf16_t*)(a->ws + WS_U);
    const float* gpost = a->in[I_NPOST] + (size_t)(p.Lpost * 3 + (p.jpost < 0 ? 0 : p.jpost)) * DM; const float* gpre = a->in[I_NPRE] + (size_t)(p.Lpre * 3 + (p.jpre < 0 ? 0 : p.jpre)) * DM;
    int rr[2] = {ra, rb}, bb[2], pp[2]; bool cx[2], on[2] = {ona, onb};
#pragma unroll
    for (int k = 0; k < 2; ++k) { bb[k] = rr[k] / TPB; pp[k] = rr[k] - bb[k] * TPB; cx[k] = pp[k] < CTXL; }
    f32x4 h[2][4], y[2][4];
#pragma unroll
    for (int k = 0; k < 2; ++k) {
        if (FROM_INPUT) { const float* src = cx[k] ? a->in[I_CTX] + (size_t)(bb[k] * CTXL + pp[k]) * DM : a->in[I_X] + (size_t)(bb[k] * SEQ + pp[k] - CTXL) * DM;
#pragma unroll
            for (int q = 0; q < 4; ++q) h[k][q] = *(const f32x4*)(src + 4 * lane + 256 * q); }
        else {
#pragma unroll
            for (int q = 0; q < 4; ++q) { const u32x2 w = *(const u32x2*)(hres + (size_t)rr[k] * DM + 4 * lane + 256 * q); h[k][q] = (f32x4){bf_lo(w.x), bf_hi(w.x), bf_lo(w.y), bf_hi(w.y)}; } }
        if (p.jpost >= 0) {
#pragma unroll
            for (int q = 0; q < 4; ++q) { const u32x2 w = *(const u32x2*)(Y + (size_t)rr[k] * DM + 4 * lane + 256 * q);
                y[k][q] = (f32x4){bf_lo(w.x), bf_hi(w.x), bf_lo(w.y), bf_hi(w.y)}; } }
    }
#pragma unroll
    for (int k = 0; k < 2; ++k) {
        const int mi = cx[k] ? 8 : bb[k];
        if (p.jpost >= 0) {
            float ss = 0.f;
#pragma unroll
            for (int q = 0; q < 4; ++q) ss += (y[k][q].x * y[k][q].x + y[k][q].y * y[k][q].y) + (y[k][q].z * y[k][q].z + y[k][q].w * y[k][q].w);
            const float rstd = 1.0f / sqrtf(wave_sum(ss) * (1.0f / DM) + EPS);
            const float* gate = mod + (size_t)(p.Lpost * 9 + mi) * 9216 + (3 * p.jpost + 2) * 1024;
#pragma unroll
            for (int q = 0; q < 4; ++q) { const f32x4 gt = *(const f32x4*)(gate + 4 * lane + 256 * q), gg = *(const f32x4*)(gpost + 4 * lane + 256 * q);
                h[k][q] += p.gs * gt * (y[k][q] * rstd * gg); }
        }
        if (on[k]) {
            if (p.final_out) { float* o = a->out + (size_t)(bb[k] * SEQ + pp[k] - CTXL) * DM;
#pragma unroll
                for (int q = 0; q < 4; ++q) *(f32x4*)(o + 4 * lane + 256 * q) = h[k][q]; }
            else {
#pragma unroll
                for (int q = 0; q < 4; ++q) { u32x2 w; w.x = cvtpk(h[k][q].x, h[k][q].y); w.y = cvtpk(h[k][q].z, h[k][q].w); *(u32x2*)(hres + (size_t)rr[k] * DM + 4 * lane + 256 * q) = w; } }
        }
        if (p.jpre >= 0) {
            float ss = 0.f;
#pragma unroll
            for (int q = 0; q < 4; ++q) ss += (h[k][q].x * h[k][q].x + h[k][q].y * h[k][q].y) + (h[k][q].z * h[k][q].z + h[k][q].w * h[k][q].w);
            const float rstd = 1.0f / sqrtf(wave_sum(ss) * (1.0f / DM) + EPS);
            const float* mb = mod + (size_t)(p.Lpre * 9 + mi) * 9216 + (3 * p.jpre) * 1024;
            if (on[k]) {
#pragma unroll
                for (int q = 0; q < 4; ++q) { const f32x4 sh = *(const f32x4*)(mb + 4 * lane + 256 * q), sc = *(const f32x4*)(mb + 1024 + 4 * lane + 256 * q), gg = *(const f32x4*)(gpre + 4 * lane + 256 * q);
                    const f32x4 u = h[k][q] * rstd * gg * (1.0f + sc) + sh;
                    u32x2 w; w.x = cvtpk(u.x, u.y); w.y = cvtpk(u.z, u.w); *(u32x2*)(U + (size_t)rr[k] * DM + 4 * lane + 256 * q) = w; } }
        }
    }
}
template <bool FROM_INPUT>
__device__ __forceinline__ void row_pass(KA a, const RowP p) {
    const int tid = tid_l(), lane = tid & 63, wave = tid >> 6;
    const int gw = blk_l() * 8 + wave, NGW = grd_l() * 8;
    for (int r0 = gw; r0 < MT; r0 += 2 * NGW) { const int r1 = r0 + NGW; const bool on1 = r1 < MT; row_pair<FROM_INPUT>(a, p, r0, on1 ? r1 : r0, true, on1, lane); }
}
__device__ __forceinline__ void row_pass_queue(KA a, const RowP p, unsigned* sig, unsigned need_lat, unsigned need_ctx, bool with_ctx, LAS unsigned char* lds) {
    const int tid = tid_l(), lane = tid & 63, wave = tid >> 6;
    volatile LAS unsigned* tk = (volatile LAS unsigned*)(lds + LDS_BYTES - 64 + 16);
    const unsigned nchunk = 512u + (with_ctx ? 32u : 0u);
    bool rdy_lat = false, rdy_ctx = false;
    for (;;) {
        if (tid == 0) tk[0] = __hip_atomic_fetch_add(sig + 128, 1u, __ATOMIC_RELAXED, __HIP_MEMORY_SCOPE_AGENT);
        __syncthreads();
        const unsigned t = tk[0];
        __syncthreads();
        if (t >= nchunk) break;
        const bool isc = t >= 512u;
        if (isc ? !rdy_ctx : !rdy_lat) {
            if (tid == 0) { unsigned* w = sig + (isc ? 64 : 0); const unsigned need = isc ? need_ctx : need_lat; unsigned sp = 0;
                while (__hip_atomic_load(w, __ATOMIC_RELAXED, __HIP_MEMORY_SCOPE_AGENT) < need) { __builtin_amdgcn_s_sleep(2); if (++sp > (1u << 22)) break; }
                __builtin_amdgcn_fence(__ATOMIC_ACQUIRE, "agent"); asm volatile("s_waitcnt vmcnt(0)" ::: "memory"); }
            __syncthreads();
            if (isc) rdy_ctx = true; else rdy_lat = true;
        }
        int rbase;
        if (!isc) { const int lr = (int)t * 64; rbase = (lr >> 12) * TPB + CTXL + (lr & 4095); }
        else { const int cr = ((int)t - 512) * 64; rbase = (cr >> 8) * TPB + (cr & 255); }
#pragma unroll 1
        for (int it = 0; it < 4; ++it) { const int r0 = rbase + wave * 8 + 2 * it; row_pair<false>(a, p, r0, r0 + 1, true, true, lane); }
    }
}

__device__ __forceinline__ void phase_qknorm_rope(KA a, int m) {
    const int tid = tid_l(), lane = tid & 63, wave = tid >> 6;
    const int gw = blk_l() * 8 + wave, NGW = grd_l() * 8;
    bf16_t* QKV = (bf16_t*)(a->ws + WS_BIG);
    const int i = lane & 31, hl = lane >> 5, d1 = i + 64 * hl, d2 = d1 + 32;
    const float qg1 = a->in[I_AQG][m * 128 + d1], qg2 = a->in[I_AQG][m * 128 + d2], kg1 = a->in[I_AKG][m * 128 + d1], kg2 = a->in[I_AKG][m * 128 + d2];
    const float inv = exp2f(-(float)i * (13.287712379549449f / 32.0f));
    for (int r = gw; r < MT; r += NGW) {
        const int b = r / TPB, pos = r - b * TPB; const bool isctx = pos < CTXL;
        float cs = 1.f, sn = 0.f;
        if (!isctx) { const int t = pos - CTXL; const float p = (float)(hl ? (t & 63) : (t >> 6)); const float ang = p * inv; cs = cosf(ang); sn = sinf(ang); }
        bf16_t* row = QKV + (size_t)r * NQKV;
#pragma unroll
        for (int hd = 0; hd < 10; ++hd) {
            float x1 = bf_f(row[hd * 128 + d1]), x2 = bf_f(row[hd * 128 + d2]);
            const float rstd = 1.0f / sqrtf(wave_sum(x1 * x1 + x2 * x2) * (1.0f / 128.0f) + EPS);
            x1 *= rstd * (hd < 8 ? qg1 : kg1); x2 *= rstd * (hd < 8 ? qg2 : kg2);
            const float o1 = x1 * cs - x2 * sn, o2 = x2 * cs + x1 * sn;
            row[hd * 128 + d1] = f_bf(o1); row[hd * 128 + d2] = f_bf(o2);
        }
    }
}

__device__ __forceinline__ void phase_attention(KA a, char* lds) {
    const int G = grd_l(); const int bx = blk_l(); const int vcu = (G % 8 == 0) ? (bx % 8) * (G / 8) + bx / 8 : bx;
    const att::bf16* QKV = (const att::bf16*)(a->ws + WS_BIG); att::bf16* AO = (att::bf16*)(a->ws + WS_ATTNO);
    for (int u = vcu; u < 1024 + 64; u += G) {
        int b, h, q0, seq;
        if (u < 1024) { const int grp = u >> 6, within = u & 63; b = grp >> 1; h = (grp & 1) * 4 + (within >> 4); q0 = CTXL + (within & 15) * 256; seq = TPB; }
        else { const int cu = u - 1024; b = cu >> 3; h = cu & 7; q0 = 0; seq = CTXL; }
        const int kvh = h >> 2; const size_t rb = (size_t)b * TPB;
        att::attn_dense_body<att::bf16>(QKV + (rb + q0) * NQKV + h * 128, QKV + rb * NQKV + 1024 + kvh * 128, QKV + rb * NQKV + 1280 + kvh * 128, AO + (rb + q0) * DM + h * 128, seq, lds);
        __syncthreads();
    }
}

namespace gla {
__device__ __forceinline__ int crow(int r, int hi) { return (r & 3) + 8 * (r >> 2) + 4 * hi; }
constexpr int QD_OFF = 0, KI_OFF = 17408, KET_OFF = 34816, VT_OFF = 53248  , SC_OFF = 90112, TS_OFF = 99328  , GSUM_OFF = 107520;
constexpr int STT_OFF = 0  , VTS_OFF = 34816  ;
constexpr size_t KET_BYTES = (size_t)2 * NB * 4 * 68 * 8192 * 2;
constexpr size_t SC_GOFF = KET_BYTES + (size_t)2 * NB * 4 * 68 * 128 * 4;
}
__device__ __forceinline__ void phase_gla_prep(KA a, int m, LAS unsigned char* lds) {
    using namespace gla;
    const int tid = tid_l(), lane = tid & 63, wave = __builtin_amdgcn_readfirstlane(tid >> 6), r32 = lane & 31, hi = lane >> 5;
    bf16_t* Gb = (bf16_t*)(a->ws + WS_BIG);
    const int d = tid & 127, tg = tid >> 7;
    LAS float* ts = (LAS float*)(lds + TS_OFF); LAS float* gsum = (LAS float*)(lds + GSUM_OFF);
    for (int item = blk_l(); item < NB * 4 * 68; item += grd_l()) {
        const int k = item % 68, h = (item / 68) & 3, b = item / 272;
        const int row0 = b * TPB + 64 * k;
        bf16_t* gp = Gb + (size_t)row0 * NGIN;
        bf16_t qn[16], kn[16];
#pragma unroll
        for (int ii = 0; ii < 16; ++ii) { qn[ii] = gp[(size_t)(16 * tg + ii) * NGIN + h * 128 + d]; kn[ii] = gp[(size_t)(16 * tg + ii) * NGIN + 512 + h * 128 + d]; }
        const u32x2 tw = *(const u32x2*)(gp + (size_t)(tid >> 3) * NGIN + 3072 + 4 * (tid & 7));
        __syncthreads();
        { const int e0 = 4 * (tid & 7), dr = e0 >> 4, r = e0 & 15; LAS float* tp = ts + dr * 1024 + (tid >> 3) * 16 + r;
          tp[0] = bf_lo(tw.x); tp[1] = bf_hi(tw.x); tp[2] = bf_lo(tw.y); tp[3] = bf_hi(tw.y); }
        __syncthreads();
        for (int dir = 0; dir < 2; ++dir) {
            float w2[16];
#pragma unroll
            for (int r = 0; r < 16; ++r) w2[r] = a->in[I_GWA2][((size_t)(m * 2 + dir) * 16 + r) * 512 + h * 128 + d];
            const float bav = a->in[I_GBA][(size_t)(m * 2 + dir) * 512 + h * 128 + d];
            float cum[16];
#pragma unroll
            for (int ii = 0; ii < 16; ++ii) { float x = bav;
#pragma unroll
                for (int r = 0; r < 16; ++r) x += ts[dir * 1024 + (16 * tg + ii) * 16 + r] * w2[r];
                cum[ii] = (fminf(x, 0.f) - __logf(1.0f + __expf(-fabsf(x)))) * (1.0f / 16.0f); }
            if (dir == 0) {
#pragma unroll
                for (int ii = 1; ii < 16; ++ii) cum[ii] += cum[ii - 1];
                gsum[tg * 128 + d] = cum[15];
            } else {
#pragma unroll
                for (int ii = 14; ii >= 0; --ii) cum[ii] += cum[ii + 1];
                gsum[tg * 128 + d] = cum[0];
            }
            __syncthreads();
            const size_t cidx = (size_t)((dir * NB + b) * 4 + h) * 68 + k;
            { const float s0 = gsum[d], s1 = gsum[128 + d], s2 = gsum[256 + d], s3 = gsum[384 + d];
              const float total = (s0 + s1) + (s2 + s3);
              float off;
              if (dir == 0) off = (tg > 0 ? s0 : 0.f) + (tg > 1 ? s1 : 0.f) + (tg > 2 ? s2 : 0.f);
              else off = (tg < 3 ? s3 : 0.f) + (tg < 2 ? s2 : 0.f) + (tg < 1 ? s1 : 0.f);
              unsigned kep[8];
              bf16_t* qdst = gp + (dir ? 512 : 0) + h * 128 + d;
#pragma unroll
              for (int ii = 0; ii < 16; ii += 2) {
                  const float c0 = cum[ii] + off, c1 = cum[ii + 1] + off;
                  const float q0 = bf_f(qn[ii]), q1 = bf_f(qn[ii + 1]), k0 = bf_f(kn[ii]), k1 = bf_f(kn[ii + 1]);
                  const int i0 = 16 * tg + ii;
                  const bf16_t qd0 = f_bf(q0 * 0.08838834764831845f * __expf(c0)), qd1 = f_bf(q1 * 0.08838834764831845f * __expf(c1));
                  *(LAS bf16_t*)(lds + QD_OFF + (i0 * 136 + d) * 2) = qd0;
                  *(LAS bf16_t*)(lds + QD_OFF + ((i0 + 1) * 136 + d) * 2) = qd1;
                  qdst[(size_t)i0 * NGIN] = qd0; qdst[(size_t)(i0 + 1) * NGIN] = qd1;
                  *(LAS bf16_t*)(lds + KI_OFF + (i0 * 136 + d) * 2) = f_bf(k0 * __expf(-c0));
                  *(LAS bf16_t*)(lds + KI_OFF + ((i0 + 1) * 136 + d) * 2) = f_bf(k1 * __expf(-c1));
                  kep[ii >> 1] = cvtpk(k0 * __expf(total - c0), k1 * __expf(total - c1));
              }
              bf16_t* ketg = (bf16_t*)a->out + cidx * 8192 + d * 64 + 16 * tg;
              *(u32x4*)ketg = (u32x4){kep[0], kep[1], kep[2], kep[3]};
              *(u32x4*)(ketg + 8) = (u32x4){kep[4], kep[5], kep[6], kep[7]};
              if (tg == 0) ((float*)((unsigned char*)a->out + KET_BYTES))[cidx * 128 + d] = __expf(total);
            }
            __syncthreads();
            if (wave < 4) {
                const int ti = (wave >> 1) & 1, tj = wave & 1;
                f32x16 acc;
#pragma unroll
                for (int r = 0; r < 16; ++r) acc[r] = 0.f;
                const int aoff = QD_OFF + ((32 * ti + r32) * 136 + 8 * hi) * 2, boff = KI_OFF + ((32 * tj + r32) * 136 + 8 * hi) * 2;
#pragma unroll
                for (int ks = 0; ks < 8; ++ks) { const bf16x8 av = *(const LAS bf16x8*)(lds + aoff + ks * 32), bv = *(const LAS bf16x8*)(lds + boff + ks * 32);
                    acc = __builtin_amdgcn_mfma_f32_32x32x16_bf16(av, bv, acc, 0, 0, 0); }
                bf16_t* scg = (bf16_t*)((unsigned char*)a->out + SC_GOFF) + cidx * 4096;
#pragma unroll
                for (int r = 0; r < 16; ++r) { const int i = 32 * ti + crow(r, hi), j = 32 * tj + r32; const bool keep = dir == 0 ? (j <= i) : (j >= i);
                    scg[i * 64 + j] = f_bf(keep ? acc[r] : 0.f); }
            }
            __syncthreads();
        }
    }
}
__device__ __forceinline__ void phase_gla_scan(KA a, int m, LAS unsigned char* lds) {
    using namespace gla;
    const int tid = tid_l(), lane = tid & 63, wave = __builtin_amdgcn_readfirstlane(tid >> 6), r32 = lane & 31, hi = lane >> 5;
    const int G = grd_l(); const int bx = blk_l(); const int vcu = (G % 8 == 0) ? (bx % 8) * (G / 8) + bx / 8 : bx;
    const bf16_t* Gb = (const bf16_t*)(a->ws + WS_BIG);
    const int dv = tid & 63, tgv = tid >> 6;
    const int ti = (wave >> 1) & 1, tj = wave & 1, role = wave >> 2, sd = wave >> 1, sv = wave & 1;
    for (int item = vcu; item < 256; item += G) {
        const int vs = item & 3, dir = (item >> 2) & 1, h = (item >> 3) & 3, b = item >> 5;
        bf16_t* Oo = (bf16_t*)(a->ws + (dir == 0 ? WS_U : WS_Y));
        const size_t cbase = (size_t)((dir * NB + b) * 4 + h) * 68;
        const bf16_t* ketb = (const bf16_t*)a->out + cbase * 8192 + (32 * sd + r32) * 64 + 8 * hi;
        const bf16_t* scb = (const bf16_t*)((const unsigned char*)a->out + SC_GOFF) + cbase * 4096 + (32 * ti + r32) * 64 + 8 * hi;
        const float* decb = (const float*)((const unsigned char*)a->out + KET_BYTES) + cbase * 128 + 32 * sd + 4 * hi;
        const int qcol = (dir ? 512 : 0) + h * 128 + 8 * hi, vcol = 1024 + h * 256 + vs * 64 + dv, ocol = h * 256 + vs * 64 + 32 * tj + r32;
        __syncthreads();
        for (int i = tid; i < 17408 / 4; i += NTHREADS) ((LAS unsigned*)(lds + STT_OFF))[i] = 0u;
        f32x16 st;
#pragma unroll
        for (int r = 0; r < 16; ++r) st[r] = 0.f;
        bf16x8 qa[8], ke[4], sa[4]; f32x4 dcv[4]; bf16_t vn[8];
#define GLA_K(c) (dir == 0 ? (c) : ((c) < 4 ? 3 - (c) : 71 - (c)))
#define GLA_ROW(c) ((size_t)b * TPB + 64 * GLA_K(c))
#define LD_QA(c) do { if (role == 1) { const size_t row_ = GLA_ROW(c); _Pragma("unroll") for (int ks = 0; ks < 8; ++ks) qa[ks] = *(const bf16x8*)(Gb + (row_ + 32 * ti + r32) * NGIN + qcol + 16 * ks); } } while (0)
#define LD_OIN(c) do { if (role == 1) { const int kk_ = GLA_K(c); _Pragma("unroll") for (int ks = 0; ks < 4; ++ks) sa[ks] = *(const bf16x8*)(scb + (size_t)kk_ * 4096 + 16 * ks); } } while (0)
#define LD_KE(c) do { const int kk_ = GLA_K(c); _Pragma("unroll") for (int ks = 0; ks < 4; ++ks) ke[ks] = *(const bf16x8*)(ketb + (size_t)kk_ * 8192 + 16 * ks); } while (0)
#define LD_DC(c) do { const int kk_ = GLA_K(c); _Pragma("unroll") for (int r4 = 0; r4 < 4; ++r4) dcv[r4] = *(const f32x4*)(decb + (size_t)kk_ * 128 + 8 * r4); } while (0)
#define LD_VN(c) do { const size_t row_ = GLA_ROW(c); _Pragma("unroll") for (int ii = 0; ii < 8; ++ii) vn[ii] = Gb[(row_ + 8 * tgv + ii) * NGIN + vcol]; } while (0)
        LD_VN(0); LD_QA(0); LD_OIN(0); LD_DC(0); LD_KE(0);
        for (int c = 0; c < 68; ++c) {
            const int p_ = c & 1; const size_t rowc_ = GLA_ROW(c); const bool more = c + 1 < 68;
            { u32x4 vp; vp.x = (unsigned)vn[0] | ((unsigned)vn[1] << 16); vp.y = (unsigned)vn[2] | ((unsigned)vn[3] << 16); vp.z = (unsigned)vn[4] | ((unsigned)vn[5] << 16); vp.w = (unsigned)vn[6] | ((unsigned)vn[7] << 16);
              *(LAS u32x4*)(lds + VTS_OFF + p_ * 9216 + (dv * 72 + 8 * tgv) * 2) = vp; }
            if (more) LD_VN(c + 1);
            __syncthreads();
            if (role == 1) {
                f32x16 acc;
#pragma unroll
                for (int r = 0; r < 16; ++r) acc[r] = 0.f;
                const int boff = STT_OFF + p_ * 17408 + ((32 * tj + r32) * 136 + 8 * hi) * 2;
#pragma unroll
                for (int ks = 0; ks < 8; ++ks) { const bf16x8 bv = *(const LAS bf16x8*)(lds + boff + ks * 32);
                    acc = __builtin_amdgcn_mfma_f32_32x32x16_bf16(qa[ks], bv, acc, 0, 0, 0); }
                if (more) LD_QA(c + 1);
                { const int voff = VTS_OFF + p_ * 9216 + ((32 * tj + r32) * 72 + 8 * hi) * 2;
#pragma unroll
                  for (int ks = 0; ks < 4; ++ks) { const bf16x8 bv = *(const LAS bf16x8*)(lds + voff + ks * 32);
                      acc = __builtin_amdgcn_mfma_f32_32x32x16_bf16(sa[ks], bv, acc, 0, 0, 0); } }
                if (more) LD_OIN(c + 1);
                bf16_t* op = Oo + (rowc_ + 32 * ti) * DM + ocol;
#pragma unroll
                for (int r = 0; r < 16; ++r) op[(size_t)crow(r, hi) * DM] = f_bf(acc[r]);
            }
            {
#pragma unroll
              for (int r = 0; r < 16; ++r) st[r] *= dcv[r >> 2][r & 3];
              if (more) LD_DC(c + 1);
              const int boff = VTS_OFF + p_ * 9216 + ((32 * sv + r32) * 72 + 8 * hi) * 2;
#pragma unroll
              for (int ks = 0; ks < 4; ++ks) { const bf16x8 bv = *(const LAS bf16x8*)(lds + boff + ks * 32);
                  st = __builtin_amdgcn_mfma_f32_32x32x16_bf16(ke[ks], bv, st, 0, 0, 0); }
              if (more) LD_KE(c + 1);
#pragma unroll
              for (int r4 = 0; r4 < 4; ++r4) { u32x2 w; w.x = cvtpk(st[4 * r4], st[4 * r4 + 1]); w.y = cvtpk(st[4 * r4 + 2], st[4 * r4 + 3]);
                  *(LAS u32x2*)(lds + STT_OFF + (p_ ^ 1) * 17408 + ((32 * sv + r32) * 136 + 32 * sd + 8 * r4 + 4 * hi) * 2) = w; }
            }
        }
#undef GLA_ROW
#undef LD_QA
#undef LD_OIN
#undef LD_KE
#undef LD_DC
#undef LD_VN
#undef GLA_K
    }
}

__device__ __forceinline__ void phase_gla_readout(KA a, int m, bool skip_ctx) {
    const int tid = tid_l(), lane = tid & 63, wave = tid >> 6;
    const int gw = blk_l() * 8 + wave, NGW = grd_l() * 8;
    const bf16_t* OF = (const bf16_t*)(a->ws + WS_U); const bf16_t* OB = (const bf16_t*)(a->ws + WS_Y); bf16_t* Gb = (bf16_t*)(a->ws + WS_BIG);
    const float* og = a->in[I_GOG] + (size_t)m * 1024;
    for (int r = gw; r < MT; r += NGW) {
        if (skip_ctx && (r % TPB) < CTXL) continue;
#pragma unroll
        for (int q = 0; q < 4; ++q) {
            const int col = 4 * lane + 256 * q;
            const u32x2 wf = *(const u32x2*)(OF + (size_t)r * DM + col), wb = *(const u32x2*)(OB + (size_t)r * DM + col), wr = *(const u32x2*)(Gb + (size_t)r * NGIN + 2048 + col);
            f32x4 s = (f32x4){bf_lo(wf.x) + bf_lo(wb.x), bf_hi(wf.x) + bf_hi(wb.x), bf_lo(wf.y) + bf_lo(wb.y), bf_hi(wf.y) + bf_hi(wb.y)};
            const float ss = wave_sum((s.x * s.x + s.y * s.y) + (s.z * s.z + s.w * s.w));
            const float rstd = 1.0f / sqrtf(ss * (1.0f / 256.0f) + EPS);
            const f32x4 gg = *(const f32x4*)(og + col);
            const f32x4 rr = (f32x4){bf_lo(wr.x), bf_hi(wr.x), bf_lo(wr.y), bf_hi(wr.y)};
            f32x4 o = s * rstd * gg; o.x *= silu(rr.x); o.y *= silu(rr.y); o.z *= silu(rr.z); o.w *= silu(rr.w);
            u32x2 w; w.x = cvtpk(o.x, o.y); w.y = cvtpk(o.z, o.w);
            *(u32x2*)(Gb + (size_t)r * NGIN + 2048 + col) = w;
        }
    }
}

__device__ __forceinline__ unsigned long long rt() { return __builtin_amdgcn_s_memrealtime(); }
#define XB_TMO      128
#define XB_XCNT(j)  (256  + 64 * (j))
#define XB_XSUB(j)  (1280 + 64 * (j))
#define XB_XGEN(j)  (2304 + 64 * (j))
#define XB_TOP      3328
#define XB_TOPGEN   3392
#define XCD_BAR_WORDS 3456
#define XB_SPIN_CAP (1u << 18)

__device__ __forceinline__ unsigned xb_ld(unsigned* p)              { return __hip_atomic_load(p, __ATOMIC_RELAXED, __HIP_MEMORY_SCOPE_AGENT); }
__device__ __forceinline__ unsigned xb_add(unsigned* p, unsigned v) { return __hip_atomic_fetch_add(p, v, __ATOMIC_RELAXED, __HIP_MEMORY_SCOPE_AGENT); }
__device__ __forceinline__ unsigned xb_xcc_id() { return (unsigned)__builtin_amdgcn_s_getreg((3 << 11) | 20) & 0xFu; }
#define XB_SPIN(cond, bar) do { unsigned _sp = 0; while (cond) { __builtin_amdgcn_s_sleep(1); \
    if ((++_sp & 255u) == 0u) { if (xb_ld(&(bar)[XB_TMO])) break; if (_sp > XB_SPIN_CAP) { atomicAdd(&(bar)[XB_TMO], 1u); break; } } } } while (0)

struct XcdBarrier {
    unsigned* bar; unsigned x;
    volatile LAS unsigned* st;
};

__device__ __forceinline__ XcdBarrier xcd_barrier_post(unsigned* bar, volatile LAS unsigned* st) {
    XcdBarrier b; b.bar = bar; b.x = xb_xcc_id(); b.st = st;
    if (threadIdx.x == 0) (void)xb_add(&bar[XB_XCNT(b.x)], 1u);
    return b;
}
__device__ __forceinline__ void xcd_barrier_complete(unsigned* bar, unsigned x, unsigned& nloc, unsigned& nx) {
    const unsigned G = gridDim.x * gridDim.y * gridDim.z;
    unsigned sum, cnt, mine, sp = 0u;
    for (;;) {
        sum = 0u; cnt = 0u; mine = 0u;
#pragma unroll
        for (unsigned j = 0; j < 16; ++j) { const unsigned c = xb_ld(&bar[XB_XCNT(j)]); sum += c; cnt += (c > 0u) ? 1u : 0u; mine = (j == x) ? c : mine; }
        if (sum == G) break;
        __builtin_amdgcn_s_sleep(1);
        if ((++sp & 255u) == 0u) { if (xb_ld(&bar[XB_TMO])) break; if (sp > XB_SPIN_CAP) { atomicAdd(&bar[XB_TMO], 1u); break; } }
    }
    nloc = mine > 0u ? mine : 1u; nx = cnt > 0u ? cnt : 1u;
}

__device__ __forceinline__ void xcd_barrier(const XcdBarrier& b) {
    asm volatile("s_waitcnt vmcnt(0)" ::: "memory");
    __syncthreads();
    if (threadIdx.x == 0) {
        unsigned* bar = b.bar;
        __builtin_amdgcn_s_waitcnt(0);
        unsigned nloc = b.st[0], nx = b.st[1];
        if (nloc == 0u) { xcd_barrier_complete(bar, b.x, nloc, nx); b.st[0] = nloc; b.st[1] = nx; }
        const unsigned old = xb_add(&bar[XB_XSUB(b.x)], 1u);
        const unsigned gen = old / nloc;
        if (old + 1u == (gen + 1u) * nloc) {
            __builtin_amdgcn_fence(__ATOMIC_RELEASE, "agent");
            asm volatile("s_waitcnt vmcnt(0)" ::: "memory");
            const unsigned og = xb_add(&bar[XB_TOP], 1u);
            const unsigned tg = og / nx;
            if (og + 1u == (tg + 1u) * nx) xb_add(&bar[XB_TOPGEN], 1u);
            else XB_SPIN(xb_ld(&bar[XB_TOPGEN]) == tg, bar);
            __builtin_amdgcn_fence(__ATOMIC_ACQUIRE, "agent");
            xb_add(&bar[XB_XGEN(b.x)], 1u);
            asm volatile("s_waitcnt vmcnt(0)" ::: "memory");
        } else {
            XB_SPIN(xb_ld(&bar[XB_XGEN(b.x)]) == gen, bar);
            __builtin_amdgcn_fence(__ATOMIC_ACQUIRE, "agent");
            asm volatile("s_waitcnt vmcnt(0)" ::: "memory");
        }
    }
    __syncthreads();
}

constexpr size_t WS_BAR = 4096;
constexpr size_t WS_XCNT = 65536;
constexpr size_t WS_XBUF = WS_HRES + 68 * MiB;
constexpr size_t WS_DFLOW = 32768;
constexpr int LDS_BARW = LDS_BYTES - 64;
#define GSYNC() do { XcdBarrier b_; b_.bar = (unsigned*)(kargs()->ws + WS_BAR); b_.x = xb_xcc_id(); b_.st = (volatile LAS unsigned*)(lds + LDS_BARW); xcd_barrier(b_); } while (0)
struct EpiRow {
    static constexpr bool PERM = true, AFTER_DRAIN = false;
    int sl; LAS unsigned char* xl;
    __device__ __forceinline__ void operator()(f32x4 (&acc)[2][2][4][2], const pg8::Unit& u, int wr, int wc, int fr, int fq) const {
        KA a_ = kargs(); unsigned char* ws = a_->ws;
        const int L = sl / 3, jpost = sl - 3 * L; const bool lastsl = sl == 3 * DEPTH - 1;
        const int Ln = (jpost == 2) ? L + 1 : L, jn = (jpost == 2) ? 0 : jpost + 1, jpre = lastsl ? -1 : jn, final_out = lastsl ? 1 : 0;
        const float gs = jpost == 1 ? 1.0f : 0.5f;
        bf16_t* hres = (bf16_t*)(ws + WS_HRES); bf16_t* U = (bf16_t*)(ws + WS_U); float* out = a_->out;
        const float* modL_post = (const float*)(ws + WS_MOD) + (size_t)L * 9 * 9216; const float* modL_pre = (const float*)(ws + WS_MOD) + (size_t)(lastsl ? L : Ln) * 9 * 9216;
        const float* gpost = a_->in[I_NPOST] + (size_t)(L * 3 + jpost) * DM; const float* gpre = a_->in[I_NPRE] + (size_t)((lastsl ? L : Ln) * 3 + (lastsl ? 0 : jn)) * DM;
        unsigned* cn1 = (unsigned*)(ws + WS_XCNT) + (size_t)(sl * 2) * 136 * 64; unsigned* cn2 = cn1 + 136 * 64;
        float* xb1 = (float*)(ws + WS_XBUF); float* xb2 = (float*)(ws + WS_XBUF + MiB);
        const int tid = threadIdx.x, wid = __builtin_amdgcn_readfirstlane(tid >> 6), lane = tid & 63;
        const int bidx = u.pm / 17, isctx = (u.pm - 17 * bidx) == 0, mi = isctx ? 8 : bidx;
        const int col0 = u.pn * 256 + wc * 32 + 8 * fq, row0 = u.pm * 256 + wr * 64 + fr, rl0 = wr * 64 + fr;
        const LAS float* S = (const LAS float*)(xl + 4096);
        pg8::rowstats_run(xb1, cn1, acc, u, wr, wc, fr, fq, xl, wid, lane);
        {
            const float* gate = modL_post + (size_t)mi * 9216 + (3 * jpost + 2) * 1024 + col0;
            f32x4 gt[2][2], gp[2][2];
#pragma unroll
            for (int bj = 0; bj < 2; ++bj)
#pragma unroll
                for (int n = 0; n < 2; ++n) { gt[bj][n] = *(const f32x4*)(gate + bj * 128 + 4 * n) * gs; gp[bj][n] = *(const f32x4*)(gpost + col0 + bj * 128 + 4 * n); gt[bj][n] = gt[bj][n] * gp[bj][n]; }
#pragma unroll
            for (int ai = 0; ai < 2; ++ai)
#pragma unroll
                for (int m = 0; m < 4; ++m) {
                    const int rl = rl0 + ai * 128 + m * 16; const size_t roff = (size_t)(row0 + ai * 128 + m * 16) * 1024 + col0;
                    const float rstd = 1.0f / sqrtf(S[rl] * (1.0f / 1024.0f) + 1e-6f);
#pragma unroll
                    for (int bj = 0; bj < 2; ++bj) {
                        const u32x4 hw = *(const u32x4*)(hres + roff + bj * 128);
                        const f32x4 h0 = {__uint_as_float(hw.x << 16), __uint_as_float(hw.x & 0xffff0000u), __uint_as_float(hw.y << 16), __uint_as_float(hw.y & 0xffff0000u)};
                        const f32x4 h1 = {__uint_as_float(hw.z << 16), __uint_as_float(hw.z & 0xffff0000u), __uint_as_float(hw.w << 16), __uint_as_float(hw.w & 0xffff0000u)};
                        const f32x4 n0 = h0 + gt[bj][0] * (acc[ai][bj][m][0] * rstd), n1 = h1 + gt[bj][1] * (acc[ai][bj][m][1] * rstd);
                        acc[ai][bj][m][0] = n0; acc[ai][bj][m][1] = n1;
                        if (final_out) { float* op = out + (size_t)(bidx * 4096 + (u.pm - 17 * bidx - 1) * 256 + wr * 64 + fr + ai * 128 + m * 16) * 1024 + col0 + bj * 128; *(f32x4*)op = n0; *(f32x4*)(op + 4) = n1; }
                        else { u32x4 w; w.x = cvtpk(n0[0], n0[1]); w.y = cvtpk(n0[2], n0[3]); w.z = cvtpk(n1[0], n1[1]); w.w = cvtpk(n1[2], n1[3]); *(u32x4*)(hres + roff + bj * 128) = w; }
                    }
                }
        }
        if (jpre < 0) return;
        pg8::rowstats_run(xb2, cn2, acc, u, wr, wc, fr, fq, xl, wid, lane);
        {
            const float* mb = modL_pre + (size_t)mi * 9216 + (3 * jpre) * 1024 + col0;
            f32x4 sh[2][2], sc[2][2];
#pragma unroll
            for (int bj = 0; bj < 2; ++bj)
#pragma unroll
                for (int n = 0; n < 2; ++n) { sh[bj][n] = *(const f32x4*)(mb + bj * 128 + 4 * n); sc[bj][n] = (1.0f + *(const f32x4*)(mb + 1024 + bj * 128 + 4 * n)) * *(const f32x4*)(gpre + col0 + bj * 128 + 4 * n); }
#pragma unroll
            for (int ai = 0; ai < 2; ++ai)
#pragma unroll
                for (int m = 0; m < 4; ++m) {
                    const int rl = rl0 + ai * 128 + m * 16; const size_t roff = (size_t)(row0 + ai * 128 + m * 16) * 1024 + col0;
                    const float rstd = 1.0f / sqrtf(S[rl] * (1.0f / 1024.0f) + 1e-6f);
#pragma unroll
                    for (int bj = 0; bj < 2; ++bj) {
                        const f32x4 u0 = acc[ai][bj][m][0] * rstd * sc[bj][0] + sh[bj][0], u1 = acc[ai][bj][m][1] * rstd * sc[bj][1] + sh[bj][1];
                        u32x4 w; w.x = cvtpk(u0[0], u0[1]); w.y = cvtpk(u0[2], u0[3]); w.z = cvtpk(u1[0], u1[1]); w.w = cvtpk(u1[2], u1[3]);
                        *(u32x4*)(U + roff + bj * 128) = w;
                    }
                }
        }
    }
};

struct EpiQKV {
    static constexpr bool PERM = true, AFTER_DRAIN = false;
    int m; LAS unsigned char* xl;
    __device__ __forceinline__ void operator()(f32x4 (&acc)[2][2][4][2], const pg8::Unit& u, int wr, int wc, int fr, int fq) const {
        KA a_ = kargs(); bf16_t* O = (bf16_t*)(a_->ws + WS_BIG);
        const int row0 = u.pm * 256 + wr * 64 + fr, col0 = u.pn * 256 + wc * 32 + 8 * fq;
        if (u.pn < 5) {
            LAS float* P = (LAS float*)xl;
#pragma unroll
            for (int ai = 0; ai < 2; ++ai)
#pragma unroll
                for (int m4 = 0; m4 < 4; ++m4)
#pragma unroll
                    for (int bj = 0; bj < 2; ++bj) {
                        const f32x4 a0 = acc[ai][bj][m4][0], a1 = acc[ai][bj][m4][1];
                        float s = ((a0[0] * a0[0] + a0[1] * a0[1]) + (a0[2] * a0[2] + a0[3] * a0[3])) + ((a1[0] * a1[0] + a1[1] * a1[1]) + (a1[2] * a1[2] + a1[3] * a1[3]));
                        s += __shfl_xor(s, 16); s += __shfl_xor(s, 32);
                        if (fq == 0) P[((ai * 128 + wr * 64 + m4 * 16 + fr) * 2 + bj) * 4 + wc] = s;
                    }
            asm volatile("s_waitcnt lgkmcnt(0)" ::: "memory"); __builtin_amdgcn_s_barrier(); asm volatile("" ::: "memory");
            const float* gain = a_->in[u.pn < 4 ? I_AQG : I_AKG] + m * 128;
            const int xi0 = wc * 16 + fq * 4, x0 = xi0 < 32 ? xi0 : xi0 + 32;
            const f32x4 g0 = *(const f32x4*)(gain + x0), g1 = *(const f32x4*)(gain + x0 + 32);
            const int fi0 = (wc & 1) * 16 + fq * 4;
            f32x4 inv;
#pragma unroll
            for (int e = 0; e < 4; ++e) inv[e] = exp2f(-(float)(fi0 + e) * (13.287712379549449f / 32.0f)) * 0.15915494309189535f;
            const int bidx = u.pm / 17, ptile = u.pm - 17 * bidx; const bool isctx = ptile == 0;
#pragma unroll
            for (int ai = 0; ai < 2; ++ai)
#pragma unroll
                for (int m4 = 0; m4 < 4; ++m4) {
                    const int rl = ai * 128 + wr * 64 + m4 * 16 + fr;
                    f32x4 cs = {1.f, 1.f, 1.f, 1.f}, sn = {0.f, 0.f, 0.f, 0.f};
                    if (!isctx) { const int t = (ptile - 1) * 256 + rl; const float p = (float)(wc < 2 ? (t >> 6) : (t & 63));
#pragma unroll
                        for (int e = 0; e < 4; ++e) { const float rev = p * inv[e]; sn[e] = __builtin_amdgcn_sinf(rev); cs[e] = __builtin_amdgcn_cosf(rev); } }
#pragma unroll
                    for (int bj = 0; bj < 2; ++bj) {
                        const LAS float* pp = P + (rl * 2 + bj) * 4;
                        const float rstd = 1.0f / sqrtf(((pp[0] + pp[1]) + (pp[2] + pp[3])) * (1.0f / 128.0f) + EPS);
                        const f32x4 x1 = acc[ai][bj][m4][0] * rstd * g0, x2 = acc[ai][bj][m4][1] * rstd * g1;
                        const f32x4 o1 = x1 * cs - x2 * sn, o2 = x2 * cs + x1 * sn;
                        u32x4 w; w.x = cvtpk(o1[0], o1[1]); w.y = cvtpk(o1[2], o1[3]); w.z = cvtpk(o2[0], o2[1]); w.w = cvtpk(o2[2], o2[3]);
                        *(u32x4*)(O + (size_t)(row0 + ai * 128 + m4 * 16) * NQKV + col0 + bj * 128) = w;
                    }
                }
        } else {
#pragma unroll
            for (int ai = 0; ai < 2; ++ai)
#pragma unroll
                for (int m4 = 0; m4 < 4; ++m4)
#pragma unroll
                    for (int bj = 0; bj < 2; ++bj) { const f32x4 v0 = acc[ai][bj][m4][0], v1 = acc[ai][bj][m4][1];
                        u32x4 w; w.x = cvtpk(v0[0], v0[1]); w.y = cvtpk(v0[2], v0[3]); w.z = cvtpk(v1[0], v1[1]); w.w = cvtpk(v1[2], v1[3]);
                        *(u32x4*)(O + (size_t)(row0 + ai * 128 + m4 * 16) * NQKV + col0 + bj * 128) = w; }
        }
    }
};

__global__ void __launch_bounds__(NTHREADS, 2) fwd_megakernel(Args unused_args) {
    extern __shared__ __attribute__((aligned(16))) unsigned char lds_raw[];
    LAS unsigned char* lds = (LAS unsigned char*)lds_raw;
    cg::grid_group grid = cg::this_grid();
    if (threadIdx.x < 16) ((LAS unsigned*)(lds + LDS_BARW))[threadIdx.x] = 0u;
    __syncthreads();
    (void)xcd_barrier_post((unsigned*)(kargs()->ws + WS_BAR), (volatile LAS unsigned*)(lds + LDS_BARW));

#ifndef SKIP_MOD
    phase_mod(kargs(), lds);
#endif
    convert_layer(kargs(), lds, 0, 0);
    grid.sync();
    row_pass<true>(kargs(), RowP{0, -1, 0.f, 0, 0, false});
    GSYNC();

    for (int sl = 0; sl < 3 * DEPTH; ++sl) {
        const int L = sl / 3, j = sl - 3 * L, m = L >> 1;
        if (j != 1) {
            unsigned char* ws = kargs()->ws; const int f = j >> 1;
            pg8::Gemm g1{(const bf16_t*)(ws + WS_U), (const bf16_t*)(ws + WS_W1T) + (size_t)(L * 2 + f) * 5632 * 1024, MT, 2 * DFF, DM, DM, DM};
            pg8::StaticOrder S; S.init(MT, 2 * DFF, DM, grd_l(), blk_l(), sl == 3 * DEPTH - 1 ? 2 : 0);
            pg8::EpiSwiglu E{(bf16_t*)(ws + WS_BIG), DFF};
#ifndef SKIP_G1
            pg8::gemm_phase<pg8::EpiSwiglu, pg8::StaticOrder, true, true>(lds, g1, S, E);
#endif
            GSYNC();
        } else {
            const bool attn = (L & 1) == 0;
            { unsigned char* ws = kargs()->ws;
              pg8::Gemm g1{(const bf16_t*)(ws + WS_U), attn ? (const bf16_t*)(ws + WS_WQKVT) + (size_t)m * NQKV * 1024 : (const bf16_t*)(ws + WS_WGINT) + (size_t)m * NGIN * 1024, MT, attn ? NQKV : NGIN, DM, DM, DM};
              pg8::StaticOrder S; S.init(MT, g1.N, DM, grd_l(), blk_l(), 0);
              pg8::EpiBf16s E{(bf16_t*)(ws + WS_BIG), g1.N, nullptr};
              if (attn) { EpiQKV EQ{m, lds + 131072}; pg8::gemm_phase<EpiQKV, pg8::StaticOrder, true, true>(lds, g1, S, EQ); }
              else pg8::gemm_phase<pg8::EpiBf16s, pg8::StaticOrder, true, true>(lds, g1, S, E);
 }
            GSYNC();
            if (attn) {
#ifndef SKIP_ATT
                phase_attention(kargs(), (char*)lds_raw);
#endif
                GSYNC();
            } else {
                phase_gla_prep(kargs(), m, lds);
                GSYNC();
                phase_gla_scan(kargs(), m, lds);
                GSYNC();
#ifndef SKIP_RO
                phase_gla_readout(kargs(), m, sl >= 10);
#endif
                GSYNC();
            }
        }
        {
            unsigned char* ws = kargs()->ws;
            pg8::Gemm g2;
            if (j != 1) g2 = pg8::Gemm{(const bf16_t*)(ws + WS_BIG), (const bf16_t*)(ws + WS_W2T) + (size_t)(L * 2 + (j >> 1)) * 1024 * 2816, MT, DM, DFF, DFF, DFF};
            else if ((L & 1) == 0) g2 = pg8::Gemm{(const bf16_t*)(ws + WS_ATTNO), (const bf16_t*)(ws + WS_WOAT) + (size_t)m * 1024 * 1024, MT, DM, DM, DM, DM};
            else g2 = pg8::Gemm{(const bf16_t*)(ws + WS_BIG) + 2048, (const bf16_t*)(ws + WS_WGOT) + (size_t)m * 1024 * 1024, MT, DM, DM, NGIN, DM};
            pg8::StaticOrder S; S.init(MT, DM, g2.K, grd_l(), blk_l(), sl >= 10 ? 2 : 3);
            EpiRow E{sl, lds + 131072};
#ifndef SKIP_G2
            pg8::gemm_phase<EpiRow, pg8::StaticOrder, true, true>(lds, g2, S, E);
#endif
            if (j == 0 && L + 1 < DEPTH && blk_l() >= 32) convert_layer(kargs(), lds, L + 1, 32);
        }
        const bool last = sl == 3 * DEPTH - 1;
        if (!last) GSYNC();
    }
}

extern "C" void kernel_launch(void* const* d_in, const int* in_sizes, int n_in, void* d_out, int out_size, void* d_ws, size_t ws_size, hipStream_t stream) {
    static int grid = 0;
    if (grid == 0) {
        if (n_in != 20 || out_size != NB * SEQ * DM || ws_size < WS_END) { fprintf(stderr, "kernel_launch: unexpected shapes: n_in %d out %d ws %zu (need %zu)\n", n_in, out_size, ws_size, (size_t)WS_END); grid = -1; return; }
        int dev = 0, cus = 0, per_cu = 0;
        (void)hipGetDevice(&dev);
        (void)hipDeviceGetAttribute(&cus, hipDeviceAttributeMultiprocessorCount, dev);
        (void)hipFuncSetAttribute((const void*)fwd_megakernel, hipFuncAttributeMaxDynamicSharedMemorySize, LDS_BYTES);
        (void)hipOccupancyMaxActiveBlocksPerMultiprocessor(&per_cu, (const void*)fwd_megakernel, NTHREADS, LDS_BYTES);
        if (per_cu < 1) per_cu = 1;
        grid = cus * per_cu;
        if (grid > 256) grid = 256;
        if (grid < 256) { fprintf(stderr, "kernel_launch: %d co-resident workgroups < 256: this build needs 256; nothing launched\n", grid); grid = -1; return; }
        fprintf(stderr, "kernel_launch: grid %d (cus %d x %d), ws %zu\n", grid, cus, per_cu, ws_size);
    }
    if (grid < 0) return;
    (void)hipMemsetAsync(d_ws, 0, 1 * MiB, stream);
    Args a{};
    for (int i = 0; i < 20; ++i) a.in[i] = (const float*)d_in[i];
    a.out = (float*)d_out; a.ws = (unsigned char*)d_ws;
    void* args[] = {&a};
    hipError_t e = hipLaunchCooperativeKernel((const void*)fwd_megakernel, dim3(grid), dim3(NTHREADS), args, LDS_BYTES, stream);
    if (e != hipSuccess) fprintf(stderr, "kernel_launch: cooperative launch failed: %s (grid %d)\n", hipGetErrorString(e), grid);
}
```

```cpp
#include <hip/hip_runtime.h>
#include <hip/hip_cooperative_groups.h>
#include <hip/hip_bf16.h>
#include <cstdio>
#include <cstdint>
namespace cg = cooperative_groups;
__device__ __forceinline__ int tid_l() { int t = threadIdx.x; asm volatile("" : "+v"(t)); return t; }
__device__ __forceinline__ int blk_l() { int t = blockIdx.x; asm volatile("" : "+s"(t)); return t; }
__device__ __forceinline__ int grd_l() { int t = gridDim.x; asm volatile("" : "+s"(t)); return t; }
namespace pg8 {
#define PG8_LAS __attribute__((address_space(3)))
typedef unsigned short bf16_t;
typedef short bf16x8 __attribute__((ext_vector_type(8)));
typedef float f32x4 __attribute__((ext_vector_type(4)));
typedef unsigned u32x4 __attribute__((ext_vector_type(4)));
constexpr int BM = 256, BK = 64, HALF = 128, HTB = HALF * BK * 2  , STAGE_BYTES = 8 * HTB, NXCD = 8, WGM = 8;

__host__ __device__ __forceinline__ int lds_byte(int r, int c) { const int st = (r >> 4) * 2 + (c >> 5), rr = r & 15, cc = c & 31, ob = rr * 64 + cc * 2; return st * 1024 + (ob ^ (((ob >> 9) & 1) << 5)); }
__host__ __device__ __forceinline__ void stage_rc(int b, int& R, int& C) { const int st = b / 1024, sb = b % 1024, swz = sb ^ (((sb >> 9) & 1) << 5); R = (st >> 1) * 16 + swz / 64; C = (st & 1) * 32 + (swz % 64) / 2; }
__host__ __device__ __forceinline__ int perm32(int rho) { const int n = rho >> 4, i = rho & 15; return 8 * (i >> 2) + 4 * n + (i & 3); }

struct Unit { int pm, pn, kt0, nt, part, sig; };
struct Gemm { const bf16_t* A; const bf16_t* Bt; int M, N, K, lda, ldb; };

struct StaticOrder {
    int nM, nN, nwg, G, c, mode, ntfull; unsigned* sig;
    __host__ __device__ void init(int M, int N, int K, int G_, int c_, int mode_) { mode = mode_; nM = mode ? 128 : M / BM; nN = N / BM; nwg = nM * nN; G = G_; c = c_; ntfull = K / BK; sig = nullptr; }
    __host__ __device__ __forceinline__ bool next(int i, Unit& u) const {
        const long L = (long)i * G + c;
        int pm = 0, pn = 0, kt0 = 0, nt = ntfull, part = -1, sg = 0; bool ok = true;
        if (L >= nwg) {
            const int e = (int)(L - nwg);
            if (mode == 3) { ok = e < 8 * nN; pm = 17 * (e / nN); pn = e % nN; sg = 2; }
            else { ok = (mode == 1) && (e < 16 * nN); const int ct = e >> 1; pm = 17 * (ct / nN); pn = ct % nN; part = e & 1; nt = ntfull >> 1; kt0 = part * nt; }
        } else {
            int wgid = (int)L; { const int q = nwg / NXCD, r = nwg % NXCD, xcd = wgid % NXCD, off = wgid / NXCD; wgid = (xcd < r ? xcd * (q + 1) : r * (q + 1) + (xcd - r) * q) + off; }
            const int nig = WGM * nN, gid = wgid / nig, fm = gid * WGM, gsz = (nM - fm) < WGM ? (nM - fm) : WGM;
            pm = fm + ((wgid % nig) % gsz); pn = (wgid % nig) / gsz;
            if (mode) pm += (pm >> 4) + 1;
            sg = (mode >= 2 && L + G >= nwg) ? 1 : 0;
        }
        u.pm = pm; u.pn = pn; u.kt0 = kt0; u.nt = nt; u.part = part; u.sig = sg;
        return ok;
    }
    __device__ __forceinline__ void a_ready(const Unit&) const {}
    __device__ __forceinline__ void done(const Unit& u) const {
        if (sig != nullptr && u.sig != 0) {
            asm volatile("s_waitcnt vmcnt(0)" ::: "memory");
            __builtin_amdgcn_s_barrier(); asm volatile("" ::: "memory");
            if (threadIdx.x == 0) {
                __builtin_amdgcn_fence(__ATOMIC_RELEASE, "agent");
                asm volatile("s_waitcnt vmcnt(0)" ::: "memory");
                __hip_atomic_fetch_add(sig + (u.sig == 1 ? 0 : 64), 1u, __ATOMIC_RELAXED, __HIP_MEMORY_SCOPE_AGENT);
            }
        }
    }
};

typedef float f32x2c_t __attribute__((ext_vector_type(2))); typedef __bf16 bf16x2c_t __attribute__((ext_vector_type(2)));
__device__ __forceinline__ unsigned cvt_pk_bf16(float lo, float hi) { f32x2c_t v = {lo, hi}; bf16x2c_t b = __builtin_convertvector(v, bf16x2c_t); return __builtin_bit_cast(unsigned, b); }
typedef float f32x2 __attribute__((ext_vector_type(2)));
struct EpiBf16s {
    static constexpr bool PERM = true, AFTER_DRAIN = false;
    bf16_t* O; int ldc; float* P;
    __device__ __forceinline__ void operator()(const f32x4 (&acc)[2][2][4][2], const Unit& u, int wr, int wc, int fr, int fq) const {
        const int row0 = u.pm * BM + wr * 64 + fr; const int col0 = u.pn * BM + wc * 32 + 8 * fq;
        if (u.part >= 0) {
            float* pb = P + (size_t)u.part * 2048 * ldc + (size_t)((u.pm / 17) * BM + wr * 64 + fr) * ldc + col0;
#pragma unroll
            for (int ai = 0; ai < 2; ++ai)
#pragma unroll
                for (int m = 0; m < 4; ++m)
#pragma unroll
                    for (int bj = 0; bj < 2; ++bj) { float* rp = pb + (size_t)(ai * HALF + m * 16) * ldc + bj * HALF; *(f32x4*)rp = acc[ai][bj][m][0]; *(f32x4*)(rp + 4) = acc[ai][bj][m][1]; }
            return;
        }
#pragma unroll
        for (int ai = 0; ai < 2; ++ai)
#pragma unroll
            for (int m = 0; m < 4; ++m) { bf16_t* rowp = O + (size_t)(row0 + ai * HALF + m * 16) * ldc + col0;
#pragma unroll
                for (int bj = 0; bj < 2; ++bj) { const f32x4 v0 = acc[ai][bj][m][0], v1 = acc[ai][bj][m][1];
                    u32x4 w; w.x = cvt_pk_bf16(v0[0], v0[1]); w.y = cvt_pk_bf16(v0[2], v0[3]); w.z = cvt_pk_bf16(v1[0], v1[1]); w.w = cvt_pk_bf16(v1[2], v1[3]);
                    *(u32x4*)(rowp + bj * HALF) = w; } }
    }
};
__device__ __forceinline__ float silu_f(float g) { return g * __builtin_amdgcn_rcpf(1.0f + __expf(-g)); }
struct EpiSwiglu {
    static constexpr bool PERM = true, AFTER_DRAIN = false;
    bf16_t* H; int ldh;
    __device__ __forceinline__ void operator()(const f32x4 (&acc)[2][2][4][2], const Unit& u, int wr, int wc, int fr, int fq) const {
        const int row0 = u.pm * BM + wr * 64 + fr; const int col0 = u.pn * HALF + wc * 32 + 8 * fq;
#pragma unroll
        for (int ai = 0; ai < 2; ++ai)
#pragma unroll
            for (int m = 0; m < 4; ++m) { bf16_t* rowp = H + (size_t)(row0 + ai * HALF + m * 16) * ldh + col0;
                const f32x4 g0 = acc[ai][0][m][0], g1 = acc[ai][0][m][1], u0 = acc[ai][1][m][0], u1 = acc[ai][1][m][1];
                u32x4 w;
                w.x = cvt_pk_bf16(silu_f(g0[0]) * u0[0], silu_f(g0[1]) * u0[1]); w.y = cvt_pk_bf16(silu_f(g0[2]) * u0[2], silu_f(g0[3]) * u0[3]);
                w.z = cvt_pk_bf16(silu_f(g1[0]) * u1[0], silu_f(g1[1]) * u1[1]); w.w = cvt_pk_bf16(silu_f(g1[2]) * u1[2], silu_f(g1[3]) * u1[3]);
                *(u32x4*)rowp = w; }
    }
};
__device__ __forceinline__ void rowstats_run(float* xbuf  , unsigned* cnt  , const f32x4 (&v)[2][2][4][2], const Unit& u, int wr, int wc, int fr, int fq, PG8_LAS unsigned char* xl, int wid, int lane) {
        PG8_LAS float* P = (PG8_LAS float*)xl;
        PG8_LAS float* S = (PG8_LAS float*)(xl + 4096);
#pragma unroll
        for (int ai = 0; ai < 2; ++ai)
#pragma unroll
            for (int m = 0; m < 4; ++m) {
                float s = 0.f;
#pragma unroll
                for (int bj = 0; bj < 2; ++bj)
#pragma unroll
                    for (int n = 0; n < 2; ++n) { const f32x4 x = v[ai][bj][m][n]; s += (x[0] * x[0] + x[1] * x[1]) + (x[2] * x[2] + x[3] * x[3]); }
                s += __shfl_xor(s, 16); s += __shfl_xor(s, 32);
                if (fq == 0) P[(ai * HALF + wr * 64 + m * 16 + fr) * 4 + wc] = s;
            }
        asm volatile("s_waitcnt lgkmcnt(0)" ::: "memory"); __builtin_amdgcn_s_barrier(); asm volatile("" ::: "memory");
        const int row = wid * 32 + (lane & 31);
        if (lane < 32) {
            const float t = (P[row * 4 + 0] + P[row * 4 + 1]) + (P[row * 4 + 2] + P[row * 4 + 3]);
            __hip_atomic_store(xbuf + ((size_t)(u.pm * BM + row) * 4 + u.pn), t, __ATOMIC_RELAXED, __HIP_MEMORY_SCOPE_AGENT);
        }
        asm volatile("s_waitcnt vmcnt(0)" ::: "memory");
        if (lane == 0) __hip_atomic_fetch_add(cnt + 64 * u.pm, 1u, __ATOMIC_RELAXED, __HIP_MEMORY_SCOPE_AGENT);
        if (wid == 0) {
            unsigned sp = 0;
            while ((unsigned)__builtin_amdgcn_readfirstlane(__hip_atomic_load(cnt + 64 * u.pm, __ATOMIC_RELAXED, __HIP_MEMORY_SCOPE_AGENT)) < 32u) { __builtin_amdgcn_s_sleep(1); if (++sp > (1u << 22)) break; }
            __builtin_amdgcn_fence(__ATOMIC_ACQUIRE, "agent");
        }
        asm volatile("s_waitcnt vmcnt(0) lgkmcnt(0)" ::: "memory"); __builtin_amdgcn_s_barrier(); asm volatile("" ::: "memory");
        if (lane < 32) {
            const float* slot = xbuf + (size_t)(u.pm * BM + row) * 4; float t = 0.f;
#pragma unroll
            for (int k = 0; k < 4; ++k) t += __hip_atomic_load(slot + k, __ATOMIC_RELAXED, __HIP_MEMORY_SCOPE_AGENT);
            S[row] = t;
        }
        asm volatile("s_waitcnt vmcnt(0) lgkmcnt(0)" ::: "memory"); __builtin_amdgcn_s_barrier(); asm volatile("" ::: "memory");
    }

template <class Epi, class Sched, bool ALIGN_EPI = false, bool SP2 = false>
__device__ __forceinline__ void gemm_phase(PG8_LAS unsigned char* lds, const Gemm g, const Sched& S, const Epi& E) {
    const int tid = tid_l(), wid = __builtin_amdgcn_readfirstlane(tid >> 6), lane = tid & 63, wr = wid >> 2, wc = wid & 3, fr = lane & 15, fq = lane >> 4;
    unsigned voffA[2], voffB[2];
#pragma unroll
    for (int i = 0; i < 2; ++i) { int R, C; stage_rc(tid * 16 + i * 8192, R, C); const int Rb = Epi::PERM ? ((R & ~31) + perm32(R & 31)) : R;
        voffA[i] = (unsigned)(R * g.lda + C) * 2u; voffB[i] = (unsigned)(Rb * g.ldb + C) * 2u; }
    const size_t kstep = (size_t)(BK * 2);
    const size_t hstepB = (size_t)HALF * g.ldb * 2, hstepA = (size_t)HALF * g.lda * 2;
    const size_t tstepA = 2 * hstepA, tstepB = 2 * hstepB;
    const unsigned ldsw = (unsigned)wid * 1024u;
    const int aoff = lds_byte(wr * 64 + fr, fq * 8), boff = lds_byte(wc * 32 + fr, fq * 8);
#define PG8_SA(b, h) (((b) * 2 + (h)) * HTB)
#define PG8_SB(b, h) ((4 + (b) * 2 + (h)) * HTB)
#define PG8_STAGE(bufoff, gbase, voff) do { _Pragma("unroll") for (int _i = 0; _i < 2; ++_i) \
        __builtin_amdgcn_global_load_lds((const unsigned*)((const char*)(gbase) + (voff)[_i]), (PG8_LAS unsigned*)(lds + (bufoff) + ldsw + _i * 8192), 16, 0, 0); } while (0)
#define PG8_LDA(dst, b, h) do { _Pragma("unroll") for (int m = 0; m < 4; ++m) _Pragma("unroll") for (int k = 0; k < 2; ++k) dst[m][k] = *(const PG8_LAS bf16x8*)(lds + PG8_SA(b, h) + aoff + m * 2048 + k * 1024); } while (0)
#define PG8_LDB(dst, b, h) do { _Pragma("unroll") for (int n = 0; n < 2; ++n) _Pragma("unroll") for (int k = 0; k < 2; ++k) dst[n][k] = *(const PG8_LAS bf16x8*)(lds + PG8_SB(b, h) + boff + n * 2048 + k * 1024); } while (0)
#define PG8_MMA(ai, bj, At, Bt) do { __builtin_amdgcn_s_setprio(1); _Pragma("unroll") for (int m = 0; m < 4; ++m) _Pragma("unroll") for (int n = 0; n < 2; ++n) _Pragma("unroll") for (int k = 0; k < 2; ++k) \
        acc[ai][bj][m][n] = __builtin_amdgcn_mfma_f32_16x16x32_bf16(Bt[n][k], At[m][k], acc[ai][bj][m][n], 0, 0, 0); __builtin_amdgcn_s_setprio(0); } while (0)
#define PG8_WAIT_V(n) asm volatile("s_waitcnt vmcnt(" #n ")" ::: "memory")
#define PG8_WAIT_L(n) asm volatile("s_waitcnt lgkmcnt(" #n ")" ::: "memory")
#define PG8_BAR __builtin_amdgcn_s_barrier()
#define PG8_SCHED __builtin_amdgcn_sched_barrier(0)
    Unit cur, nxt; int ui = 0;
    if (!S.next(0, cur)) return;
    f32x4 acc[2][2][4][2];
#pragma unroll
    for (int a = 0; a < 2; ++a)
#pragma unroll
        for (int b = 0; b < 2; ++b)
#pragma unroll
            for (int m = 0; m < 4; ++m)
#pragma unroll
                for (int n = 0; n < 2; ++n) acc[a][b][m][n] = (f32x4){0.f, 0.f, 0.f, 0.f};
    bf16x8 At[4][2], B0[2][2], B1[2][2];
    const char* cA = (const char*)g.A + (size_t)cur.pm * tstepA + (size_t)cur.kt0 * kstep; const char* cB = (const char*)g.Bt + (size_t)cur.pn * tstepB + (size_t)cur.kt0 * kstep;
    S.a_ready(cur);
    if constexpr (SP2) {
        PG8_STAGE(PG8_SB(0, 0), cB, voffB); PG8_STAGE(PG8_SB(0, 1), cB + hstepB, voffB); PG8_STAGE(PG8_SA(0, 0), cA, voffA); PG8_STAGE(PG8_SA(0, 1), cA + hstepA, voffA);
        if (wr == 1) PG8_BAR;
        PG8_WAIT_V(2); PG8_BAR;
        PG8_STAGE(PG8_SB(1, 0), cB + kstep, voffB); PG8_STAGE(PG8_SA(1, 0), cA + kstep, voffA); PG8_STAGE(PG8_SB(1, 1), cB + hstepB + kstep, voffB);
        PG8_WAIT_V(6); PG8_BAR;
    } else {
        PG8_STAGE(PG8_SB(0, 0), cB, voffB); PG8_STAGE(PG8_SA(0, 0), cA, voffA); PG8_STAGE(PG8_SB(0, 1), cB + hstepB, voffB); PG8_STAGE(PG8_SA(0, 1), cA + hstepA, voffA);
        if (wr == 1) PG8_BAR;
        PG8_WAIT_V(4); PG8_BAR;
        PG8_STAGE(PG8_SB(1, 0), cB + kstep, voffB); PG8_STAGE(PG8_SA(1, 0), cA + kstep, voffA); PG8_STAGE(PG8_SB(1, 1), cB + hstepB + kstep, voffB);
        PG8_WAIT_V(6); PG8_BAR;
    }
    for (;;) {
        const bool has_next = S.next(ui + 1, nxt);
        const char* nA = has_next ? (const char*)g.A + (size_t)nxt.pm * tstepA + (size_t)nxt.kt0 * kstep : cA; const char* nB = has_next ? (const char*)g.Bt + (size_t)nxt.pn * tstepB + (size_t)nxt.kt0 * kstep : cB;
        const int nt = cur.nt;
        for (int t = 0; t < nt; t += 2) {
            const bool last = (t == nt - 2);
            const char* a1 = cA + (size_t)(t + 1) * kstep;
            const char* a2 = last ? nA : cA + (size_t)(t + 2) * kstep; const char* b2 = last ? nB : cB + (size_t)(t + 2) * kstep;
            const char* a3 = a2 + kstep; const char* b3 = b2 + kstep;
            if (last && has_next) S.a_ready(nxt);
            if constexpr (SP2) {
            PG8_LDB(B0, 0, 0); PG8_LDB(B1, 0, 1); PG8_SCHED; PG8_LDA(At, 0, 0); PG8_STAGE(PG8_SA(1, 1), a1 + hstepA, voffA);
            PG8_WAIT_V(8); PG8_WAIT_L(0); PG8_BAR; PG8_MMA(0, 0, At, B0); PG8_MMA(0, 1, At, B1); PG8_BAR; PG8_SCHED;
            PG8_LDA(At, 0, 1); PG8_STAGE(PG8_SB(0, 0), b2, voffB); PG8_STAGE(PG8_SB(0, 1), b2 + hstepB, voffB); PG8_STAGE(PG8_SA(0, 0), a2, voffA);
            PG8_WAIT_V(8); PG8_WAIT_L(0); PG8_BAR; PG8_MMA(1, 0, At, B0); PG8_MMA(1, 1, At, B1); PG8_BAR; PG8_SCHED;
            PG8_LDB(B0, 1, 0); PG8_LDB(B1, 1, 1); PG8_SCHED; PG8_LDA(At, 1, 0); PG8_STAGE(PG8_SA(0, 1), a2 + hstepA, voffA);
            PG8_WAIT_V(8); PG8_WAIT_L(0); PG8_BAR; PG8_MMA(0, 0, At, B0); PG8_MMA(0, 1, At, B1); PG8_BAR; PG8_SCHED;
            PG8_LDA(At, 1, 1); PG8_STAGE(PG8_SB(1, 0), b3, voffB); PG8_STAGE(PG8_SB(1, 1), b3 + hstepB, voffB); PG8_STAGE(PG8_SA(1, 0), a3, voffA);
            PG8_WAIT_V(8); PG8_WAIT_L(0); PG8_BAR; PG8_MMA(1, 0, At, B0); PG8_MMA(1, 1, At, B1); PG8_BAR; PG8_SCHED;
            } else {
            PG8_LDB(B0, 0, 0); PG8_SCHED; PG8_LDA(At, 0, 0); PG8_STAGE(PG8_SA(1, 1), a1 + hstepA, voffA);
            PG8_WAIT_L(8); PG8_BAR; PG8_WAIT_L(0); PG8_MMA(0, 0, At, B0); PG8_BAR; PG8_SCHED;
            PG8_LDB(B1, 0, 1); PG8_STAGE(PG8_SB(0, 0), b2, voffB);
            PG8_BAR; PG8_WAIT_L(0); PG8_MMA(0, 1, At, B1); PG8_BAR;
            PG8_LDA(At, 0, 1); PG8_STAGE(PG8_SA(0, 0), a2, voffA);
            PG8_BAR; PG8_WAIT_L(0); PG8_MMA(1, 0, At, B0); PG8_BAR; PG8_SCHED;
            PG8_STAGE(PG8_SB(0, 1), b2 + hstepB, voffB);
            PG8_WAIT_V(6); PG8_BAR; PG8_MMA(1, 1, At, B1); PG8_BAR;
            PG8_LDB(B0, 1, 0); PG8_SCHED; PG8_LDA(At, 1, 0); PG8_STAGE(PG8_SA(0, 1), a2 + hstepA, voffA);
            PG8_WAIT_L(8); PG8_BAR; PG8_WAIT_L(0); PG8_MMA(0, 0, At, B0); PG8_BAR; PG8_SCHED;
            PG8_LDB(B1, 1, 1); PG8_STAGE(PG8_SB(1, 0), b3, voffB);
            PG8_BAR; PG8_WAIT_L(0); PG8_MMA(0, 1, At, B1); PG8_BAR;
            PG8_LDA(At, 1, 1); PG8_STAGE(PG8_SA(1, 0), a3, voffA);
            PG8_BAR; PG8_WAIT_L(0); PG8_MMA(1, 0, At, B0); PG8_BAR; PG8_SCHED;
            PG8_STAGE(PG8_SB(1, 1), b3 + hstepB, voffB);
            PG8_WAIT_V(6); PG8_BAR; PG8_MMA(1, 1, At, B1); PG8_BAR;
            }
        }
        if constexpr (ALIGN_EPI) { if (wr == 0) PG8_BAR; }
        if constexpr (!Epi::AFTER_DRAIN) { E(acc, cur, wr, wc, fr, fq); S.done(cur); }
        if (!has_next) break;
#pragma unroll
        for (int a = 0; a < 2; ++a)
#pragma unroll
            for (int b = 0; b < 2; ++b)
#pragma unroll
                for (int m = 0; m < 4; ++m)
#pragma unroll
                    for (int n = 0; n < 2; ++n) acc[a][b][m][n] = (f32x4){0.f, 0.f, 0.f, 0.f};
        cur = nxt; cA = nA; cB = nB; ++ui;
        if constexpr (ALIGN_EPI) { if (wr == 1) PG8_BAR; }
    }
    PG8_WAIT_V(0);
    if constexpr (!ALIGN_EPI) { if (wr == 0) PG8_BAR; }
    PG8_BAR;
    if constexpr (Epi::AFTER_DRAIN) { E.fused(acc, cur, wr, wc, fr, fq, lds, wid, lane); S.done(cur); }
#undef PG8_SA
#undef PG8_SB
#undef PG8_STAGE
#undef PG8_LDA
#undef PG8_LDB
#undef PG8_MMA
#undef PG8_WAIT_V
#undef PG8_WAIT_L
#undef PG8_BAR
#undef PG8_SCHED
}
}
namespace att {
using bf16 = __hip_bfloat16;
constexpr int   D = 128, NW = 8, QBLK = 32, KVBLK = 64;
constexpr float SCALE = 0.088388347648318440f;
constexpr float THR = 8.f;
constexpr int SDEPTH = 2;
constexpr int LDQ = 1536, LDK = 1536, LDO = 1024;
constexpr size_t SHM_V = KVBLK * D * 2, SHM_K = KVBLK * D * 2, SHM_ATTN = 2 * SHM_V + 2 * SHM_K + NW * 64 * 4;
using bf16x8 = __attribute__((ext_vector_type(8))) short;
using s16x4  = __attribute__((ext_vector_type(4))) short;
using f32x16 = __attribute__((ext_vector_type(16))) float;
using f32x8  = __attribute__((ext_vector_type(8))) float;
using u32x4  = __attribute__((ext_vector_type(4))) unsigned;
#define KSWZ(row, colB) ((row) * 256 + ((colB) ^ (((row) & 7) << 4)))
#define SBAR() __builtin_amdgcn_sched_barrier(0)
__device__ __forceinline__ int crow(int r, int hi) { return (r & 3) + 8 * (r >> 2) + 4 * hi; }
__device__ __forceinline__ unsigned cvtpk(float lo, float hi) {
  unsigned r; asm volatile("v_cvt_pk_bf16_f32 %0, %1, %2" : "=v"(r) : "v"(lo), "v"(hi)); return r;
}
template <typename TIn> struct Stage;
template <> struct Stage<bf16>  { using T = bf16x8;
  __device__ static __forceinline__ T ld8(const bf16* p) { return *reinterpret_cast<const bf16x8*>(p); }
  __device__ static __forceinline__ bf16x8 tobf(T x) { return x; } };
template <> struct Stage<float> { using T = f32x8;
  __device__ static __forceinline__ T ld8(const float* p) { return *reinterpret_cast<const f32x8*>(p); }
  __device__ static __forceinline__ bf16x8 tobf(T x) {
    u32x4 w = {cvtpk(x[0], x[1]), cvtpk(x[2], x[3]), cvtpk(x[4], x[5]), cvtpk(x[6], x[7])}; return *reinterpret_cast<bf16x8*>(&w); } };

__device__ __forceinline__ void partialSM(f32x16& p0, f32x16& p1, float& m_reg, float& mn, float& alpha) {
  constexpr float C = SCALE * 1.4426950408889634f;
  float pmax = p0[0]; for (int r = 1; r < 16; ++r) pmax = fmaxf(pmax, p0[r]); for (int r = 0; r < 16; ++r) pmax = fmaxf(pmax, p1[r]);
  { auto rr = __builtin_amdgcn_permlane32_swap(__float_as_uint(pmax), __float_as_uint(pmax), false, false);
    pmax = fmaxf(__uint_as_float(rr[0]), __uint_as_float(rr[1])); }
  if (__builtin_expect(__all(pmax - m_reg <= THR / SCALE), 1)) { mn = m_reg; alpha = 1.f; }
  else { mn = fmaxf(m_reg, pmax); alpha = __builtin_amdgcn_exp2f((m_reg - mn) * C); m_reg = mn; }
  float mnC = -mn * C;
  for (int r = 0; r < 16; ++r) p0[r] = fmaf(p0[r], C, mnC); for (int r = 0; r < 16; ++r) p1[r] = fmaf(p1[r], C, mnC);
  for (int r = 0; r < 16; ++r) p0[r] = __builtin_amdgcn_exp2f(p0[r]);
}
__device__ __forceinline__ void finishSM(f32x16& p0, f32x16& p1, float alpha, float& l_reg, bf16x8& pa0, bf16x8& pa1, bf16x8& pa2, bf16x8& pa3) {
  for (int r = 0; r < 16; ++r) p1[r] = __builtin_amdgcn_exp2f(p1[r]);
  float ps = 0; for (int r = 0; r < 16; ++r) ps += p0[r]; for (int r = 0; r < 16; ++r) ps += p1[r];
  { auto rr = __builtin_amdgcn_permlane32_swap(__float_as_uint(ps), __float_as_uint(ps), false, false);
    ps = __uint_as_float(rr[0]) + __uint_as_float(rr[1]); }
  l_reg = l_reg * alpha + ps;
#define PK4(P, BASE, OUT) do { unsigned a0 = cvtpk(P[BASE + 0], P[BASE + 1]), a1 = cvtpk(P[BASE + 2], P[BASE + 3]);   \
    unsigned b0 = cvtpk(P[BASE + 4], P[BASE + 5]), b1 = cvtpk(P[BASE + 6], P[BASE + 7]);                              \
    auto r0 = __builtin_amdgcn_permlane32_swap(a0, b0, false, false); auto r1 = __builtin_amdgcn_permlane32_swap(a1, b1, false, false); \
    u32x4 w = {r0[0], r1[0], r0[1], r1[1]}; OUT = *reinterpret_cast<bf16x8*>(&w); } while (0)
  PK4(p0, 0, pa0); PK4(p0, 8, pa1); PK4(p1, 0, pa2); PK4(p1, 8, pa3);
#undef PK4
}
__device__ __forceinline__ void qkt(f32x16& p0, f32x16& p1, const bf16* Ks, const bf16x8* qr, int r32, int hi) {
  p0 = f32x16{}; p1 = f32x16{};
  for (int d0 = 0; d0 < 8; ++d0) { int cb = (d0 * 16 + hi * 8) * 2;
    bf16x8 b0 = *reinterpret_cast<const bf16x8*>((const char*)Ks + KSWZ(r32, cb));
    bf16x8 b1 = *reinterpret_cast<const bf16x8*>((const char*)Ks + KSWZ(32 + r32, cb));
    p0 = __builtin_amdgcn_mfma_f32_32x32x16_bf16(b0, qr[d0], p0, 0, 0, 0);
    p1 = __builtin_amdgcn_mfma_f32_32x32x16_bf16(b1, qr[d0], p1, 0, 0, 0); }
}
__device__ __forceinline__ int v_st(int k, int c) { const int kk = (k & ~0xC) | ((k & 4) << 1) | ((k & 8) >> 1); return ((kk >> 3) * 4 + (c >> 5)) * 512 + ((kk & 7) * 32 + (c & 31)) * 2; }
__device__ __forceinline__ int v_rd_base(int lane) { return ((lane & 3) << 3) | (((lane >> 2) & 3) << 6) | (((lane >> 4) & 1) << 5) | (((lane >> 5) & 1) << 8); }
constexpr int v_rd_off(int d0, int ks, int half) { return d0 * 512 + ks * 4096 + half * 2048; }
template <int OFF> __device__ __forceinline__ s16x4 tr_read(int vb) {
  s16x4 r; asm volatile("ds_read_b64_tr_b16 %0, %1 offset:%2" : "=&v"(r) : "v"(vb), "i"(OFF) : "memory"); return r;
}
template <int D0> __device__ __forceinline__ void pv_one(f32x16& od, int vb, bf16x8 pa0, bf16x8 pa1, bf16x8 pa2, bf16x8 pa3) {
  const s16x4 l0 = tr_read<v_rd_off(D0, 0, 0)>(vb), h0 = tr_read<v_rd_off(D0, 0, 1)>(vb), l1 = tr_read<v_rd_off(D0, 1, 0)>(vb), h1 = tr_read<v_rd_off(D0, 1, 1)>(vb);
  const s16x4 l2 = tr_read<v_rd_off(D0, 2, 0)>(vb), h2 = tr_read<v_rd_off(D0, 2, 1)>(vb), l3 = tr_read<v_rd_off(D0, 3, 0)>(vb), h3 = tr_read<v_rd_off(D0, 3, 1)>(vb);
  asm volatile("s_waitcnt lgkmcnt(0)" ::: "memory"); SBAR();
#define PK(L, H) (bf16x8){L[0], L[1], L[2], L[3], H[0], H[1], H[2], H[3]}
  od = __builtin_amdgcn_mfma_f32_32x32x16_bf16(pa0, PK(l0, h0), od, 0, 0, 0);
  od = __builtin_amdgcn_mfma_f32_32x32x16_bf16(pa1, PK(l1, h1), od, 0, 0, 0);
  od = __builtin_amdgcn_mfma_f32_32x32x16_bf16(pa2, PK(l2, h2), od, 0, 0, 0);
  od = __builtin_amdgcn_mfma_f32_32x32x16_bf16(pa3, PK(l3, h3), od, 0, 0, 0);
#undef PK
}
__device__ __forceinline__ void pv_d0(f32x16* o, int vb, bf16x8 pa0, bf16x8 pa1, bf16x8 pa2, bf16x8 pa3) {
  pv_one<0>(o[0], vb, pa0, pa1, pa2, pa3); pv_one<1>(o[1], vb, pa0, pa1, pa2, pa3); pv_one<2>(o[2], vb, pa0, pa1, pa2, pa3); pv_one<3>(o[3], vb, pa0, pa1, pa2, pa3);
}

template <typename TQ>
__device__ __forceinline__ void attn_dense_body(const TQ* __restrict__ Qb, const bf16* __restrict__ Kh, const bf16* __restrict__ Vh,
                                                bf16* __restrict__ Ob, int seq, char* lds) {
  using St = Stage<bf16>; using SQ = Stage<TQ>;
  const int tid = tid_l(), wid = tid >> 6, lane = tid & 63, r32 = lane & 31, hi = lane >> 5;
  bf16* V_lds = (bf16*)lds; bf16* K_lds = (bf16*)(lds + 2 * SHM_V);
  float* ws = (float*)(lds + 2 * SHM_V + 2 * SHM_K) + wid * 64; float* li_l = ws; float* al_l = ws + 32;
  float m_reg = -1e30f, l_reg = 0; f32x16 o[4] = {}; bf16x8 qr[8];
  const TQ* Qw = Qb + (long)(wid * QBLK + r32) * LDQ + hi * 8;
#pragma unroll
  for (int d0 = 0; d0 < 8; ++d0) qr[d0] = SQ::tobf(SQ::ld8(Qw + d0 * 16));
  const int sr = tid >> 4, sc = (tid & 15) * 8, vst0 = v_st(sr, sc), vst1 = v_st(32 + sr, sc);
  const int vb0 = (int)(uintptr_t)V_lds + v_rd_base(lane);
  struct { typename St::T vs0, vs1, ks0, ks1; } sr_[SDEPTH];
#define SLOAD(i, k0) do { sr_[i].vs0 = St::ld8(&Vh[(long)((k0) + sr) * LDK + sc]); sr_[i].vs1 = St::ld8(&Vh[(long)((k0) + 32 + sr) * LDK + sc]); \
    sr_[i].ks0 = St::ld8(&Kh[(long)((k0) + sr) * LDK + sc]); sr_[i].ks1 = St::ld8(&Kh[(long)((k0) + 32 + sr) * LDK + sc]); } while (0)
#define SWRITE(b, i) do { *(bf16x8*)((char*)V_lds + (b) * SHM_V + vst0) = St::tobf(sr_[i].vs0);          \
    *(bf16x8*)((char*)V_lds + (b) * SHM_V + vst1) = St::tobf(sr_[i].vs1); int kc = sc * 2;               \
    *(bf16x8*)((char*)K_lds + (b) * SHM_K + KSWZ(sr, kc)) = St::tobf(sr_[i].ks0);                       \
    *(bf16x8*)((char*)K_lds + (b) * SHM_K + KSWZ(32 + sr, kc)) = St::tobf(sr_[i].ks1); } while (0)
#define SWAIT() do { if constexpr (SDEPTH == 2) asm volatile("s_waitcnt vmcnt(4)" ::: "memory"); else asm volatile("s_waitcnt vmcnt(0)" ::: "memory"); } while (0)
#define RESC(a) do { if (__any((a) < 1.f)) { if (hi == 0) al_l[r32] = (a); asm volatile("s_waitcnt lgkmcnt(0)" ::: "memory"); \
    for (int d = 0; d < 4; ++d) for (int r = 0; r < 16; ++r) o[d][r] *= al_l[crow(r, hi)]; } } while (0)
  f32x16 pA0, pA1, pB0, pB1; float mnA, mnB, alA, alB; bf16x8 pa0, pa1, pa2, pa3; const int NT = seq / KVBLK;
  constexpr int SE = 0, SO = SDEPTH - 1;
  SLOAD(SE, 0); asm volatile("s_waitcnt vmcnt(0)" ::: "memory"); SWRITE(0, SE); __syncthreads();
  qkt(pA0, pA1, K_lds, qr, r32, hi); partialSM(pA0, pA1, m_reg, mnA, alA);
  SLOAD(SO, KVBLK); if constexpr (SDEPTH == 2) { if (2 < NT) SLOAD(SE, 2 * KVBLK); }
  SWAIT(); SWRITE(1, SO); __syncthreads();
  for (int j = 1; j + 1 < NT; j += 2) {
    SBAR(); qkt(pB0, pB1, (bf16*)((char*)K_lds + SHM_K), qr, r32, hi);
    finishSM(pA0, pA1, alA, l_reg, pa0, pa1, pa2, pa3); SBAR();
    SLOAD(SO, (j + SDEPTH) * KVBLK); SBAR();
    pv_d0(o, vb0, pa0, pa1, pa2, pa3); partialSM(pB0, pB1, m_reg, mnB, alB);
    __syncthreads(); SWAIT(); SWRITE(0, SE);
    RESC(alB); __syncthreads();
    SBAR(); qkt(pA0, pA1, K_lds, qr, r32, hi);
    finishSM(pB0, pB1, alB, l_reg, pa0, pa1, pa2, pa3); SBAR();
    if (SDEPTH == 1 || j + 3 < NT) SLOAD(SE, (j + 1 + SDEPTH) * KVBLK); SBAR();
    pv_d0(o, vb0 + (int)SHM_V, pa0, pa1, pa2, pa3); partialSM(pA0, pA1, m_reg, mnA, alA);
    __syncthreads(); SWAIT(); SWRITE(1, SO);
    RESC(alA); __syncthreads();
  }
  SBAR(); qkt(pB0, pB1, (bf16*)((char*)K_lds + SHM_K), qr, r32, hi);
  finishSM(pA0, pA1, alA, l_reg, pa0, pa1, pa2, pa3); SBAR();
  pv_d0(o, vb0, pa0, pa1, pa2, pa3); partialSM(pB0, pB1, m_reg, mnB, alB);
  __syncthreads(); RESC(alB);
  finishSM(pB0, pB1, alB, l_reg, pa0, pa1, pa2, pa3); SBAR();
  pv_d0(o, vb0 + (int)SHM_V, pa0, pa1, pa2, pa3);
  if (hi == 0) li_l[r32] = l_reg; asm volatile("s_waitcnt lgkmcnt(0)" ::: "memory");
  float rli[16];
#pragma unroll
  for (int r = 0; r < 16; ++r) rli[r] = __builtin_amdgcn_rcpf(li_l[crow(r, hi)]);
  bf16* Ow = Ob + (long)(wid * QBLK) * LDO;
#pragma unroll
  for (int r = 0; r < 16; ++r) { int orow = crow(r, hi);
    for (int d0 = 0; d0 < 4; ++d0) Ow[(long)orow * LDO + d0 * 32 + r32] = __float2bfloat16(o[d0][r] * rli[r]); }
#undef SLOAD
#undef SWRITE
#undef SWAIT
#undef RESC
}
}
#define LAS __attribute__((address_space(3)))
typedef unsigned short bf16_t;
typedef short bf16x8 __attribute__((ext_vector_type(8)));
typedef float f32x4 __attribute__((ext_vector_type(4)));
typedef float f32x16 __attribute__((ext_vector_type(16)));
typedef unsigned u32x4 __attribute__((ext_vector_type(4)));
typedef unsigned u32x2 __attribute__((ext_vector_type(2)));

constexpr int DM = 1024, NB = 8, SEQ = 4096, CTXL = 256, TPB = SEQ + CTXL, MT = NB * TPB, DFF = 2816, DEPTH = 4;
constexpr int NQKV = 1536, NGIN = 3328;
constexpr float EPS = 1e-6f;
constexpr int LDS_BYTES = 147456;
constexpr int NTHREADS = 512;

constexpr size_t MiB = 1u << 20;
constexpr size_t WS_MOD = 1 * MiB;
constexpr size_t WS_W1T = 3 * MiB;
constexpr size_t WS_W2T = WS_W1T + 88 * MiB;
constexpr size_t WS_WQKVT = WS_W2T + 44 * MiB;
constexpr size_t WS_WOAT = WS_WQKVT + 6 * MiB;
constexpr size_t WS_WGINT = WS_WOAT + 4 * MiB;
constexpr size_t WS_WGOT = WS_WGINT + 13 * MiB;
constexpr size_t WS_HRES = WS_WGOT + 4 * MiB;
constexpr size_t WS_U = WS_HRES + 136 * MiB;
constexpr size_t WS_Y = WS_U + 68 * MiB;
constexpr size_t WS_BIG = WS_Y + 68 * MiB;
constexpr size_t WS_ATTNO = WS_BIG + 102 * MiB;
constexpr size_t WS_END = WS_BIG + 221 * MiB;
constexpr size_t WS_PART_IN_OUT = 112 * MiB;
static_assert((size_t)MT * NGIN * 2 <= 221 * MiB && (size_t)MT * DFF * 2 <= 221 * MiB && (size_t)MT * NQKV * 2 <= 102 * MiB, "ws map");

struct Args { const float* in[20]; float* out; unsigned char* ws; };
typedef const __attribute__((address_space(4))) Args* KA;
__device__ __forceinline__ KA kargs() { KA p = (KA)__builtin_amdgcn_kernarg_segment_ptr(); asm volatile("" : "+s"(p)); return p; }
enum { I_X = 0, I_C, I_CTX, I_CCTX, I_ADAW, I_ADAB, I_NPRE, I_NPOST, I_FW1, I_FW2, I_AQKV, I_AQG, I_AKG, I_AWO, I_GWIN, I_GWA1, I_GWA2, I_GBA, I_GOG, I_GWO };

__device__ __forceinline__ unsigned cvtpk(float lo, float hi) { return pg8::cvt_pk_bf16(lo, hi); }
__device__ __forceinline__ float bf_lo(unsigned w) { return __uint_as_float(w << 16); }
__device__ __forceinline__ float bf_hi(unsigned w) { return __uint_as_float(w & 0xffff0000u); }
__device__ __forceinline__ float bf_f(bf16_t h) { return __uint_as_float(((unsigned)h) << 16); }
__device__ __forceinline__ bf16_t f_bf(float f) { return (bf16_t)(cvtpk(f, 0.f) & 0xffffu); }
__device__ __forceinline__ float wave_sum(float v) {
#pragma unroll
    for (int o = 1; o < 64; o <<= 1) v += __shfl_xor(v, o);
    return v;
}
__device__ __forceinline__ float silu(float x) { return x / (1.0f + __expf(-x)); }

__device__ __forceinline__ void phase_mod(KA a, LAS unsigned char* lds) {
    LAS float* sv = (LAS float*)lds;
    LAS float* red = (LAS float*)(lds + 9 * 1024 * 4);
    const int tid = tid_l(), lane = tid & 63, wave = tid >> 6;
    const float* c = a->in[I_C]; const float* cc = a->in[I_CCTX];
    for (int i = tid; i < 9 * 1024; i += NTHREADS) { const int v = i >> 10, k = i & 1023; const float x = v < 8 ? c[v * 1024 + k] : cc[k]; sv[i] = silu(x); }
    __syncthreads();
    float* mod = (float*)(a->ws + WS_MOD);
    for (int it = blk_l(); it < DEPTH * 144; it += grd_l()) {
        const int L = it / 144, cgp = it % 144;
        const float* w = a->in[I_ADAW] + (size_t)L * 1024 * 9216 + cgp * 64 + lane;
        float acc[9];
#pragma unroll
        for (int v = 0; v < 9; ++v) acc[v] = 0.f;
        const int k0 = wave * 128;
#pragma unroll 8
        for (int k = 0; k < 128; ++k) { const float wv = w[(size_t)(k0 + k) * 9216];
#pragma unroll
            for (int v = 0; v < 9; ++v) acc[v] += sv[v * 1024 + k0 + k] * wv; }
#pragma unroll
        for (int v = 0; v < 9; ++v) red[(wave * 9 + v) * 64 + lane] = acc[v];
        __syncthreads();
        for (int i = tid; i < 576; i += NTHREADS) { const int v = i >> 6, l = i & 63; float s = 0.f;
#pragma unroll
            for (int w8 = 0; w8 < 8; ++w8) s += red[(w8 * 9 + v) * 64 + l];
            s += a->in[I_ADAB][L * 9216 + cgp * 64 + l];
            mod[(size_t)(L * 9 + v) * 9216 + cgp * 64 + l] = s; }
        __syncthreads();
    }
}

__device__ __forceinline__ unsigned pk2(float lo, float hi) { return cvtpk(lo, hi); }
__device__ __forceinline__ void tr_item(const float* W, int Nsrc, int srccol_l  , int k0, bf16_t* dst  , int K, LAS float* scr, int lane) {
#pragma unroll 8
    for (int i = 0; i < 32; ++i) { const int kk = 2 * i + (lane >> 5); scr[kk * 33 + (lane & 31)] = W[(size_t)(k0 + kk) * Nsrc + srccol_l]; }
    asm volatile("s_waitcnt lgkmcnt(0)" ::: "memory");
    const int c = lane & 7;
#pragma unroll
    for (int j = 0; j < 4; ++j) { const int n = (lane >> 3) + 8 * j; const LAS float* s = scr + (8 * c) * 33 + n;
        u32x4 o; o.x = pk2(s[0 * 33], s[1 * 33]); o.y = pk2(s[2 * 33], s[3 * 33]); o.z = pk2(s[4 * 33], s[5 * 33]); o.w = pk2(s[6 * 33], s[7 * 33]);
        *(u32x4*)(dst + (size_t)n * K + 8 * c) = o; }
    asm volatile("s_waitcnt lgkmcnt(0)" ::: "memory");
}
__device__ __forceinline__ void convert_layer(KA a, LAS unsigned char* lds, int L, int bfirst) {
    const int tid = tid_l(), lane = tid & 63, wave = tid >> 6;
    LAS float* scr = (LAS float*)(lds + 65536 + wave * 8704);
    const int gw = (blk_l() - bfirst) * 8 + wave, NGW = (grd_l() - bfirst) * 8;
    constexpr int I_W1 = 176 * 16, I_W2 = 32 * 44, I_QKV = 48 * 16, I_SQ = 32 * 16, I_GIN = 96 * 16;
    const bool attn = (L & 1) == 0; const int mx = L >> 1;
    const int N1 = 2 * I_W1, N2 = 2 * I_W2, N3 = attn ? I_QKV : I_GIN, N4 = I_SQ;
    const int NITEMS = N1 + N2 + N3 + N4;
    for (int it = gw; it < NITEMS; it += NGW) {
        int r = it;
        if (r < N1) { const int mat = 2 * L + r / I_W1, q = r % I_W1, ng = q / 16, kb = q % 16; const int pn = ng >> 3, r0 = (ng & 7) * 32;
            const int src = r0 < 128 ? 128 * pn + r0 : DFF + 128 * pn + (r0 - 128);
            tr_item(a->in[I_FW1] + (size_t)mat * 1024 * 5632, 5632, src + (lane & 31), kb * 64, (bf16_t*)(a->ws + WS_W1T) + (size_t)mat * 5632 * 1024 + (size_t)(ng * 32) * 1024 + kb * 64, 1024, scr, lane); continue; }
        r -= N1;
        if (r < N2) { const int mat = 2 * L + r / I_W2, q = r % I_W2, ng = q / 44, kb = q % 44;
            tr_item(a->in[I_FW2] + (size_t)mat * 2816 * 1024, 1024, ng * 32 + (lane & 31), kb * 64, (bf16_t*)(a->ws + WS_W2T) + (size_t)mat * 1024 * 2816 + (size_t)(ng * 32) * 2816 + kb * 64, 2816, scr, lane); continue; }
        r -= N2;
        if (r < N3) {
            if (attn) { const int ng = r / 16, kb = r % 16;
                int qsrc = ng * 32 + (lane & 31);
                if (ng < 40) { const int l = lane & 31, wcc = ng & 3, xi = wcc * 16 + (l >> 3) * 4 + (l & 3), x = xi < 32 ? xi : xi + 32; qsrc = (ng >> 2) * 128 + x + 32 * ((l >> 2) & 1); }
                tr_item(a->in[I_AQKV] + (size_t)mx * 1024 * 1536, 1536, qsrc, kb * 64, (bf16_t*)(a->ws + WS_WQKVT) + (size_t)mx * 1536 * 1024 + (size_t)(ng * 32) * 1024 + kb * 64, 1024, scr, lane); }
            else { const int ng = r / 16, kb = r % 16;
                tr_item(a->in[I_GWIN] + (size_t)mx * 1024 * 3072, 3072, ng * 32 + (lane & 31), kb * 64, (bf16_t*)(a->ws + WS_WGINT) + (size_t)mx * NGIN * 1024 + (size_t)(ng * 32) * 1024 + kb * 64, 1024, scr, lane); }
            continue; }
        r -= N3;
        { const int ng = r / 16, kb = r % 16;
            if (attn) tr_item(a->in[I_AWO] + (size_t)mx * 1024 * 1024, 1024, ng * 32 + (lane & 31), kb * 64, (bf16_t*)(a->ws + WS_WOAT) + (size_t)mx * 1024 * 1024 + (size_t)(ng * 32) * 1024 + kb * 64, 1024, scr, lane);
            else tr_item(a->in[I_GWO] + (size_t)mx * 1024 * 1024, 1024, ng * 32 + (lane & 31), kb * 64, (bf16_t*)(a->ws + WS_WGOT) + (size_t)mx * 1024 * 1024 + (size_t)(ng * 32) * 1024 + kb * 64, 1024, scr, lane); }
    }
    if (!attn) {
        const int gt = (blk_l() - bfirst) * NTHREADS + tid, NGT = (grd_l() - bfirst) * NTHREADS;
        for (int i = gt; i < 256 * 128; i += NGT) {
            const int jj = i / 128, k8 = (i % 128) * 8;
            float v[8];
#pragma unroll
            for (int e = 0; e < 8; ++e) v[e] = jj < 32 ? a->in[I_GWA1][((size_t)(mx * 2 + (jj >> 4)) * 1024 + k8 + e) * 16 + (jj & 15)] : 0.f;
            u32x4 o; o.x = pk2(v[0], v[1]); o.y = pk2(v[2], v[3]); o.z = pk2(v[4], v[5]); o.w = pk2(v[6], v[7]);
            *(u32x4*)((bf16_t*)(a->ws + WS_WGINT) + (size_t)mx * NGIN * 1024 + (size_t)(3072 + jj) * 1024 + k8) = o;
        }
    }
}

struct RowP { int Lpost, jpost; float gs; int Lpre, jpre; bool final_out; };
template <bool FROM_INPUT>
__device__ __forceinline__ void row_pair(KA a, const RowP p, int ra, int rb, bool ona, bool onb, int lane) {
    bf16_t* hres = (bf16_t*)(a->ws + WS_HRES); const float* mod = (const float*)(a->ws + WS_MOD);
    const bf16_t* Y = (const bf16_t*)(a->ws + WS_Y); bf16_t* U = (bf16_t*)(a->ws + WS_U);
    const float* gpost = a->in[I_NPOST] + (size_t)(p.Lpost * 3 + (p.jpost < 0 ? 0 : p.jpost)) * DM; const float* gpre = a->in[I_NPRE] + (size_t)(p.Lpre * 3 + (p.jpre < 0 ? 0 : p.jpre)) * DM;
    int rr[2] = {ra, rb}, bb[2], pp[2]; bool cx[2], on[2] = {ona, onb};
#pragma unroll
    for (int k = 0; k < 2; ++k) { bb[k] = rr[k] / TPB; pp[k] = rr[k] - bb[k] * TPB; cx[k] = pp[k] < CTXL; }
    f32x4 h[2][4], y[2][4];
#pragma unroll
    for (int k = 0; k < 2; ++k) {
        if (FROM_INPUT) { const float* src = cx[k] ? a->in[I_CTX] + (size_t)(bb[k] * CTXL + pp[k]) * DM : a->in[I_X] + (size_t)(bb[k] * SEQ + pp[k] - CTXL) * DM;
#pragma unroll
            for (int q = 0; q < 4; ++q) h[k][q] = *(const f32x4*)(src + 4 * lane + 256 * q); }
        else {
#pragma unroll
            for (int q = 0; q < 4; ++q) { const u32x2 w = *(const u32x2*)(hres + (size_t)rr[k] * DM + 4 * lane + 256 * q); h[k][q] = (f32x4){bf_lo(w.x), bf_hi(w.x), bf_lo(w.y), bf_hi(w.y)}; } }
        if (p.jpost >= 0) {
#pragma unroll
            for (int q = 0; q < 4; ++q) { const u32x2 w = *(const u32x2*)(Y + (size_t)rr[k] * DM + 4 * lane + 256 * q);
                y[k][q] = (f32x4){bf_lo(w.x), bf_hi(w.x), bf_lo(w.y), bf_hi(w.y)}; } }
    }
#pragma unroll
    for (int k = 0; k < 2; ++k) {
        const int mi = cx[k] ? 8 : bb[k];
        if (p.jpost >= 0) {
            float ss = 0.f;
#pragma unroll
            for (int q = 0; q < 4; ++q) ss += (y[k][q].x * y[k][q].x + y[k][q].y * y[k][q].y) + (y[k][q].z * y[k][q].z + y[k][q].w * y[k][q].w);
            const float rstd = 1.0f / sqrtf(wave_sum(ss) * (1.0f / DM) + EPS);
            const float* gate = mod + (size_t)(p.Lpost * 9 + mi) * 9216 + (3 * p.jpost + 2) * 1024;
#pragma unroll
            for (int q = 0; q < 4; ++q) { const f32x4 gt = *(const f32x4*)(gate + 4 * lane + 256 * q), gg = *(const f32x4*)(gpost + 4 * lane + 256 * q);
                h[k][q] += p.gs * gt * (y[k][q] * rstd * gg); }
        }
        if (on[k]) {
            if (p.final_out) { float* o = a->out + (size_t)(bb[k] * SEQ + pp[k] - CTXL) * DM;
#pragma unroll
                for (int q = 0; q < 4; ++q) *(f32x4*)(o + 4 * lane + 256 * q) = h[k][q]; }
            else {
#pragma unroll
                for (int q = 0; q < 4; ++q) { u32x2 w; w.x = cvtpk(h[k][q].x, h[k][q].y); w.y = cvtpk(h[k][q].z, h[k][q].w); *(u32x2*)(hres + (size_t)rr[k] * DM + 4 * lane + 256 * q) = w; } }
        }
        if (p.jpre >= 0) {
            float ss = 0.f;
#pragma unroll
            for (int q = 0; q < 4; ++q) ss += (h[k][q].x * h[k][q].x + h[k][q].y * h[k][q].y) + (h[k][q].z * h[k][q].z + h[k][q].w * h[k][q].w);
            const float rstd = 1.0f / sqrtf(wave_sum(ss) * (1.0f / DM) + EPS);
            const float* mb = mod + (size_t)(p.Lpre * 9 + mi) * 9216 + (3 * p.jpre) * 1024;
            if (on[k]) {
#pragma unroll
                for (int q = 0; q < 4; ++q) { const f32x4 sh = *(const f32x4*)(mb + 4 * lane + 256 * q), sc = *(const f32x4*)(mb + 1024 + 4 * lane + 256 * q), gg = *(const f32x4*)(gpre + 4 * lane + 256 * q);
                    const f32x4 u = h[k][q] * rstd * gg * (1.0f + sc) + sh;
                    u32x2 w; w.x = cvtpk(u.x, u.y); w.y = cvtpk(u.z, u.w); *(u32x2*)(U + (size_t)rr[k] * DM + 4 * lane + 256 * q) = w; } }
        }
    }
}
template <bool FROM_INPUT>
__device__ __forceinline__ void row_pass(KA a, const RowP p) {
    const int tid = tid_l(), lane = tid & 63, wave = tid >> 6;
    const int gw = blk_l() * 8 + wave, NGW = grd_l() * 8;
    for (int r0 = gw; r0 < MT; r0 += 2 * NGW) { const int r1 = r0 + NGW; const bool on1 = r1 < MT; row_pair<FROM_INPUT>(a, p, r0, on1 ? r1 : r0, true, on1, lane); }
}
__device__ __forceinline__ void row_pass_queue(KA a, const RowP p, unsigned* sig, unsigned need_lat, unsigned need_ctx, bool with_ctx, LAS unsigned char* lds) {
    const int tid = tid_l(), lane = tid & 63, wave = tid >> 6;
    volatile LAS unsigned* tk = (volatile LAS unsigned*)(lds + LDS_BYTES - 64 + 16);
    const unsigned nchunk = 512u + (with_ctx ? 32u : 0u);
    bool rdy_lat = false, rdy_ctx = false;
    for (;;) {
        if (tid == 0) tk[0] = __hip_atomic_fetch_add(sig + 128, 1u, __ATOMIC_RELAXED, __HIP_MEMORY_SCOPE_AGENT);
        __syncthreads();
        const unsigned t = tk[0];
        __syncthreads();
        if (t >= nchunk) break;
        const bool isc = t >= 512u;
        if (isc ? !rdy_ctx : !rdy_lat) {
            if (tid == 0) { unsigned* w = sig + (isc ? 64 : 0); const unsigned need = isc ? need_ctx : need_lat; unsigned sp = 0;
                while (__hip_atomic_load(w, __ATOMIC_RELAXED, __HIP_MEMORY_SCOPE_AGENT) < need) { __builtin_amdgcn_s_sleep(2); if (++sp > (1u << 22)) break; }
                __builtin_amdgcn_fence(__ATOMIC_ACQUIRE, "agent"); asm volatile("s_waitcnt vmcnt(0)" ::: "memory"); }
            __syncthreads();
            if (isc) rdy_ctx = true; else rdy_lat = true;
        }
        int rbase;
        if (!isc) { const int lr = (int)t * 64; rbase = (lr >> 12) * TPB + CTXL + (lr & 4095); }
        else { const int cr = ((int)t - 512) * 64; rbase = (cr >> 8) * TPB + (cr & 255); }
#pragma unroll 1
        for (int it = 0; it < 4; ++it) { const int r0 = rbase + wave * 8 + 2 * it; row_pair<false>(a, p, r0, r0 + 1, true, true, lane); }
    }
}

__device__ __forceinline__ void phase_qknorm_rope(KA a, int m) {
    const int tid = tid_l(), lane = tid & 63, wave = tid >> 6;
    const int gw = blk_l() * 8 + wave, NGW = grd_l() * 8;
    bf16_t* QKV = (bf16_t*)(a->ws + WS_BIG);
    const int i = lane & 31, hl = lane >> 5, d1 = i + 64 * hl, d2 = d1 + 32;
    const float qg1 = a->in[I_AQG][m * 128 + d1], qg2 = a->in[I_AQG][m * 128 + d2], kg1 = a->in[I_AKG][m * 128 + d1], kg2 = a->in[I_AKG][m * 128 + d2];
    const float inv = exp2f(-(float)i * (13.287712379549449f / 32.0f));
    for (int r = gw; r < MT; r += NGW) {
        const int b = r / TPB, pos = r - b * TPB; const bool isctx = pos < CTXL;
        float cs = 1.f, sn = 0.f;
        if (!isctx) { const int t = pos - CTXL; const float p = (float)(hl ? (t & 63) : (t >> 6)); const float ang = p * inv; cs = cosf(ang); sn = sinf(ang); }
        bf16_t* row = QKV + (size_t)r * NQKV;
#pragma unroll
        for (int hd = 0; hd < 10; ++hd) {
            float x1 = bf_f(row[hd * 128 + d1]), x2 = bf_f(row[hd * 128 + d2]);
            const float rstd = 1.0f / sqrtf(wave_sum(x1 * x1 + x2 * x2) * (1.0f / 128.0f) + EPS);
            x1 *= rstd * (hd < 8 ? qg1 : kg1); x2 *= rstd * (hd < 8 ? qg2 : kg2);
            const float o1 = x1 * cs - x2 * sn, o2 = x2 * cs + x1 * sn;
            row[hd * 128 + d1] = f_bf(o1); row[hd * 128 + d2] = f_bf(o2);
        }
    }
}

__device__ __forceinline__ void phase_attention(KA a, char* lds) {
    const int G = grd_l(); const int bx = blk_l(); const int vcu = (G % 8 == 0) ? (bx % 8) * (G / 8) + bx / 8 : bx;
    const att::bf16* QKV = (const att::bf16*)(a->ws + WS_BIG); att::bf16* AO = (att::bf16*)(a->ws + WS_ATTNO);
    for (int u = vcu; u < 1024 + 64; u += G) {
        int b, h, q0, seq;
        if (u < 1024) { const int grp = u >> 6, within = u & 63; b = grp >> 1; h = (grp & 1) * 4 + (within >> 4); q0 = CTXL + (within & 15) * 256; seq = TPB; }
        else { const int cu = u - 1024; b = cu >> 3; h = cu & 7; q0 = 0; seq = CTXL; }
        const int kvh = h >> 2; const size_t rb = (size_t)b * TPB;
        att::attn_dense_body<att::bf16>(QKV + (rb + q0) * NQKV + h * 128, QKV + rb * NQKV + 1024 + kvh * 128, QKV + rb * NQKV + 1280 + kvh * 128, AO + (rb + q0) * DM + h * 128, seq, lds);
        __syncthreads();
    }
}

namespace gla {
__device__ __forceinline__ int crow(int r, int hi) { return (r & 3) + 8 * (r >> 2) + 4 * hi; }
constexpr int QD_OFF = 0, KI_OFF = 17408, KET_OFF = 34816, VT_OFF = 53248  , SC_OFF = 90112, TS_OFF = 99328  , GSUM_OFF = 107520;
constexpr int STT_OFF = 0  , VTS_OFF = 34816  ;
constexpr size_t KET_BYTES = (size_t)2 * NB * 4 * 68 * 8192 * 2;
constexpr size_t SC_GOFF = KET_BYTES + (size_t)2 * NB * 4 * 68 * 128 * 4;
}
__device__ __forceinline__ void phase_gla_prep(KA a, int m, LAS unsigned char* lds) {
    using namespace gla;
    const int tid = tid_l(), lane = tid & 63, wave = __builtin_amdgcn_readfirstlane(tid >> 6), r32 = lane & 31, hi = lane >> 5;
    bf16_t* Gb = (bf16_t*)(a->ws + WS_BIG);
    const int d = tid & 127, tg = tid >> 7;
    LAS float* ts = (LAS float*)(lds + TS_OFF); LAS float* gsum = (LAS float*)(lds + GSUM_OFF);
    for (int item = blk_l(); item < NB * 4 * 68; item += grd_l()) {
        const int k = item % 68, h = (item / 68) & 3, b = item / 272;
        const int row0 = b * TPB + 64 * k;
        bf16_t* gp = Gb + (size_t)row0 * NGIN;
        bf16_t qn[16], kn[16];
#pragma unroll
        for (int ii = 0; ii < 16; ++ii) { qn[ii] = gp[(size_t)(16 * tg + ii) * NGIN + h * 128 + d]; kn[ii] = gp[(size_t)(16 * tg + ii) * NGIN + 512 + h * 128 + d]; }
        const u32x2 tw = *(const u32x2*)(gp + (size_t)(tid >> 3) * NGIN + 3072 + 4 * (tid & 7));
        __syncthreads();
        { const int e0 = 4 * (tid & 7), dr = e0 >> 4, r = e0 & 15; LAS float* tp = ts + dr * 1024 + (tid >> 3) * 16 + r;
          tp[0] = bf_lo(tw.x); tp[1] = bf_hi(tw.x); tp[2] = bf_lo(tw.y); tp[3] = bf_hi(tw.y); }
        __syncthreads();
        for (int dir = 0; dir < 2; ++dir) {
            float w2[16];
#pragma unroll
            for (int r = 0; r < 16; ++r) w2[r] = a->in[I_GWA2][((size_t)(m * 2 + dir) * 16 + r) * 512 + h * 128 + d];
            const float bav = a->in[I_GBA][(size_t)(m * 2 + dir) * 512 + h * 128 + d];
            float cum[16];
#pragma unroll
            for (int ii = 0; ii < 16; ++ii) { float x = bav;
#pragma unroll
                for (int r = 0; r < 16; ++r) x += ts[dir * 1024 + (16 * tg + ii) * 16 + r] * w2[r];
                cum[ii] = (fminf(x, 0.f) - __logf(1.0f + __expf(-fabsf(x)))) * (1.0f / 16.0f); }
            if (dir == 0) {
#pragma unroll
                for (int ii = 1; ii < 16; ++ii) cum[ii] += cum[ii - 1];
                gsum[tg * 128 + d] = cum[15];
            } else {
#pragma unroll
                for (int ii = 14; ii >= 0; --ii) cum[ii] += cum[ii + 1];
                gsum[tg * 128 + d] = cum[0];
            }
            __syncthreads();
            const size_t cidx = (size_t)((dir * NB + b) * 4 + h) * 68 + k;
            { const float s0 = gsum[d], s1 = gsum[128 + d], s2 = gsum[256 + d], s3 = gsum[384 + d];
              const float total = (s0 + s1) + (s2 + s3);
              float off;
              if (dir == 0) off = (tg > 0 ? s0 : 0.f) + (tg > 1 ? s1 : 0.f) + (tg > 2 ? s2 : 0.f);
              else off = (tg < 3 ? s3 : 0.f) + (tg < 2 ? s2 : 0.f) + (tg < 1 ? s1 : 0.f);
              unsigned kep[8];
              bf16_t* qdst = gp + (dir ? 512 : 0) + h * 128 + d;
#pragma unroll
              for (int ii = 0; ii < 16; ii += 2) {
                  const float c0 = cum[ii] + off, c1 = cum[ii + 1] + off;
                  const float q0 = bf_f(qn[ii]), q1 = bf_f(qn[ii + 1]), k0 = bf_f(kn[ii]), k1 = bf_f(kn[ii + 1]);
                  const int i0 = 16 * tg + ii;
                  const bf16_t qd0 = f_bf(q0 * 0.08838834764831845f * __expf(c0)), qd1 = f_bf(q1 * 0.08838834764831845f * __expf(c1));
                  *(LAS bf16_t*)(lds + QD_OFF + (i0 * 136 + d) * 2) = qd0;
                  *(LAS bf16_t*)(lds + QD_OFF + ((i0 + 1) * 136 + d) * 2) = qd1;
                  qdst[(size_t)i0 * NGIN] = qd0; qdst[(size_t)(i0 + 1) * NGIN] = qd1;
                  *(LAS bf16_t*)(lds + KI_OFF + (i0 * 136 + d) * 2) = f_bf(k0 * __expf(-c0));
                  *(LAS bf16_t*)(lds + KI_OFF + ((i0 + 1) * 136 + d) * 2) = f_bf(k1 * __expf(-c1));
                  kep[ii >> 1] = cvtpk(k0 * __expf(total - c0), k1 * __expf(total - c1));
              }
              bf16_t* ketg = (bf16_t*)a->out + cidx * 8192 + d * 64 + 16 * tg;
              *(u32x4*)ketg = (u32x4){kep[0], kep[1], kep[2], kep[3]};
              *(u32x4*)(ketg + 8) = (u32x4){kep[4], kep[5], kep[6], kep[7]};
              if (tg == 0) ((float*)((unsigned char*)a->out + KET_BYTES))[cidx * 128 + d] = __expf(total);
            }
            __syncthreads();
            if (wave < 4) {
                const int ti = (wave >> 1) & 1, tj = wave & 1;
                f32x16 acc;
#pragma unroll
                for (int r = 0; r < 16; ++r) acc[r] = 0.f;
                const int aoff = QD_OFF + ((32 * ti + r32) * 136 + 8 * hi) * 2, boff = KI_OFF + ((32 * tj + r32) * 136 + 8 * hi) * 2;
#pragma unroll
                for (int ks = 0; ks < 8; ++ks) { const bf16x8 av = *(const LAS bf16x8*)(lds + aoff + ks * 32), bv = *(const LAS bf16x8*)(lds + boff + ks * 32);
                    acc = __builtin_amdgcn_mfma_f32_32x32x16_bf16(av, bv, acc, 0, 0, 0); }
                bf16_t* scg = (bf16_t*)((unsigned char*)a->out + SC_GOFF) + cidx * 4096;
#pragma unroll
                for (int r = 0; r < 16; ++r) { const int i = 32 * ti + crow(r, hi), j = 32 * tj + r32; const bool keep = dir == 0 ? (j <= i) : (j >= i);
                    scg[i * 64 + j] = f_bf(keep ? acc[r] : 0.f); }
            }
            __syncthreads();
        }
    }
}
__device__ __forceinline__ void phase_gla_scan(KA a, int m, LAS unsigned char* lds) {
    using namespace gla;
    constexpr int O_STT = 0  , O_OST = 17408  , STG0 = 25600, STAGE = 54784, O_QD = 0, O_KET = 17408, O_SC = 35840, O_VT = 45056, O_DEC = 54272;
    const int tid = tid_l(), lane = tid & 63, wave = __builtin_amdgcn_readfirstlane(tid >> 6), r32 = lane & 31, hi = lane >> 5;
    const int G = grd_l(); const int bx = blk_l(); const int vcu = (G % 8 == 0) ? (bx % 8) * (G / 8) + bx / 8 : bx;
    const bf16_t* Gb = (const bf16_t*)(a->ws + WS_BIG);
    const int ti = (wave >> 1) & 1, tj = wave & 1, role = wave >> 2, sd = wave >> 1, sv = wave & 1;
    const int t8 = tid >> 3, p8 = tid & 7;
#define LBAR() do { asm volatile("s_waitcnt lgkmcnt(0)" ::: "memory"); __builtin_amdgcn_s_barrier(); asm volatile("" ::: "memory"); } while (0)
    for (int item = vcu; item < 256; item += G) {
        const int vs = item & 3, dir = (item >> 2) & 1, h = (item >> 3) & 3, b = item >> 5;
        bf16_t* Oo = (bf16_t*)(a->ws + (dir == 0 ? WS_U : WS_Y));
        const size_t cbase = (size_t)((dir * NB + b) * 4 + h) * 68;
        const bf16_t* ketg = (const bf16_t*)a->out + cbase * 8192;
        const bf16_t* scg = (const bf16_t*)((const unsigned char*)a->out + SC_GOFF) + cbase * 4096;
        const float* decg = (const float*)((const unsigned char*)a->out + KET_BYTES) + cbase * 128;
        const int qcol = (dir ? 512 : 0) + h * 128, vcol = 1024 + h * 256 + vs * 64, ocol = h * 256 + vs * 64;
        __syncthreads();
        for (int i = tid; i < 17408 / 4; i += NTHREADS) ((LAS unsigned*)(lds + O_STT))[i] = 0u;
        f32x16 st;
#pragma unroll
        for (int r = 0; r < 16; ++r) st[r] = 0.f;
        u32x4 rq0[2], rq1[2], rk0[2], rk1[2], rs0[2], rv0[2]; f32x4 rd0[2];
#define GLA_K(c) (dir == 0 ? (c) : ((c) < 4 ? 3 - (c) : 71 - (c)))
#define GLA_ROW(c) ((size_t)b * TPB + 64 * GLA_K(c))
#define GLA_FETCH(c, S) do { const int kk_ = GLA_K(c); const size_t row_ = GLA_ROW(c); \
            rq0[S] = *(const u32x4*)(Gb + (row_ + t8) * NGIN + qcol + 8 * p8); rq1[S] = *(const u32x4*)(Gb + (row_ + t8) * NGIN + qcol + 64 + 8 * p8); \
            rk0[S] = *(const u32x4*)(ketg + (size_t)kk_ * 8192 + tid * 8); rk1[S] = *(const u32x4*)(ketg + (size_t)kk_ * 8192 + 4096 + tid * 8); \
            rs0[S] = *(const u32x4*)(scg + (size_t)kk_ * 4096 + tid * 8); \
            rv0[S] = *(const u32x4*)(Gb + (row_ + t8) * NGIN + vcol + 8 * p8); \
            if (tid < 32) rd0[S] = *(const f32x4*)(decg + (size_t)kk_ * 128 + 4 * tid); } while (0)
#define GLA_STAGE(S, B) do { LAS unsigned char* sb_ = lds + STG0 + (B) * STAGE; \
            *(LAS u32x4*)(sb_ + O_QD + (t8 * 136 + 8 * p8) * 2) = rq0[S]; *(LAS u32x4*)(sb_ + O_QD + (t8 * 136 + 64 + 8 * p8) * 2) = rq1[S]; \
            *(LAS u32x4*)(sb_ + O_KET + (t8 * 72 + 8 * p8) * 2) = rk0[S]; *(LAS u32x4*)(sb_ + O_KET + ((64 + t8) * 72 + 8 * p8) * 2) = rk1[S]; \
            *(LAS u32x4*)(sb_ + O_SC + (t8 * 72 + 8 * p8) * 2) = rs0[S]; \
            _Pragma("unroll") for (int e = 0; e < 4; ++e) { const unsigned w_ = rv0[S][e]; \
                *(LAS bf16_t*)(sb_ + O_VT + ((8 * p8 + 2 * e) * 72 + t8) * 2) = (bf16_t)(w_ & 0xffffu); *(LAS bf16_t*)(sb_ + O_VT + ((8 * p8 + 2 * e + 1) * 72 + t8) * 2) = (bf16_t)(w_ >> 16); } \
            if (tid < 32) *(LAS f32x4*)(sb_ + O_DEC + 16 * tid) = rd0[S]; } while (0)
#define GLA_FLUSH(cprev) do { const u32x4 ov_ = *(const LAS u32x4*)(lds + O_OST + (t8 * 64 + 8 * p8) * 2); \
            *(u32x4*)(Oo + (GLA_ROW(cprev) + t8) * DM + ocol + 8 * p8) = ov_; } while (0)
#define GLA_COMPUTE(c) do { const int p_ = (c) & 1; const LAS unsigned char* sb_ = lds + STG0 + p_ * STAGE; \
            f32x16 acc; \
            if (role == 1) { \
                _Pragma("unroll") for (int r = 0; r < 16; ++r) acc[r] = 0.f; \
                { const int ao = O_QD + ((32 * ti + r32) * 136 + 8 * hi) * 2, bo = O_STT + ((32 * tj + r32) * 136 + 8 * hi) * 2; \
                  _Pragma("unroll") for (int ks = 0; ks < 8; ++ks) { const bf16x8 av = *(const LAS bf16x8*)(sb_ + ao + ks * 32), bv = *(const LAS bf16x8*)(lds + bo + ks * 32); \
                      acc = __builtin_amdgcn_mfma_f32_32x32x16_bf16(av, bv, acc, 0, 0, 0); } } \
                { const int ao = O_SC + ((32 * ti + r32) * 72 + 8 * hi) * 2, bo = O_VT + ((32 * tj + r32) * 72 + 8 * hi) * 2; \
                  _Pragma("unroll") for (int ks = 0; ks < 4; ++ks) { const bf16x8 av = *(const LAS bf16x8*)(sb_ + ao + ks * 32), bv = *(const LAS bf16x8*)(sb_ + bo + ks * 32); \
                      acc = __builtin_amdgcn_mfma_f32_32x32x16_bf16(av, bv, acc, 0, 0, 0); } } } \
            { const LAS float* dcp = (const LAS float*)(sb_ + O_DEC) + 32 * sd + 4 * hi; \
              _Pragma("unroll") for (int r4 = 0; r4 < 4; ++r4) { const f32x4 dq = *(const LAS f32x4*)(dcp + 8 * r4); st[4 * r4] *= dq[0]; st[4 * r4 + 1] *= dq[1]; st[4 * r4 + 2] *= dq[2]; st[4 * r4 + 3] *= dq[3]; } \
              const int ao = O_KET + ((32 * sd + r32) * 72 + 8 * hi) * 2, bo = O_VT + ((32 * sv + r32) * 72 + 8 * hi) * 2; \
              _Pragma("unroll") for (int ks = 0; ks < 4; ++ks) { const bf16x8 av = *(const LAS bf16x8*)(sb_ + ao + ks * 32), bv = *(const LAS bf16x8*)(sb_ + bo + ks * 32); \
                  st = __builtin_amdgcn_mfma_f32_32x32x16_bf16(av, bv, st, 0, 0, 0); } } \
            LBAR();                                                  \
            if (role == 1) { _Pragma("unroll") for (int r = 0; r < 16; ++r) *(LAS bf16_t*)(lds + O_OST + ((32 * ti + crow(r, hi)) * 64 + 32 * tj + r32) * 2) = f_bf(acc[r]); } \
            { _Pragma("unroll") for (int r4 = 0; r4 < 4; ++r4) { u32x2 w; w.x = cvtpk(st[4 * r4], st[4 * r4 + 1]); w.y = cvtpk(st[4 * r4 + 2], st[4 * r4 + 3]); \
                  *(LAS u32x2*)(lds + O_STT + ((32 * sv + r32) * 136 + 32 * sd + 8 * r4 + 4 * hi) * 2) = w; } } } while (0)
        GLA_FETCH(0, 0); GLA_STAGE(0, 0); GLA_FETCH(1, 1); GLA_FETCH(2, 0);
        for (int c = 0; c < 68; c += 2) {
            LBAR();
            if (c > 0) GLA_FLUSH(c - 1);
            GLA_STAGE(1, 1); if (c + 3 < 68) GLA_FETCH(c + 3, 1);
            GLA_COMPUTE(c);
            LBAR();
            GLA_FLUSH(c);
            if (c + 2 < 68) { GLA_STAGE(0, 0); if (c + 4 < 68) GLA_FETCH(c + 4, 0); }
            GLA_COMPUTE(c + 1);
        }
        LBAR();
        GLA_FLUSH(67);
#undef GLA_K
#undef GLA_ROW
#undef GLA_FETCH
#undef GLA_STAGE
#undef GLA_FLUSH
#undef GLA_COMPUTE
    }
#undef LBAR
}

__device__ __forceinline__ void phase_gla_readout(KA a, int m, bool skip_ctx) {
    const int tid = tid_l(), lane = tid & 63, wave = tid >> 6;
    const int gw = blk_l() * 8 + wave, NGW = grd_l() * 8;
    const bf16_t* OF = (const bf16_t*)(a->ws + WS_U); const bf16_t* OB = (const bf16_t*)(a->ws + WS_Y); bf16_t* Gb = (bf16_t*)(a->ws + WS_BIG);
    const float* og = a->in[I_GOG] + (size_t)m * 1024;
    for (int r = gw; r < MT; r += NGW) {
        if (skip_ctx && (r % TPB) < CTXL) continue;
#pragma unroll
        for (int q = 0; q < 4; ++q) {
            const int col = 4 * lane + 256 * q;
            const u32x2 wf = *(const u32x2*)(OF + (size_t)r * DM + col), wb = *(const u32x2*)(OB + (size_t)r * DM + col), wr = *(const u32x2*)(Gb + (size_t)r * NGIN + 2048 + col);
            f32x4 s = (f32x4){bf_lo(wf.x) + bf_lo(wb.x), bf_hi(wf.x) + bf_hi(wb.x), bf_lo(wf.y) + bf_lo(wb.y), bf_hi(wf.y) + bf_hi(wb.y)};
            const float ss = wave_sum((s.x * s.x + s.y * s.y) + (s.z * s.z + s.w * s.w));
            const float rstd = 1.0f / sqrtf(ss * (1.0f / 256.0f) + EPS);
            const f32x4 gg = *(const f32x4*)(og + col);
            const f32x4 rr = (f32x4){bf_lo(wr.x), bf_hi(wr.x), bf_lo(wr.y), bf_hi(wr.y)};
            f32x4 o = s * rstd * gg; o.x *= silu(rr.x); o.y *= silu(rr.y); o.z *= silu(rr.z); o.w *= silu(rr.w);
            u32x2 w; w.x = cvtpk(o.x, o.y); w.y = cvtpk(o.z, o.w);
            *(u32x2*)(Gb + (size_t)r * NGIN + 2048 + col) = w;
        }
    }
}

__device__ __forceinline__ unsigned long long rt() { return __builtin_amdgcn_s_memrealtime(); }
#define XB_TMO      128
#define XB_XCNT(j)  (256  + 64 * (j))
#define XB_XSUB(j)  (1280 + 64 * (j))
#define XB_XGEN(j)  (2304 + 64 * (j))
#define XB_TOP      3328
#define XB_TOPGEN   3392
#define XCD_BAR_WORDS 3456
#define XB_SPIN_CAP (1u << 18)

__device__ __forceinline__ unsigned xb_ld(unsigned* p)              { return __hip_atomic_load(p, __ATOMIC_RELAXED, __HIP_MEMORY_SCOPE_AGENT); }
__device__ __forceinline__ unsigned xb_add(unsigned* p, unsigned v) { return __hip_atomic_fetch_add(p, v, __ATOMIC_RELAXED, __HIP_MEMORY_SCOPE_AGENT); }
__device__ __forceinline__ unsigned xb_xcc_id() { return (unsigned)__builtin_amdgcn_s_getreg((3 << 11) | 20) & 0xFu; }
#define XB_SPIN(cond, bar) do { unsigned _sp = 0; while (cond) { __builtin_amdgcn_s_sleep(1); \
    if ((++_sp & 255u) == 0u) { if (xb_ld(&(bar)[XB_TMO])) break; if (_sp > XB_SPIN_CAP) { atomicAdd(&(bar)[XB_TMO], 1u); break; } } } } while (0)

struct XcdBarrier {
    unsigned* bar; unsigned x;
    volatile LAS unsigned* st;
};

__device__ __forceinline__ XcdBarrier xcd_barrier_post(unsigned* bar, volatile LAS unsigned* st) {
    XcdBarrier b; b.bar = bar; b.x = xb_xcc_id(); b.st = st;
    if (threadIdx.x == 0) (void)xb_add(&bar[XB_XCNT(b.x)], 1u);
    return b;
}
__device__ __forceinline__ void xcd_barrier_complete(unsigned* bar, unsigned x, unsigned& nloc, unsigned& nx) {
    const unsigned G = gridDim.x * gridDim.y * gridDim.z;
    unsigned sum, cnt, mine, sp = 0u;
    for (;;) {
        sum = 0u; cnt = 0u; mine = 0u;
#pragma unroll
        for (unsigned j = 0; j < 16; ++j) { const unsigned c = xb_ld(&bar[XB_XCNT(j)]); sum += c; cnt += (c > 0u) ? 1u : 0u; mine = (j == x) ? c : mine; }
        if (sum == G) break;
        __builtin_amdgcn_s_sleep(1);
        if ((++sp & 255u) == 0u) { if (xb_ld(&bar[XB_TMO])) break; if (sp > XB_SPIN_CAP) { atomicAdd(&bar[XB_TMO], 1u); break; } }
    }
    nloc = mine > 0u ? mine : 1u; nx = cnt > 0u ? cnt : 1u;
}

__device__ __forceinline__ void xcd_barrier(const XcdBarrier& b) {
    asm volatile("s_waitcnt vmcnt(0)" ::: "memory");
    __syncthreads();
    if (threadIdx.x == 0) {
        unsigned* bar = b.bar;
        __builtin_amdgcn_s_waitcnt(0);
        unsigned nloc = b.st[0], nx = b.st[1];
        if (nloc == 0u) { xcd_barrier_complete(bar, b.x, nloc, nx); b.st[0] = nloc; b.st[1] = nx; }
        const unsigned old = xb_add(&bar[XB_XSUB(b.x)], 1u);
        const unsigned gen = old / nloc;
        if (old + 1u == (gen + 1u) * nloc) {
            __builtin_amdgcn_fence(__ATOMIC_RELEASE, "agent");
            asm volatile("s_waitcnt vmcnt(0)" ::: "memory");
            const unsigned og = xb_add(&bar[XB_TOP], 1u);
            const unsigned tg = og / nx;
            if (og + 1u == (tg + 1u) * nx) xb_add(&bar[XB_TOPGEN], 1u);
            else XB_SPIN(xb_ld(&bar[XB_TOPGEN]) == tg, bar);
            __builtin_amdgcn_fence(__ATOMIC_ACQUIRE, "agent");
            xb_add(&bar[XB_XGEN(b.x)], 1u);
            asm volatile("s_waitcnt vmcnt(0)" ::: "memory");
        } else {
            XB_SPIN(xb_ld(&bar[XB_XGEN(b.x)]) == gen, bar);
            __builtin_amdgcn_fence(__ATOMIC_ACQUIRE, "agent");
            asm volatile("s_waitcnt vmcnt(0)" ::: "memory");
        }
    }
    __syncthreads();
}

constexpr size_t WS_BAR = 4096;
constexpr size_t WS_XCNT = 65536;
constexpr size_t WS_XBUF = WS_HRES + 68 * MiB;
constexpr size_t WS_DFLOW = 32768;
constexpr int LDS_BARW = LDS_BYTES - 64;
#define GSYNC() do { XcdBarrier b_; b_.bar = (unsigned*)(kargs()->ws + WS_BAR); b_.x = xb_xcc_id(); b_.st = (volatile LAS unsigned*)(lds + LDS_BARW); xcd_barrier(b_); } while (0)
struct EpiRow {
    static constexpr bool PERM = true, AFTER_DRAIN = false;
    int sl; LAS unsigned char* xl;
    __device__ __forceinline__ void operator()(f32x4 (&acc)[2][2][4][2], const pg8::Unit& u, int wr, int wc, int fr, int fq) const {
        KA a_ = kargs(); unsigned char* ws = a_->ws;
        const int L = sl / 3, jpost = sl - 3 * L; const bool lastsl = sl == 3 * DEPTH - 1;
        const int Ln = (jpost == 2) ? L + 1 : L, jn = (jpost == 2) ? 0 : jpost + 1, jpre = lastsl ? -1 : jn, final_out = lastsl ? 1 : 0;
        const float gs = jpost == 1 ? 1.0f : 0.5f;
        bf16_t* hres = (bf16_t*)(ws + WS_HRES); bf16_t* U = (bf16_t*)(ws + WS_U); float* out = a_->out;
        const float* modL_post = (const float*)(ws + WS_MOD) + (size_t)L * 9 * 9216; const float* modL_pre = (const float*)(ws + WS_MOD) + (size_t)(lastsl ? L : Ln) * 9 * 9216;
        const float* gpost = a_->in[I_NPOST] + (size_t)(L * 3 + jpost) * DM; const float* gpre = a_->in[I_NPRE] + (size_t)((lastsl ? L : Ln) * 3 + (lastsl ? 0 : jn)) * DM;
        unsigned* cn1 = (unsigned*)(ws + WS_XCNT) + (size_t)(sl * 2) * 136 * 64; unsigned* cn2 = cn1 + 136 * 64;
        float* xb1 = (float*)(ws + WS_XBUF); float* xb2 = (float*)(ws + WS_XBUF + MiB);
        const int tid = threadIdx.x, wid = __builtin_amdgcn_readfirstlane(tid >> 6), lane = tid & 63;
        const int bidx = u.pm / 17, isctx = (u.pm - 17 * bidx) == 0, mi = isctx ? 8 : bidx;
        const int col0 = u.pn * 256 + wc * 32 + 8 * fq, row0 = u.pm * 256 + wr * 64 + fr, rl0 = wr * 64 + fr;
        const LAS float* S = (const LAS float*)(xl + 4096);
        pg8::rowstats_run(xb1, cn1, acc, u, wr, wc, fr, fq, xl, wid, lane);
        {
            const float* gate = modL_post + (size_t)mi * 9216 + (3 * jpost + 2) * 1024 + col0;
            f32x4 gt[2][2], gp[2][2];
#pragma unroll
            for (int bj = 0; bj < 2; ++bj)
#pragma unroll
                for (int n = 0; n < 2; ++n) { gt[bj][n] = *(const f32x4*)(gate + bj * 128 + 4 * n) * gs; gp[bj][n] = *(const f32x4*)(gpost + col0 + bj * 128 + 4 * n); gt[bj][n] = gt[bj][n] * gp[bj][n]; }
#pragma unroll
            for (int ai = 0; ai < 2; ++ai)
#pragma unroll
                for (int m = 0; m < 4; ++m) {
                    const int rl = rl0 + ai * 128 + m * 16; const size_t roff = (size_t)(row0 + ai * 128 + m * 16) * 1024 + col0;
                    const float rstd = 1.0f / sqrtf(S[rl] * (1.0f / 1024.0f) + 1e-6f);
#pragma unroll
                    for (int bj = 0; bj < 2; ++bj) {
                        const u32x4 hw = *(const u32x4*)(hres + roff + bj * 128);
                        const f32x4 h0 = {__uint_as_float(hw.x << 16), __uint_as_float(hw.x & 0xffff0000u), __uint_as_float(hw.y << 16), __uint_as_float(hw.y & 0xffff0000u)};
                        const f32x4 h1 = {__uint_as_float(hw.z << 16), __uint_as_float(hw.z & 0xffff0000u), __uint_as_float(hw.w << 16), __uint_as_float(hw.w & 0xffff0000u)};
                        const f32x4 n0 = h0 + gt[bj][0] * (acc[ai][bj][m][0] * rstd), n1 = h1 + gt[bj][1] * (acc[ai][bj][m][1] * rstd);
                        acc[ai][bj][m][0] = n0; acc[ai][bj][m][1] = n1;
                        if (final_out) { float* op = out + (size_t)(bidx * 4096 + (u.pm - 17 * bidx - 1) * 256 + wr * 64 + fr + ai * 128 + m * 16) * 1024 + col0 + bj * 128; *(f32x4*)op = n0; *(f32x4*)(op + 4) = n1; }
                        else { u32x4 w; w.x = cvtpk(n0[0], n0[1]); w.y = cvtpk(n0[2], n0[3]); w.z = cvtpk(n1[0], n1[1]); w.w = cvtpk(n1[2], n1[3]); *(u32x4*)(hres + roff + bj * 128) = w; }
                    }
                }
        }
        if (jpre < 0) return;
        pg8::rowstats_run(xb2, cn2, acc, u, wr, wc, fr, fq, xl, wid, lane);
        {
            const float* mb = modL_pre + (size_t)mi * 9216 + (3 * jpre) * 1024 + col0;
            f32x4 sh[2][2], sc[2][2];
#pragma unroll
            for (int bj = 0; bj < 2; ++bj)
#pragma unroll
                for (int n = 0; n < 2; ++n) { sh[bj][n] = *(const f32x4*)(mb + bj * 128 + 4 * n); sc[bj][n] = (1.0f + *(const f32x4*)(mb + 1024 + bj * 128 + 4 * n)) * *(const f32x4*)(gpre + col0 + bj * 128 + 4 * n); }
#pragma unroll
            for (int ai = 0; ai < 2; ++ai)
#pragma unroll
                for (int m = 0; m < 4; ++m) {
                    const int rl = rl0 + ai * 128 + m * 16; const size_t roff = (size_t)(row0 + ai * 128 + m * 16) * 1024 + col0;
                    const float rstd = 1.0f / sqrtf(S[rl] * (1.0f / 1024.0f) + 1e-6f);
#pragma unroll
                    for (int bj = 0; bj < 2; ++bj) {
                        const f32x4 u0 = acc[ai][bj][m][0] * rstd * sc[bj][0] + sh[bj][0], u1 = acc[ai][bj][m][1] * rstd * sc[bj][1] + sh[bj][1];
                        u32x4 w; w.x = cvtpk(u0[0], u0[1]); w.y = cvtpk(u0[2], u0[3]); w.z = cvtpk(u1[0], u1[1]); w.w = cvtpk(u1[2], u1[3]);
                        *(u32x4*)(U + roff + bj * 128) = w;
                    }
                }
        }
    }
};

struct EpiQKV {
    static constexpr bool PERM = true, AFTER_DRAIN = false;
    int m; LAS unsigned char* xl;
    __device__ __forceinline__ void operator()(f32x4 (&acc)[2][2][4][2], const pg8::Unit& u, int wr, int wc, int fr, int fq) const {
        KA a_ = kargs(); bf16_t* O = (bf16_t*)(a_->ws + WS_BIG);
        const int row0 = u.pm * 256 + wr * 64 + fr, col0 = u.pn * 256 + wc * 32 + 8 * fq;
        if (u.pn < 5) {
            LAS float* P = (LAS float*)xl;
#pragma unroll
            for (int ai = 0; ai < 2; ++ai)
#pragma unroll
                for (int m4 = 0; m4 < 4; ++m4)
#pragma unroll
                    for (int bj = 0; bj < 2; ++bj) {
                        const f32x4 a0 = acc[ai][bj][m4][0], a1 = acc[ai][bj][m4][1];
                        float s = ((a0[0] * a0[0] + a0[1] * a0[1]) + (a0[2] * a0[2] + a0[3] * a0[3])) + ((a1[0] * a1[0] + a1[1] * a1[1]) + (a1[2] * a1[2] + a1[3] * a1[3]));
                        s += __shfl_xor(s, 16); s += __shfl_xor(s, 32);
                        if (fq == 0) P[((ai * 128 + wr * 64 + m4 * 16 + fr) * 2 + bj) * 4 + wc] = s;
                    }
            asm volatile("s_waitcnt lgkmcnt(0)" ::: "memory"); __builtin_amdgcn_s_barrier(); asm volatile("" ::: "memory");
            const float* gain = a_->in[u.pn < 4 ? I_AQG : I_AKG] + m * 128;
            const int xi0 = wc * 16 + fq * 4, x0 = xi0 < 32 ? xi0 : xi0 + 32;
            const f32x4 g0 = *(const f32x4*)(gain + x0), g1 = *(const f32x4*)(gain + x0 + 32);
            const int fi0 = (wc & 1) * 16 + fq * 4;
            f32x4 inv;
#pragma unroll
            for (int e = 0; e < 4; ++e) inv[e] = exp2f(-(float)(fi0 + e) * (13.287712379549449f / 32.0f)) * 0.15915494309189535f;
            const int bidx = u.pm / 17, ptile = u.pm - 17 * bidx; const bool isctx = ptile == 0;
#pragma unroll
            for (int ai = 0; ai < 2; ++ai)
#pragma unroll
                for (int m4 = 0; m4 < 4; ++m4) {
                    const int rl = ai * 128 + wr * 64 + m4 * 16 + fr;
                    f32x4 cs = {1.f, 1.f, 1.f, 1.f}, sn = {0.f, 0.f, 0.f, 0.f};
                    if (!isctx) { const int t = (ptile - 1) * 256 + rl; const float p = (float)(wc < 2 ? (t >> 6) : (t & 63));
#pragma unroll
                        for (int e = 0; e < 4; ++e) { const float rev = p * inv[e]; sn[e] = __builtin_amdgcn_sinf(rev); cs[e] = __builtin_amdgcn_cosf(rev); } }
#pragma unroll
                    for (int bj = 0; bj < 2; ++bj) {
                        const LAS float* pp = P + (rl * 2 + bj) * 4;
                        const float rstd = 1.0f / sqrtf(((pp[0] + pp[1]) + (pp[2] + pp[3])) * (1.0f / 128.0f) + EPS);
                        const f32x4 x1 = acc[ai][bj][m4][0] * rstd * g0, x2 = acc[ai][bj][m4][1] * rstd * g1;
                        const f32x4 o1 = x1 * cs - x2 * sn, o2 = x2 * cs + x1 * sn;
                        u32x4 w; w.x = cvtpk(o1[0], o1[1]); w.y = cvtpk(o1[2], o1[3]); w.z = cvtpk(o2[0], o2[1]); w.w = cvtpk(o2[2], o2[3]);
                        *(u32x4*)(O + (size_t)(row0 + ai * 128 + m4 * 16) * NQKV + col0 + bj * 128) = w;
                    }
                }
        } else {
#pragma unroll
            for (int ai = 0; ai < 2; ++ai)
#pragma unroll
                for (int m4 = 0; m4 < 4; ++m4)
#pragma unroll
                    for (int bj = 0; bj < 2; ++bj) { const f32x4 v0 = acc[ai][bj][m4][0], v1 = acc[ai][bj][m4][1];
                        u32x4 w; w.x = cvtpk(v0[0], v0[1]); w.y = cvtpk(v0[2], v0[3]); w.z = cvtpk(v1[0], v1[1]); w.w = cvtpk(v1[2], v1[3]);
                        *(u32x4*)(O + (size_t)(row0 + ai * 128 + m4 * 16) * NQKV + col0 + bj * 128) = w; }
        }
    }
};

__global__ void __launch_bounds__(NTHREADS, 2) fwd_megakernel(Args unused_args) {
    extern __shared__ __attribute__((aligned(16))) unsigned char lds_raw[];
    LAS unsigned char* lds = (LAS unsigned char*)lds_raw;
    cg::grid_group grid = cg::this_grid();
    if (threadIdx.x < 16) ((LAS unsigned*)(lds + LDS_BARW))[threadIdx.x] = 0u;
    __syncthreads();
    (void)xcd_barrier_post((unsigned*)(kargs()->ws + WS_BAR), (volatile LAS unsigned*)(lds + LDS_BARW));

#ifndef SKIP_MOD
    phase_mod(kargs(), lds);
#endif
    convert_layer(kargs(), lds, 0, 0);
    grid.sync();
    row_pass<true>(kargs(), RowP{0, -1, 0.f, 0, 0, false});
    GSYNC();

    for (int sl = 0; sl < 3 * DEPTH; ++sl) {
        const int L = sl / 3, j = sl - 3 * L, m = L >> 1;
        if (j != 1) {
            unsigned char* ws = kargs()->ws; const int f = j >> 1;
            pg8::Gemm g1{(const bf16_t*)(ws + WS_U), (const bf16_t*)(ws + WS_W1T) + (size_t)(L * 2 + f) * 5632 * 1024, MT, 2 * DFF, DM, DM, DM};
            pg8::StaticOrder S; S.init(MT, 2 * DFF, DM, grd_l(), blk_l(), sl == 3 * DEPTH - 1 ? 2 : 0);
            pg8::EpiSwiglu E{(bf16_t*)(ws + WS_BIG), DFF};
#ifndef SKIP_G1
            pg8::gemm_phase<pg8::EpiSwiglu, pg8::StaticOrder, true, true>(lds, g1, S, E);
#endif
            GSYNC();
        } else {
            const bool attn = (L & 1) == 0;
            { unsigned char* ws = kargs()->ws;
              pg8::Gemm g1{(const bf16_t*)(ws + WS_U), attn ? (const bf16_t*)(ws + WS_WQKVT) + (size_t)m * NQKV * 1024 : (const bf16_t*)(ws + WS_WGINT) + (size_t)m * NGIN * 1024, MT, attn ? NQKV : NGIN, DM, DM, DM};
              pg8::StaticOrder S; S.init(MT, g1.N, DM, grd_l(), blk_l(), 0);
              pg8::EpiBf16s E{(bf16_t*)(ws + WS_BIG), g1.N, nullptr};
              if (attn) { EpiQKV EQ{m, lds + 131072}; pg8::gemm_phase<EpiQKV, pg8::StaticOrder, true, true>(lds, g1, S, EQ); }
              else pg8::gemm_phase<pg8::EpiBf16s, pg8::StaticOrder, true, true>(lds, g1, S, E);
 }
            GSYNC();
            if (attn) {
#ifndef SKIP_ATT
                phase_attention(kargs(), (char*)lds_raw);
#endif
                GSYNC();
            } else {
                phase_gla_prep(kargs(), m, lds);
                GSYNC();
                phase_gla_scan(kargs(), m, lds);
                GSYNC();
#ifndef SKIP_RO
                phase_gla_readout(kargs(), m, sl >= 10);
#endif
                GSYNC();
            }
        }
        {
            unsigned char* ws = kargs()->ws;
            pg8::Gemm g2;
            if (j != 1) g2 = pg8::Gemm{(const bf16_t*)(ws + WS_BIG), (const bf16_t*)(ws + WS_W2T) + (size_t)(L * 2 + (j >> 1)) * 1024 * 2816, MT, DM, DFF, DFF, DFF};
            else if ((L & 1) == 0) g2 = pg8::Gemm{(const bf16_t*)(ws + WS_ATTNO), (const bf16_t*)(ws + WS_WOAT) + (size_t)m * 1024 * 1024, MT, DM, DM, DM, DM};
            else g2 = pg8::Gemm{(const bf16_t*)(ws + WS_BIG) + 2048, (const bf16_t*)(ws + WS_WGOT) + (size_t)m * 1024 * 1024, MT, DM, DM, NGIN, DM};
            pg8::StaticOrder S; S.init(MT, DM, g2.K, grd_l(), blk_l(), sl >= 10 ? 2 : 3);
            EpiRow E{sl, lds + 131072};
#ifndef SKIP_G2
            pg8::gemm_phase<EpiRow, pg8::StaticOrder, true, true>(lds, g2, S, E);
#endif
            if (j == 0 && L + 1 < DEPTH && blk_l() >= 32) convert_layer(kargs(), lds, L + 1, 32);
        }
        const bool last = sl == 3 * DEPTH - 1;
        if (!last) GSYNC();
    }
}

extern "C" void kernel_launch(void* const* d_in, const int* in_sizes, int n_in, void* d_out, int out_size, void* d_ws, size_t ws_size, hipStream_t stream) {
    static int grid = 0;
    if (grid == 0) {
        if (n_in != 20 || out_size != NB * SEQ * DM || ws_size < WS_END) { fprintf(stderr, "kernel_launch: unexpected shapes: n_in %d out %d ws %zu (need %zu)\n", n_in, out_size, ws_size, (size_t)WS_END); grid = -1; return; }
        int dev = 0, cus = 0, per_cu = 0;
        (void)hipGetDevice(&dev);
        (void)hipDeviceGetAttribute(&cus, hipDeviceAttributeMultiprocessorCount, dev);
        (void)hipFuncSetAttribute((const void*)fwd_megakernel, hipFuncAttributeMaxDynamicSharedMemorySize, LDS_BYTES);
        (void)hipOccupancyMaxActiveBlocksPerMultiprocessor(&per_cu, (const void*)fwd_megakernel, NTHREADS, LDS_BYTES);
        if (per_cu < 1) per_cu = 1;
        grid = cus * per_cu;
        if (grid > 256) grid = 256;
        if (grid < 256) { fprintf(stderr, "kernel_launch: %d co-resident workgroups < 256: this build needs 256; nothing launched\n", grid); grid = -1; return; }
        fprintf(stderr, "kernel_launch: grid %d (cus %d x %d), ws %zu\n", grid, cus, per_cu, ws_size);
    }
    if (grid < 0) return;
    (void)hipMemsetAsync(d_ws, 0, 1 * MiB, stream);
    Args a{};
    for (int i = 0; i < 20; ++i) a.in[i] = (const float*)d_in[i];
    a.out = (float*)d_out; a.ws = (unsigned char*)d_ws;
    void* args[] = {&a};
    hipError_t e = hipLaunchCooperativeKernel((const void*)fwd_megakernel, dim3(grid), dim3(NTHREADS), args, LDS_BYTES, stream);
    if (e != hipSuccess) fprintf(stderr, "kernel_launch: cooperative launch failed: %s (grid %d)\n", hipGetErrorString(e), grid);
}
```

```cpp
#include <hip/hip_runtime.h>
#include <hip/hip_cooperative_groups.h>
#include <hip/hip_bf16.h>
#include <cstdio>
#include <cstdint>
namespace cg = cooperative_groups;
__device__ __forceinline__ int tid_l() { int t = threadIdx.x; asm volatile("" : "+v"(t)); return t; }
__device__ __forceinline__ int blk_l() { int t = blockIdx.x; asm volatile("" : "+s"(t)); return t; }
__device__ __forceinline__ int grd_l() { int t = gridDim.x; asm volatile("" : "+s"(t)); return t; }
namespace pg8 {
#define PG8_LAS __attribute__((address_space(3)))
typedef unsigned short bf16_t;
typedef short bf16x8 __attribute__((ext_vector_type(8)));
typedef float f32x4 __attribute__((ext_vector_type(4)));
typedef unsigned u32x4 __attribute__((ext_vector_type(4)));
constexpr int BM = 256, BK = 64, HALF = 128, HTB = HALF * BK * 2  , STAGE_BYTES = 8 * HTB, NXCD = 8, WGM = 8;

__host__ __device__ __forceinline__ int lds_byte(int r, int c) { const int st = (r >> 4) * 2 + (c >> 5), rr = r & 15, cc = c & 31, ob = rr * 64 + cc * 2; return st * 1024 + (ob ^ (((ob >> 9) & 1) << 5)); }
__host__ __device__ __forceinline__ void stage_rc(int b, int& R, int& C) { const int st = b / 1024, sb = b % 1024, swz = sb ^ (((sb >> 9) & 1) << 5); R = (st >> 1) * 16 + swz / 64; C = (st & 1) * 32 + (swz % 64) / 2; }
__host__ __device__ __forceinline__ int perm32(int rho) { const int n = rho >> 4, i = rho & 15; return 8 * (i >> 2) + 4 * n + (i & 3); }

struct Unit { int pm, pn, kt0, nt, part, sig; };
struct Gemm { const bf16_t* A; const bf16_t* Bt; int M, N, K, lda, ldb; };

struct StaticOrder {
    int nM, nN, nwg, G, c, mode, ntfull; unsigned* sig;
    __host__ __device__ void init(int M, int N, int K, int G_, int c_, int mode_) { mode = mode_; nM = mode ? 128 : M / BM; nN = N / BM; nwg = nM * nN; G = G_; c = c_; ntfull = K / BK; sig = nullptr; }
    __host__ __device__ __forceinline__ bool next(int i, Unit& u) const {
        const long L = (long)i * G + c;
        int pm = 0, pn = 0, kt0 = 0, nt = ntfull, part = -1, sg = 0; bool ok = true;
        if (L >= nwg) {
            const int e = (int)(L - nwg);
            if (mode == 3) { ok = e < 8 * nN; pm = 17 * (e / nN); pn = e % nN; sg = 2; }
            else { ok = (mode == 1) && (e < 16 * nN); const int ct = e >> 1; pm = 17 * (ct / nN); pn = ct % nN; part = e & 1; nt = ntfull >> 1; kt0 = part * nt; }
        } else {
            int wgid = (int)L; { const int q = nwg / NXCD, r = nwg % NXCD, xcd = wgid % NXCD, off = wgid / NXCD; wgid = (xcd < r ? xcd * (q + 1) : r * (q + 1) + (xcd - r) * q) + off; }
            const int nig = WGM * nN, gid = wgid / nig, fm = gid * WGM, gsz = (nM - fm) < WGM ? (nM - fm) : WGM;
            pm = fm + ((wgid % nig) % gsz); pn = (wgid % nig) / gsz;
            if (mode) pm += (pm >> 4) + 1;
            sg = (mode >= 2 && L + G >= nwg) ? 1 : 0;
        }
        u.pm = pm; u.pn = pn; u.kt0 = kt0; u.nt = nt; u.part = part; u.sig = sg;
        return ok;
    }
    __device__ __forceinline__ void a_ready(const Unit&) const {}
    __device__ __forceinline__ void done(const Unit& u) const {
        if (sig != nullptr && u.sig != 0) {
            asm volatile("s_waitcnt vmcnt(0)" ::: "memory");
            __builtin_amdgcn_s_barrier(); asm volatile("" ::: "memory");
            if (threadIdx.x == 0) {
                __builtin_amdgcn_fence(__ATOMIC_RELEASE, "agent");
                asm volatile("s_waitcnt vmcnt(0)" ::: "memory");
                __hip_atomic_fetch_add(sig + (u.sig == 1 ? 0 : 64), 1u, __ATOMIC_RELAXED, __HIP_MEMORY_SCOPE_AGENT);
            }
        }
    }
};

typedef float f32x2c_t __attribute__((ext_vector_type(2))); typedef __bf16 bf16x2c_t __attribute__((ext_vector_type(2)));
__device__ __forceinline__ unsigned cvt_pk_bf16(float lo, float hi) { f32x2c_t v = {lo, hi}; bf16x2c_t b = __builtin_convertvector(v, bf16x2c_t); return __builtin_bit_cast(unsigned, b); }
typedef float f32x2 __attribute__((ext_vector_type(2)));
struct EpiBf16s {
    static constexpr bool PERM = true, AFTER_DRAIN = false;
    bf16_t* O; int ldc; float* P;
    __device__ __forceinline__ void operator()(const f32x4 (&acc)[2][2][4][2], const Unit& u, int wr, int wc, int fr, int fq) const {
        const int row0 = u.pm * BM + wr * 64 + fr; const int col0 = u.pn * BM + wc * 32 + 8 * fq;
        if (u.part >= 0) {
            float* pb = P + (size_t)u.part * 2048 * ldc + (size_t)((u.pm / 17) * BM + wr * 64 + fr) * ldc + col0;
#pragma unroll
            for (int ai = 0; ai < 2; ++ai)
#pragma unroll
                for (int m = 0; m < 4; ++m)
#pragma unroll
                    for (int bj = 0; bj < 2; ++bj) { float* rp = pb + (size_t)(ai * HALF + m * 16) * ldc + bj * HALF; *(f32x4*)rp = acc[ai][bj][m][0]; *(f32x4*)(rp + 4) = acc[ai][bj][m][1]; }
            return;
        }
#pragma unroll
        for (int ai = 0; ai < 2; ++ai)
#pragma unroll
            for (int m = 0; m < 4; ++m) { bf16_t* rowp = O + (size_t)(row0 + ai * HALF + m * 16) * ldc + col0;
#pragma unroll
                for (int bj = 0; bj < 2; ++bj) { const f32x4 v0 = acc[ai][bj][m][0], v1 = acc[ai][bj][m][1];
                    u32x4 w; w.x = cvt_pk_bf16(v0[0], v0[1]); w.y = cvt_pk_bf16(v0[2], v0[3]); w.z = cvt_pk_bf16(v1[0], v1[1]); w.w = cvt_pk_bf16(v1[2], v1[3]);
                    *(u32x4*)(rowp + bj * HALF) = w; } }
    }
};
__device__ __forceinline__ float silu_f(float g) { return g * __builtin_amdgcn_rcpf(1.0f + __expf(-g)); }
struct EpiSwiglu {
    static constexpr bool PERM = true, AFTER_DRAIN = false;
    bf16_t* H; int ldh;
    __device__ __forceinline__ void operator()(const f32x4 (&acc)[2][2][4][2], const Unit& u, int wr, int wc, int fr, int fq) const {
        const int row0 = u.pm * BM + wr * 64 + fr; const int col0 = u.pn * HALF + wc * 32 + 8 * fq;
#pragma unroll
        for (int ai = 0; ai < 2; ++ai)
#pragma unroll
            for (int m = 0; m < 4; ++m) { bf16_t* rowp = H + (size_t)(row0 + ai * HALF + m * 16) * ldh + col0;
                const f32x4 g0 = acc[ai][0][m][0], g1 = acc[ai][0][m][1], u0 = acc[ai][1][m][0], u1 = acc[ai][1][m][1];
                u32x4 w;
                w.x = cvt_pk_bf16(silu_f(g0[0]) * u0[0], silu_f(g0[1]) * u0[1]); w.y = cvt_pk_bf16(silu_f(g0[2]) * u0[2], silu_f(g0[3]) * u0[3]);
                w.z = cvt_pk_bf16(silu_f(g1[0]) * u1[0], silu_f(g1[1]) * u1[1]); w.w = cvt_pk_bf16(silu_f(g1[2]) * u1[2], silu_f(g1[3]) * u1[3]);
                *(u32x4*)rowp = w; }
    }
};
__device__ __forceinline__ void rowstats_run(float* xbuf  , unsigned* cnt  , const f32x4 (&v)[2][2][4][2], const Unit& u, int wr, int wc, int fr, int fq, PG8_LAS unsigned char* xl, int wid, int lane) {
        PG8_LAS float* P = (PG8_LAS float*)xl;
        PG8_LAS float* S = (PG8_LAS float*)(xl + 4096);
#pragma unroll
        for (int ai = 0; ai < 2; ++ai)
#pragma unroll
            for (int m = 0; m < 4; ++m) {
                float s = 0.f;
#pragma unroll
                for (int bj = 0; bj < 2; ++bj)
#pragma unroll
                    for (int n = 0; n < 2; ++n) { const f32x4 x = v[ai][bj][m][n]; s += (x[0] * x[0] + x[1] * x[1]) + (x[2] * x[2] + x[3] * x[3]); }
                s += __shfl_xor(s, 16); s += __shfl_xor(s, 32);
                if (fq == 0) P[(ai * HALF + wr * 64 + m * 16 + fr) * 4 + wc] = s;
            }
        asm volatile("s_waitcnt lgkmcnt(0)" ::: "memory"); __builtin_amdgcn_s_barrier(); asm volatile("" ::: "memory");
        const int row = wid * 32 + (lane & 31);
        if (lane < 32) {
            const float t = (P[row * 4 + 0] + P[row * 4 + 1]) + (P[row * 4 + 2] + P[row * 4 + 3]);
            __hip_atomic_store(xbuf + ((size_t)(u.pm * BM + row) * 4 + u.pn), t, __ATOMIC_RELAXED, __HIP_MEMORY_SCOPE_AGENT);
        }
        asm volatile("s_waitcnt vmcnt(0)" ::: "memory");
        if (lane == 0) __hip_atomic_fetch_add(cnt + 64 * u.pm, 1u, __ATOMIC_RELAXED, __HIP_MEMORY_SCOPE_AGENT);
        if (wid == 0) {
            unsigned sp = 0;
            while ((unsigned)__builtin_amdgcn_readfirstlane(__hip_atomic_load(cnt + 64 * u.pm, __ATOMIC_RELAXED, __HIP_MEMORY_SCOPE_AGENT)) < 32u) { __builtin_amdgcn_s_sleep(1); if (++sp > (1u << 22)) break; }
            __builtin_amdgcn_fence(__ATOMIC_ACQUIRE, "agent");
        }
        asm volatile("s_waitcnt vmcnt(0) lgkmcnt(0)" ::: "memory"); __builtin_amdgcn_s_barrier(); asm volatile("" ::: "memory");
        if (lane < 32) {
            const float* slot = xbuf + (size_t)(u.pm * BM + row) * 4; float t = 0.f;
#pragma unroll
            for (int k = 0; k < 4; ++k) t += __hip_atomic_load(slot + k, __ATOMIC_RELAXED, __HIP_MEMORY_SCOPE_AGENT);
            S[row] = t;
        }
        asm volatile("s_waitcnt vmcnt(0) lgkmcnt(0)" ::: "memory"); __builtin_amdgcn_s_barrier(); asm volatile("" ::: "memory");
    }

template <class Epi, class Sched, bool ALIGN_EPI = false, bool SP2 = false>
__device__ __forceinline__ void gemm_phase(PG8_LAS unsigned char* lds, const Gemm g, const Sched& S, const Epi& E) {
    const int tid = tid_l(), wid = __builtin_amdgcn_readfirstlane(tid >> 6), lane = tid & 63, wr = wid >> 2, wc = wid & 3, fr = lane & 15, fq = lane >> 4;
    unsigned voffA[2], voffB[2];
#pragma unroll
    for (int i = 0; i < 2; ++i) { int R, C; stage_rc(tid * 16 + i * 8192, R, C); const int Rb = Epi::PERM ? ((R & ~31) + perm32(R & 31)) : R;
        voffA[i] = (unsigned)(R * g.lda + C) * 2u; voffB[i] = (unsigned)(Rb * g.ldb + C) * 2u; }
    const size_t kstep = (size_t)(BK * 2);
    const size_t hstepB = (size_t)HALF * g.ldb * 2, hstepA = (size_t)HALF * g.lda * 2;
    const size_t tstepA = 2 * hstepA, tstepB = 2 * hstepB;
    const unsigned ldsw = (unsigned)wid * 1024u;
    const int aoff = lds_byte(wr * 64 + fr, fq * 8), boff = lds_byte(wc * 32 + fr, fq * 8);
#define PG8_SA(b, h) (((b) * 2 + (h)) * HTB)
#define PG8_SB(b, h) ((4 + (b) * 2 + (h)) * HTB)
#define PG8_STAGE(bufoff, gbase, voff) do { _Pragma("unroll") for (int _i = 0; _i < 2; ++_i) \
        __builtin_amdgcn_global_load_lds((const unsigned*)((const char*)(gbase) + (voff)[_i]), (PG8_LAS unsigned*)(lds + (bufoff) + ldsw + _i * 8192), 16, 0, 0); } while (0)
#define PG8_LDA(dst, b, h) do { _Pragma("unroll") for (int m = 0; m < 4; ++m) _Pragma("unroll") for (int k = 0; k < 2; ++k) dst[m][k] = *(const PG8_LAS bf16x8*)(lds + PG8_SA(b, h) + aoff + m * 2048 + k * 1024); } while (0)
#define PG8_LDB(dst, b, h) do { _Pragma("unroll") for (int n = 0; n < 2; ++n) _Pragma("unroll") for (int k = 0; k < 2; ++k) dst[n][k] = *(const PG8_LAS bf16x8*)(lds + PG8_SB(b, h) + boff + n * 2048 + k * 1024); } while (0)
#define PG8_MMA(ai, bj, At, Bt) do { __builtin_amdgcn_s_setprio(1); _Pragma("unroll") for (int m = 0; m < 4; ++m) _Pragma("unroll") for (int n = 0; n < 2; ++n) _Pragma("unroll") for (int k = 0; k < 2; ++k) \
        acc[ai][bj][m][n] = __builtin_amdgcn_mfma_f32_16x16x32_bf16(Bt[n][k], At[m][k], acc[ai][bj][m][n], 0, 0, 0); __builtin_amdgcn_s_setprio(0); } while (0)
#define PG8_WAIT_V(n) asm volatile("s_waitcnt vmcnt(" #n ")" ::: "memory")
#define PG8_WAIT_L(n) asm volatile("s_waitcnt lgkmcnt(" #n ")" ::: "memory")
#define PG8_BAR __builtin_amdgcn_s_barrier()
#define PG8_SCHED __builtin_amdgcn_sched_barrier(0)
    Unit cur, nxt; int ui = 0;
    if (!S.next(0, cur)) return;
    f32x4 acc[2][2][4][2];
#pragma unroll
    for (int a = 0; a < 2; ++a)
#pragma unroll
        for (int b = 0; b < 2; ++b)
#pragma unroll
            for (int m = 0; m < 4; ++m)
#pragma unroll
                for (int n = 0; n < 2; ++n) acc[a][b][m][n] = (f32x4){0.f, 0.f, 0.f, 0.f};
    bf16x8 At[4][2], B0[2][2], B1[2][2];
    const char* cA = (const char*)g.A + (size_t)cur.pm * tstepA + (size_t)cur.kt0 * kstep; const char* cB = (const char*)g.Bt + (size_t)cur.pn * tstepB + (size_t)cur.kt0 * kstep;
    S.a_ready(cur);
    if constexpr (SP2) {
        PG8_STAGE(PG8_SB(0, 0), cB, voffB); PG8_STAGE(PG8_SB(0, 1), cB + hstepB, voffB); PG8_STAGE(PG8_SA(0, 0), cA, voffA); PG8_STAGE(PG8_SA(0, 1), cA + hstepA, voffA);
        if (wr == 1) PG8_BAR;
        PG8_WAIT_V(2); PG8_BAR;
        PG8_STAGE(PG8_SB(1, 0), cB + kstep, voffB); PG8_STAGE(PG8_SA(1, 0), cA + kstep, voffA); PG8_STAGE(PG8_SB(1, 1), cB + hstepB + kstep, voffB);
        PG8_WAIT_V(6); PG8_BAR;
    } else {
        PG8_STAGE(PG8_SB(0, 0), cB, voffB); PG8_STAGE(PG8_SA(0, 0), cA, voffA); PG8_STAGE(PG8_SB(0, 1), cB + hstepB, voffB); PG8_STAGE(PG8_SA(0, 1), cA + hstepA, voffA);
        if (wr == 1) PG8_BAR;
        PG8_WAIT_V(4); PG8_BAR;
        PG8_STAGE(PG8_SB(1, 0), cB + kstep, voffB); PG8_STAGE(PG8_SA(1, 0), cA + kstep, voffA); PG8_STAGE(PG8_SB(1, 1), cB + hstepB + kstep, voffB);
        PG8_WAIT_V(6); PG8_BAR;
    }
    for (;;) {
        const bool has_next = S.next(ui + 1, nxt);
        const char* nA = has_next ? (const char*)g.A + (size_t)nxt.pm * tstepA + (size_t)nxt.kt0 * kstep : cA; const char* nB = has_next ? (const char*)g.Bt + (size_t)nxt.pn * tstepB + (size_t)nxt.kt0 * kstep : cB;
        const int nt = cur.nt;
        for (int t = 0; t < nt; t += 2) {
            const bool last = (t == nt - 2);
            const char* a1 = cA + (size_t)(t + 1) * kstep;
            const char* a2 = last ? nA : cA + (size_t)(t + 2) * kstep; const char* b2 = last ? nB : cB + (size_t)(t + 2) * kstep;
            const char* a3 = a2 + kstep; const char* b3 = b2 + kstep;
            if (last && has_next) S.a_ready(nxt);
            if constexpr (SP2) {
            PG8_LDB(B0, 0, 0); PG8_LDB(B1, 0, 1); PG8_SCHED; PG8_LDA(At, 0, 0); PG8_STAGE(PG8_SA(1, 1), a1 + hstepA, voffA);
            PG8_WAIT_V(8); PG8_WAIT_L(0); PG8_BAR; PG8_MMA(0, 0, At, B0); PG8_MMA(0, 1, At, B1); PG8_BAR; PG8_SCHED;
            PG8_LDA(At, 0, 1); PG8_STAGE(PG8_SB(0, 0), b2, voffB); PG8_STAGE(PG8_SB(0, 1), b2 + hstepB, voffB); PG8_STAGE(PG8_SA(0, 0), a2, voffA);
            PG8_WAIT_V(8); PG8_WAIT_L(0); PG8_BAR; PG8_MMA(1, 0, At, B0); PG8_MMA(1, 1, At, B1); PG8_BAR; PG8_SCHED;
            PG8_LDB(B0, 1, 0); PG8_LDB(B1, 1, 1); PG8_SCHED; PG8_LDA(At, 1, 0); PG8_STAGE(PG8_SA(0, 1), a2 + hstepA, voffA);
            PG8_WAIT_V(8); PG8_WAIT_L(0); PG8_BAR; PG8_MMA(0, 0, At, B0); PG8_MMA(0, 1, At, B1); PG8_BAR; PG8_SCHED;
            PG8_LDA(At, 1, 1); PG8_STAGE(PG8_SB(1, 0), b3, voffB); PG8_STAGE(PG8_SB(1, 1), b3 + hstepB, voffB); PG8_STAGE(PG8_SA(1, 0), a3, voffA);
            PG8_WAIT_V(8); PG8_WAIT_L(0); PG8_BAR; PG8_MMA(1, 0, At, B0); PG8_MMA(1, 1, At, B1); PG8_BAR; PG8_SCHED;
            } else {
            PG8_LDB(B0, 0, 0); PG8_SCHED; PG8_LDA(At, 0, 0); PG8_STAGE(PG8_SA(1, 1), a1 + hstepA, voffA);
            PG8_WAIT_L(8); PG8_BAR; PG8_WAIT_L(0); PG8_MMA(0, 0, At, B0); PG8_BAR; PG8_SCHED;
            PG8_LDB(B1, 0, 1); PG8_STAGE(PG8_SB(0, 0), b2, voffB);
            PG8_BAR; PG8_WAIT_L(0); PG8_MMA(0, 1, At, B1); PG8_BAR;
            PG8_LDA(At, 0, 1); PG8_STAGE(PG8_SA(0, 0), a2, voffA);
            PG8_BAR; PG8_WAIT_L(0); PG8_MMA(1, 0, At, B0); PG8_BAR; PG8_SCHED;
            PG8_STAGE(PG8_SB(0, 1), b2 + hstepB, voffB);
            PG8_WAIT_V(6); PG8_BAR; PG8_MMA(1, 1, At, B1); PG8_BAR;
            PG8_LDB(B0, 1, 0); PG8_SCHED; PG8_LDA(At, 1, 0); PG8_STAGE(PG8_SA(0, 1), a2 + hstepA, voffA);
            PG8_WAIT_L(8); PG8_BAR; PG8_WAIT_L(0); PG8_MMA(0, 0, At, B0); PG8_BAR; PG8_SCHED;
            PG8_LDB(B1, 1, 1); PG8_STAGE(PG8_SB(1, 0), b3, voffB);
            PG8_BAR; PG8_WAIT_L(0); PG8_MMA(0, 1, At, B1); PG8_BAR;
            PG8_LDA(At, 1, 1); PG8_STAGE(PG8_SA(1, 0), a3, voffA);
            PG8_BAR; PG8_WAIT_L(0); PG8_MMA(1, 0, At, B0); PG8_BAR; PG8_SCHED;
            PG8_STAGE(PG8_SB(1, 1), b3 + hstepB, voffB);
            PG8_WAIT_V(6); PG8_BAR; PG8_MMA(1, 1, At, B1); PG8_BAR;
            }
        }
        if constexpr (ALIGN_EPI) { if (wr == 0) PG8_BAR; }
        if constexpr (!Epi::AFTER_DRAIN) { E(acc, cur, wr, wc, fr, fq); S.done(cur); }
        if (!has_next) break;
#pragma unroll
        for (int a = 0; a < 2; ++a)
#pragma unroll
            for (int b = 0; b < 2; ++b)
#pragma unroll
                for (int m = 0; m < 4; ++m)
#pragma unroll
                    for (int n = 0; n < 2; ++n) acc[a][b][m][n] = (f32x4){0.f, 0.f, 0.f, 0.f};
        cur = nxt; cA = nA; cB = nB; ++ui;
        if constexpr (ALIGN_EPI) { if (wr == 1) PG8_BAR; }
    }
    PG8_WAIT_V(0);
    if constexpr (!ALIGN_EPI) { if (wr == 0) PG8_BAR; }
    PG8_BAR;
    if constexpr (Epi::AFTER_DRAIN) { E.fused(acc, cur, wr, wc, fr, fq, lds, wid, lane); S.done(cur); }
#undef PG8_SA
#undef PG8_SB
#undef PG8_STAGE
#undef PG8_LDA
#undef PG8_LDB
#undef PG8_MMA
#undef PG8_WAIT_V
#undef PG8_WAIT_L
#undef PG8_BAR
#undef PG8_SCHED
}
}
namespace att {
using bf16 = __hip_bfloat16;
constexpr int   D = 128, NW = 8, QBLK = 32, KVBLK = 64;
constexpr float SCALE = 0.088388347648318440f;
constexpr float THR = 8.f;
constexpr int SDEPTH = 2;
constexpr int LDQ = 1536, LDK = 1536, LDO = 1024;
constexpr size_t SHM_V = KVBLK * D * 2, SHM_K = KVBLK * D * 2, SHM_ATTN = 2 * SHM_V + 2 * SHM_K + NW * 64 * 4;
using bf16x8 = __attribute__((ext_vector_type(8))) short;
using s16x4  = __attribute__((ext_vector_type(4))) short;
using f32x16 = __attribute__((ext_vector_type(16))) float;
using f32x8  = __attribute__((ext_vector_type(8))) float;
using u32x4  = __attribute__((ext_vector_type(4))) unsigned;
#define KSWZ(row, colB) ((row) * 256 + ((colB) ^ (((row) & 7) << 4)))
#define SBAR() __builtin_amdgcn_sched_barrier(0)
__device__ __forceinline__ int crow(int r, int hi) { return (r & 3) + 8 * (r >> 2) + 4 * hi; }
__device__ __forceinline__ unsigned cvtpk(float lo, float hi) {
  unsigned r; asm volatile("v_cvt_pk_bf16_f32 %0, %1, %2" : "=v"(r) : "v"(lo), "v"(hi)); return r;
}
template <typename TIn> struct Stage;
template <> struct Stage<bf16>  { using T = bf16x8;
  __device__ static __forceinline__ T ld8(const bf16* p) { return *reinterpret_cast<const bf16x8*>(p); }
  __device__ static __forceinline__ bf16x8 tobf(T x) { return x; } };
template <> struct Stage<float> { using T = f32x8;
  __device__ static __forceinline__ T ld8(const float* p) { return *reinterpret_cast<const f32x8*>(p); }
  __device__ static __forceinline__ bf16x8 tobf(T x) {
    u32x4 w = {cvtpk(x[0], x[1]), cvtpk(x[2], x[3]), cvtpk(x[4], x[5]), cvtpk(x[6], x[7])}; return *reinterpret_cast<bf16x8*>(&w); } };

__device__ __forceinline__ void partialSM(f32x16& p0, f32x16& p1, float& m_reg, float& mn, float& alpha) {
  constexpr float C = SCALE * 1.4426950408889634f;
  float pmax = p0[0]; for (int r = 1; r < 16; ++r) pmax = fmaxf(pmax, p0[r]); for (int r = 0; r < 16; ++r) pmax = fmaxf(pmax, p1[r]);
  { auto rr = __builtin_amdgcn_permlane32_swap(__float_as_uint(pmax), __float_as_uint(pmax), false, false);
    pmax = fmaxf(__uint_as_float(rr[0]), __uint_as_float(rr[1])); }
  if (__builtin_expect(__all(pmax - m_reg <= THR / SCALE), 1)) { mn = m_reg; alpha = 1.f; }
  else { mn = fmaxf(m_reg, pmax); alpha = __builtin_amdgcn_exp2f((m_reg - mn) * C); m_reg = mn; }
  float mnC = -mn * C;
  for (int r = 0; r < 16; ++r) p0[r] = fmaf(p0[r], C, mnC); for (int r = 0; r < 16; ++r) p1[r] = fmaf(p1[r], C, mnC);
  for (int r = 0; r < 16; ++r) p0[r] = __builtin_amdgcn_exp2f(p0[r]);
}
__device__ __forceinline__ void finishSM(f32x16& p0, f32x16& p1, float alpha, float& l_reg, bf16x8& pa0, bf16x8& pa1, bf16x8& pa2, bf16x8& pa3) {
  for (int r = 0; r < 16; ++r) p1[r] = __builtin_amdgcn_exp2f(p1[r]);
  float ps = 0; for (int r = 0; r < 16; ++r) ps += p0[r]; for (int r = 0; r < 16; ++r) ps += p1[r];
  { auto rr = __builtin_amdgcn_permlane32_swap(__float_as_uint(ps), __float_as_uint(ps), false, false);
    ps = __uint_as_float(rr[0]) + __uint_as_float(rr[1]); }
  l_reg = l_reg * alpha + ps;
#define PK4(P, BASE, OUT) do { unsigned a0 = cvtpk(P[BASE + 0], P[BASE + 1]), a1 = cvtpk(P[BASE + 2], P[BASE + 3]);   \
    unsigned b0 = cvtpk(P[BASE + 4], P[BASE + 5]), b1 = cvtpk(P[BASE + 6], P[BASE + 7]);                              \
    auto r0 = __builtin_amdgcn_permlane32_swap(a0, b0, false, false); auto r1 = __builtin_amdgcn_permlane32_swap(a1, b1, false, false); \
    u32x4 w = {r0[0], r1[0], r0[1], r1[1]}; OUT = *reinterpret_cast<bf16x8*>(&w); } while (0)
  PK4(p0, 0, pa0); PK4(p0, 8, pa1); PK4(p1, 0, pa2); PK4(p1, 8, pa3);
#undef PK4
}
__device__ __forceinline__ void qkt(f32x16& p0, f32x16& p1, const bf16* Ks, const bf16x8* qr, int r32, int hi) {
  p0 = f32x16{}; p1 = f32x16{};
  for (int d0 = 0; d0 < 8; ++d0) { int cb = (d0 * 16 + hi * 8) * 2;
    bf16x8 b0 = *reinterpret_cast<const bf16x8*>((const char*)Ks + KSWZ(r32, cb));
    bf16x8 b1 = *reinterpret_cast<const bf16x8*>((const char*)Ks + KSWZ(32 + r32, cb));
    p0 = __builtin_amdgcn_mfma_f32_32x32x16_bf16(b0, qr[d0], p0, 0, 0, 0);
    p1 = __builtin_amdgcn_mfma_f32_32x32x16_bf16(b1, qr[d0], p1, 0, 0, 0); }
}
__device__ __forceinline__ int v_st(int k, int c) { const int kk = (k & ~0xC) | ((k & 4) << 1) | ((k & 8) >> 1); return ((kk >> 3) * 4 + (c >> 5)) * 512 + ((kk & 7) * 32 + (c & 31)) * 2; }
__device__ __forceinline__ int v_rd_base(int lane) { return ((lane & 3) << 3) | (((lane >> 2) & 3) << 6) | (((lane >> 4) & 1) << 5) | (((lane >> 5) & 1) << 8); }
constexpr int v_rd_off(int d0, int ks, int half) { return d0 * 512 + ks * 4096 + half * 2048; }
template <int OFF> __device__ __forceinline__ s16x4 tr_read(int vb) {
  s16x4 r; asm volatile("ds_read_b64_tr_b16 %0, %1 offset:%2" : "=&v"(r) : "v"(vb), "i"(OFF) : "memory"); return r;
}
template <int D0> __device__ __forceinline__ void pv_one(f32x16& od, int vb, bf16x8 pa0, bf16x8 pa1, bf16x8 pa2, bf16x8 pa3) {
  const s16x4 l0 = tr_read<v_rd_off(D0, 0, 0)>(vb), h0 = tr_read<v_rd_off(D0, 0, 1)>(vb), l1 = tr_read<v_rd_off(D0, 1, 0)>(vb), h1 = tr_read<v_rd_off(D0, 1, 1)>(vb);
  const s16x4 l2 = tr_read<v_rd_off(D0, 2, 0)>(vb), h2 = tr_read<v_rd_off(D0, 2, 1)>(vb), l3 = tr_read<v_rd_off(D0, 3, 0)>(vb), h3 = tr_read<v_rd_off(D0, 3, 1)>(vb);
  asm volatile("s_waitcnt lgkmcnt(0)" ::: "memory"); SBAR();
#define PK(L, H) (bf16x8){L[0], L[1], L[2], L[3], H[0], H[1], H[2], H[3]}
  od = __builtin_amdgcn_mfma_f32_32x32x16_bf16(pa0, PK(l0, h0), od, 0, 0, 0);
  od = __builtin_amdgcn_mfma_f32_32x32x16_bf16(pa1, PK(l1, h1), od, 0, 0, 0);
  od = __builtin_amdgcn_mfma_f32_32x32x16_bf16(pa2, PK(l2, h2), od, 0, 0, 0);
  od = __builtin_amdgcn_mfma_f32_32x32x16_bf16(pa3, PK(l3, h3), od, 0, 0, 0);
#undef PK
}
__device__ __forceinline__ void pv_d0(f32x16* o, int vb, bf16x8 pa0, bf16x8 pa1, bf16x8 pa2, bf16x8 pa3) {
  pv_one<0>(o[0], vb, pa0, pa1, pa2, pa3); pv_one<1>(o[1], vb, pa0, pa1, pa2, pa3); pv_one<2>(o[2], vb, pa0, pa1, pa2, pa3); pv_one<3>(o[3], vb, pa0, pa1, pa2, pa3);
}

template <typename TQ>
__device__ __forceinline__ void attn_dense_body(const TQ* __restrict__ Qb, const bf16* __restrict__ Kh, const bf16* __restrict__ Vh,
                                                bf16* __restrict__ Ob, int seq, char* lds) {
  using St = Stage<bf16>; using SQ = Stage<TQ>;
  const int tid = tid_l(), wid = tid >> 6, lane = tid & 63, r32 = lane & 31, hi = lane >> 5;
  bf16* V_lds = (bf16*)lds; bf16* K_lds = (bf16*)(lds + 2 * SHM_V);
  float* ws = (float*)(lds + 2 * SHM_V + 2 * SHM_K) + wid * 64; float* li_l = ws; float* al_l = ws + 32;
  float m_reg = -1e30f, l_reg = 0; f32x16 o[4] = {}; bf16x8 qr[8];
  const TQ* Qw = Qb + (long)(wid * QBLK + r32) * LDQ + hi * 8;
#pragma unroll
  for (int d0 = 0; d0 < 8; ++d0) qr[d0] = SQ::tobf(SQ::ld8(Qw + d0 * 16));
  const int sr = tid >> 4, sc = (tid & 15) * 8, vst0 = v_st(sr, sc), vst1 = v_st(32 + sr, sc);
  const int vb0 = (int)(uintptr_t)V_lds + v_rd_base(lane);
  struct { typename St::T vs0, vs1, ks0, ks1; } sr_[SDEPTH];
#define SLOAD(i, k0) do { sr_[i].vs0 = St::ld8(&Vh[(long)((k0) + sr) * LDK + sc]); sr_[i].vs1 = St::ld8(&Vh[(long)((k0) + 32 + sr) * LDK + sc]); \
    sr_[i].ks0 = St::ld8(&Kh[(long)((k0) + sr) * LDK + sc]); sr_[i].ks1 = St::ld8(&Kh[(long)((k0) + 32 + sr) * LDK + sc]); } while (0)
#define SWRITE(b, i) do { *(bf16x8*)((char*)V_lds + (b) * SHM_V + vst0) = St::tobf(sr_[i].vs0);          \
    *(bf16x8*)((char*)V_lds + (b) * SHM_V + vst1) = St::tobf(sr_[i].vs1); int kc = sc * 2;               \
    *(bf16x8*)((char*)K_lds + (b) * SHM_K + KSWZ(sr, kc)) = St::tobf(sr_[i].ks0);                       \
    *(bf16x8*)((char*)K_lds + (b) * SHM_K + KSWZ(32 + sr, kc)) = St::tobf(sr_[i].ks1); } while (0)
#define SWAIT() do { if constexpr (SDEPTH == 2) asm volatile("s_waitcnt vmcnt(4)" ::: "memory"); else asm volatile("s_waitcnt vmcnt(0)" ::: "memory"); } while (0)
#define RESC(a) do { if (__any((a) < 1.f)) { if (hi == 0) al_l[r32] = (a); asm volatile("s_waitcnt lgkmcnt(0)" ::: "memory"); \
    for (int d = 0; d < 4; ++d) for (int r = 0; r < 16; ++r) o[d][r] *= al_l[crow(r, hi)]; } } while (0)
  f32x16 pA0, pA1, pB0, pB1; float mnA, mnB, alA, alB; bf16x8 pa0, pa1, pa2, pa3; const int NT = seq / KVBLK;
  constexpr int SE = 0, SO = SDEPTH - 1;
  SLOAD(SE, 0); asm volatile("s_waitcnt vmcnt(0)" ::: "memory"); SWRITE(0, SE); __syncthreads();
  qkt(pA0, pA1, K_lds, qr, r32, hi); partialSM(pA0, pA1, m_reg, mnA, alA);
  SLOAD(SO, KVBLK); if constexpr (SDEPTH == 2) { if (2 < NT) SLOAD(SE, 2 * KVBLK); }
  SWAIT(); SWRITE(1, SO); __syncthreads();
  for (int j = 1; j + 1 < NT; j += 2) {
    SBAR(); qkt(pB0, pB1, (bf16*)((char*)K_lds + SHM_K), qr, r32, hi);
    finishSM(pA0, pA1, alA, l_reg, pa0, pa1, pa2, pa3); SBAR();
    SLOAD(SO, (j + SDEPTH) * KVBLK); SBAR();
    pv_d0(o, vb0, pa0, pa1, pa2, pa3); partialSM(pB0, pB1, m_reg, mnB, alB);
    __syncthreads(); SWAIT(); SWRITE(0, SE);
    RESC(alB); __syncthreads();
    SBAR(); qkt(pA0, pA1, K_lds, qr, r32, hi);
    finishSM(pB0, pB1, alB, l_reg, pa0, pa1, pa2, pa3); SBAR();
    if (SDEPTH == 1 || j + 3 < NT) SLOAD(SE, (j + 1 + SDEPTH) * KVBLK); SBAR();
    pv_d0(o, vb0 + (int)SHM_V, pa0, pa1, pa2, pa3); partialSM(pA0, pA1, m_reg, mnA, alA);
    __syncthreads(); SWAIT(); SWRITE(1, SO);
    RESC(alA); __syncthreads();
  }
  SBAR(); qkt(pB0, pB1, (bf16*)((char*)K_lds + SHM_K), qr, r32, hi);
  finishSM(pA0, pA1, alA, l_reg, pa0, pa1, pa2, pa3); SBAR();
  pv_d0(o, vb0, pa0, pa1, pa2, pa3); partialSM(pB0, pB1, m_reg, mnB, alB);
  __syncthreads(); RESC(alB);
  finishSM(pB0, pB1, alB, l_reg, pa0, pa1, pa2, pa3); SBAR();
  pv_d0(o, vb0 + (int)SHM_V, pa0, pa1, pa2, pa3);
  if (hi == 0) li_l[r32] = l_reg; asm volatile("s_waitcnt lgkmcnt(0)" ::: "memory");
  float rli[16];
#pragma unroll
  for (int r = 0; r < 16; ++r) rli[r] = __builtin_amdgcn_rcpf(li_l[crow(r, hi)]);
  bf16* Ow = Ob + (long)(wid * QBLK) * LDO;
#pragma unroll
  for (int r = 0; r < 16; ++r) { int orow = crow(r, hi);
    for (int d0 = 0; d0 < 4; ++d0) Ow[(long)orow * LDO + d0 * 32 + r32] = __float2bfloat16(o[d0][r] * rli[r]); }
#undef SLOAD
#undef SWRITE
#undef SWAIT
#undef RESC
}
}
#define LAS __attribute__((address_space(3)))
typedef unsigned short bf16_t;
typedef short bf16x8 __attribute__((ext_vector_type(8)));
typedef float f32x4 __attribute__((ext_vector_type(4)));
typedef float f32x16 __attribute__((ext_vector_type(16)));
typedef unsigned u32x4 __attribute__((ext_vector_type(4)));
typedef unsigned u32x2 __attribute__((ext_vector_type(2)));

constexpr int DM = 1024, NB = 8, SEQ = 4096, CTXL = 256, TPB = SEQ + CTXL, MT = NB * TPB, DFF = 2816, DEPTH = 4;
constexpr int NQKV = 1536, NGIN = 3328;
constexpr float EPS = 1e-6f;
constexpr int LDS_BYTES = 147456;
constexpr int NTHREADS = 512;

constexpr size_t MiB = 1u << 20;
constexpr size_t WS_MOD = 1 * MiB;
constexpr size_t WS_W1T = 3 * MiB;
constexpr size_t WS_W2T = WS_W1T + 88 * MiB;
constexpr size_t WS_WQKVT = WS_W2T + 44 * MiB;
constexpr size_t WS_WOAT = WS_WQKVT + 6 * MiB;
constexpr size_t WS_WGINT = WS_WOAT + 4 * MiB;
constexpr size_t WS_WGOT = WS_WGINT + 13 * MiB;
constexpr size_t WS_HRES = WS_WGOT + 4 * MiB;
constexpr size_t WS_U = WS_HRES + 136 * MiB;
constexpr size_t WS_Y = WS_U + 68 * MiB;
constexpr size_t WS_BIG = WS_Y + 68 * MiB;
constexpr size_t WS_ATTNO = WS_BIG + 102 * MiB;
constexpr size_t WS_END = WS_BIG + 221 * MiB;
constexpr size_t WS_PART_IN_OUT = 112 * MiB;
static_assert((size_t)MT * NGIN * 2 <= 221 * MiB && (size_t)MT * DFF * 2 <= 221 * MiB && (size_t)MT * NQKV * 2 <= 102 * MiB, "ws map");

struct Args { const float* in[20]; float* out; unsigned char* ws; };
typedef const __attribute__((address_space(4))) Args* KA;
__device__ __forceinline__ KA kargs() { KA p = (KA)__builtin_amdgcn_kernarg_segment_ptr(); asm volatile("" : "+s"(p)); return p; }
enum { I_X = 0, I_C, I_CTX, I_CCTX, I_ADAW, I_ADAB, I_NPRE, I_NPOST, I_FW1, I_FW2, I_AQKV, I_AQG, I_AKG, I_AWO, I_GWIN, I_GWA1, I_GWA2, I_GBA, I_GOG, I_GWO };

__device__ __forceinline__ unsigned cvtpk(float lo, float hi) { return pg8::cvt_pk_bf16(lo, hi); }
__device__ __forceinline__ float bf_lo(unsigned w) { return __uint_as_float(w << 16); }
__device__ __forceinline__ float bf_hi(unsigned w) { return __uint_as_float(w & 0xffff0000u); }
__device__ __forceinline__ float bf_f(bf16_t h) { return __uint_as_float(((unsigned)h) << 16); }
__device__ __forceinline__ bf16_t f_bf(float f) { return (bf16_t)(cvtpk(f, 0.f) & 0xffffu); }
__device__ __forceinline__ float wave_sum(float v) {
#pragma unroll
    for (int o = 1; o < 64; o <<= 1) v += __shfl_xor(v, o);
    return v;
}
__device__ __forceinline__ float silu(float x) { return x / (1.0f + __expf(-x)); }

__device__ __forceinline__ void phase_mod(KA a, LAS unsigned char* lds) {
    LAS float* sv = (LAS float*)lds;
    LAS float* red = (LAS float*)(lds + 9 * 1024 * 4);
    const int tid = tid_l(), lane = tid & 63, wave = tid >> 6;
    const float* c = a->in[I_C]; const float* cc = a->in[I_CCTX];
    for (int i = tid; i < 9 * 1024; i += NTHREADS) { const int v = i >> 10, k = i & 1023; const float x = v < 8 ? c[v * 1024 + k] : cc[k]; sv[i] = silu(x); }
    __syncthreads();
    float* mod = (float*)(a->ws + WS_MOD);
    for (int it = blk_l(); it < DEPTH * 144; it += grd_l()) {
        const int L = it / 144, cgp = it % 144;
        const float* w = a->in[I_ADAW] + (size_t)L * 1024 * 9216 + cgp * 64 + lane;
        float acc[9];
#pragma unroll
        for (int v = 0; v < 9; ++v) acc[v] = 0.f;
        const int k0 = wave * 128;
#pragma unroll 8
        for (int k = 0; k < 128; ++k) { const float wv = w[(size_t)(k0 + k) * 9216];
#pragma unroll
            for (int v = 0; v < 9; ++v) acc[v] += sv[v * 1024 + k0 + k] * wv; }
#pragma unroll
        for (int v = 0; v < 9; ++v) red[(wave * 9 + v) * 64 + lane] = acc[v];
        __syncthreads();
        for (int i = tid; i < 576; i += NTHREADS) { const int v = i >> 6, l = i & 63; float s = 0.f;
#pragma unroll
            for (int w8 = 0; w8 < 8; ++w8) s += red[(w8 * 9 + v) * 64 + l];
            s += a->in[I_ADAB][L * 9216 + cgp * 64 + l];
            mod[(size_t)(L * 9 + v) * 9216 + cgp * 64 + l] = s; }
        __syncthreads();
    }
}

__device__ __forceinline__ unsigned pk2(float lo, float hi) { return cvtpk(lo, hi); }
__device__ __forceinline__ void tr_item(const float* W, int Nsrc, int srccol_l  , int k0, bf16_t* dst  , int K, LAS float* scr, int lane) {
#pragma unroll 8
    for (int i = 0; i < 32; ++i) { const int kk = 2 * i + (lane >> 5); scr[kk * 33 + (lane & 31)] = W[(size_t)(k0 + kk) * Nsrc + srccol_l]; }
    asm volatile("s_waitcnt lgkmcnt(0)" ::: "memory");
    const int c = lane & 7;
#pragma unroll
    for (int j = 0; j < 4; ++j) { const int n = (lane >> 3) + 8 * j; const LAS float* s = scr + (8 * c) * 33 + n;
        u32x4 o; o.x = pk2(s[0 * 33], s[1 * 33]); o.y = pk2(s[2 * 33], s[3 * 33]); o.z = pk2(s[4 * 33], s[5 * 33]); o.w = pk2(s[6 * 33], s[7 * 33]);
        *(u32x4*)(dst + (size_t)n * K + 8 * c) = o; }
    asm volatile("s_waitcnt lgkmcnt(0)" ::: "memory");
}
__device__ __forceinline__ void convert_layer(KA a, LAS unsigned char* lds, int L, int bfirst) {
    const int tid = tid_l(), lane = tid & 63, wave = tid >> 6;
    LAS float* scr = (LAS float*)(lds + 65536 + wave * 8704);
    const int gw = (blk_l() - bfirst) * 8 + wave, NGW = (grd_l() - bfirst) * 8;
    constexpr int I_W1 = 176 * 16, I_W2 = 32 * 44, I_QKV = 48 * 16, I_SQ = 32 * 16, I_GIN = 96 * 16;
    const bool attn = (L & 1) == 0; const int mx = L >> 1;
    const int N1 = 2 * I_W1, N2 = 2 * I_W2, N3 = attn ? I_QKV : I_GIN, N4 = I_SQ;
    const int NITEMS = N1 + N2 + N3 + N4;
    for (int it = gw; it < NITEMS; it += NGW) {
        int r = it;
        if (r < N1) { const int mat = 2 * L + r / I_W1, q = r % I_W1, ng = q / 16, kb = q % 16; const int pn = ng >> 3, r0 = (ng & 7) * 32;
            const int src = r0 < 128 ? 128 * pn + r0 : DFF + 128 * pn + (r0 - 128);
            tr_item(a->in[I_FW1] + (size_t)mat * 1024 * 5632, 5632, src + (lane & 31), kb * 64, (bf16_t*)(a->ws + WS_W1T) + (size_t)mat * 5632 * 1024 + (size_t)(ng * 32) * 1024 + kb * 64, 1024, scr, lane); continue; }
        r -= N1;
        if (r < N2) { const int mat = 2 * L + r / I_W2, q = r % I_W2, ng = q / 44, kb = q % 44;
            tr_item(a->in[I_FW2] + (size_t)mat * 2816 * 1024, 1024, ng * 32 + (lane & 31), kb * 64, (bf16_t*)(a->ws + WS_W2T) + (size_t)mat * 1024 * 2816 + (size_t)(ng * 32) * 2816 + kb * 64, 2816, scr, lane); continue; }
        r -= N2;
        if (r < N3) {
            if (attn) { const int ng = r / 16, kb = r % 16;
                int qsrc = ng * 32 + (lane & 31);
                if (ng < 40) { const int l = lane & 31, wcc = ng & 3, xi = wcc * 16 + (l >> 3) * 4 + (l & 3), x = xi < 32 ? xi : xi + 32; qsrc = (ng >> 2) * 128 + x + 32 * ((l >> 2) & 1); }
                tr_item(a->in[I_AQKV] + (size_t)mx * 1024 * 1536, 1536, qsrc, kb * 64, (bf16_t*)(a->ws + WS_WQKVT) + (size_t)mx * 1536 * 1024 + (size_t)(ng * 32) * 1024 + kb * 64, 1024, scr, lane); }
            else { const int ng = r / 16, kb = r % 16;
                tr_item(a->in[I_GWIN] + (size_t)mx * 1024 * 3072, 3072, ng * 32 + (lane & 31), kb * 64, (bf16_t*)(a->ws + WS_WGINT) + (size_t)mx * NGIN * 1024 + (size_t)(ng * 32) * 1024 + kb * 64, 1024, scr, lane); }
            continue; }
        r -= N3;
        { const int ng = r / 16, kb = r % 16;
            if (attn) tr_item(a->in[I_AWO] + (size_t)mx * 1024 * 1024, 1024, ng * 32 + (lane & 31), kb * 64, (bf16_t*)(a->ws + WS_WOAT) + (size_t)mx * 1024 * 1024 + (size_t)(ng * 32) * 1024 + kb * 64, 1024, scr, lane);
            else tr_item(a->in[I_GWO] + (size_t)mx * 1024 * 1024, 1024, ng * 32 + (lane & 31), kb * 64, (bf16_t*)(a->ws + WS_WGOT) + (size_t)mx * 1024 * 1024 + (size_t)(ng * 32) * 1024 + kb * 64, 1024, scr, lane); }
    }
    if (!attn) {
        const int gt = (blk_l() - bfirst) * NTHREADS + tid, NGT = (grd_l() - bfirst) * NTHREADS;
        for (int i = gt; i < 256 * 128; i += NGT) {
            const int jj = i / 128, k8 = (i % 128) * 8;
            float v[8];
#pragma unroll
            for (int e = 0; e < 8; ++e) v[e] = jj < 32 ? a->in[I_GWA1][((size_t)(mx * 2 + (jj >> 4)) * 1024 + k8 + e) * 16 + (jj & 15)] : 0.f;
            u32x4 o; o.x = pk2(v[0], v[1]); o.y = pk2(v[2], v[3]); o.z = pk2(v[4], v[5]); o.w = pk2(v[6], v[7]);
            *(u32x4*)((bf16_t*)(a->ws + WS_WGINT) + (size_t)mx * NGIN * 1024 + (size_t)(3072 + jj) * 1024 + k8) = o;
        }
    }
}

struct RowP { int Lpost, jpost; float gs; int Lpre, jpre; bool final_out; };
template <bool FROM_INPUT>
__device__ __forceinline__ void row_pair(KA a, const RowP p, int ra, int rb, bool ona, bool onb, int lane) {
    bf16_t* hres = (bf16_t*)(a->ws + WS_HRES); const float* mod = (const float*)(a->ws + WS_MOD);
    const bf16_t* Y = (const bf16_t*)(a->ws + WS_Y); bf16_t* U = (bf16_t*)(a->ws + WS_U);
    const float* gpost = a->in[I_NPOST] + (size_t)(p.Lpost * 3 + (p.jpost < 0 ? 0 : p.jpost)) * DM; const float* gpre = a->in[I_NPRE] + (size_t)(p.Lpre * 3 + (p.jpre < 0 ? 0 : p.jpre)) * DM;
    int rr[2] = {ra, rb}, bb[2], pp[2]; bool cx[2], on[2] = {ona, onb};
#pragma unroll
    for (int k = 0; k < 2; ++k) { bb[k] = rr[k] / TPB; pp[k] = rr[k] - bb[k] * TPB; cx[k] = pp[k] < CTXL; }
    f32x4 h[2][4], y[2][4];
#pragma unroll
    for (int k = 0; k < 2; ++k) {
        if (FROM_INPUT) { const float* src = cx[k] ? a->in[I_CTX] + (size_t)(bb[k] * CTXL + pp[k]) * DM : a->in[I_X] + (size_t)(bb[k] * SEQ + pp[k] - CTXL) * DM;
#pragma unroll
            for (int q = 0; q < 4; ++q) h[k][q] = *(const f32x4*)(src + 4 * lane + 256 * q); }
        else {
#pragma unroll
            for (int q = 0; q < 4; ++q) { const u32x2 w = *(const u32x2*)(hres + (size_t)rr[k] * DM + 4 * lane + 256 * q); h[k][q] = (f32x4){bf_lo(w.x), bf_hi(w.x), bf_lo(w.y), bf_hi(w.y)}; } }
        if (p.jpost >= 0) {
#pragma unroll
            for (int q = 0; q < 4; ++q) { const u32x2 w = *(const u32x2*)(Y + (size_t)rr[k] * DM + 4 * lane + 256 * q);
                y[k][q] = (f32x4){bf_lo(w.x), bf_hi(w.x), bf_lo(w.y), bf_hi(w.y)}; } }
    }
#pragma unroll
    for (int k = 0; k < 2; ++k) {
        const int mi = cx[k] ? 8 : bb[k];
        if (p.jpost >= 0) {
            float ss = 0.f;
#pragma unroll
            for (int q = 0; q < 4; ++q) ss += (y[k][q].x * y[k][q].x + y[k][q].y * y[k][q].y) + (y[k][q].z * y[k][q].z + y[k][q].w * y[k][q].w);
            const float rstd = 1.0f / sqrtf(wave_sum(ss) * (1.0f / DM) + EPS);
            const float* gate = mod + (size_t)(p.Lpost * 9 + mi) * 9216 + (3 * p.jpost + 2) * 1024;
#pragma unroll
            for (int q = 0; q < 4; ++q) { const f32x4 gt = *(const f32x4*)(gate + 4 * lane + 256 * q), gg = *(const f32x4*)(gpost + 4 * lane + 256 * q);
                h[k][q] += p.gs * gt * (y[k][q] * rstd * gg); }
        }
        if (on[k]) {
            if (p.final_out) { float* o = a->out + (size_t)(bb[k] * SEQ + pp[k] - CTXL) * DM;
#pragma unroll
                for (int q = 0; q < 4; ++q) *(f32x4*)(o + 4 * lane + 256 * q) = h[k][q]; }
            else {
#pragma unroll
                for (int q = 0; q < 4; ++q) { u32x2 w; w.x = cvtpk(h[k][q].x, h[k][q].y); w.y = cvtpk(h[k][q].z, h[k][q].w); *(u32x2*)(hres + (size_t)rr[k] * DM + 4 * lane + 256 * q) = w; } }
        }
        if (p.jpre >= 0) {
            float ss = 0.f;
#pragma unroll
            for (int q = 0; q < 4; ++q) ss += (h[k][q].x * h[k][q].x + h[k][q].y * h[k][q].y) + (h[k][q].z * h[k][q].z + h[k][q].w * h[k][q].w);
            const float rstd = 1.0f / sqrtf(wave_sum(ss) * (1.0f / DM) + EPS);
            const float* mb = mod + (size_t)(p.Lpre * 9 + mi) * 9216 + (3 * p.jpre) * 1024;
            if (on[k]) {
#pragma unroll
                for (int q = 0; q < 4; ++q) { const f32x4 sh = *(const f32x4*)(mb + 4 * lane + 256 * q), sc = *(const f32x4*)(mb + 1024 + 4 * lane + 256 * q), gg = *(const f32x4*)(gpre + 4 * lane + 256 * q);
                    const f32x4 u = h[k][q] * rstd * gg * (1.0f + sc) + sh;
                    u32x2 w; w.x = cvtpk(u.x, u.y); w.y = cvtpk(u.z, u.w); *(u32x2*)(U + (size_t)rr[k] * DM + 4 * lane + 256 * q) = w; } }
        }
    }
}
template <bool FROM_INPUT>
__device__ __forceinline__ void row_pass(KA a, const RowP p) {
    const int tid = tid_l(), lane = tid & 63, wave = tid >> 6;
    const int gw = blk_l() * 8 + wave, NGW = grd_l() * 8;
    for (int r0 = gw; r0 < MT; r0 += 2 * NGW) { const int r1 = r0 + NGW; const bool on1 = r1 < MT; row_pair<FROM_INPUT>(a, p, r0, on1 ? r1 : r0, true, on1, lane); }
}
__device__ __forceinline__ void row_pass_queue(KA a, const RowP p, unsigned* sig, unsigned need_lat, unsigned need_ctx, bool with_ctx, LAS unsigned char* lds) {
    const int tid = tid_l(), lane = tid & 63, wave = tid >> 6;
    volatile LAS unsigned* tk = (volatile LAS unsigned*)(lds + LDS_BYTES - 64 + 16);
    const unsigned nchunk = 512u + (with_ctx ? 32u : 0u);
    bool rdy_lat = false, rdy_ctx = false;
    for (;;) {
        if (tid == 0) tk[0] = __hip_atomic_fetch_add(sig + 128, 1u, __ATOMIC_RELAXED, __HIP_MEMORY_SCOPE_AGENT);
        __syncthreads();
        const unsigned t = tk[0];
        __syncthreads();
        if (t >= nchunk) break;
        const bool isc = t >= 512u;
        if (isc ? !rdy_ctx : !rdy_lat) {
            if (tid == 0) { unsigned* w = sig + (isc ? 64 : 0); const unsigned need = isc ? need_ctx : need_lat; unsigned sp = 0;
                while (__hip_atomic_load(w, __ATOMIC_RELAXED, __HIP_MEMORY_SCOPE_AGENT) < need) { __builtin_amdgcn_s_sleep(2); if (++sp > (1u << 22)) break; }
                __builtin_amdgcn_fence(__ATOMIC_ACQUIRE, "agent"); asm volatile("s_waitcnt vmcnt(0)" ::: "memory"); }
            __syncthreads();
            if (isc) rdy_ctx = true; else rdy_lat = true;
        }
        int rbase;
        if (!isc) { const int lr = (int)t * 64; rbase = (lr >> 12) * TPB + CTXL + (lr & 4095); }
        else { const int cr = ((int)t - 512) * 64; rbase = (cr >> 8) * TPB + (cr & 255); }
#pragma unroll 1
        for (int it = 0; it < 4; ++it) { const int r0 = rbase + wave * 8 + 2 * it; row_pair<false>(a, p, r0, r0 + 1, true, true, lane); }
    }
}

__device__ __forceinline__ void phase_qknorm_rope(KA a, int m) {
    const int tid = tid_l(), lane = tid & 63, wave = tid >> 6;
    const int gw = blk_l() * 8 + wave, NGW = grd_l() * 8;
    bf16_t* QKV = (bf16_t*)(a->ws + WS_BIG);
    const int i = lane & 31, hl = lane >> 5, d1 = i + 64 * hl, d2 = d1 + 32;
    const float qg1 = a->in[I_AQG][m * 128 + d1], qg2 = a->in[I_AQG][m * 128 + d2], kg1 = a->in[I_AKG][m * 128 + d1], kg2 = a->in[I_AKG][m * 128 + d2];
    const float inv = exp2f(-(float)i * (13.287712379549449f / 32.0f));
    for (int r = gw; r < MT; r += NGW) {
        const int b = r / TPB, pos = r - b * TPB; const bool isctx = pos < CTXL;
        float cs = 1.f, sn = 0.f;
        if (!isctx) { const int t = pos - CTXL; const float p = (float)(hl ? (t & 63) : (t >> 6)); const float ang = p * inv; cs = cosf(ang); sn = sinf(ang); }
        bf16_t* row = QKV + (size_t)r * NQKV;
#pragma unroll
        for (int hd = 0; hd < 10; ++hd) {
            float x1 = bf_f(row[hd * 128 + d1]), x2 = bf_f(row[hd * 128 + d2]);
            const float rstd = 1.0f / sqrtf(wave_sum(x1 * x1 + x2 * x2) * (1.0f / 128.0f) + EPS);
            x1 *= rstd * (hd < 8 ? qg1 : kg1); x2 *= rstd * (hd < 8 ? qg2 : kg2);
            const float o1 = x1 * cs - x2 * sn, o2 = x2 * cs + x1 * sn;
            row[hd * 128 + d1] = f_bf(o1); row[hd * 128 + d2] = f_bf(o2);
        }
    }
}

__device__ __forceinline__ void phase_attention(KA a, char* lds) {
    const int G = grd_l(); const int bx = blk_l(); const int vcu = (G % 8 == 0) ? (bx % 8) * (G / 8) + bx / 8 : bx;
    const att::bf16* QKV = (const att::bf16*)(a->ws + WS_BIG); att::bf16* AO = (att::bf16*)(a->ws + WS_ATTNO);
    for (int u = vcu; u < 1024 + 64; u += G) {
        int b, h, q0, seq;
        if (u < 1024) { const int grp = u >> 6, within = u & 63; b = grp >> 1; h = (grp & 1) * 4 + (within >> 4); q0 = CTXL + (within & 15) * 256; seq = TPB; }
        else { const int cu = u - 1024; b = cu >> 3; h = cu & 7; q0 = 0; seq = CTXL; }
        const int kvh = h >> 2; const size_t rb = (size_t)b * TPB;
        att::attn_dense_body<att::bf16>(QKV + (rb + q0) * NQKV + h * 128, QKV + rb * NQKV + 1024 + kvh * 128, QKV + rb * NQKV + 1280 + kvh * 128, AO + (rb + q0) * DM + h * 128, seq, lds);
        __syncthreads();
    }
}

namespace gla {
__device__ __forceinline__ int crow(int r, int hi) { return (r & 3) + 8 * (r >> 2) + 4 * hi; }
constexpr int QD_OFF = 0, KI_OFF = 17408, KET_OFF = 34816, VT_OFF = 53248  , SC_OFF = 90112, TS_OFF = 99328  , GSUM_OFF = 107520;
constexpr int STT_OFF = 0  , VTS_OFF = 34816  ;
constexpr size_t KET_BYTES = (size_t)2 * NB * 4 * 68 * 8192 * 2;
constexpr size_t SC_GOFF = KET_BYTES + (size_t)2 * NB * 4 * 68 * 128 * 4;
}
__device__ __forceinline__ void phase_gla_prep(KA a, int m, LAS unsigned char* lds) {
    using namespace gla;
    const int tid = tid_l(), lane = tid & 63, wave = __builtin_amdgcn_readfirstlane(tid >> 6), r32 = lane & 31, hi = lane >> 5;
    bf16_t* Gb = (bf16_t*)(a->ws + WS_BIG);
    const int d = tid & 127, tg = tid >> 7;
    LAS float* ts = (LAS float*)(lds + TS_OFF); LAS float* gsum = (LAS float*)(lds + GSUM_OFF);
    for (int item = blk_l(); item < NB * 4 * 68; item += grd_l()) {
        const int k = item % 68, h = (item / 68) & 3, b = item / 272;
        const int row0 = b * TPB + 64 * k;
        bf16_t* gp = Gb + (size_t)row0 * NGIN;
        bf16_t qn[16], kn[16];
#pragma unroll
        for (int ii = 0; ii < 16; ++ii) { qn[ii] = gp[(size_t)(16 * tg + ii) * NGIN + h * 128 + d]; kn[ii] = gp[(size_t)(16 * tg + ii) * NGIN + 512 + h * 128 + d]; }
        const u32x2 tw = *(const u32x2*)(gp + (size_t)(tid >> 3) * NGIN + 3072 + 4 * (tid & 7));
        __syncthreads();
        { const int e0 = 4 * (tid & 7), dr = e0 >> 4, r = e0 & 15; LAS float* tp = ts + dr * 1024 + (tid >> 3) * 16 + r;
          tp[0] = bf_lo(tw.x); tp[1] = bf_hi(tw.x); tp[2] = bf_lo(tw.y); tp[3] = bf_hi(tw.y); }
        __syncthreads();
        for (int dir = 0; dir < 2; ++dir) {
            float w2[16];
#pragma unroll
            for (int r = 0; r < 16; ++r) w2[r] = a->in[I_GWA2][((size_t)(m * 2 + dir) * 16 + r) * 512 + h * 128 + d];
            const float bav = a->in[I_GBA][(size_t)(m * 2 + dir) * 512 + h * 128 + d];
            float cum[16];
#pragma unroll
            for (int ii = 0; ii < 16; ++ii) { float x = bav;
#pragma unroll
                for (int r = 0; r < 16; ++r) x += ts[dir * 1024 + (16 * tg + ii) * 16 + r] * w2[r];
                cum[ii] = (fminf(x, 0.f) - __logf(1.0f + __expf(-fabsf(x)))) * (1.0f / 16.0f); }
            if (dir == 0) {
#pragma unroll
                for (int ii = 1; ii < 16; ++ii) cum[ii] += cum[ii - 1];
                gsum[tg * 128 + d] = cum[15];
            } else {
#pragma unroll
                for (int ii = 14; ii >= 0; --ii) cum[ii] += cum[ii + 1];
                gsum[tg * 128 + d] = cum[0];
            }
            __syncthreads();
            const size_t cidx = (size_t)((dir * NB + b) * 4 + h) * 68 + k;
            { const float s0 = gsum[d], s1 = gsum[128 + d], s2 = gsum[256 + d], s3 = gsum[384 + d];
              const float total = (s0 + s1) + (s2 + s3);
              float off;
              if (dir == 0) off = (tg > 0 ? s0 : 0.f) + (tg > 1 ? s1 : 0.f) + (tg > 2 ? s2 : 0.f);
              else off = (tg < 3 ? s3 : 0.f) + (tg < 2 ? s2 : 0.f) + (tg < 1 ? s1 : 0.f);
              unsigned kep[8];
              bf16_t* qdst = gp + (dir ? 512 : 0) + h * 128 + d;
#pragma unroll
              for (int ii = 0; ii < 16; ii += 2) {
                  const float c0 = cum[ii] + off, c1 = cum[ii + 1] + off;
                  const float q0 = bf_f(qn[ii]), q1 = bf_f(qn[ii + 1]), k0 = bf_f(kn[ii]), k1 = bf_f(kn[ii + 1]);
                  const int i0 = 16 * tg + ii;
                  const bf16_t qd0 = f_bf(q0 * 0.08838834764831845f * __expf(c0)), qd1 = f_bf(q1 * 0.08838834764831845f * __expf(c1));
                  *(LAS bf16_t*)(lds + QD_OFF + (i0 * 136 + d) * 2) = qd0;
                  *(LAS bf16_t*)(lds + QD_OFF + ((i0 + 1) * 136 + d) * 2) = qd1;
                  qdst[(size_t)i0 * NGIN] = qd0; qdst[(size_t)(i0 + 1) * NGIN] = qd1;
                  *(LAS bf16_t*)(lds + KI_OFF + (i0 * 136 + d) * 2) = f_bf(k0 * __expf(-c0));
                  *(LAS bf16_t*)(lds + KI_OFF + ((i0 + 1) * 136 + d) * 2) = f_bf(k1 * __expf(-c1));
                  kep[ii >> 1] = cvtpk(k0 * __expf(total - c0), k1 * __expf(total - c1));
              }
              bf16_t* ketg = (bf16_t*)a->out + cidx * 8192 + d * 64 + 16 * tg;
              *(u32x4*)ketg = (u32x4){kep[0], kep[1], kep[2], kep[3]};
              *(u32x4*)(ketg + 8) = (u32x4){kep[4], kep[5], kep[6], kep[7]};
              if (tg == 0) ((float*)((unsigned char*)a->out + KET_BYTES))[cidx * 128 + d] = __expf(total);
            }
            __syncthreads();
            if (wave < 4) {
                const int ti = (wave >> 1) & 1, tj = wave & 1;
                f32x16 acc;
#pragma unroll
                for (int r = 0; r < 16; ++r) acc[r] = 0.f;
                const int aoff = QD_OFF + ((32 * ti + r32) * 136 + 8 * hi) * 2, boff = KI_OFF + ((32 * tj + r32) * 136 + 8 * hi) * 2;
#pragma unroll
                for (int ks = 0; ks < 8; ++ks) { const bf16x8 av = *(const LAS bf16x8*)(lds + aoff + ks * 32), bv = *(const LAS bf16x8*)(lds + boff + ks * 32);
                    acc = __builtin_amdgcn_mfma_f32_32x32x16_bf16(av, bv, acc, 0, 0, 0); }
                bf16_t* scg = (bf16_t*)((unsigned char*)a->out + SC_GOFF) + cidx * 4096;
#pragma unroll
                for (int r = 0; r < 16; ++r) { const int i = 32 * ti + crow(r, hi), j = 32 * tj + r32; const bool keep = dir == 0 ? (j <= i) : (j >= i);
                    scg[i * 64 + j] = f_bf(keep ? acc[r] : 0.f); }
            }
            __syncthreads();
        }
    }
}
__device__ __forceinline__ void phase_gla_scan(KA a, int m, LAS unsigned char* lds) {
    using namespace gla;
    constexpr int O_STT = 0  , O_OST = 17408  , STG0 = 25600, STAGE = 54784, O_QD = 0, O_KET = 17408, O_SC = 35840, O_VT = 45056, O_DEC = 54272;
    const int tid = tid_l(), lane = tid & 63, wave = __builtin_amdgcn_readfirstlane(tid >> 6), r32 = lane & 31, hi = lane >> 5;
    const int G = grd_l(); const int bx = blk_l(); const int vcu = (G % 8 == 0) ? (bx % 8) * (G / 8) + bx / 8 : bx;
    const bf16_t* Gb = (const bf16_t*)(a->ws + WS_BIG);
    const int ti = (wave >> 1) & 1, tj = wave & 1, role = wave >> 2, sd = wave >> 1, sv = wave & 1;
    const int t8 = tid >> 3, p8 = tid & 7;
#define LBAR() do { asm volatile("s_waitcnt lgkmcnt(0)" ::: "memory"); __builtin_amdgcn_s_barrier(); asm volatile("" ::: "memory"); } while (0)
    for (int item = vcu; item < 256; item += G) {
        const int vs = item & 3, dir = (item >> 2) & 1, h = (item >> 3) & 3, b = item >> 5;
        bf16_t* Oo = (bf16_t*)(a->ws + (dir == 0 ? WS_U : WS_Y));
        const size_t cbase = (size_t)((dir * NB + b) * 4 + h) * 68;
        const bf16_t* ketg = (const bf16_t*)a->out + cbase * 8192;
        const bf16_t* scg = (const bf16_t*)((const unsigned char*)a->out + SC_GOFF) + cbase * 4096;
        const float* decg = (const float*)((const unsigned char*)a->out + KET_BYTES) + cbase * 128;
        const int qcol = (dir ? 512 : 0) + h * 128, vcol = 1024 + h * 256 + vs * 64, ocol = h * 256 + vs * 64;
        __syncthreads();
        for (int i = tid; i < 17408 / 4; i += NTHREADS) ((LAS unsigned*)(lds + O_STT))[i] = 0u;
        f32x16 st;
#pragma unroll
        for (int r = 0; r < 16; ++r) st[r] = 0.f;
        u32x4 rq0[2], rq1[2], rk0[2], rk1[2], rs0[2], rv0[2]; f32x4 rd0[2];
#define GLA_K(c) (dir == 0 ? (c) : ((c) < 4 ? 3 - (c) : 71 - (c)))
#define GLA_ROW(c) ((size_t)b * TPB + 64 * GLA_K(c))
#define GLA_FETCH(c, S) do { const int kk_ = GLA_K(c); const size_t row_ = GLA_ROW(c); \
            rq0[S] = *(const u32x4*)(Gb + (row_ + t8) * NGIN + qcol + 8 * p8); rq1[S] = *(const u32x4*)(Gb + (row_ + t8) * NGIN + qcol + 64 + 8 * p8); \
            rk0[S] = *(const u32x4*)(ketg + (size_t)kk_ * 8192 + tid * 8); rk1[S] = *(const u32x4*)(ketg + (size_t)kk_ * 8192 + 4096 + tid * 8); \
            rs0[S] = *(const u32x4*)(scg + (size_t)kk_ * 4096 + tid * 8); \
            rv0[S] = *(const u32x4*)(Gb + (row_ + t8) * NGIN + vcol + 8 * p8); \
            if (tid < 32) rd0[S] = *(const f32x4*)(decg + (size_t)kk_ * 128 + 4 * tid); } while (0)
#define GLA_STAGE(S, B) do { LAS unsigned char* sb_ = lds + STG0 + (B) * STAGE; \
            *(LAS u32x4*)(sb_ + O_QD + (t8 * 136 + 8 * p8) * 2) = rq0[S]; *(LAS u32x4*)(sb_ + O_QD + (t8 * 136 + 64 + 8 * p8) * 2) = rq1[S]; \
            *(LAS u32x4*)(sb_ + O_KET + (t8 * 72 + 8 * p8) * 2) = rk0[S]; *(LAS u32x4*)(sb_ + O_KET + ((64 + t8) * 72 + 8 * p8) * 2) = rk1[S]; \
            *(LAS u32x4*)(sb_ + O_SC + (t8 * 72 + 8 * p8) * 2) = rs0[S]; \
            _Pragma("unroll") for (int e = 0; e < 4; ++e) { const unsigned w_ = rv0[S][e]; \
                *(LAS bf16_t*)(sb_ + O_VT + ((8 * p8 + 2 * e) * 72 + t8) * 2) = (bf16_t)(w_ & 0xffffu); *(LAS bf16_t*)(sb_ + O_VT + ((8 * p8 + 2 * e + 1) * 72 + t8) * 2) = (bf16_t)(w_ >> 16); } \
            if (tid < 32) *(LAS f32x4*)(sb_ + O_DEC + 16 * tid) = rd0[S]; } while (0)
#define GLA_FLUSH(cprev) do { const u32x4 ov_ = *(const LAS u32x4*)(lds + O_OST + (t8 * 64 + 8 * p8) * 2); \
            *(u32x4*)(Oo + (GLA_ROW(cprev) + t8) * DM + ocol + 8 * p8) = ov_; } while (0)
#define GLA_COMPUTE(c) do { const int p_ = (c) & 1; const LAS unsigned char* sb_ = lds + STG0 + p_ * STAGE; \
            f32x16 acc; \
            if (role == 1) { \
                _Pragma("unroll") for (int r = 0; r < 16; ++r) acc[r] = 0.f; \
                { const int ao = O_QD + ((32 * ti + r32) * 136 + 8 * hi) * 2, bo = O_STT + ((32 * tj + r32) * 136 + 8 * hi) * 2; \
                  _Pragma("unroll") for (int ks = 0; ks < 8; ++ks) { const bf16x8 av = *(const LAS bf16x8*)(sb_ + ao + ks * 32), bv = *(const LAS bf16x8*)(lds + bo + ks * 32); \
                      acc = __builtin_amdgcn_mfma_f32_32x32x16_bf16(av, bv, acc, 0, 0, 0); } } \
                { const int ao = O_SC + ((32 * ti + r32) * 72 + 8 * hi) * 2, bo = O_VT + ((32 * tj + r32) * 72 + 8 * hi) * 2; \
                  _Pragma("unroll") for (int ks = 0; ks < 4; ++ks) { const bf16x8 av = *(const LAS bf16x8*)(sb_ + ao + ks * 32), bv = *(const LAS bf16x8*)(sb_ + bo + ks * 32); \
                      acc = __builtin_amdgcn_mfma_f32_32x32x16_bf16(av, bv, acc, 0, 0, 0); } } } \
            { const LAS float* dcp = (const LAS float*)(sb_ + O_DEC) + 32 * sd + 4 * hi; \
              _Pragma("unroll") for (int r4 = 0; r4 < 4; ++r4) { const f32x4 dq = *(const LAS f32x4*)(dcp + 8 * r4); st[4 * r4] *= dq[0]; st[4 * r4 + 1] *= dq[1]; st[4 * r4 + 2] *= dq[2]; st[4 * r4 + 3] *= dq[3]; } \
              const int ao = O_KET + ((32 * sd + r32) * 72 + 8 * hi) * 2, bo = O_VT + ((32 * sv + r32) * 72 + 8 * hi) * 2; \
              _Pragma("unroll") for (int ks = 0; ks < 4; ++ks) { const bf16x8 av = *(const LAS bf16x8*)(sb_ + ao + ks * 32), bv = *(const LAS bf16x8*)(sb_ + bo + ks * 32); \
                  st = __builtin_amdgcn_mfma_f32_32x32x16_bf16(av, bv, st, 0, 0, 0); } } \
            LBAR();                                                  \
            if (role == 1) { _Pragma("unroll") for (int r = 0; r < 16; ++r) *(LAS bf16_t*)(lds + O_OST + ((32 * ti + crow(r, hi)) * 64 + 32 * tj + r32) * 2) = f_bf(acc[r]); } \
            { _Pragma("unroll") for (int r4 = 0; r4 < 4; ++r4) { u32x2 w; w.x = cvtpk(st[4 * r4], st[4 * r4 + 1]); w.y = cvtpk(st[4 * r4 + 2], st[4 * r4 + 3]); \
                  *(LAS u32x2*)(lds + O_STT + ((32 * sv + r32) * 136 + 32 * sd + 8 * r4 + 4 * hi) * 2) = w; } } } while (0)
        GLA_FETCH(0, 0); GLA_STAGE(0, 0); GLA_FETCH(1, 1); GLA_FETCH(2, 0);
        for (int c = 0; c < 68; c += 2) {
            LBAR();
            if (c > 0) GLA_FLUSH(c - 1);
            GLA_STAGE(1, 1); if (c + 3 < 68) GLA_FETCH(c + 3, 1);
            GLA_COMPUTE(c);
            LBAR();
            GLA_FLUSH(c);
            if (c + 2 < 68) { GLA_STAGE(0, 0); if (c + 4 < 68) GLA_FETCH(c + 4, 0); }
            GLA_COMPUTE(c + 1);
        }
        LBAR();
        GLA_FLUSH(67);
#undef GLA_K
#undef GLA_ROW
#undef GLA_FETCH
#undef GLA_STAGE
#undef GLA_FLUSH
#undef GLA_COMPUTE
    }
#undef LBAR
}

__device__ __forceinline__ void phase_gla_readout(KA a, int m, bool skip_ctx) {
    const int tid = tid_l(), lane = tid & 63, wave = tid >> 6;
    const int gw = blk_l() * 8 + wave, NGW = grd_l() * 8;
    const bf16_t* OF = (const bf16_t*)(a->ws + WS_U); const bf16_t* OB = (const bf16_t*)(a->ws + WS_Y); bf16_t* Gb = (bf16_t*)(a->ws + WS_BIG);
    const float* og = a->in[I_GOG] + (size_t)m * 1024;
    for (int r = gw; r < MT; r += NGW) {
        if (skip_ctx && (r % TPB) < CTXL) continue;
#pragma unroll
        for (int q = 0; q < 4; ++q) {
            const int col = 4 * lane + 256 * q;
            const u32x2 wf = *(const u32x2*)(OF + (size_t)r * DM + col), wb = *(const u32x2*)(OB + (size_t)r * DM + col), wr = *(const u32x2*)(Gb + (size_t)r * NGIN + 2048 + col);
            f32x4 s = (f32x4){bf_lo(wf.x) + bf_lo(wb.x), bf_hi(wf.x) + bf_hi(wb.x), bf_lo(wf.y) + bf_lo(wb.y), bf_hi(wf.y) + bf_hi(wb.y)};
            const float ss = wave_sum((s.x * s.x + s.y * s.y) + (s.z * s.z + s.w * s.w));
            const float rstd = 1.0f / sqrtf(ss * (1.0f / 256.0f) + EPS);
            const f32x4 gg = *(const f32x4*)(og + col);
            const f32x4 rr = (f32x4){bf_lo(wr.x), bf_hi(wr.x), bf_lo(wr.y), bf_hi(wr.y)};
            f32x4 o = s * rstd * gg; o.x *= silu(rr.x); o.y *= silu(rr.y); o.z *= silu(rr.z); o.w *= silu(rr.w);
            u32x2 w; w.x = cvtpk(o.x, o.y); w.y = cvtpk(o.z, o.w);
            *(u32x2*)(Gb + (size_t)r * NGIN + 2048 + col) = w;
        }
    }
}

__device__ __forceinline__ unsigned long long rt() { return __builtin_amdgcn_s_memrealtime(); }
#define XB_TMO      128
#define XB_XCNT(j)  (256  + 64 * (j))
#define XB_XSUB(j)  (1280 + 64 * (j))
#define XB_XGEN(j)  (2304 + 64 * (j))
#define XB_TOP      3328
#define XB_TOPGEN   3392
#define XCD_BAR_WORDS 3456
#define XB_SPIN_CAP (1u << 18)

__device__ __forceinline__ unsigned xb_ld(unsigned* p)              { return __hip_atomic_load(p, __ATOMIC_RELAXED, __HIP_MEMORY_SCOPE_AGENT); }
__device__ __forceinline__ unsigned xb_add(unsigned* p, unsigned v) { return __hip_atomic_fetch_add(p, v, __ATOMIC_RELAXED, __HIP_MEMORY_SCOPE_AGENT); }
__device__ __forceinline__ unsigned xb_xcc_id() { return (unsigned)__builtin_amdgcn_s_getreg((3 << 11) | 20) & 0xFu; }
#define XB_SPIN(cond, bar) do { unsigned _sp = 0; while (cond) { __builtin_amdgcn_s_sleep(1); \
    if ((++_sp & 255u) == 0u) { if (xb_ld(&(bar)[XB_TMO])) break; if (_sp > XB_SPIN_CAP) { atomicAdd(&(bar)[XB_TMO], 1u); break; } } } } while (0)

struct XcdBarrier {
    unsigned* bar; unsigned x;
    volatile LAS unsigned* st;
};

__device__ __forceinline__ XcdBarrier xcd_barrier_post(unsigned* bar, volatile LAS unsigned* st) {
    XcdBarrier b; b.bar = bar; b.x = xb_xcc_id(); b.st = st;
    if (threadIdx.x == 0) (void)xb_add(&bar[XB_XCNT(b.x)], 1u);
    return b;
}
__device__ __forceinline__ void xcd_barrier_complete(unsigned* bar, unsigned x, unsigned& nloc, unsigned& nx) {
    const unsigned G = gridDim.x * gridDim.y * gridDim.z;
    unsigned sum, cnt, mine, sp = 0u;
    for (;;) {
        sum = 0u; cnt = 0u; mine = 0u;
#pragma unroll
        for (unsigned j = 0; j < 16; ++j) { const unsigned c = xb_ld(&bar[XB_XCNT(j)]); sum += c; cnt += (c > 0u) ? 1u : 0u; mine = (j == x) ? c : mine; }
        if (sum == G) break;
        __builtin_amdgcn_s_sleep(1);
        if ((++sp & 255u) == 0u) { if (xb_ld(&bar[XB_TMO])) break; if (sp > XB_SPIN_CAP) { atomicAdd(&bar[XB_TMO], 1u); break; } }
    }
    nloc = mine > 0u ? mine : 1u; nx = cnt > 0u ? cnt : 1u;
}

__device__ __forceinline__ void xcd_barrier(const XcdBarrier& b) {
    asm volatile("s_waitcnt vmcnt(0)" ::: "memory");
    __syncthreads();
    if (threadIdx.x == 0) {
        unsigned* bar = b.bar;
        __builtin_amdgcn_s_waitcnt(0);
        unsigned nloc = b.st[0], nx = b.st[1];
        if (nloc == 0u) { xcd_barrier_complete(bar, b.x, nloc, nx); b.st[0] = nloc; b.st[1] = nx; }
        const unsigned old = xb_add(&bar[XB_XSUB(b.x)], 1u);
        const unsigned gen = old / nloc;
        if (old + 1u == (gen + 1u) * nloc) {
            __builtin_amdgcn_fence(__ATOMIC_RELEASE, "agent");
            asm volatile("s_waitcnt vmcnt(0)" ::: "memory");
            const unsigned og = xb_add(&bar[XB_TOP], 1u);
            const unsigned tg = og / nx;
            if (og + 1u == (tg + 1u) * nx) xb_add(&bar[XB_TOPGEN], 1u);
            else XB_SPIN(xb_ld(&bar[XB_TOPGEN]) == tg, bar);
            __builtin_amdgcn_fence(__ATOMIC_ACQUIRE, "agent");
            xb_add(&bar[XB_XGEN(b.x)], 1u);
            asm volatile("s_waitcnt vmcnt(0)" ::: "memory");
        } else {
            XB_SPIN(xb_ld(&bar[XB_XGEN(b.x)]) == gen, bar);
            __builtin_amdgcn_fence(__ATOMIC_ACQUIRE, "agent");
            asm volatile("s_waitcnt vmcnt(0)" ::: "memory");
        }
    }
    __syncthreads();
}

constexpr size_t WS_BAR = 4096;
constexpr size_t WS_XCNT = 65536;
constexpr size_t WS_XBUF = WS_HRES + 68 * MiB;
constexpr size_t WS_DFLOW = 32768;
constexpr int LDS_BARW = LDS_BYTES - 64;
#define GSYNC() do { XcdBarrier b_; b_.bar = (unsigned*)(kargs()->ws + WS_BAR); b_.x = xb_xcc_id(); b_.st = (volatile LAS unsigned*)(lds + LDS_BARW); xcd_barrier(b_); } while (0)
struct EpiRow {
    static constexpr bool PERM = true, AFTER_DRAIN = false;
    int sl; LAS unsigned char* xl;
    __device__ __forceinline__ void operator()(f32x4 (&acc)[2][2][4][2], const pg8::Unit& u, int wr, int wc, int fr, int fq) const {
        KA a_ = kargs(); unsigned char* ws = a_->ws;
        const int L = sl / 3, jpost = sl - 3 * L; const bool lastsl = sl == 3 * DEPTH - 1;
        const int Ln = (jpost == 2) ? L + 1 : L, jn = (jpost == 2) ? 0 : jpost + 1, jpre = lastsl ? -1 : jn, final_out = lastsl ? 1 : 0;
        const float gs = jpost == 1 ? 1.0f : 0.5f;
        bf16_t* hres = (bf16_t*)(ws + WS_HRES); bf16_t* U = (bf16_t*)(ws + WS_U); float* out = a_->out;
        const float* modL_post = (const float*)(ws + WS_MOD) + (size_t)L * 9 * 9216; const float* modL_pre = (const float*)(ws + WS_MOD) + (size_t)(lastsl ? L : Ln) * 9 * 9216;
        const float* gpost = a_->in[I_NPOST] + (size_t)(L * 3 + jpost) * DM; const float* gpre = a_->in[I_NPRE] + (size_t)((lastsl ? L : Ln) * 3 + (lastsl ? 0 : jn)) * DM;
        unsigned* cn1 = (unsigned*)(ws + WS_XCNT) + (size_t)(sl * 2) * 136 * 64; unsigned* cn2 = cn1 + 136 * 64;
        float* xb1 = (float*)(ws + WS_XBUF); float* xb2 = (float*)(ws + WS_XBUF + MiB);
        const int tid = threadIdx.x, wid = __builtin_amdgcn_readfirstlane(tid >> 6), lane = tid & 63;
        const int bidx = u.pm / 17, isctx = (u.pm - 17 * bidx) == 0, mi = isctx ? 8 : bidx;
        const int col0 = u.pn * 256 + wc * 32 + 8 * fq, row0 = u.pm * 256 + wr * 64 + fr, rl0 = wr * 64 + fr;
        const LAS float* S = (const LAS float*)(xl + 4096);
        const float* gate = modL_post + (size_t)mi * 9216 + (3 * jpost + 2) * 1024 + col0;
        f32x4 gt[2][2], gp[2][2];
#pragma unroll
        for (int bj = 0; bj < 2; ++bj)
#pragma unroll
            for (int n = 0; n < 2; ++n) { gt[bj][n] = *(const f32x4*)(gate + bj * 128 + 4 * n) * gs; gp[bj][n] = *(const f32x4*)(gpost + col0 + bj * 128 + 4 * n); gt[bj][n] = gt[bj][n] * gp[bj][n]; }
        u32x4 hpre[1][4][2];
#pragma unroll
        for (int ai = 0; ai < 1; ++ai)
#pragma unroll
            for (int m = 0; m < 4; ++m)
#pragma unroll
                for (int bj = 0; bj < 2; ++bj) hpre[ai][m][bj] = *(const u32x4*)(hres + (size_t)(row0 + ai * 128 + m * 16) * 1024 + col0 + bj * 128);
        pg8::rowstats_run(xb1, cn1, acc, u, wr, wc, fr, fq, xl, wid, lane);
        {
#pragma unroll
            for (int ai = 0; ai < 2; ++ai)
#pragma unroll
                for (int m = 0; m < 4; ++m) {
                    const int rl = rl0 + ai * 128 + m * 16; const size_t roff = (size_t)(row0 + ai * 128 + m * 16) * 1024 + col0;
                    const float rstd = 1.0f / sqrtf(S[rl] * (1.0f / 1024.0f) + 1e-6f);
#pragma unroll
                    for (int bj = 0; bj < 2; ++bj) {
                        const u32x4 hw = ai == 0 ? hpre[0][m][bj] : *(const u32x4*)(hres + roff + bj * 128);
                        const f32x4 h0 = {__uint_as_float(hw.x << 16), __uint_as_float(hw.x & 0xffff0000u), __uint_as_float(hw.y << 16), __uint_as_float(hw.y & 0xffff0000u)};
                        const f32x4 h1 = {__uint_as_float(hw.z << 16), __uint_as_float(hw.z & 0xffff0000u), __uint_as_float(hw.w << 16), __uint_as_float(hw.w & 0xffff0000u)};
                        const f32x4 n0 = h0 + gt[bj][0] * (acc[ai][bj][m][0] * rstd), n1 = h1 + gt[bj][1] * (acc[ai][bj][m][1] * rstd);
                        acc[ai][bj][m][0] = n0; acc[ai][bj][m][1] = n1;
                        if (final_out) { float* op = out + (size_t)(bidx * 4096 + (u.pm - 17 * bidx - 1) * 256 + wr * 64 + fr + ai * 128 + m * 16) * 1024 + col0 + bj * 128; *(f32x4*)op = n0; *(f32x4*)(op + 4) = n1; }
                        else { u32x4 w; w.x = cvtpk(n0[0], n0[1]); w.y = cvtpk(n0[2], n0[3]); w.z = cvtpk(n1[0], n1[1]); w.w = cvtpk(n1[2], n1[3]); *(u32x4*)(hres + roff + bj * 128) = w; }
                    }
                }
        }
        if (jpre < 0) return;
        const float* mb = modL_pre + (size_t)mi * 9216 + (3 * jpre) * 1024 + col0;
        f32x4 sh[2][2], sc[2][2];
#pragma unroll
        for (int bj = 0; bj < 2; ++bj)
#pragma unroll
            for (int n = 0; n < 2; ++n) { sh[bj][n] = *(const f32x4*)(mb + bj * 128 + 4 * n); sc[bj][n] = (1.0f + *(const f32x4*)(mb + 1024 + bj * 128 + 4 * n)) * *(const f32x4*)(gpre + col0 + bj * 128 + 4 * n); }
        pg8::rowstats_run(xb2, cn2, acc, u, wr, wc, fr, fq, xl, wid, lane);
        {
#pragma unroll
            for (int ai = 0; ai < 2; ++ai)
#pragma unroll
                for (int m = 0; m < 4; ++m) {
                    const int rl = rl0 + ai * 128 + m * 16; const size_t roff = (size_t)(row0 + ai * 128 + m * 16) * 1024 + col0;
                    const float rstd = 1.0f / sqrtf(S[rl] * (1.0f / 1024.0f) + 1e-6f);
#pragma unroll
                    for (int bj = 0; bj < 2; ++bj) {
                        const f32x4 u0 = acc[ai][bj][m][0] * rstd * sc[bj][0] + sh[bj][0], u1 = acc[ai][bj][m][1] * rstd * sc[bj][1] + sh[bj][1];
                        u32x4 w; w.x = cvtpk(u0[0], u0[1]); w.y = cvtpk(u0[2], u0[3]); w.z = cvtpk(u1[0], u1[1]); w.w = cvtpk(u1[2], u1[3]);
                        *(u32x4*)(U + roff + bj * 128) = w;
                    }
                }
        }
    }
};

struct EpiQKV {
    static constexpr bool PERM = true, AFTER_DRAIN = false;
    int m; LAS unsigned char* xl;
    __device__ __forceinline__ void operator()(f32x4 (&acc)[2][2][4][2], const pg8::Unit& u, int wr, int wc, int fr, int fq) const {
        KA a_ = kargs(); bf16_t* O = (bf16_t*)(a_->ws + WS_BIG);
        const int row0 = u.pm * 256 + wr * 64 + fr, col0 = u.pn * 256 + wc * 32 + 8 * fq;
        if (u.pn < 5) {
            LAS float* P = (LAS float*)xl;
#pragma unroll
            for (int ai = 0; ai < 2; ++ai)
#pragma unroll
                for (int m4 = 0; m4 < 4; ++m4)
#pragma unroll
                    for (int bj = 0; bj < 2; ++bj) {
                        const f32x4 a0 = acc[ai][bj][m4][0], a1 = acc[ai][bj][m4][1];
                        float s = ((a0[0] * a0[0] + a0[1] * a0[1]) + (a0[2] * a0[2] + a0[3] * a0[3])) + ((a1[0] * a1[0] + a1[1] * a1[1]) + (a1[2] * a1[2] + a1[3] * a1[3]));
                        s += __shfl_xor(s, 16); s += __shfl_xor(s, 32);
                        if (fq == 0) P[((ai * 128 + wr * 64 + m4 * 16 + fr) * 2 + bj) * 4 + wc] = s;
                    }
            asm volatile("s_waitcnt lgkmcnt(0)" ::: "memory"); __builtin_amdgcn_s_barrier(); asm volatile("" ::: "memory");
            const float* gain = a_->in[u.pn < 4 ? I_AQG : I_AKG] + m * 128;
            const int xi0 = wc * 16 + fq * 4, x0 = xi0 < 32 ? xi0 : xi0 + 32;
            const f32x4 g0 = *(const f32x4*)(gain + x0), g1 = *(const f32x4*)(gain + x0 + 32);
            const int fi0 = (wc & 1) * 16 + fq * 4;
            f32x4 inv;
#pragma unroll
            for (int e = 0; e < 4; ++e) inv[e] = exp2f(-(float)(fi0 + e) * (13.287712379549449f / 32.0f)) * 0.15915494309189535f;
            const int bidx = u.pm / 17, ptile = u.pm - 17 * bidx; const bool isctx = ptile == 0;
#pragma unroll
            for (int ai = 0; ai < 2; ++ai)
#pragma unroll
                for (int m4 = 0; m4 < 4; ++m4) {
                    const int rl = ai * 128 + wr * 64 + m4 * 16 + fr;
                    f32x4 cs = {1.f, 1.f, 1.f, 1.f}, sn = {0.f, 0.f, 0.f, 0.f};
                    if (!isctx) { const int t = (ptile - 1) * 256 + rl; const float p = (float)(wc < 2 ? (t >> 6) : (t & 63));
#pragma unroll
                        for (int e = 0; e < 4; ++e) { const float rev = p * inv[e]; sn[e] = __builtin_amdgcn_sinf(rev); cs[e] = __builtin_amdgcn_cosf(rev); } }
#pragma unroll
                    for (int bj = 0; bj < 2; ++bj) {
                        const LAS float* pp = P + (rl * 2 + bj) * 4;
                        const float rstd = 1.0f / sqrtf(((pp[0] + pp[1]) + (pp[2] + pp[3])) * (1.0f / 128.0f) + EPS);
                        const f32x4 x1 = acc[ai][bj][m4][0] * rstd * g0, x2 = acc[ai][bj][m4][1] * rstd * g1;
                        const f32x4 o1 = x1 * cs - x2 * sn, o2 = x2 * cs + x1 * sn;
                        u32x4 w; w.x = cvtpk(o1[0], o1[1]); w.y = cvtpk(o1[2], o1[3]); w.z = cvtpk(o2[0], o2[1]); w.w = cvtpk(o2[2], o2[3]);
                        *(u32x4*)(O + (size_t)(row0 + ai * 128 + m4 * 16) * NQKV + col0 + bj * 128) = w;
                    }
                }
        } else {
#pragma unroll
            for (int ai = 0; ai < 2; ++ai)
#pragma unroll
                for (int m4 = 0; m4 < 4; ++m4)
#pragma unroll
                    for (int bj = 0; bj < 2; ++bj) { const f32x4 v0 = acc[ai][bj][m4][0], v1 = acc[ai][bj][m4][1];
                        u32x4 w; w.x = cvtpk(v0[0], v0[1]); w.y = cvtpk(v0[2], v0[3]); w.z = cvtpk(v1[0], v1[1]); w.w = cvtpk(v1[2], v1[3]);
                        *(u32x4*)(O + (size_t)(row0 + ai * 128 + m4 * 16) * NQKV + col0 + bj * 128) = w; }
        }
    }
};

__global__ void __launch_bounds__(NTHREADS, 2) fwd_megakernel(Args unused_args) {
    extern __shared__ __attribute__((aligned(16))) unsigned char lds_raw[];
    LAS unsigned char* lds = (LAS unsigned char*)lds_raw;
    cg::grid_group grid = cg::this_grid();
    if (threadIdx.x < 16) ((LAS unsigned*)(lds + LDS_BARW))[threadIdx.x] = 0u;
    __syncthreads();
    (void)xcd_barrier_post((unsigned*)(kargs()->ws + WS_BAR), (volatile LAS unsigned*)(lds + LDS_BARW));

#ifndef SKIP_MOD
    phase_mod(kargs(), lds);
#endif
    convert_layer(kargs(), lds, 0, 0);
    grid.sync();
    row_pass<true>(kargs(), RowP{0, -1, 0.f, 0, 0, false});
    GSYNC();

    for (int sl = 0; sl < 3 * DEPTH; ++sl) {
        const int L = sl / 3, j = sl - 3 * L, m = L >> 1;
        if (j != 1) {
            unsigned char* ws = kargs()->ws; const int f = j >> 1;
            pg8::Gemm g1{(const bf16_t*)(ws + WS_U), (const bf16_t*)(ws + WS_W1T) + (size_t)(L * 2 + f) * 5632 * 1024, MT, 2 * DFF, DM, DM, DM};
            pg8::StaticOrder S; S.init(MT, 2 * DFF, DM, grd_l(), blk_l(), sl == 3 * DEPTH - 1 ? 2 : 0);
            pg8::EpiSwiglu E{(bf16_t*)(ws + WS_BIG), DFF};
#ifndef SKIP_G1
            pg8::gemm_phase<pg8::EpiSwiglu, pg8::StaticOrder, true, true>(lds, g1, S, E);
#endif
            GSYNC();
        } else {
            const bool attn = (L & 1) == 0;
            { unsigned char* ws = kargs()->ws;
              pg8::Gemm g1{(const bf16_t*)(ws + WS_U), attn ? (const bf16_t*)(ws + WS_WQKVT) + (size_t)m * NQKV * 1024 : (const bf16_t*)(ws + WS_WGINT) + (size_t)m * NGIN * 1024, MT, attn ? NQKV : NGIN, DM, DM, DM};
              pg8::StaticOrder S; S.init(MT, g1.N, DM, grd_l(), blk_l(), 0);
              pg8::EpiBf16s E{(bf16_t*)(ws + WS_BIG), g1.N, nullptr};
              if (attn) { EpiQKV EQ{m, lds + 131072}; pg8::gemm_phase<EpiQKV, pg8::StaticOrder, true, true>(lds, g1, S, EQ); }
              else pg8::gemm_phase<pg8::EpiBf16s, pg8::StaticOrder, true, true>(lds, g1, S, E);
 }
            GSYNC();
            if (attn) {
#ifndef SKIP_ATT
                phase_attention(kargs(), (char*)lds_raw);
#endif
                GSYNC();
            } else {
                phase_gla_prep(kargs(), m, lds);
                GSYNC();
                phase_gla_scan(kargs(), m, lds);
                GSYNC();
#ifndef SKIP_RO
                phase_gla_readout(kargs(), m, sl >= 10);
#endif
                GSYNC();
            }
        }
        {
            unsigned char* ws = kargs()->ws;
            pg8::Gemm g2;
            if (j != 1) g2 = pg8::Gemm{(const bf16_t*)(ws + WS_BIG), (const bf16_t*)(ws + WS_W2T) + (size_t)(L * 2 + (j >> 1)) * 1024 * 2816, MT, DM, DFF, DFF, DFF};
            else if ((L & 1) == 0) g2 = pg8::Gemm{(const bf16_t*)(ws + WS_ATTNO), (const bf16_t*)(ws + WS_WOAT) + (size_t)m * 1024 * 1024, MT, DM, DM, DM, DM};
            else g2 = pg8::Gemm{(const bf16_t*)(ws + WS_BIG) + 2048, (const bf16_t*)(ws + WS_WGOT) + (size_t)m * 1024 * 1024, MT, DM, DM, NGIN, DM};
            pg8::StaticOrder S; S.init(MT, DM, g2.K, grd_l(), blk_l(), sl >= 10 ? 2 : 3);
            EpiRow E{sl, lds + 131072};
#ifndef SKIP_G2
            pg8::gemm_phase<EpiRow, pg8::StaticOrder, true, true>(lds, g2, S, E);
#endif
            if (j == 0 && L + 1 < DEPTH && blk_l() >= 32) convert_layer(kargs(), lds, L + 1, 32);
        }
        const bool last = sl == 3 * DEPTH - 1;
        if (!last) GSYNC();
    }
}

extern "C" void kernel_launch(void* const* d_in, const int* in_sizes, int n_in, void* d_out, int out_size, void* d_ws, size_t ws_size, hipStream_t stream) {
    static int grid = 0;
    if (grid == 0) {
        if (n_in != 20 || out_size != NB * SEQ * DM || ws_size < WS_END) { fprintf(stderr, "kernel_launch: unexpected shapes: n_in %d out %d ws %zu (need %zu)\n", n_in, out_size, ws_size, (size_t)WS_END); grid = -1; return; }
        int dev = 0, cus = 0, per_cu = 0;
        (void)hipGetDevice(&dev);
        (void)hipDeviceGetAttribute(&cus, hipDeviceAttributeMultiprocessorCount, dev);
        (void)hipFuncSetAttribute((const void*)fwd_megakernel, hipFuncAttributeMaxDynamicSharedMemorySize, LDS_BYTES);
        (void)hipOccupancyMaxActiveBlocksPerMultiprocessor(&per_cu, (const void*)fwd_megakernel, NTHREADS, LDS_BYTES);
        if (per_cu < 1) per_cu = 1;
        grid = cus * per_cu;
        if (grid > 256) grid = 256;
        if (grid < 256) { fprintf(stderr, "kernel_launch: %d co-resident workgroups < 256: this build needs 256; nothing launched\n", grid); grid = -1; return; }
        fprintf(stderr, "kernel_launch: grid %d (cus %d x %d), ws %zu\n", grid, cus, per_cu, ws_size);
    }
    if (grid < 0) return;
    (void)hipMemsetAsync(d_ws, 0, 1 * MiB, stream);
    Args a{};
    for (int i = 0; i < 20; ++i) a.in[i] = (const float*)d_in[i];
    a.out = (float*)d_out; a.ws = (unsigned char*)d_ws;
    void* args[] = {&a};
    hipError_t e = hipLaunchCooperativeKernel((const void*)fwd_megakernel, dim3(grid), dim3(NTHREADS), args, LDS_BYTES, stream);
    if (e != hipSuccess) fprintf(stderr, "kernel_launch: cooperative launch failed: %s (grid %d)\n", hipGetErrorString(e), grid);
}
```

```cpp
#include <hip/hip_runtime.h>
#include <hip/hip_cooperative_groups.h>
#include <hip/hip_bf16.h>
#include <cstdio>
#include <cstdint>
namespace cg = cooperative_groups;
__device__ __forceinline__ int tid_l() { int t = threadIdx.x; asm volatile("" : "+v"(t)); return t; }
__device__ __forceinline__ int blk_l() { int t = blockIdx.x; asm volatile("" : "+s"(t)); return t; }
__device__ __forceinline__ int grd_l() { int t = gridDim.x; asm volatile("" : "+s"(t)); return t; }
namespace pg8 {
#define PG8_LAS __attribute__((address_space(3)))
typedef unsigned short bf16_t;
typedef short bf16x8 __attribute__((ext_vector_type(8)));
typedef float f32x4 __attribute__((ext_vector_type(4)));
typedef unsigned u32x4 __attribute__((ext_vector_type(4)));
constexpr int BM = 256, BK = 64, HALF = 128, HTB = HALF * BK * 2  , STAGE_BYTES = 8 * HTB, NXCD = 8, WGM = 8;

__host__ __device__ __forceinline__ int lds_byte(int r, int c) { const int st = (r >> 4) * 2 + (c >> 5), rr = r & 15, cc = c & 31, ob = rr * 64 + cc * 2; return st * 1024 + (ob ^ (((ob >> 9) & 1) << 5)); }
__host__ __device__ __forceinline__ void stage_rc(int b, int& R, int& C) { const int st = b / 1024, sb = b % 1024, swz = sb ^ (((sb >> 9) & 1) << 5); R = (st >> 1) * 16 + swz / 64; C = (st & 1) * 32 + (swz % 64) / 2; }
__host__ __device__ __forceinline__ int perm32(int rho) { const int n = rho >> 4, i = rho & 15; return 8 * (i >> 2) + 4 * n + (i & 3); }

struct Unit { int pm, pn, kt0, nt, part, sig; };
struct Gemm { const bf16_t* A; const bf16_t* Bt; int M, N, K, lda, ldb; };

struct StaticOrder {
    int nM, nN, nwg, G, c, mode, ntfull; unsigned* sig;
    __host__ __device__ void init(int M, int N, int K, int G_, int c_, int mode_) { mode = mode_; nM = mode ? 128 : M / BM; nN = N / BM; nwg = mode == 4 ? 0 : nM * nN; G = G_; c = c_; ntfull = K / BK; sig = nullptr; }
    __host__ __device__ __forceinline__ bool next(int i, Unit& u) const {
        const long L = (long)i * G + c;
        int pm = 0, pn = 0, kt0 = 0, nt = ntfull, part = -1, sg = 0; bool ok = true;
        if (L >= nwg) {
            const int e = (int)(L - nwg);
            if (mode == 3) { ok = e < 8 * nN; pm = 17 * (e / nN); pn = e % nN; sg = 2; }
            else { ok = (mode == 1 || mode == 4) && (e < 16 * nN); const int ct = e >> 1; pm = 17 * (ct / nN); pn = ct % nN; part = e & 1; nt = ntfull >> 1; kt0 = part * nt; }
        } else {
            int wgid = (int)L; { const int q = nwg / NXCD, r = nwg % NXCD, xcd = wgid % NXCD, off = wgid / NXCD; wgid = (xcd < r ? xcd * (q + 1) : r * (q + 1) + (xcd - r) * q) + off; }
            const int nig = WGM * nN, gid = wgid / nig, fm = gid * WGM, gsz = (nM - fm) < WGM ? (nM - fm) : WGM;
            pm = fm + ((wgid % nig) % gsz); pn = (wgid % nig) / gsz;
            if (mode) pm += (pm >> 4) + 1;
            sg = (mode >= 2 && L + G >= nwg) ? 1 : 0;
        }
        u.pm = pm; u.pn = pn; u.kt0 = kt0; u.nt = nt; u.part = part; u.sig = sg;
        return ok;
    }
    __device__ __forceinline__ void a_ready(const Unit&) const {}
    __device__ __forceinline__ void done(const Unit& u) const {
        if (sig != nullptr && u.sig != 0) {
            asm volatile("s_waitcnt vmcnt(0)" ::: "memory");
            __builtin_amdgcn_s_barrier(); asm volatile("" ::: "memory");
            if (threadIdx.x == 0) {
                __builtin_amdgcn_fence(__ATOMIC_RELEASE, "agent");
                asm volatile("s_waitcnt vmcnt(0)" ::: "memory");
                __hip_atomic_fetch_add(sig + (u.sig == 1 ? 0 : 64), 1u, __ATOMIC_RELAXED, __HIP_MEMORY_SCOPE_AGENT);
            }
        }
    }
};

typedef float f32x2c_t __attribute__((ext_vector_type(2))); typedef __bf16 bf16x2c_t __attribute__((ext_vector_type(2)));
__device__ __forceinline__ unsigned cvt_pk_bf16(float lo, float hi) { f32x2c_t v = {lo, hi}; bf16x2c_t b = __builtin_convertvector(v, bf16x2c_t); return __builtin_bit_cast(unsigned, b); }
typedef float f32x2 __attribute__((ext_vector_type(2)));
struct EpiBf16s {
    static constexpr bool PERM = true, AFTER_DRAIN = false;
    bf16_t* O; int ldc; float* P;
    __device__ __forceinline__ void operator()(const f32x4 (&acc)[2][2][4][2], const Unit& u, int wr, int wc, int fr, int fq) const {
        const int row0 = u.pm * BM + wr * 64 + fr; const int col0 = u.pn * BM + wc * 32 + 8 * fq;
        if (u.part >= 0) {
            float* pb = P + (size_t)u.part * 2048 * ldc + (size_t)((u.pm / 17) * BM + wr * 64 + fr) * ldc + col0;
#pragma unroll
            for (int ai = 0; ai < 2; ++ai)
#pragma unroll
                for (int m = 0; m < 4; ++m)
#pragma unroll
                    for (int bj = 0; bj < 2; ++bj) { float* rp = pb + (size_t)(ai * HALF + m * 16) * ldc + bj * HALF; *(f32x4*)rp = acc[ai][bj][m][0]; *(f32x4*)(rp + 4) = acc[ai][bj][m][1]; }
            return;
        }
#pragma unroll
        for (int ai = 0; ai < 2; ++ai)
#pragma unroll
            for (int m = 0; m < 4; ++m) { bf16_t* rowp = O + (size_t)(row0 + ai * HALF + m * 16) * ldc + col0;
#pragma unroll
                for (int bj = 0; bj < 2; ++bj) { const f32x4 v0 = acc[ai][bj][m][0], v1 = acc[ai][bj][m][1];
                    u32x4 w; w.x = cvt_pk_bf16(v0[0], v0[1]); w.y = cvt_pk_bf16(v0[2], v0[3]); w.z = cvt_pk_bf16(v1[0], v1[1]); w.w = cvt_pk_bf16(v1[2], v1[3]);
                    *(u32x4*)(rowp + bj * HALF) = w; } }
    }
};
__device__ __forceinline__ float silu_f(float g) { return g * __builtin_amdgcn_rcpf(1.0f + __expf(-g)); }
struct EpiSwiglu {
    static constexpr bool PERM = true, AFTER_DRAIN = false;
    bf16_t* H; int ldh;
    __device__ __forceinline__ void operator()(const f32x4 (&acc)[2][2][4][2], const Unit& u, int wr, int wc, int fr, int fq) const {
        const int row0 = u.pm * BM + wr * 64 + fr; const int col0 = u.pn * HALF + wc * 32 + 8 * fq;
#pragma unroll
        for (int ai = 0; ai < 2; ++ai)
#pragma unroll
            for (int m = 0; m < 4; ++m) { bf16_t* rowp = H + (size_t)(row0 + ai * HALF + m * 16) * ldh + col0;
                const f32x4 g0 = acc[ai][0][m][0], g1 = acc[ai][0][m][1], u0 = acc[ai][1][m][0], u1 = acc[ai][1][m][1];
                u32x4 w;
                w.x = cvt_pk_bf16(silu_f(g0[0]) * u0[0], silu_f(g0[1]) * u0[1]); w.y = cvt_pk_bf16(silu_f(g0[2]) * u0[2], silu_f(g0[3]) * u0[3]);
                w.z = cvt_pk_bf16(silu_f(g1[0]) * u1[0], silu_f(g1[1]) * u1[1]); w.w = cvt_pk_bf16(silu_f(g1[2]) * u1[2], silu_f(g1[3]) * u1[3]);
                *(u32x4*)rowp = w; }
    }
};
__device__ __forceinline__ void rowstats_run(float* xbuf  , unsigned* cnt  , const f32x4 (&v)[2][2][4][2], const Unit& u, int wr, int wc, int fr, int fq, PG8_LAS unsigned char* xl, int wid, int lane) {
        PG8_LAS float* P = (PG8_LAS float*)xl;
        PG8_LAS float* S = (PG8_LAS float*)(xl + 4096);
#pragma unroll
        for (int ai = 0; ai < 2; ++ai)
#pragma unroll
            for (int m = 0; m < 4; ++m) {
                float s = 0.f;
#pragma unroll
                for (int bj = 0; bj < 2; ++bj)
#pragma unroll
                    for (int n = 0; n < 2; ++n) { const f32x4 x = v[ai][bj][m][n]; s += (x[0] * x[0] + x[1] * x[1]) + (x[2] * x[2] + x[3] * x[3]); }
                s += __shfl_xor(s, 16); s += __shfl_xor(s, 32);
                if (fq == 0) P[(ai * HALF + wr * 64 + m * 16 + fr) * 4 + wc] = s;
            }
        asm volatile("s_waitcnt lgkmcnt(0)" ::: "memory"); __builtin_amdgcn_s_barrier(); asm volatile("" ::: "memory");
        const int row = wid * 32 + (lane & 31);
        if (lane < 32) {
            const float t = (P[row * 4 + 0] + P[row * 4 + 1]) + (P[row * 4 + 2] + P[row * 4 + 3]);
            __hip_atomic_store(xbuf + ((size_t)(u.pm * BM + row) * 4 + u.pn), t, __ATOMIC_RELAXED, __HIP_MEMORY_SCOPE_AGENT);
        }
        asm volatile("s_waitcnt vmcnt(0)" ::: "memory");
        if (lane == 0) __hip_atomic_fetch_add(cnt + 64 * u.pm, 1u, __ATOMIC_RELAXED, __HIP_MEMORY_SCOPE_AGENT);
        if (wid == 0) {
            unsigned sp = 0;
            while ((unsigned)__builtin_amdgcn_readfirstlane(__hip_atomic_load(cnt + 64 * u.pm, __ATOMIC_RELAXED, __HIP_MEMORY_SCOPE_AGENT)) < 32u) { __builtin_amdgcn_s_sleep(1); if (++sp > (1u << 22)) break; }
            __builtin_amdgcn_fence(__ATOMIC_ACQUIRE, "agent");
        }
        asm volatile("s_waitcnt vmcnt(0) lgkmcnt(0)" ::: "memory"); __builtin_amdgcn_s_barrier(); asm volatile("" ::: "memory");
        if (lane < 32) {
            const float* slot = xbuf + (size_t)(u.pm * BM + row) * 4; float t = 0.f;
#pragma unroll
            for (int k = 0; k < 4; ++k) t += __hip_atomic_load(slot + k, __ATOMIC_RELAXED, __HIP_MEMORY_SCOPE_AGENT);
            S[row] = t;
        }
        asm volatile("s_waitcnt vmcnt(0) lgkmcnt(0)" ::: "memory"); __builtin_amdgcn_s_barrier(); asm volatile("" ::: "memory");
    }

template <class Epi, class Sched, bool ALIGN_EPI = false, bool SP2 = false>
__device__ __forceinline__ void gemm_phase(PG8_LAS unsigned char* lds, const Gemm g, const Sched& S, const Epi& E) {
    const int tid = tid_l(), wid = __builtin_amdgcn_readfirstlane(tid >> 6), lane = tid & 63, wr = wid >> 2, wc = wid & 3, fr = lane & 15, fq = lane >> 4;
    unsigned voffA[2], voffB[2];
#pragma unroll
    for (int i = 0; i < 2; ++i) { int R, C; stage_rc(tid * 16 + i * 8192, R, C); const int Rb = Epi::PERM ? ((R & ~31) + perm32(R & 31)) : R;
        voffA[i] = (unsigned)(R * g.lda + C) * 2u; voffB[i] = (unsigned)(Rb * g.ldb + C) * 2u; }
    const size_t kstep = (size_t)(BK * 2);
    const size_t hstepB = (size_t)HALF * g.ldb * 2, hstepA = (size_t)HALF * g.lda * 2;
    const size_t tstepA = 2 * hstepA, tstepB = 2 * hstepB;
    const unsigned ldsw = (unsigned)wid * 1024u;
    const int aoff = lds_byte(wr * 64 + fr, fq * 8), boff = lds_byte(wc * 32 + fr, fq * 8);
#define PG8_SA(b, h) (((b) * 2 + (h)) * HTB)
#define PG8_SB(b, h) ((4 + (b) * 2 + (h)) * HTB)
#define PG8_STAGE(bufoff, gbase, voff) do { _Pragma("unroll") for (int _i = 0; _i < 2; ++_i) \
        __builtin_amdgcn_global_load_lds((const unsigned*)((const char*)(gbase) + (voff)[_i]), (PG8_LAS unsigned*)(lds + (bufoff) + ldsw + _i * 8192), 16, 0, 0); } while (0)
#define PG8_LDA(dst, b, h) do { _Pragma("unroll") for (int m = 0; m < 4; ++m) _Pragma("unroll") for (int k = 0; k < 2; ++k) dst[m][k] = *(const PG8_LAS bf16x8*)(lds + PG8_SA(b, h) + aoff + m * 2048 + k * 1024); } while (0)
#define PG8_LDB(dst, b, h) do { _Pragma("unroll") for (int n = 0; n < 2; ++n) _Pragma("unroll") for (int k = 0; k < 2; ++k) dst[n][k] = *(const PG8_LAS bf16x8*)(lds + PG8_SB(b, h) + boff + n * 2048 + k * 1024); } while (0)
#define PG8_MMA(ai, bj, At, Bt) do { __builtin_amdgcn_s_setprio(1); _Pragma("unroll") for (int m = 0; m < 4; ++m) _Pragma("unroll") for (int n = 0; n < 2; ++n) _Pragma("unroll") for (int k = 0; k < 2; ++k) \
        acc[ai][bj][m][n] = __builtin_amdgcn_mfma_f32_16x16x32_bf16(Bt[n][k], At[m][k], acc[ai][bj][m][n], 0, 0, 0); __builtin_amdgcn_s_setprio(0); } while (0)
#define PG8_WAIT_V(n) asm volatile("s_waitcnt vmcnt(" #n ")" ::: "memory")
#define PG8_WAIT_L(n) asm volatile("s_waitcnt lgkmcnt(" #n ")" ::: "memory")
#define PG8_BAR __builtin_amdgcn_s_barrier()
#define PG8_SCHED __builtin_amdgcn_sched_barrier(0)
    Unit cur, nxt; int ui = 0;
    if (!S.next(0, cur)) return;
    f32x4 acc[2][2][4][2];
#pragma unroll
    for (int a = 0; a < 2; ++a)
#pragma unroll
        for (int b = 0; b < 2; ++b)
#pragma unroll
            for (int m = 0; m < 4; ++m)
#pragma unroll
                for (int n = 0; n < 2; ++n) acc[a][b][m][n] = (f32x4){0.f, 0.f, 0.f, 0.f};
    bf16x8 At[4][2], B0[2][2], B1[2][2];
    const char* cA = (const char*)g.A + (size_t)cur.pm * tstepA + (size_t)cur.kt0 * kstep; const char* cB = (const char*)g.Bt + (size_t)cur.pn * tstepB + (size_t)cur.kt0 * kstep;
    S.a_ready(cur);
    if constexpr (SP2) {
        PG8_STAGE(PG8_SB(0, 0), cB, voffB); PG8_STAGE(PG8_SB(0, 1), cB + hstepB, voffB); PG8_STAGE(PG8_SA(0, 0), cA, voffA); PG8_STAGE(PG8_SA(0, 1), cA + hstepA, voffA);
        if (wr == 1) PG8_BAR;
        PG8_WAIT_V(2); PG8_BAR;
        PG8_STAGE(PG8_SB(1, 0), cB + kstep, voffB); PG8_STAGE(PG8_SA(1, 0), cA + kstep, voffA); PG8_STAGE(PG8_SB(1, 1), cB + hstepB + kstep, voffB);
        PG8_WAIT_V(6); PG8_BAR;
    } else {
        PG8_STAGE(PG8_SB(0, 0), cB, voffB); PG8_STAGE(PG8_SA(0, 0), cA, voffA); PG8_STAGE(PG8_SB(0, 1), cB + hstepB, voffB); PG8_STAGE(PG8_SA(0, 1), cA + hstepA, voffA);
        if (wr == 1) PG8_BAR;
        PG8_WAIT_V(4); PG8_BAR;
        PG8_STAGE(PG8_SB(1, 0), cB + kstep, voffB); PG8_STAGE(PG8_SA(1, 0), cA + kstep, voffA); PG8_STAGE(PG8_SB(1, 1), cB + hstepB + kstep, voffB);
        PG8_WAIT_V(6); PG8_BAR;
    }
    for (;;) {
        const bool has_next = S.next(ui + 1, nxt);
        const char* nA = has_next ? (const char*)g.A + (size_t)nxt.pm * tstepA + (size_t)nxt.kt0 * kstep : cA; const char* nB = has_next ? (const char*)g.Bt + (size_t)nxt.pn * tstepB + (size_t)nxt.kt0 * kstep : cB;
        const int nt = cur.nt;
        for (int t = 0; t < nt; t += 2) {
            const bool last = (t == nt - 2);
            const char* a1 = cA + (size_t)(t + 1) * kstep;
            const char* a2 = last ? nA : cA + (size_t)(t + 2) * kstep; const char* b2 = last ? nB : cB + (size_t)(t + 2) * kstep;
            const char* a3 = a2 + kstep; const char* b3 = b2 + kstep;
            if (last && has_next) S.a_ready(nxt);
            if constexpr (SP2) {
            PG8_LDB(B0, 0, 0); PG8_LDB(B1, 0, 1); PG8_SCHED; PG8_LDA(At, 0, 0); PG8_STAGE(PG8_SA(1, 1), a1 + hstepA, voffA);
            PG8_WAIT_V(8); PG8_WAIT_L(0); PG8_BAR; PG8_MMA(0, 0, At, B0); PG8_MMA(0, 1, At, B1); PG8_BAR; PG8_SCHED;
            PG8_LDA(At, 0, 1); PG8_STAGE(PG8_SB(0, 0), b2, voffB); PG8_STAGE(PG8_SB(0, 1), b2 + hstepB, voffB); PG8_STAGE(PG8_SA(0, 0), a2, voffA);
            PG8_WAIT_V(8); PG8_WAIT_L(0); PG8_BAR; PG8_MMA(1, 0, At, B0); PG8_MMA(1, 1, At, B1); PG8_BAR; PG8_SCHED;
            PG8_LDB(B0, 1, 0); PG8_LDB(B1, 1, 1); PG8_SCHED; PG8_LDA(At, 1, 0); PG8_STAGE(PG8_SA(0, 1), a2 + hstepA, voffA);
            PG8_WAIT_V(8); PG8_WAIT_L(0); PG8_BAR; PG8_MMA(0, 0, At, B0); PG8_MMA(0, 1, At, B1); PG8_BAR; PG8_SCHED;
            PG8_LDA(At, 1, 1); PG8_STAGE(PG8_SB(1, 0), b3, voffB); PG8_STAGE(PG8_SB(1, 1), b3 + hstepB, voffB); PG8_STAGE(PG8_SA(1, 0), a3, voffA);
            PG8_WAIT_V(8); PG8_WAIT_L(0); PG8_BAR; PG8_MMA(1, 0, At, B0); PG8_MMA(1, 1, At, B1); PG8_BAR; PG8_SCHED;
            } else {
            PG8_LDB(B0, 0, 0); PG8_SCHED; PG8_LDA(At, 0, 0); PG8_STAGE(PG8_SA(1, 1), a1 + hstepA, voffA);
            PG8_WAIT_L(8); PG8_BAR; PG8_WAIT_L(0); PG8_MMA(0, 0, At, B0); PG8_BAR; PG8_SCHED;
            PG8_LDB(B1, 0, 1); PG8_STAGE(PG8_SB(0, 0), b2, voffB);
            PG8_BAR; PG8_WAIT_L(0); PG8_MMA(0, 1, At, B1); PG8_BAR;
            PG8_LDA(At, 0, 1); PG8_STAGE(PG8_SA(0, 0), a2, voffA);
            PG8_BAR; PG8_WAIT_L(0); PG8_MMA(1, 0, At, B0); PG8_BAR; PG8_SCHED;
            PG8_STAGE(PG8_SB(0, 1), b2 + hstepB, voffB);
            PG8_WAIT_V(6); PG8_BAR; PG8_MMA(1, 1, At, B1); PG8_BAR;
            PG8_LDB(B0, 1, 0); PG8_SCHED; PG8_LDA(At, 1, 0); PG8_STAGE(PG8_SA(0, 1), a2 + hstepA, voffA);
            PG8_WAIT_L(8); PG8_BAR; PG8_WAIT_L(0); PG8_MMA(0, 0, At, B0); PG8_BAR; PG8_SCHED;
            PG8_LDB(B1, 1, 1); PG8_STAGE(PG8_SB(1, 0), b3, voffB);
            PG8_BAR; PG8_WAIT_L(0); PG8_MMA(0, 1, At, B1); PG8_BAR;
            PG8_LDA(At, 1, 1); PG8_STAGE(PG8_SA(1, 0), a3, voffA);
            PG8_BAR; PG8_WAIT_L(0); PG8_MMA(1, 0, At, B0); PG8_BAR; PG8_SCHED;
            PG8_STAGE(PG8_SB(1, 1), b3 + hstepB, voffB);
            PG8_WAIT_V(6); PG8_BAR; PG8_MMA(1, 1, At, B1); PG8_BAR;
            }
        }
        if constexpr (ALIGN_EPI) { if (wr == 0) PG8_BAR; }
        if constexpr (!Epi::AFTER_DRAIN) { E(acc, cur, wr, wc, fr, fq); S.done(cur); }
        if (!has_next) break;
#pragma unroll
        for (int a = 0; a < 2; ++a)
#pragma unroll
            for (int b = 0; b < 2; ++b)
#pragma unroll
                for (int m = 0; m < 4; ++m)
#pragma unroll
                    for (int n = 0; n < 2; ++n) acc[a][b][m][n] = (f32x4){0.f, 0.f, 0.f, 0.f};
        cur = nxt; cA = nA; cB = nB; ++ui;
        if constexpr (ALIGN_EPI) { if (wr == 1) PG8_BAR; }
    }
    PG8_WAIT_V(0);
    if constexpr (!ALIGN_EPI) { if (wr == 0) PG8_BAR; }
    PG8_BAR;
    if constexpr (Epi::AFTER_DRAIN) { E.fused(acc, cur, wr, wc, fr, fq, lds, wid, lane); S.done(cur); }
#undef PG8_SA
#undef PG8_SB
#undef PG8_STAGE
#undef PG8_LDA
#undef PG8_LDB
#undef PG8_MMA
#undef PG8_WAIT_V
#undef PG8_WAIT_L
#undef PG8_BAR
#undef PG8_SCHED
}
}
namespace att {
using bf16 = __hip_bfloat16;
constexpr int   D = 128, NW = 8, QBLK = 32, KVBLK = 64;
constexpr float SCALE = 0.088388347648318440f;
constexpr float THR = 8.f;
constexpr int SDEPTH = 2;
constexpr int LDQ = 1536, LDK = 1536, LDO = 1024;
constexpr size_t SHM_V = KVBLK * D * 2, SHM_K = KVBLK * D * 2, SHM_ATTN = 2 * SHM_V + 2 * SHM_K + NW * 64 * 4;
using bf16x8 = __attribute__((ext_vector_type(8))) short;
using s16x4  = __attribute__((ext_vector_type(4))) short;
using f32x16 = __attribute__((ext_vector_type(16))) float;
using f32x8  = __attribute__((ext_vector_type(8))) float;
using u32x4  = __attribute__((ext_vector_type(4))) unsigned;
#define KSWZ(row, colB) ((row) * 256 + ((colB) ^ (((row) & 7) << 4)))
#define SBAR() __builtin_amdgcn_sched_barrier(0)
__device__ __forceinline__ int crow(int r, int hi) { return (r & 3) + 8 * (r >> 2) + 4 * hi; }
__device__ __forceinline__ unsigned cvtpk(float lo, float hi) {
  unsigned r; asm volatile("v_cvt_pk_bf16_f32 %0, %1, %2" : "=v"(r) : "v"(lo), "v"(hi)); return r;
}
template <typename TIn> struct Stage;
template <> struct Stage<bf16>  { using T = bf16x8;
  __device__ static __forceinline__ T ld8(const bf16* p) { return *reinterpret_cast<const bf16x8*>(p); }
  __device__ static __forceinline__ bf16x8 tobf(T x) { return x; } };
template <> struct Stage<float> { using T = f32x8;
  __device__ static __forceinline__ T ld8(const float* p) { return *reinterpret_cast<const f32x8*>(p); }
  __device__ static __forceinline__ bf16x8 tobf(T x) {
    u32x4 w = {cvtpk(x[0], x[1]), cvtpk(x[2], x[3]), cvtpk(x[4], x[5]), cvtpk(x[6], x[7])}; return *reinterpret_cast<bf16x8*>(&w); } };

__device__ __forceinline__ void partialSM(f32x16& p0, f32x16& p1, float& m_reg, float& mn, float& alpha) {
  constexpr float C = SCALE * 1.4426950408889634f;
  float pmax = p0[0]; for (int r = 1; r < 16; ++r) pmax = fmaxf(pmax, p0[r]); for (int r = 0; r < 16; ++r) pmax = fmaxf(pmax, p1[r]);
  { auto rr = __builtin_amdgcn_permlane32_swap(__float_as_uint(pmax), __float_as_uint(pmax), false, false);
    pmax = fmaxf(__uint_as_float(rr[0]), __uint_as_float(rr[1])); }
  if (__builtin_expect(__all(pmax - m_reg <= THR / SCALE), 1)) { mn = m_reg; alpha = 1.f; }
  else { mn = fmaxf(m_reg, pmax); alpha = __builtin_amdgcn_exp2f((m_reg - mn) * C); m_reg = mn; }
  float mnC = -mn * C;
  for (int r = 0; r < 16; ++r) p0[r] = fmaf(p0[r], C, mnC); for (int r = 0; r < 16; ++r) p1[r] = fmaf(p1[r], C, mnC);
  for (int r = 0; r < 16; ++r) p0[r] = __builtin_amdgcn_exp2f(p0[r]);
}
__device__ __forceinline__ void finishSM(f32x16& p0, f32x16& p1, float alpha, float& l_reg, bf16x8& pa0, bf16x8& pa1, bf16x8& pa2, bf16x8& pa3) {
  for (int r = 0; r < 16; ++r) p1[r] = __builtin_amdgcn_exp2f(p1[r]);
  float ps = 0; for (int r = 0; r < 16; ++r) ps += p0[r]; for (int r = 0; r < 16; ++r) ps += p1[r];
  { auto rr = __builtin_amdgcn_permlane32_swap(__float_as_uint(ps), __float_as_uint(ps), false, false);
    ps = __uint_as_float(rr[0]) + __uint_as_float(rr[1]); }
  l_reg = l_reg * alpha + ps;
#define PK4(P, BASE, OUT) do { unsigned a0 = cvtpk(P[BASE + 0], P[BASE + 1]), a1 = cvtpk(P[BASE + 2], P[BASE + 3]);   \
    unsigned b0 = cvtpk(P[BASE + 4], P[BASE + 5]), b1 = cvtpk(P[BASE + 6], P[BASE + 7]);                              \
    auto r0 = __builtin_amdgcn_permlane32_swap(a0, b0, false, false); auto r1 = __builtin_amdgcn_permlane32_swap(a1, b1, false, false); \
    u32x4 w = {r0[0], r1[0], r0[1], r1[1]}; OUT = *reinterpret_cast<bf16x8*>(&w); } while (0)
  PK4(p0, 0, pa0); PK4(p0, 8, pa1); PK4(p1, 0, pa2); PK4(p1, 8, pa3);
#undef PK4
}
__device__ __forceinline__ void qkt(f32x16& p0, f32x16& p1, const bf16* Ks, const bf16x8* qr, int r32, int hi) {
  p0 = f32x16{}; p1 = f32x16{};
  for (int d0 = 0; d0 < 8; ++d0) { int cb = (d0 * 16 + hi * 8) * 2;
    bf16x8 b0 = *reinterpret_cast<const bf16x8*>((const char*)Ks + KSWZ(r32, cb));
    bf16x8 b1 = *reinterpret_cast<const bf16x8*>((const char*)Ks + KSWZ(32 + r32, cb));
    p0 = __builtin_amdgcn_mfma_f32_32x32x16_bf16(b0, qr[d0], p0, 0, 0, 0);
    p1 = __builtin_amdgcn_mfma_f32_32x32x16_bf16(b1, qr[d0], p1, 0, 0, 0); }
}
__device__ __forceinline__ int v_st(int k, int c) { const int kk = (k & ~0xC) | ((k & 4) << 1) | ((k & 8) >> 1); return ((kk >> 3) * 4 + (c >> 5)) * 512 + ((kk & 7) * 32 + (c & 31)) * 2; }
__device__ __forceinline__ int v_rd_base(int lane) { return ((lane & 3) << 3) | (((lane >> 2) & 3) << 6) | (((lane >> 4) & 1) << 5) | (((lane >> 5) & 1) << 8); }
constexpr int v_rd_off(int d0, int ks, int half) { return d0 * 512 + ks * 4096 + half * 2048; }
template <int OFF> __device__ __forceinline__ s16x4 tr_read(int vb) {
  s16x4 r; asm volatile("ds_read_b64_tr_b16 %0, %1 offset:%2" : "=&v"(r) : "v"(vb), "i"(OFF) : "memory"); return r;
}
template <int D0> __device__ __forceinline__ void pv_one(f32x16& od, int vb, bf16x8 pa0, bf16x8 pa1, bf16x8 pa2, bf16x8 pa3) {
  const s16x4 l0 = tr_read<v_rd_off(D0, 0, 0)>(vb), h0 = tr_read<v_rd_off(D0, 0, 1)>(vb), l1 = tr_read<v_rd_off(D0, 1, 0)>(vb), h1 = tr_read<v_rd_off(D0, 1, 1)>(vb);
  const s16x4 l2 = tr_read<v_rd_off(D0, 2, 0)>(vb), h2 = tr_read<v_rd_off(D0, 2, 1)>(vb), l3 = tr_read<v_rd_off(D0, 3, 0)>(vb), h3 = tr_read<v_rd_off(D0, 3, 1)>(vb);
  asm volatile("s_waitcnt lgkmcnt(0)" ::: "memory"); SBAR();
#define PK(L, H) (bf16x8){L[0], L[1], L[2], L[3], H[0], H[1], H[2], H[3]}
  od = __builtin_amdgcn_mfma_f32_32x32x16_bf16(pa0, PK(l0, h0), od, 0, 0, 0);
  od = __builtin_amdgcn_mfma_f32_32x32x16_bf16(pa1, PK(l1, h1), od, 0, 0, 0);
  od = __builtin_amdgcn_mfma_f32_32x32x16_bf16(pa2, PK(l2, h2), od, 0, 0, 0);
  od = __builtin_amdgcn_mfma_f32_32x32x16_bf16(pa3, PK(l3, h3), od, 0, 0, 0);
#undef PK
}
__device__ __forceinline__ void pv_d0(f32x16* o, int vb, bf16x8 pa0, bf16x8 pa1, bf16x8 pa2, bf16x8 pa3) {
  pv_one<0>(o[0], vb, pa0, pa1, pa2, pa3); pv_one<1>(o[1], vb, pa0, pa1, pa2, pa3); pv_one<2>(o[2], vb, pa0, pa1, pa2, pa3); pv_one<3>(o[3], vb, pa0, pa1, pa2, pa3);
}

template <typename TQ>
__device__ __forceinline__ void attn_dense_body(const TQ* __restrict__ Qb, const bf16* __restrict__ Kh, const bf16* __restrict__ Vh,
                                                bf16* __restrict__ Ob, int seq, char* lds) {
  using St = Stage<bf16>; using SQ = Stage<TQ>;
  const int tid = tid_l(), wid = tid >> 6, lane = tid & 63, r32 = lane & 31, hi = lane >> 5;
  bf16* V_lds = (bf16*)lds; bf16* K_lds = (bf16*)(lds + 2 * SHM_V);
  float* ws = (float*)(lds + 2 * SHM_V + 2 * SHM_K) + wid * 64; float* li_l = ws; float* al_l = ws + 32;
  float m_reg = -1e30f, l_reg = 0; f32x16 o[4] = {}; bf16x8 qr[8];
  const TQ* Qw = Qb + (long)(wid * QBLK + r32) * LDQ + hi * 8;
#pragma unroll
  for (int d0 = 0; d0 < 8; ++d0) qr[d0] = SQ::tobf(SQ::ld8(Qw + d0 * 16));
  const int sr = tid >> 4, sc = (tid & 15) * 8, vst0 = v_st(sr, sc), vst1 = v_st(32 + sr, sc);
  const int vb0 = (int)(uintptr_t)V_lds + v_rd_base(lane);
  struct { typename St::T vs0, vs1, ks0, ks1; } sr_[SDEPTH];
#define SLOAD(i, k0) do { sr_[i].vs0 = St::ld8(&Vh[(long)((k0) + sr) * LDK + sc]); sr_[i].vs1 = St::ld8(&Vh[(long)((k0) + 32 + sr) * LDK + sc]); \
    sr_[i].ks0 = St::ld8(&Kh[(long)((k0) + sr) * LDK + sc]); sr_[i].ks1 = St::ld8(&Kh[(long)((k0) + 32 + sr) * LDK + sc]); } while (0)
#define SWRITE(b, i) do { *(bf16x8*)((char*)V_lds + (b) * SHM_V + vst0) = St::tobf(sr_[i].vs0);          \
    *(bf16x8*)((char*)V_lds + (b) * SHM_V + vst1) = St::tobf(sr_[i].vs1); int kc = sc * 2;               \
    *(bf16x8*)((char*)K_lds + (b) * SHM_K + KSWZ(sr, kc)) = St::tobf(sr_[i].ks0);                       \
    *(bf16x8*)((char*)K_lds + (b) * SHM_K + KSWZ(32 + sr, kc)) = St::tobf(sr_[i].ks1); } while (0)
#define SWAIT() do { if constexpr (SDEPTH == 2) asm volatile("s_waitcnt vmcnt(4)" ::: "memory"); else asm volatile("s_waitcnt vmcnt(0)" ::: "memory"); } while (0)
#define RESC(a) do { if (__any((a) < 1.f)) { if (hi == 0) al_l[r32] = (a); asm volatile("s_waitcnt lgkmcnt(0)" ::: "memory"); \
    for (int d = 0; d < 4; ++d) for (int r = 0; r < 16; ++r) o[d][r] *= al_l[crow(r, hi)]; } } while (0)
  f32x16 pA0, pA1, pB0, pB1; float mnA, mnB, alA, alB; bf16x8 pa0, pa1, pa2, pa3; const int NT = seq / KVBLK;
  constexpr int SE = 0, SO = SDEPTH - 1;
  SLOAD(SE, 0); asm volatile("s_waitcnt vmcnt(0)" ::: "memory"); SWRITE(0, SE); __syncthreads();
  qkt(pA0, pA1, K_lds, qr, r32, hi); partialSM(pA0, pA1, m_reg, mnA, alA);
  SLOAD(SO, KVBLK); if constexpr (SDEPTH == 2) { if (2 < NT) SLOAD(SE, 2 * KVBLK); }
  SWAIT(); SWRITE(1, SO); __syncthreads();
  for (int j = 1; j + 1 < NT; j += 2) {
    SBAR(); qkt(pB0, pB1, (bf16*)((char*)K_lds + SHM_K), qr, r32, hi);
    finishSM(pA0, pA1, alA, l_reg, pa0, pa1, pa2, pa3); SBAR();
    SLOAD(SO, (j + SDEPTH) * KVBLK); SBAR();
    pv_d0(o, vb0, pa0, pa1, pa2, pa3); partialSM(pB0, pB1, m_reg, mnB, alB);
    __syncthreads(); SWAIT(); SWRITE(0, SE);
    RESC(alB); __syncthreads();
    SBAR(); qkt(pA0, pA1, K_lds, qr, r32, hi);
    finishSM(pB0, pB1, alB, l_reg, pa0, pa1, pa2, pa3); SBAR();
    if (SDEPTH == 1 || j + 3 < NT) SLOAD(SE, (j + 1 + SDEPTH) * KVBLK); SBAR();
    pv_d0(o, vb0 + (int)SHM_V, pa0, pa1, pa2, pa3); partialSM(pA0, pA1, m_reg, mnA, alA);
    __syncthreads(); SWAIT(); SWRITE(1, SO);
    RESC(alA); __syncthreads();
  }
  SBAR(); qkt(pB0, pB1, (bf16*)((char*)K_lds + SHM_K), qr, r32, hi);
  finishSM(pA0, pA1, alA, l_reg, pa0, pa1, pa2, pa3); SBAR();
  pv_d0(o, vb0, pa0, pa1, pa2, pa3); partialSM(pB0, pB1, m_reg, mnB, alB);
  __syncthreads(); RESC(alB);
  finishSM(pB0, pB1, alB, l_reg, pa0, pa1, pa2, pa3); SBAR();
  pv_d0(o, vb0 + (int)SHM_V, pa0, pa1, pa2, pa3);
  if (hi == 0) li_l[r32] = l_reg; asm volatile("s_waitcnt lgkmcnt(0)" ::: "memory");
  float rli[16];
#pragma unroll
  for (int r = 0; r < 16; ++r) rli[r] = __builtin_amdgcn_rcpf(li_l[crow(r, hi)]);
  bf16* Ow = Ob + (long)(wid * QBLK) * LDO;
#pragma unroll
  for (int r = 0; r < 16; ++r) { int orow = crow(r, hi);
    for (int d0 = 0; d0 < 4; ++d0) Ow[(long)orow * LDO + d0 * 32 + r32] = __float2bfloat16(o[d0][r] * rli[r]); }
#undef SLOAD
#undef SWRITE
#undef SWAIT
#undef RESC
}
}
#define LAS __attribute__((address_space(3)))
typedef unsigned short bf16_t;
typedef short bf16x8 __attribute__((ext_vector_type(8)));
typedef float f32x4 __attribute__((ext_vector_type(4)));
typedef float f32x16 __attribute__((ext_vector_type(16)));
typedef unsigned u32x4 __attribute__((ext_vector_type(4)));
typedef unsigned u32x2 __attribute__((ext_vector_type(2)));

constexpr int DM = 1024, NB = 8, SEQ = 4096, CTXL = 256, TPB = SEQ + CTXL, MT = NB * TPB, DFF = 2816, DEPTH = 4;
constexpr int NQKV = 1536, NGIN = 3328;
constexpr float EPS = 1e-6f;
constexpr int LDS_BYTES = 147456;
constexpr int NTHREADS = 512;

constexpr size_t MiB = 1u << 20;
constexpr size_t WS_MOD = 1 * MiB;
constexpr size_t WS_W1T = 3 * MiB;
constexpr size_t WS_W2T = WS_W1T + 88 * MiB;
constexpr size_t WS_WQKVT = WS_W2T + 44 * MiB;
constexpr size_t WS_WOAT = WS_WQKVT + 6 * MiB;
constexpr size_t WS_WGINT = WS_WOAT + 4 * MiB;
constexpr size_t WS_WGOT = WS_WGINT + 13 * MiB;
constexpr size_t WS_HRES = WS_WGOT + 4 * MiB;
constexpr size_t WS_U = WS_HRES + 136 * MiB;
constexpr size_t WS_Y = WS_U + 68 * MiB;
constexpr size_t WS_BIG = WS_Y + 68 * MiB;
constexpr size_t WS_ATTNO = WS_BIG + 102 * MiB;
constexpr size_t WS_END = WS_BIG + 221 * MiB;
constexpr size_t WS_PART_IN_OUT = 112 * MiB;
static_assert((size_t)MT * NGIN * 2 <= 221 * MiB && (size_t)MT * DFF * 2 <= 221 * MiB && (size_t)MT * NQKV * 2 <= 102 * MiB, "ws map");

struct Args { const float* in[20]; float* out; unsigned char* ws; };
typedef const __attribute__((address_space(4))) Args* KA;
__device__ __forceinline__ KA kargs() { KA p = (KA)__builtin_amdgcn_kernarg_segment_ptr(); asm volatile("" : "+s"(p)); return p; }
enum { I_X = 0, I_C, I_CTX, I_CCTX, I_ADAW, I_ADAB, I_NPRE, I_NPOST, I_FW1, I_FW2, I_AQKV, I_AQG, I_AKG, I_AWO, I_GWIN, I_GWA1, I_GWA2, I_GBA, I_GOG, I_GWO };

__device__ __forceinline__ unsigned cvtpk(float lo, float hi) { return pg8::cvt_pk_bf16(lo, hi); }
__device__ __forceinline__ float bf_lo(unsigned w) { return __uint_as_float(w << 16); }
__device__ __forceinline__ float bf_hi(unsigned w) { return __uint_as_float(w & 0xffff0000u); }
__device__ __forceinline__ float bf_f(bf16_t h) { return __uint_as_float(((unsigned)h) << 16); }
__device__ __forceinline__ bf16_t f_bf(float f) { return (bf16_t)(cvtpk(f, 0.f) & 0xffffu); }
__device__ __forceinline__ float wave_sum(float v) {
#pragma unroll
    for (int o = 1; o < 64; o <<= 1) v += __shfl_xor(v, o);
    return v;
}
__device__ __forceinline__ float silu(float x) { return x / (1.0f + __expf(-x)); }

__device__ __forceinline__ void phase_mod(KA a, LAS unsigned char* lds) {
    LAS float* sv = (LAS float*)lds;
    LAS float* red = (LAS float*)(lds + 9 * 1024 * 4);
    const int tid = tid_l(), lane = tid & 63, wave = tid >> 6;
    const float* c = a->in[I_C]; const float* cc = a->in[I_CCTX];
    for (int i = tid; i < 9 * 1024; i += NTHREADS) { const int v = i >> 10, k = i & 1023; const float x = v < 8 ? c[v * 1024 + k] : cc[k]; sv[i] = silu(x); }
    __syncthreads();
    float* mod = (float*)(a->ws + WS_MOD);
    for (int it = blk_l(); it < DEPTH * 144; it += grd_l()) {
        const int L = it / 144, cgp = it % 144;
        const float* w = a->in[I_ADAW] + (size_t)L * 1024 * 9216 + cgp * 64 + lane;
        float acc[9];
#pragma unroll
        for (int v = 0; v < 9; ++v) acc[v] = 0.f;
        const int k0 = wave * 128;
#pragma unroll 8
        for (int k = 0; k < 128; ++k) { const float wv = w[(size_t)(k0 + k) * 9216];
#pragma unroll
            for (int v = 0; v < 9; ++v) acc[v] += sv[v * 1024 + k0 + k] * wv; }
#pragma unroll
        for (int v = 0; v < 9; ++v) red[(wave * 9 + v) * 64 + lane] = acc[v];
        __syncthreads();
        for (int i = tid; i < 576; i += NTHREADS) { const int v = i >> 6, l = i & 63; float s = 0.f;
#pragma unroll
            for (int w8 = 0; w8 < 8; ++w8) s += red[(w8 * 9 + v) * 64 + l];
            s += a->in[I_ADAB][L * 9216 + cgp * 64 + l];
            mod[(size_t)(L * 9 + v) * 9216 + cgp * 64 + l] = s; }
        __syncthreads();
    }
}

__device__ __forceinline__ unsigned pk2(float lo, float hi) { return cvtpk(lo, hi); }
__device__ __forceinline__ void tr_item(const float* W, int Nsrc, int srccol_l  , int k0, bf16_t* dst  , int K, LAS float* scr, int lane) {
#pragma unroll 8
    for (int i = 0; i < 32; ++i) { const int kk = 2 * i + (lane >> 5); scr[kk * 33 + (lane & 31)] = W[(size_t)(k0 + kk) * Nsrc + srccol_l]; }
    asm volatile("s_waitcnt lgkmcnt(0)" ::: "memory");
    const int c = lane & 7;
#pragma unroll
    for (int j = 0; j < 4; ++j) { const int n = (lane >> 3) + 8 * j; const LAS float* s = scr + (8 * c) * 33 + n;
        u32x4 o; o.x = pk2(s[0 * 33], s[1 * 33]); o.y = pk2(s[2 * 33], s[3 * 33]); o.z = pk2(s[4 * 33], s[5 * 33]); o.w = pk2(s[6 * 33], s[7 * 33]);
        *(u32x4*)(dst + (size_t)n * K + 8 * c) = o; }
    asm volatile("s_waitcnt lgkmcnt(0)" ::: "memory");
}
__device__ __forceinline__ void convert_layer(KA a, LAS unsigned char* lds, int L, int bfirst) {
    const int tid = tid_l(), lane = tid & 63, wave = tid >> 6;
    LAS float* scr = (LAS float*)(lds + 65536 + wave * 8704);
    const int gw = (blk_l() - bfirst) * 8 + wave, NGW = (grd_l() - bfirst) * 8;
    constexpr int I_W1 = 176 * 16, I_W2 = 32 * 44, I_QKV = 48 * 16, I_SQ = 32 * 16, I_GIN = 96 * 16;
    const bool attn = (L & 1) == 0; const int mx = L >> 1;
    const int N1 = 2 * I_W1, N2 = 2 * I_W2, N3 = attn ? I_QKV : I_GIN, N4 = I_SQ;
    const int NITEMS = N1 + N2 + N3 + N4;
    for (int it = gw; it < NITEMS; it += NGW) {
        int r = it;
        if (r < N1) { const int mat = 2 * L + r / I_W1, q = r % I_W1, ng = q / 16, kb = q % 16; const int pn = ng >> 3, r0 = (ng & 7) * 32;
            const int src = r0 < 128 ? 128 * pn + r0 : DFF + 128 * pn + (r0 - 128);
            tr_item(a->in[I_FW1] + (size_t)mat * 1024 * 5632, 5632, src + (lane & 31), kb * 64, (bf16_t*)(a->ws + WS_W1T) + (size_t)mat * 5632 * 1024 + (size_t)(ng * 32) * 1024 + kb * 64, 1024, scr, lane); continue; }
        r -= N1;
        if (r < N2) { const int mat = 2 * L + r / I_W2, q = r % I_W2, ng = q / 44, kb = q % 44;
            tr_item(a->in[I_FW2] + (size_t)mat * 2816 * 1024, 1024, ng * 32 + (lane & 31), kb * 64, (bf16_t*)(a->ws + WS_W2T) + (size_t)mat * 1024 * 2816 + (size_t)(ng * 32) * 2816 + kb * 64, 2816, scr, lane); continue; }
        r -= N2;
        if (r < N3) {
            if (attn) { const int ng = r / 16, kb = r % 16;
                int qsrc = ng * 32 + (lane & 31);
                if (ng < 40) { const int l = lane & 31, wcc = ng & 3, xi = wcc * 16 + (l >> 3) * 4 + (l & 3), x = xi < 32 ? xi : xi + 32; qsrc = (ng >> 2) * 128 + x + 32 * ((l >> 2) & 1); }
                tr_item(a->in[I_AQKV] + (size_t)mx * 1024 * 1536, 1536, qsrc, kb * 64, (bf16_t*)(a->ws + WS_WQKVT) + (size_t)mx * 1536 * 1024 + (size_t)(ng * 32) * 1024 + kb * 64, 1024, scr, lane); }
            else { const int ng = r / 16, kb = r % 16;
                tr_item(a->in[I_GWIN] + (size_t)mx * 1024 * 3072, 3072, ng * 32 + (lane & 31), kb * 64, (bf16_t*)(a->ws + WS_WGINT) + (size_t)mx * NGIN * 1024 + (size_t)(ng * 32) * 1024 + kb * 64, 1024, scr, lane); }
            continue; }
        r -= N3;
        { const int ng = r / 16, kb = r % 16;
            if (attn) tr_item(a->in[I_AWO] + (size_t)mx * 1024 * 1024, 1024, ng * 32 + (lane & 31), kb * 64, (bf16_t*)(a->ws + WS_WOAT) + (size_t)mx * 1024 * 1024 + (size_t)(ng * 32) * 1024 + kb * 64, 1024, scr, lane);
            else tr_item(a->in[I_GWO] + (size_t)mx * 1024 * 1024, 1024, ng * 32 + (lane & 31), kb * 64, (bf16_t*)(a->ws + WS_WGOT) + (size_t)mx * 1024 * 1024 + (size_t)(ng * 32) * 1024 + kb * 64, 1024, scr, lane); }
    }
    if (!attn) {
        const int gt = (blk_l() - bfirst) * NTHREADS + tid, NGT = (grd_l() - bfirst) * NTHREADS;
        for (int i = gt; i < 256 * 128; i += NGT) {
            const int jj = i / 128, k8 = (i % 128) * 8;
            float v[8];
#pragma unroll
            for (int e = 0; e < 8; ++e) v[e] = jj < 32 ? a->in[I_GWA1][((size_t)(mx * 2 + (jj >> 4)) * 1024 + k8 + e) * 16 + (jj & 15)] : 0.f;
            u32x4 o; o.x = pk2(v[0], v[1]); o.y = pk2(v[2], v[3]); o.z = pk2(v[4], v[5]); o.w = pk2(v[6], v[7]);
            *(u32x4*)((bf16_t*)(a->ws + WS_WGINT) + (size_t)mx * NGIN * 1024 + (size_t)(3072 + jj) * 1024 + k8) = o;
        }
    }
}

struct RowP { int Lpost, jpost; float gs; int Lpre, jpre; bool final_out; };
template <bool FROM_INPUT>
__device__ __forceinline__ void row_pair(KA a, const RowP p, int ra, int rb, bool ona, bool onb, int lane) {
    bf16_t* hres = (bf16_t*)(a->ws + WS_HRES); const float* mod = (const float*)(a->ws + WS_MOD);
    const bf16_t* Y = (const bf16_t*)(a->ws + WS_Y); bf16_t* U = (bf16_t*)(a->ws + WS_U);
    const float* gpost = a->in[I_NPOST] + (size_t)(p.Lpost * 3 + (p.jpost < 0 ? 0 : p.jpost)) * DM; const float* gpre = a->in[I_NPRE] + (size_t)(p.Lpre * 3 + (p.jpre < 0 ? 0 : p.jpre)) * DM;
    int rr[2] = {ra, rb}, bb[2], pp[2]; bool cx[2], on[2] = {ona, onb};
#pragma unroll
    for (int k = 0; k < 2; ++k) { bb[k] = rr[k] / TPB; pp[k] = rr[k] - bb[k] * TPB; cx[k] = pp[k] < CTXL; }
    f32x4 h[2][4], y[2][4];
#pragma unroll
    for (int k = 0; k < 2; ++k) {
        if (FROM_INPUT) { const float* src = cx[k] ? a->in[I_CTX] + (size_t)(bb[k] * CTXL + pp[k]) * DM : a->in[I_X] + (size_t)(bb[k] * SEQ + pp[k] - CTXL) * DM;
#pragma unroll
            for (int q = 0; q < 4; ++q) h[k][q] = *(const f32x4*)(src + 4 * lane + 256 * q); }
        else {
#pragma unroll
            for (int q = 0; q < 4; ++q) { const u32x2 w = *(const u32x2*)(hres + (size_t)rr[k] * DM + 4 * lane + 256 * q); h[k][q] = (f32x4){bf_lo(w.x), bf_hi(w.x), bf_lo(w.y), bf_hi(w.y)}; } }
        if (p.jpost >= 0) {
#pragma unroll
            for (int q = 0; q < 4; ++q) { const u32x2 w = *(const u32x2*)(Y + (size_t)rr[k] * DM + 4 * lane + 256 * q);
                y[k][q] = (f32x4){bf_lo(w.x), bf_hi(w.x), bf_lo(w.y), bf_hi(w.y)}; } }
    }
#pragma unroll
    for (int k = 0; k < 2; ++k) {
        const int mi = cx[k] ? 8 : bb[k];
        if (p.jpost >= 0) {
            float ss = 0.f;
#pragma unroll
            for (int q = 0; q < 4; ++q) ss += (y[k][q].x * y[k][q].x + y[k][q].y * y[k][q].y) + (y[k][q].z * y[k][q].z + y[k][q].w * y[k][q].w);
            const float rstd = 1.0f / sqrtf(wave_sum(ss) * (1.0f / DM) + EPS);
            const float* gate = mod + (size_t)(p.Lpost * 9 + mi) * 9216 + (3 * p.jpost + 2) * 1024;
#pragma unroll
            for (int q = 0; q < 4; ++q) { const f32x4 gt = *(const f32x4*)(gate + 4 * lane + 256 * q), gg = *(const f32x4*)(gpost + 4 * lane + 256 * q);
                h[k][q] += p.gs * gt * (y[k][q] * rstd * gg); }
        }
        if (on[k]) {
            if (p.final_out) { float* o = a->out + (size_t)(bb[k] * SEQ + pp[k] - CTXL) * DM;
#pragma unroll
                for (int q = 0; q < 4; ++q) *(f32x4*)(o + 4 * lane + 256 * q) = h[k][q]; }
            else {
#pragma unroll
                for (int q = 0; q < 4; ++q) { u32x2 w; w.x = cvtpk(h[k][q].x, h[k][q].y); w.y = cvtpk(h[k][q].z, h[k][q].w); *(u32x2*)(hres + (size_t)rr[k] * DM + 4 * lane + 256 * q) = w; } }
        }
        if (p.jpre >= 0) {
            float ss = 0.f;
#pragma unroll
            for (int q = 0; q < 4; ++q) ss += (h[k][q].x * h[k][q].x + h[k][q].y * h[k][q].y) + (h[k][q].z * h[k][q].z + h[k][q].w * h[k][q].w);
            const float rstd = 1.0f / sqrtf(wave_sum(ss) * (1.0f / DM) + EPS);
            const float* mb = mod + (size_t)(p.Lpre * 9 + mi) * 9216 + (3 * p.jpre) * 1024;
            if (on[k]) {
#pragma unroll
                for (int q = 0; q < 4; ++q) { const f32x4 sh = *(const f32x4*)(mb + 4 * lane + 256 * q), sc = *(const f32x4*)(mb + 1024 + 4 * lane + 256 * q), gg = *(const f32x4*)(gpre + 4 * lane + 256 * q);
                    const f32x4 u = h[k][q] * rstd * gg * (1.0f + sc) + sh;
                    u32x2 w; w.x = cvtpk(u.x, u.y); w.y = cvtpk(u.z, u.w); *(u32x2*)(U + (size_t)rr[k] * DM + 4 * lane + 256 * q) = w; } }
        }
    }
}
template <bool FROM_INPUT>
__device__ __forceinline__ void row_pass(KA a, const RowP p) {
    const int tid = tid_l(), lane = tid & 63, wave = tid >> 6;
    const int gw = blk_l() * 8 + wave, NGW = grd_l() * 8;
    for (int r0 = gw; r0 < MT; r0 += 2 * NGW) { const int r1 = r0 + NGW; const bool on1 = r1 < MT; row_pair<FROM_INPUT>(a, p, r0, on1 ? r1 : r0, true, on1, lane); }
}
__device__ __forceinline__ void row_pass_queue(KA a, const RowP p, unsigned* sig, unsigned need_lat, unsigned need_ctx, bool with_ctx, LAS unsigned char* lds) {
    const int tid = tid_l(), lane = tid & 63, wave = tid >> 6;
    volatile LAS unsigned* tk = (volatile LAS unsigned*)(lds + LDS_BYTES - 64 + 16);
    const unsigned nchunk = 512u + (with_ctx ? 32u : 0u);
    bool rdy_lat = false, rdy_ctx = false;
    for (;;) {
        if (tid == 0) tk[0] = __hip_atomic_fetch_add(sig + 128, 1u, __ATOMIC_RELAXED, __HIP_MEMORY_SCOPE_AGENT);
        __syncthreads();
        const unsigned t = tk[0];
        __syncthreads();
        if (t >= nchunk) break;
        const bool isc = t >= 512u;
        if (isc ? !rdy_ctx : !rdy_lat) {
            if (tid == 0) { unsigned* w = sig + (isc ? 64 : 0); const unsigned need = isc ? need_ctx : need_lat; unsigned sp = 0;
                while (__hip_atomic_load(w, __ATOMIC_RELAXED, __HIP_MEMORY_SCOPE_AGENT) < need) { __builtin_amdgcn_s_sleep(2); if (++sp > (1u << 22)) break; }
                __builtin_amdgcn_fence(__ATOMIC_ACQUIRE, "agent"); asm volatile("s_waitcnt vmcnt(0)" ::: "memory"); }
            __syncthreads();
            if (isc) rdy_ctx = true; else rdy_lat = true;
        }
        int rbase;
        if (!isc) { const int lr = (int)t * 64; rbase = (lr >> 12) * TPB + CTXL + (lr & 4095); }
        else { const int cr = ((int)t - 512) * 64; rbase = (cr >> 8) * TPB + (cr & 255); }
#pragma unroll 1
        for (int it = 0; it < 4; ++it) { const int r0 = rbase + wave * 8 + 2 * it; row_pair<false>(a, p, r0, r0 + 1, true, true, lane); }
    }
}

__device__ __forceinline__ void phase_qknorm_rope(KA a, int m) {
    const int tid = tid_l(), lane = tid & 63, wave = tid >> 6;
    const int gw = blk_l() * 8 + wave, NGW = grd_l() * 8;
    bf16_t* QKV = (bf16_t*)(a->ws + WS_BIG);
    const int i = lane & 31, hl = lane >> 5, d1 = i + 64 * hl, d2 = d1 + 32;
    const float qg1 = a->in[I_AQG][m * 128 + d1], qg2 = a->in[I_AQG][m * 128 + d2], kg1 = a->in[I_AKG][m * 128 + d1], kg2 = a->in[I_AKG][m * 128 + d2];
    const float inv = exp2f(-(float)i * (13.287712379549449f / 32.0f));
    for (int r = gw; r < MT; r += NGW) {
        const int b = r / TPB, pos = r - b * TPB; const bool isctx = pos < CTXL;
        float cs = 1.f, sn = 0.f;
        if (!isctx) { const int t = pos - CTXL; const float p = (float)(hl ? (t & 63) : (t >> 6)); const float ang = p * inv; cs = cosf(ang); sn = sinf(ang); }
        bf16_t* row = QKV + (size_t)r * NQKV;
#pragma unroll
        for (int hd = 0; hd < 10; ++hd) {
            float x1 = bf_f(row[hd * 128 + d1]), x2 = bf_f(row[hd * 128 + d2]);
            const float rstd = 1.0f / sqrtf(wave_sum(x1 * x1 + x2 * x2) * (1.0f / 128.0f) + EPS);
            x1 *= rstd * (hd < 8 ? qg1 : kg1); x2 *= rstd * (hd < 8 ? qg2 : kg2);
            const float o1 = x1 * cs - x2 * sn, o2 = x2 * cs + x1 * sn;
            row[hd * 128 + d1] = f_bf(o1); row[hd * 128 + d2] = f_bf(o2);
        }
    }
}

__device__ __forceinline__ void phase_attention(KA a, char* lds) {
    const int G = grd_l(); const int bx = blk_l(); const int vcu = (G % 8 == 0) ? (bx % 8) * (G / 8) + bx / 8 : bx;
    const att::bf16* QKV = (const att::bf16*)(a->ws + WS_BIG); att::bf16* AO = (att::bf16*)(a->ws + WS_ATTNO);
    for (int u = vcu; u < 1024 + 64; u += G) {
        int b, h, q0, seq;
        if (u < 1024) { const int grp = u >> 6, within = u & 63; b = grp >> 1; h = (grp & 1) * 4 + (within >> 4); q0 = CTXL + (within & 15) * 256; seq = TPB; }
        else { const int cu = u - 1024; b = cu >> 3; h = cu & 7; q0 = 0; seq = CTXL; }
        const int kvh = h >> 2; const size_t rb = (size_t)b * TPB;
        att::attn_dense_body<att::bf16>(QKV + (rb + q0) * NQKV + h * 128, QKV + rb * NQKV + 1024 + kvh * 128, QKV + rb * NQKV + 1280 + kvh * 128, AO + (rb + q0) * DM + h * 128, seq, lds);
        __syncthreads();
    }
}

namespace gla {
__device__ __forceinline__ int crow(int r, int hi) { return (r & 3) + 8 * (r >> 2) + 4 * hi; }
constexpr int QD_OFF = 0, KI_OFF = 17408, KET_OFF = 34816, VT_OFF = 53248  , SC_OFF = 90112, TS_OFF = 99328  , GSUM_OFF = 107520;
constexpr int STT_OFF = 0  , VTS_OFF = 34816  ;
constexpr size_t KET_BYTES = (size_t)2 * NB * 4 * 68 * 8192 * 2;
constexpr size_t SC_GOFF = KET_BYTES + (size_t)2 * NB * 4 * 68 * 128 * 4;
}
__device__ __forceinline__ void phase_gla_prep(KA a, int m, LAS unsigned char* lds) {
    using namespace gla;
    const int tid = tid_l(), lane = tid & 63, wave = __builtin_amdgcn_readfirstlane(tid >> 6), r32 = lane & 31, hi = lane >> 5;
    bf16_t* Gb = (bf16_t*)(a->ws + WS_BIG);
    const int d = tid & 127, tg = tid >> 7;
    LAS float* ts = (LAS float*)(lds + TS_OFF); LAS float* gsum = (LAS float*)(lds + GSUM_OFF);
    for (int item = blk_l(); item < NB * 4 * 68; item += grd_l()) {
        const int k = item % 68, h = (item / 68) & 3, b = item / 272;
        const int row0 = b * TPB + 64 * k;
        bf16_t* gp = Gb + (size_t)row0 * NGIN;
        bf16_t qn[16], kn[16];
#pragma unroll
        for (int ii = 0; ii < 16; ++ii) { qn[ii] = gp[(size_t)(16 * tg + ii) * NGIN + h * 128 + d]; kn[ii] = gp[(size_t)(16 * tg + ii) * NGIN + 512 + h * 128 + d]; }
        const u32x2 tw = *(const u32x2*)(gp + (size_t)(tid >> 3) * NGIN + 3072 + 4 * (tid & 7));
        __syncthreads();
        { const int e0 = 4 * (tid & 7), dr = e0 >> 4, r = e0 & 15; LAS float* tp = ts + dr * 1024 + (tid >> 3) * 16 + r;
          tp[0] = bf_lo(tw.x); tp[1] = bf_hi(tw.x); tp[2] = bf_lo(tw.y); tp[3] = bf_hi(tw.y); }
        __syncthreads();
        for (int dir = 0; dir < 2; ++dir) {
            float w2[16];
#pragma unroll
            for (int r = 0; r < 16; ++r) w2[r] = a->in[I_GWA2][((size_t)(m * 2 + dir) * 16 + r) * 512 + h * 128 + d];
            const float bav = a->in[I_GBA][(size_t)(m * 2 + dir) * 512 + h * 128 + d];
            float cum[16];
#pragma unroll
            for (int ii = 0; ii < 16; ++ii) { float x = bav;
#pragma unroll
                for (int r = 0; r < 16; ++r) x += ts[dir * 1024 + (16 * tg + ii) * 16 + r] * w2[r];
                cum[ii] = (fminf(x, 0.f) - __logf(1.0f + __expf(-fabsf(x)))) * (1.0f / 16.0f); }
            if (dir == 0) {
#pragma unroll
                for (int ii = 1; ii < 16; ++ii) cum[ii] += cum[ii - 1];
                gsum[tg * 128 + d] = cum[15];
            } else {
#pragma unroll
                for (int ii = 14; ii >= 0; --ii) cum[ii] += cum[ii + 1];
                gsum[tg * 128 + d] = cum[0];
            }
            __syncthreads();
            const size_t cidx = (size_t)((dir * NB + b) * 4 + h) * 68 + k;
            { const float s0 = gsum[d], s1 = gsum[128 + d], s2 = gsum[256 + d], s3 = gsum[384 + d];
              const float total = (s0 + s1) + (s2 + s3);
              float off;
              if (dir == 0) off = (tg > 0 ? s0 : 0.f) + (tg > 1 ? s1 : 0.f) + (tg > 2 ? s2 : 0.f);
              else off = (tg < 3 ? s3 : 0.f) + (tg < 2 ? s2 : 0.f) + (tg < 1 ? s1 : 0.f);
              unsigned kep[8];
              bf16_t* qdst = gp + (dir ? 512 : 0) + h * 128 + d;
#pragma unroll
              for (int ii = 0; ii < 16; ii += 2) {
                  const float c0 = cum[ii] + off, c1 = cum[ii + 1] + off;
                  const float q0 = bf_f(qn[ii]), q1 = bf_f(qn[ii + 1]), k0 = bf_f(kn[ii]), k1 = bf_f(kn[ii + 1]);
                  const int i0 = 16 * tg + ii;
                  const bf16_t qd0 = f_bf(q0 * 0.08838834764831845f * __expf(c0)), qd1 = f_bf(q1 * 0.08838834764831845f * __expf(c1));
                  *(LAS bf16_t*)(lds + QD_OFF + (i0 * 136 + d) * 2) = qd0;
                  *(LAS bf16_t*)(lds + QD_OFF + ((i0 + 1) * 136 + d) * 2) = qd1;
                  qdst[(size_t)i0 * NGIN] = qd0; qdst[(size_t)(i0 + 1) * NGIN] = qd1;
                  *(LAS bf16_t*)(lds + KI_OFF + (i0 * 136 + d) * 2) = f_bf(k0 * __expf(-c0));
                  *(LAS bf16_t*)(lds + KI_OFF + ((i0 + 1) * 136 + d) * 2) = f_bf(k1 * __expf(-c1));
                  kep[ii >> 1] = cvtpk(k0 * __expf(total - c0), k1 * __expf(total - c1));
              }
              bf16_t* ketg = (bf16_t*)a->out + cidx * 8192 + d * 64 + 16 * tg;
              *(u32x4*)ketg = (u32x4){kep[0], kep[1], kep[2], kep[3]};
              *(u32x4*)(ketg + 8) = (u32x4){kep[4], kep[5], kep[6], kep[7]};
              if (tg == 0) ((float*)((unsigned char*)a->out + KET_BYTES))[cidx * 128 + d] = __expf(total);
            }
            __syncthreads();
            if (wave < 4) {
                const int ti = (wave >> 1) & 1, tj = wave & 1;
                f32x16 acc;
#pragma unroll
                for (int r = 0; r < 16; ++r) acc[r] = 0.f;
                const int aoff = QD_OFF + ((32 * ti + r32) * 136 + 8 * hi) * 2, boff = KI_OFF + ((32 * tj + r32) * 136 + 8 * hi) * 2;
#pragma unroll
                for (int ks = 0; ks < 8; ++ks) { const bf16x8 av = *(const LAS bf16x8*)(lds + aoff + ks * 32), bv = *(const LAS bf16x8*)(lds + boff + ks * 32);
                    acc = __builtin_amdgcn_mfma_f32_32x32x16_bf16(av, bv, acc, 0, 0, 0); }
                bf16_t* scg = (bf16_t*)((unsigned char*)a->out + SC_GOFF) + cidx * 4096;
#pragma unroll
                for (int r = 0; r < 16; ++r) { const int i = 32 * ti + crow(r, hi), j = 32 * tj + r32; const bool keep = dir == 0 ? (j <= i) : (j >= i);
                    scg[i * 64 + j] = f_bf(keep ? acc[r] : 0.f); }
            }
            __syncthreads();
        }
    }
}
__device__ __forceinline__ void phase_gla_scan(KA a, int m, LAS unsigned char* lds) {
    using namespace gla;
    constexpr int O_STT = 0  , O_OST = 17408  , STG0 = 25600, STAGE = 54784, O_QD = 0, O_KET = 17408, O_SC = 35840, O_VT = 45056, O_DEC = 54272;
    const int tid = tid_l(), lane = tid & 63, wave = __builtin_amdgcn_readfirstlane(tid >> 6), r32 = lane & 31, hi = lane >> 5;
    const int G = grd_l(); const int bx = blk_l(); const int vcu = (G % 8 == 0) ? (bx % 8) * (G / 8) + bx / 8 : bx;
    const bf16_t* Gb = (const bf16_t*)(a->ws + WS_BIG);
    const int ti = (wave >> 1) & 1, tj = wave & 1, role = wave >> 2, sd = wave >> 1, sv = wave & 1;
    const int t8 = tid >> 3, p8 = tid & 7;
#define LBAR() do { asm volatile("s_waitcnt lgkmcnt(0)" ::: "memory"); __builtin_amdgcn_s_barrier(); asm volatile("" ::: "memory"); } while (0)
    for (int item = vcu; item < 256; item += G) {
        const int vs = item & 3, dir = (item >> 2) & 1, h = (item >> 3) & 3, b = item >> 5;
        bf16_t* Oo = (bf16_t*)(a->ws + (dir == 0 ? WS_U : WS_Y));
        const size_t cbase = (size_t)((dir * NB + b) * 4 + h) * 68;
        const bf16_t* ketg = (const bf16_t*)a->out + cbase * 8192;
        const bf16_t* scg = (const bf16_t*)((const unsigned char*)a->out + SC_GOFF) + cbase * 4096;
        const float* decg = (const float*)((const unsigned char*)a->out + KET_BYTES) + cbase * 128;
        const int qcol = (dir ? 512 : 0) + h * 128, vcol = 1024 + h * 256 + vs * 64, ocol = h * 256 + vs * 64;
        __syncthreads();
        for (int i = tid; i < 17408 / 4; i += NTHREADS) ((LAS unsigned*)(lds + O_STT))[i] = 0u;
        f32x16 st;
#pragma unroll
        for (int r = 0; r < 16; ++r) st[r] = 0.f;
        u32x4 rq0[2], rq1[2], rk0[2], rk1[2], rs0[2], rv0[2]; f32x4 rd0[2];
#define GLA_K(c) (dir == 0 ? (c) : ((c) < 4 ? 3 - (c) : 71 - (c)))
#define GLA_ROW(c) ((size_t)b * TPB + 64 * GLA_K(c))
#define GLA_FETCH(c, S) do { const int kk_ = GLA_K(c); const size_t row_ = GLA_ROW(c); \
            rq0[S] = *(const u32x4*)(Gb + (row_ + t8) * NGIN + qcol + 8 * p8); rq1[S] = *(const u32x4*)(Gb + (row_ + t8) * NGIN + qcol + 64 + 8 * p8); \
            rk0[S] = *(const u32x4*)(ketg + (size_t)kk_ * 8192 + tid * 8); rk1[S] = *(const u32x4*)(ketg + (size_t)kk_ * 8192 + 4096 + tid * 8); \
            rs0[S] = *(const u32x4*)(scg + (size_t)kk_ * 4096 + tid * 8); \
            rv0[S] = *(const u32x4*)(Gb + (row_ + t8) * NGIN + vcol + 8 * p8); \
            if (tid < 32) rd0[S] = *(const f32x4*)(decg + (size_t)kk_ * 128 + 4 * tid); } while (0)
#define GLA_STAGE(S, B) do { LAS unsigned char* sb_ = lds + STG0 + (B) * STAGE; \
            *(LAS u32x4*)(sb_ + O_QD + (t8 * 136 + 8 * p8) * 2) = rq0[S]; *(LAS u32x4*)(sb_ + O_QD + (t8 * 136 + 64 + 8 * p8) * 2) = rq1[S]; \
            *(LAS u32x4*)(sb_ + O_KET + (t8 * 72 + 8 * p8) * 2) = rk0[S]; *(LAS u32x4*)(sb_ + O_KET + ((64 + t8) * 72 + 8 * p8) * 2) = rk1[S]; \
            *(LAS u32x4*)(sb_ + O_SC + (t8 * 72 + 8 * p8) * 2) = rs0[S]; \
            _Pragma("unroll") for (int e = 0; e < 4; ++e) { const unsigned w_ = rv0[S][e]; \
                *(LAS bf16_t*)(sb_ + O_VT + ((8 * p8 + 2 * e) * 72 + t8) * 2) = (bf16_t)(w_ & 0xffffu); *(LAS bf16_t*)(sb_ + O_VT + ((8 * p8 + 2 * e + 1) * 72 + t8) * 2) = (bf16_t)(w_ >> 16); } \
            if (tid < 32) *(LAS f32x4*)(sb_ + O_DEC + 16 * tid) = rd0[S]; } while (0)
#define GLA_FLUSH(cprev) do { const u32x4 ov_ = *(const LAS u32x4*)(lds + O_OST + (t8 * 64 + 8 * p8) * 2); \
            *(u32x4*)(Oo + (GLA_ROW(cprev) + t8) * DM + ocol + 8 * p8) = ov_; } while (0)
#define GLA_COMPUTE(c) do { const int p_ = (c) & 1; const LAS unsigned char* sb_ = lds + STG0 + p_ * STAGE; \
            f32x16 acc; \
            if (role == 1) { \
                _Pragma("unroll") for (int r = 0; r < 16; ++r) acc[r] = 0.f; \
                { const int ao = O_QD + ((32 * ti + r32) * 136 + 8 * hi) * 2, bo = O_STT + ((32 * tj + r32) * 136 + 8 * hi) * 2; \
                  _Pragma("unroll") for (int ks = 0; ks < 8; ++ks) { const bf16x8 av = *(const LAS bf16x8*)(sb_ + ao + ks * 32), bv = *(const LAS bf16x8*)(lds + bo + ks * 32); \
                      acc = __builtin_amdgcn_mfma_f32_32x32x16_bf16(av, bv, acc, 0, 0, 0); } } \
                { const int ao = O_SC + ((32 * ti + r32) * 72 + 8 * hi) * 2, bo = O_VT + ((32 * tj + r32) * 72 + 8 * hi) * 2; \
                  _Pragma("unroll") for (int ks = 0; ks < 4; ++ks) { const bf16x8 av = *(const LAS bf16x8*)(sb_ + ao + ks * 32), bv = *(const LAS bf16x8*)(sb_ + bo + ks * 32); \
                      acc = __builtin_amdgcn_mfma_f32_32x32x16_bf16(av, bv, acc, 0, 0, 0); } } } \
            { const LAS float* dcp = (const LAS float*)(sb_ + O_DEC) + 32 * sd + 4 * hi; \
              _Pragma("unroll") for (int r4 = 0; r4 < 4; ++r4) { const f32x4 dq = *(const LAS f32x4*)(dcp + 8 * r4); st[4 * r4] *= dq[0]; st[4 * r4 + 1] *= dq[1]; st[4 * r4 + 2] *= dq[2]; st[4 * r4 + 3] *= dq[3]; } \
              const int ao = O_KET + ((32 * sd + r32) * 72 + 8 * hi) * 2, bo = O_VT + ((32 * sv + r32) * 72 + 8 * hi) * 2; \
              _Pragma("unroll") for (int ks = 0; ks < 4; ++ks) { const bf16x8 av = *(const LAS bf16x8*)(sb_ + ao + ks * 32), bv = *(const LAS bf16x8*)(sb_ + bo + ks * 32); \
                  st = __builtin_amdgcn_mfma_f32_32x32x16_bf16(av, bv, st, 0, 0, 0); } } \
            LBAR();                                                  \
            if (role == 1) { _Pragma("unroll") for (int r = 0; r < 16; ++r) *(LAS bf16_t*)(lds + O_OST + ((32 * ti + crow(r, hi)) * 64 + 32 * tj + r32) * 2) = f_bf(acc[r]); } \
            { _Pragma("unroll") for (int r4 = 0; r4 < 4; ++r4) { u32x2 w; w.x = cvtpk(st[4 * r4], st[4 * r4 + 1]); w.y = cvtpk(st[4 * r4 + 2], st[4 * r4 + 3]); \
                  *(LAS u32x2*)(lds + O_STT + ((32 * sv + r32) * 136 + 32 * sd + 8 * r4 + 4 * hi) * 2) = w; } } } while (0)
        GLA_FETCH(0, 0); GLA_STAGE(0, 0); GLA_FETCH(1, 1); GLA_FETCH(2, 0);
        for (int c = 0; c < 68; c += 2) {
            LBAR();
            if (c > 0) GLA_FLUSH(c - 1);
            GLA_STAGE(1, 1); if (c + 3 < 68) GLA_FETCH(c + 3, 1);
            GLA_COMPUTE(c);
            LBAR();
            GLA_FLUSH(c);
            if (c + 2 < 68) { GLA_STAGE(0, 0); if (c + 4 < 68) GLA_FETCH(c + 4, 0); }
            GLA_COMPUTE(c + 1);
        }
        LBAR();
        GLA_FLUSH(67);
#undef GLA_K
#undef GLA_ROW
#undef GLA_FETCH
#undef GLA_STAGE
#undef GLA_FLUSH
#undef GLA_COMPUTE
    }
#undef LBAR
}

__device__ __forceinline__ void phase_gla_readout(KA a, int m, bool skip_ctx) {
    const int tid = tid_l(), lane = tid & 63, wave = tid >> 6;
    const int gw = blk_l() * 8 + wave, NGW = grd_l() * 8;
    const bf16_t* OF = (const bf16_t*)(a->ws + WS_U); const bf16_t* OB = (const bf16_t*)(a->ws + WS_Y); bf16_t* Gb = (bf16_t*)(a->ws + WS_BIG);
    const float* og = a->in[I_GOG] + (size_t)m * 1024;
    for (int r = gw; r < MT; r += NGW) {
        if (skip_ctx && (r % TPB) < CTXL) continue;
#pragma unroll
        for (int q = 0; q < 4; ++q) {
            const int col = 4 * lane + 256 * q;
            const u32x2 wf = *(const u32x2*)(OF + (size_t)r * DM + col), wb = *(const u32x2*)(OB + (size_t)r * DM + col), wr = *(const u32x2*)(Gb + (size_t)r * NGIN + 2048 + col);
            f32x4 s = (f32x4){bf_lo(wf.x) + bf_lo(wb.x), bf_hi(wf.x) + bf_hi(wb.x), bf_lo(wf.y) + bf_lo(wb.y), bf_hi(wf.y) + bf_hi(wb.y)};
            const float ss = wave_sum((s.x * s.x + s.y * s.y) + (s.z * s.z + s.w * s.w));
            const float rstd = 1.0f / sqrtf(ss * (1.0f / 256.0f) + EPS);
            const f32x4 gg = *(const f32x4*)(og + col);
            const f32x4 rr = (f32x4){bf_lo(wr.x), bf_hi(wr.x), bf_lo(wr.y), bf_hi(wr.y)};
            f32x4 o = s * rstd * gg; o.x *= silu(rr.x); o.y *= silu(rr.y); o.z *= silu(rr.z); o.w *= silu(rr.w);
            u32x2 w; w.x = cvtpk(o.x, o.y); w.y = cvtpk(o.z, o.w);
            *(u32x2*)(Gb + (size_t)r * NGIN + 2048 + col) = w;
        }
    }
}

__device__ __forceinline__ unsigned long long rt() { return __builtin_amdgcn_s_memrealtime(); }
#define XB_TMO      128
#define XB_XCNT(j)  (256  + 64 * (j))
#define XB_XSUB(j)  (1280 + 64 * (j))
#define XB_XGEN(j)  (2304 + 64 * (j))
#define XB_TOP      3328
#define XB_TOPGEN   3392
#define XCD_BAR_WORDS 3456
#define XB_SPIN_CAP (1u << 18)

__device__ __forceinline__ unsigned xb_ld(unsigned* p)              { return __hip_atomic_load(p, __ATOMIC_RELAXED, __HIP_MEMORY_SCOPE_AGENT); }
__device__ __forceinline__ unsigned xb_add(unsigned* p, unsigned v) { return __hip_atomic_fetch_add(p, v, __ATOMIC_RELAXED, __HIP_MEMORY_SCOPE_AGENT); }
__device__ __forceinline__ unsigned xb_xcc_id() { return (unsigned)__builtin_amdgcn_s_getreg((3 << 11) | 20) & 0xFu; }
#define XB_SPIN(cond, bar) do { unsigned _sp = 0; while (cond) { __builtin_amdgcn_s_sleep(1); \
    if ((++_sp & 255u) == 0u) { if (xb_ld(&(bar)[XB_TMO])) break; if (_sp > XB_SPIN_CAP) { atomicAdd(&(bar)[XB_TMO], 1u); break; } } } } while (0)

struct XcdBarrier {
    unsigned* bar; unsigned x;
    volatile LAS unsigned* st;
};

__device__ __forceinline__ XcdBarrier xcd_barrier_post(unsigned* bar, volatile LAS unsigned* st) {
    XcdBarrier b; b.bar = bar; b.x = xb_xcc_id(); b.st = st;
    if (threadIdx.x == 0) (void)xb_add(&bar[XB_XCNT(b.x)], 1u);
    return b;
}
__device__ __forceinline__ void xcd_barrier_complete(unsigned* bar, unsigned x, unsigned& nloc, unsigned& nx) {
    const unsigned G = gridDim.x * gridDim.y * gridDim.z;
    unsigned sum, cnt, mine, sp = 0u;
    for (;;) {
        sum = 0u; cnt = 0u; mine = 0u;
#pragma unroll
        for (unsigned j = 0; j < 16; ++j) { const unsigned c = xb_ld(&bar[XB_XCNT(j)]); sum += c; cnt += (c > 0u) ? 1u : 0u; mine = (j == x) ? c : mine; }
        if (sum == G) break;
        __builtin_amdgcn_s_sleep(1);
        if ((++sp & 255u) == 0u) { if (xb_ld(&bar[XB_TMO])) break; if (sp > XB_SPIN_CAP) { atomicAdd(&bar[XB_TMO], 1u); break; } }
    }
    nloc = mine > 0u ? mine : 1u; nx = cnt > 0u ? cnt : 1u;
}

__device__ __forceinline__ void xcd_barrier(const XcdBarrier& b) {
    asm volatile("s_waitcnt vmcnt(0)" ::: "memory");
    __syncthreads();
    if (threadIdx.x == 0) {
        unsigned* bar = b.bar;
        __builtin_amdgcn_s_waitcnt(0);
        unsigned nloc = b.st[0], nx = b.st[1];
        if (nloc == 0u) { xcd_barrier_complete(bar, b.x, nloc, nx); b.st[0] = nloc; b.st[1] = nx; }
        const unsigned old = xb_add(&bar[XB_XSUB(b.x)], 1u);
        const unsigned gen = old / nloc;
        if (old + 1u == (gen + 1u) * nloc) {
            __builtin_amdgcn_fence(__ATOMIC_RELEASE, "agent");
            asm volatile("s_waitcnt vmcnt(0)" ::: "memory");
            const unsigned og = xb_add(&bar[XB_TOP], 1u);
            const unsigned tg = og / nx;
            if (og + 1u == (tg + 1u) * nx) xb_add(&bar[XB_TOPGEN], 1u);
            else XB_SPIN(xb_ld(&bar[XB_TOPGEN]) == tg, bar);
            __builtin_amdgcn_fence(__ATOMIC_ACQUIRE, "agent");
            xb_add(&bar[XB_XGEN(b.x)], 1u);
            asm volatile("s_waitcnt vmcnt(0)" ::: "memory");
        } else {
            XB_SPIN(xb_ld(&bar[XB_XGEN(b.x)]) == gen, bar);
            __builtin_amdgcn_fence(__ATOMIC_ACQUIRE, "agent");
            asm volatile("s_waitcnt vmcnt(0)" ::: "memory");
        }
    }
    __syncthreads();
}

constexpr size_t WS_BAR = 4096;
constexpr size_t WS_XCNT = 65536;
constexpr size_t WS_XBUF = WS_HRES + 68 * MiB;
constexpr size_t WS_DFLOW = 32768;
constexpr int LDS_BARW = LDS_BYTES - 64;
#define GSYNC() do { XcdBarrier b_; b_.bar = (unsigned*)(kargs()->ws + WS_BAR); b_.x = xb_xcc_id(); b_.st = (volatile LAS unsigned*)(lds + LDS_BARW); xcd_barrier(b_); } while (0)
struct EpiRow {
    static constexpr bool PERM = true, AFTER_DRAIN = false;
    int sl; LAS unsigned char* xl;
    __device__ __forceinline__ void operator()(f32x4 (&acc)[2][2][4][2], const pg8::Unit& u, int wr, int wc, int fr, int fq) const {
        KA a_ = kargs(); unsigned char* ws = a_->ws;
        const int L = sl / 3, jpost = sl - 3 * L; const bool lastsl = sl == 3 * DEPTH - 1;
        const int Ln = (jpost == 2) ? L + 1 : L, jn = (jpost == 2) ? 0 : jpost + 1, jpre = lastsl ? -1 : jn, final_out = lastsl ? 1 : 0;
        const float gs = jpost == 1 ? 1.0f : 0.5f;
        bf16_t* hres = (bf16_t*)(ws + WS_HRES); bf16_t* U = (bf16_t*)(ws + WS_U); float* out = a_->out;
        const float* modL_post = (const float*)(ws + WS_MOD) + (size_t)L * 9 * 9216; const float* modL_pre = (const float*)(ws + WS_MOD) + (size_t)(lastsl ? L : Ln) * 9 * 9216;
        const float* gpost = a_->in[I_NPOST] + (size_t)(L * 3 + jpost) * DM; const float* gpre = a_->in[I_NPRE] + (size_t)((lastsl ? L : Ln) * 3 + (lastsl ? 0 : jn)) * DM;
        unsigned* cn1 = (unsigned*)(ws + WS_XCNT) + (size_t)(sl * 2) * 136 * 64; unsigned* cn2 = cn1 + 136 * 64;
        float* xb1 = (float*)(ws + WS_XBUF); float* xb2 = (float*)(ws + WS_XBUF + MiB);
        const int tid = threadIdx.x, wid = __builtin_amdgcn_readfirstlane(tid >> 6), lane = tid & 63;
        const int bidx = u.pm / 17, isctx = (u.pm - 17 * bidx) == 0, mi = isctx ? 8 : bidx;
        const int col0 = u.pn * 256 + wc * 32 + 8 * fq, row0 = u.pm * 256 + wr * 64 + fr, rl0 = wr * 64 + fr;
        const LAS float* S = (const LAS float*)(xl + 4096);
        const float* gate = modL_post + (size_t)mi * 9216 + (3 * jpost + 2) * 1024 + col0;
        f32x4 gt[2][2], gp[2][2];
#pragma unroll
        for (int bj = 0; bj < 2; ++bj)
#pragma unroll
            for (int n = 0; n < 2; ++n) { gt[bj][n] = *(const f32x4*)(gate + bj * 128 + 4 * n) * gs; gp[bj][n] = *(const f32x4*)(gpost + col0 + bj * 128 + 4 * n); gt[bj][n] = gt[bj][n] * gp[bj][n]; }
        u32x4 hpre[1][4][2];
#pragma unroll
        for (int ai = 0; ai < 1; ++ai)
#pragma unroll
            for (int m = 0; m < 4; ++m)
#pragma unroll
                for (int bj = 0; bj < 2; ++bj) hpre[ai][m][bj] = *(const u32x4*)(hres + (size_t)(row0 + ai * 128 + m * 16) * 1024 + col0 + bj * 128);
        pg8::rowstats_run(xb1, cn1, acc, u, wr, wc, fr, fq, xl, wid, lane);
        {
#pragma unroll
            for (int ai = 0; ai < 2; ++ai)
#pragma unroll
                for (int m = 0; m < 4; ++m) {
                    const int rl = rl0 + ai * 128 + m * 16; const size_t roff = (size_t)(row0 + ai * 128 + m * 16) * 1024 + col0;
                    const float rstd = 1.0f / sqrtf(S[rl] * (1.0f / 1024.0f) + 1e-6f);
#pragma unroll
                    for (int bj = 0; bj < 2; ++bj) {
                        const u32x4 hw = ai == 0 ? hpre[0][m][bj] : *(const u32x4*)(hres + roff + bj * 128);
                        const f32x4 h0 = {__uint_as_float(hw.x << 16), __uint_as_float(hw.x & 0xffff0000u), __uint_as_float(hw.y << 16), __uint_as_float(hw.y & 0xffff0000u)};
                        const f32x4 h1 = {__uint_as_float(hw.z << 16), __uint_as_float(hw.z & 0xffff0000u), __uint_as_float(hw.w << 16), __uint_as_float(hw.w & 0xffff0000u)};
                        const f32x4 n0 = h0 + gt[bj][0] * (acc[ai][bj][m][0] * rstd), n1 = h1 + gt[bj][1] * (acc[ai][bj][m][1] * rstd);
                        acc[ai][bj][m][0] = n0; acc[ai][bj][m][1] = n1;
                        if (final_out) { float* op = out + (size_t)(bidx * 4096 + (u.pm - 17 * bidx - 1) * 256 + wr * 64 + fr + ai * 128 + m * 16) * 1024 + col0 + bj * 128; *(f32x4*)op = n0; *(f32x4*)(op + 4) = n1; }
                        else { u32x4 w; w.x = cvtpk(n0[0], n0[1]); w.y = cvtpk(n0[2], n0[3]); w.z = cvtpk(n1[0], n1[1]); w.w = cvtpk(n1[2], n1[3]); *(u32x4*)(hres + roff + bj * 128) = w; }
                    }
                }
        }
        if (jpre < 0) return;
        const float* mb = modL_pre + (size_t)mi * 9216 + (3 * jpre) * 1024 + col0;
        f32x4 sh[2][2], sc[2][2];
#pragma unroll
        for (int bj = 0; bj < 2; ++bj)
#pragma unroll
            for (int n = 0; n < 2; ++n) { sh[bj][n] = *(const f32x4*)(mb + bj * 128 + 4 * n); sc[bj][n] = (1.0f + *(const f32x4*)(mb + 1024 + bj * 128 + 4 * n)) * *(const f32x4*)(gpre + col0 + bj * 128 + 4 * n); }
        pg8::rowstats_run(xb2, cn2, acc, u, wr, wc, fr, fq, xl, wid, lane);
        {
#pragma unroll
            for (int ai = 0; ai < 2; ++ai)
#pragma unroll
                for (int m = 0; m < 4; ++m) {
                    const int rl = rl0 + ai * 128 + m * 16; const size_t roff = (size_t)(row0 + ai * 128 + m * 16) * 1024 + col0;
                    const float rstd = 1.0f / sqrtf(S[rl] * (1.0f / 1024.0f) + 1e-6f);
#pragma unroll
                    for (int bj = 0; bj < 2; ++bj) {
                        const f32x4 u0 = acc[ai][bj][m][0] * rstd * sc[bj][0] + sh[bj][0], u1 = acc[ai][bj][m][1] * rstd * sc[bj][1] + sh[bj][1];
                        u32x4 w; w.x = cvtpk(u0[0], u0[1]); w.y = cvtpk(u0[2], u0[3]); w.z = cvtpk(u1[0], u1[1]); w.w = cvtpk(u1[2], u1[3]);
                        *(u32x4*)(U + roff + bj * 128) = w;
                    }
                }
        }
    }
};

struct EpiQKV {
    static constexpr bool PERM = true, AFTER_DRAIN = false;
    int m; LAS unsigned char* xl;
    __device__ __forceinline__ void operator()(f32x4 (&acc)[2][2][4][2], const pg8::Unit& u, int wr, int wc, int fr, int fq) const {
        KA a_ = kargs(); bf16_t* O = (bf16_t*)(a_->ws + WS_BIG);
        const int row0 = u.pm * 256 + wr * 64 + fr, col0 = u.pn * 256 + wc * 32 + 8 * fq;
        if (u.pn < 5) {
            LAS float* P = (LAS float*)xl;
#pragma unroll
            for (int ai = 0; ai < 2; ++ai)
#pragma unroll
                for (int m4 = 0; m4 < 4; ++m4)
#pragma unroll
                    for (int bj = 0; bj < 2; ++bj) {
                        const f32x4 a0 = acc[ai][bj][m4][0], a1 = acc[ai][bj][m4][1];
                        float s = ((a0[0] * a0[0] + a0[1] * a0[1]) + (a0[2] * a0[2] + a0[3] * a0[3])) + ((a1[0] * a1[0] + a1[1] * a1[1]) + (a1[2] * a1[2] + a1[3] * a1[3]));
                        s += __shfl_xor(s, 16); s += __shfl_xor(s, 32);
                        if (fq == 0) P[((ai * 128 + wr * 64 + m4 * 16 + fr) * 2 + bj) * 4 + wc] = s;
                    }
            asm volatile("s_waitcnt lgkmcnt(0)" ::: "memory"); __builtin_amdgcn_s_barrier(); asm volatile("" ::: "memory");
            const float* gain = a_->in[u.pn < 4 ? I_AQG : I_AKG] + m * 128;
            const int xi0 = wc * 16 + fq * 4, x0 = xi0 < 32 ? xi0 : xi0 + 32;
            const f32x4 g0 = *(const f32x4*)(gain + x0), g1 = *(const f32x4*)(gain + x0 + 32);
            const int fi0 = (wc & 1) * 16 + fq * 4;
            f32x4 inv;
#pragma unroll
            for (int e = 0; e < 4; ++e) inv[e] = exp2f(-(float)(fi0 + e) * (13.287712379549449f / 32.0f)) * 0.15915494309189535f;
            const int bidx = u.pm / 17, ptile = u.pm - 17 * bidx; const bool isctx = ptile == 0;
#pragma unroll
            for (int ai = 0; ai < 2; ++ai)
#pragma unroll
                for (int m4 = 0; m4 < 4; ++m4) {
                    const int rl = ai * 128 + wr * 64 + m4 * 16 + fr;
                    f32x4 cs = {1.f, 1.f, 1.f, 1.f}, sn = {0.f, 0.f, 0.f, 0.f};
                    if (!isctx) { const int t = (ptile - 1) * 256 + rl; const float p = (float)(wc < 2 ? (t >> 6) : (t & 63));
#pragma unroll
                        for (int e = 0; e < 4; ++e) { const float rev = p * inv[e]; sn[e] = __builtin_amdgcn_sinf(rev); cs[e] = __builtin_amdgcn_cosf(rev); } }
#pragma unroll
                    for (int bj = 0; bj < 2; ++bj) {
                        const LAS float* pp = P + (rl * 2 + bj) * 4;
                        const float rstd = 1.0f / sqrtf(((pp[0] + pp[1]) + (pp[2] + pp[3])) * (1.0f / 128.0f) + EPS);
                        const f32x4 x1 = acc[ai][bj][m4][0] * rstd * g0, x2 = acc[ai][bj][m4][1] * rstd * g1;
                        const f32x4 o1 = x1 * cs - x2 * sn, o2 = x2 * cs + x1 * sn;
                        u32x4 w; w.x = cvtpk(o1[0], o1[1]); w.y = cvtpk(o1[2], o1[3]); w.z = cvtpk(o2[0], o2[1]); w.w = cvtpk(o2[2], o2[3]);
                        *(u32x4*)(O + (size_t)(row0 + ai * 128 + m4 * 16) * NQKV + col0 + bj * 128) = w;
                    }
                }
        } else {
#pragma unroll
            for (int ai = 0; ai < 2; ++ai)
#pragma unroll
                for (int m4 = 0; m4 < 4; ++m4)
#pragma unroll
                    for (int bj = 0; bj < 2; ++bj) { const f32x4 v0 = acc[ai][bj][m4][0], v1 = acc[ai][bj][m4][1];
                        u32x4 w; w.x = cvtpk(v0[0], v0[1]); w.y = cvtpk(v0[2], v0[3]); w.z = cvtpk(v1[0], v1[1]); w.w = cvtpk(v1[2], v1[3]);
                        *(u32x4*)(O + (size_t)(row0 + ai * 128 + m4 * 16) * NQKV + col0 + bj * 128) = w; }
        }
    }
};

__device__ __forceinline__ void ctx_rows(KA a, int sl) {
    const int tid = tid_l(), lane = tid & 63, wave = tid >> 6;
    const int L = sl / 3, jpost = sl - 3 * L, Ln = (jpost == 2) ? L + 1 : L, jpre = (jpost == 2) ? 0 : jpost + 1;
    const float gs = jpost == 1 ? 1.0f : 0.5f;
    bf16_t* hres = (bf16_t*)(a->ws + WS_HRES); bf16_t* U = (bf16_t*)(a->ws + WS_U);
    const float* gate = (const float*)(a->ws + WS_MOD) + (size_t)(L * 9 + 8) * 9216 + (3 * jpost + 2) * 1024; const float* mb = (const float*)(a->ws + WS_MOD) + (size_t)(Ln * 9 + 8) * 9216 + (3 * jpre) * 1024;
    const float* gpost = a->in[I_NPOST] + (size_t)(L * 3 + jpost) * DM; const float* gpre = a->in[I_NPRE] + (size_t)(Ln * 3 + jpre) * DM;
    const float* P0 = (const float*)((const unsigned char*)a->out + WS_PART_IN_OUT);
    for (int cr = blk_l() * 8 + wave; cr < NB * CTXL; cr += grd_l() * 8) {
        const size_t r = (size_t)(cr >> 8) * TPB + (cr & 255);
        f32x4 h[4], y[4]; float ss = 0.f;
#pragma unroll
        for (int q = 0; q < 4; ++q) { const float* p = P0 + (size_t)cr * DM + 4 * lane + 256 * q; y[q] = *(const f32x4*)p + *(const f32x4*)(p + (size_t)2048 * DM);
            const u32x2 w = *(const u32x2*)(hres + r * DM + 4 * lane + 256 * q); h[q] = (f32x4){bf_lo(w.x), bf_hi(w.x), bf_lo(w.y), bf_hi(w.y)};
            ss += (y[q].x * y[q].x + y[q].y * y[q].y) + (y[q].z * y[q].z + y[q].w * y[q].w); }
        const float ry = 1.0f / sqrtf(wave_sum(ss) * (1.0f / DM) + EPS);
        float s2 = 0.f;
#pragma unroll
        for (int q = 0; q < 4; ++q) { const f32x4 gt = *(const f32x4*)(gate + 4 * lane + 256 * q), gg = *(const f32x4*)(gpost + 4 * lane + 256 * q);
            h[q] += (gt * gs * gg) * (y[q] * ry);
            u32x2 w; w.x = cvtpk(h[q].x, h[q].y); w.y = cvtpk(h[q].z, h[q].w); *(u32x2*)(hres + r * DM + 4 * lane + 256 * q) = w;
            s2 += (h[q].x * h[q].x + h[q].y * h[q].y) + (h[q].z * h[q].z + h[q].w * h[q].w); }
        const float rh = 1.0f / sqrtf(wave_sum(s2) * (1.0f / DM) + EPS);
#pragma unroll
        for (int q = 0; q < 4; ++q) { const f32x4 sh = *(const f32x4*)(mb + 4 * lane + 256 * q), sc = *(const f32x4*)(mb + 1024 + 4 * lane + 256 * q), gg = *(const f32x4*)(gpre + 4 * lane + 256 * q);
            const f32x4 u = h[q] * rh * (gg * (1.0f + sc)) + sh;
            u32x2 w; w.x = cvtpk(u.x, u.y); w.y = cvtpk(u.z, u.w); *(u32x2*)(U + r * DM + 4 * lane + 256 * q) = w; }
    }
}

__global__ void __launch_bounds__(NTHREADS, 2) fwd_megakernel(Args unused_args) {
    extern __shared__ __attribute__((aligned(16))) unsigned char lds_raw[];
    LAS unsigned char* lds = (LAS unsigned char*)lds_raw;
    cg::grid_group grid = cg::this_grid();
    if (threadIdx.x < 16) ((LAS unsigned*)(lds + LDS_BARW))[threadIdx.x] = 0u;
    __syncthreads();
    (void)xcd_barrier_post((unsigned*)(kargs()->ws + WS_BAR), (volatile LAS unsigned*)(lds + LDS_BARW));

#ifndef SKIP_MOD
    phase_mod(kargs(), lds);
#endif
    convert_layer(kargs(), lds, 0, 0);
    grid.sync();
    row_pass<true>(kargs(), RowP{0, -1, 0.f, 0, 0, false});
    GSYNC();

    for (int sl = 0; sl < 3 * DEPTH; ++sl) {
        const int L = sl / 3, j = sl - 3 * L, m = L >> 1;
        if (j != 1) {
            unsigned char* ws = kargs()->ws; const int f = j >> 1;
            pg8::Gemm g1{(const bf16_t*)(ws + WS_U), (const bf16_t*)(ws + WS_W1T) + (size_t)(L * 2 + f) * 5632 * 1024, MT, 2 * DFF, DM, DM, DM};
            pg8::StaticOrder S; S.init(MT, 2 * DFF, DM, grd_l(), blk_l(), sl == 3 * DEPTH - 1 ? 2 : 0);
            pg8::EpiSwiglu E{(bf16_t*)(ws + WS_BIG), DFF};
#ifndef SKIP_G1
            pg8::gemm_phase<pg8::EpiSwiglu, pg8::StaticOrder, true, true>(lds, g1, S, E);
#endif
            GSYNC();
        } else {
            const bool attn = (L & 1) == 0;
            { unsigned char* ws = kargs()->ws;
              pg8::Gemm g1{(const bf16_t*)(ws + WS_U), attn ? (const bf16_t*)(ws + WS_WQKVT) + (size_t)m * NQKV * 1024 : (const bf16_t*)(ws + WS_WGINT) + (size_t)m * NGIN * 1024, MT, attn ? NQKV : NGIN, DM, DM, DM};
              pg8::StaticOrder S; S.init(MT, g1.N, DM, grd_l(), blk_l(), 0);
              pg8::EpiBf16s E{(bf16_t*)(ws + WS_BIG), g1.N, nullptr};
              if (attn) { EpiQKV EQ{m, lds + 131072}; pg8::gemm_phase<EpiQKV, pg8::StaticOrder, true, true>(lds, g1, S, EQ); }
              else pg8::gemm_phase<pg8::EpiBf16s, pg8::StaticOrder, true, true>(lds, g1, S, E);
 }
            GSYNC();
            if (attn) {
#ifndef SKIP_ATT
                phase_attention(kargs(), (char*)lds_raw);
#endif
                GSYNC();
            } else {
                phase_gla_prep(kargs(), m, lds);
                GSYNC();
                phase_gla_scan(kargs(), m, lds);
                GSYNC();
#ifndef SKIP_RO
                phase_gla_readout(kargs(), m, sl >= 10);
#endif
                GSYNC();
            }
        }
        {
            unsigned char* ws = kargs()->ws;
            pg8::Gemm g2;
            if (j != 1) g2 = pg8::Gemm{(const bf16_t*)(ws + WS_BIG), (const bf16_t*)(ws + WS_W2T) + (size_t)(L * 2 + (j >> 1)) * 1024 * 2816, MT, DM, DFF, DFF, DFF};
            else if ((L & 1) == 0) g2 = pg8::Gemm{(const bf16_t*)(ws + WS_ATTNO), (const bf16_t*)(ws + WS_WOAT) + (size_t)m * 1024 * 1024, MT, DM, DM, DM, DM};
            else g2 = pg8::Gemm{(const bf16_t*)(ws + WS_BIG) + 2048, (const bf16_t*)(ws + WS_WGOT) + (size_t)m * 1024 * 1024, MT, DM, DM, NGIN, DM};
            pg8::StaticOrder S; S.init(MT, DM, g2.K, grd_l(), blk_l(), 2);
            EpiRow E{sl, lds + 131072};
#ifndef SKIP_G2
            pg8::gemm_phase<EpiRow, pg8::StaticOrder, true, true>(lds, g2, S, E);
#endif
            if (sl < 10) {
                pg8::StaticOrder S4; S4.init(MT, DM, g2.K, grd_l(), blk_l(), 4);
                pg8::EpiBf16s E4{nullptr, DM, (float*)((unsigned char*)kargs()->out + WS_PART_IN_OUT)};
                pg8::gemm_phase<pg8::EpiBf16s, pg8::StaticOrder, true, true>(lds, g2, S4, E4);
            }
            if (j == 0 && L + 1 < DEPTH && blk_l() >= 64) convert_layer(kargs(), lds, L + 1, 64);
        }
        if (sl < 10) { GSYNC(); ctx_rows(kargs(), sl); }
        const bool last = sl == 3 * DEPTH - 1;
        if (!last) GSYNC();
    }
}

extern "C" void kernel_launch(void* const* d_in, const int* in_sizes, int n_in, void* d_out, int out_size, void* d_ws, size_t ws_size, hipStream_t stream) {
    static int grid = 0;
    if (grid == 0) {
        if (n_in != 20 || out_size != NB * SEQ * DM || ws_size < WS_END) { fprintf(stderr, "kernel_launch: unexpected shapes: n_in %d out %d ws %zu (need %zu)\n", n_in, out_size, ws_size, (size_t)WS_END); grid = -1; return; }
        int dev = 0, cus = 0, per_cu = 0;
        (void)hipGetDevice(&dev);
        (void)hipDeviceGetAttribute(&cus, hipDeviceAttributeMultiprocessorCount, dev);
        (void)hipFuncSetAttribute((const void*)fwd_megakernel, hipFuncAttributeMaxDynamicSharedMemorySize, LDS_BYTES);
        (void)hipOccupancyMaxActiveBlocksPerMultiprocessor(&per_cu, (const void*)fwd_megakernel, NTHREADS, LDS_BYTES);
        if (per_cu < 1) per_cu = 1;
        grid = cus * per_cu;
        if (grid > 256) grid = 256;
        if (grid < 256) { fprintf(stderr, "kernel_launch: %d co-resident workgroups < 256: this build needs 256; nothing launched\n", grid); grid = -1; return; }
        fprintf(stderr, "kernel_launch: grid %d (cus %d x %d), ws %zu\n", grid, cus, per_cu, ws_size);
    }
    if (grid < 0) return;
    (void)hipMemsetAsync(d_ws, 0, 1 * MiB, stream);
    Args a{};
    for (int i = 0; i < 20; ++i) a.in[i] = (const float*)d_in[i];
    a.out = (float*)d_out; a.ws = (unsigned char*)d_ws;
    void* args[] = {&a};
    hipError_t e = hipLaunchCooperativeKernel((const void*)fwd_megakernel, dim3(grid), dim3(NTHREADS), args, LDS_BYTES, stream);
    if (e != hipSuccess) fprintf(stderr, "kernel_launch: cooperative launch failed: %s (grid %d)\n", hipGetErrorString(e), grid);
}
```
